# Optimizing an MI355X kernel written in HIP

```python
import math
import jax, jax.numpy as jnp
from jax import lax
import numpy as np

D_MODEL = 1024
BATCH = 8
SEQ = 8192
DEPTH = 4
DEC_BATCH = 4
DEC_SEQ = 4096
PAST_LEN = 128

D_GROUP = 512
N_MIXERS = 3
D_MIX = N_MIXERS * D_GROUP
D_FF = 2816
EPS = 1e-6
CONV_W = 4
CONV_LEFT = CONV_W // 2
CONV_RIGHT = CONV_W - 1 - CONV_LEFT
LRU_BLOCKS = 8
LRU_BLOCK = D_GROUP // LRU_BLOCKS
LRU_C = 8.0
SSD_HEADS = 8
SSD_HEAD_DIM = D_GROUP // SSD_HEADS
SSD_STATE = 64
SSD_GROUPS = 2
SSD_HPG = SSD_HEADS // SSD_GROUPS
SSD_CHUNK = 128
SSD_XBC = D_GROUP + 2 * SSD_GROUPS * SSD_STATE
RET_HEADS = 4
RET_HEAD_DIM = D_GROUP // RET_HEADS
RET_CHUNK = 128
ROPE_BASE = 10000.0
PROJ_SIZES = (D_GROUP, D_GROUP, D_GROUP, SSD_XBC, 2 * SSD_HEADS, D_GROUP, D_GROUP, D_GROUP, D_GROUP)
D_PROJ = 7 * D_GROUP + SSD_XBC + 2 * SSD_HEADS

kernel_name = 'hybrid_bidir_rglru_ssd_retention_encoder'


def _rmsnorm(x, w):
    xf = x.astype(jnp.float32)
    xf = xf * lax.rsqrt(jnp.mean(xf * xf, axis=-1, keepdims=True) + EPS)
    return (xf * w.astype(jnp.float32)).astype(x.dtype)


def _swiglu(x, w_gu, w_down):
    g, u = jnp.split(x @ w_gu, 2, axis=-1)
    return (jax.nn.silu(g) * u) @ w_down


def _centred_dwconv(x, w, b):
    s = x.shape[1]
    xp = jnp.pad(x, ((0, 0), (CONV_LEFT, CONV_RIGHT), (0, 0)))
    out = b
    for tap in range(CONV_W):
        out = out + xp[:, tap:tap + s] * w[tap]
    return out


def _linear_scan(a, b, reverse):
    def combine(e1, e2):
        a1, b1 = e1
        a2, b2 = e2
        return a1 * a2, a2 * b1 + b2
    return lax.associative_scan(combine, (a, b), reverse=reverse, axis=1)[1]


def _rglru_group(xb, gate, conv_w, conv_b, w_a, b_a, w_i, b_i, lam):
    f32 = jnp.float32
    bsz, s, _ = xb.shape
    xc = _centred_dwconv(xb, conv_w, conv_b).astype(f32)
    xblk = xc.reshape(bsz, s, LRU_BLOCKS, LRU_BLOCK)
    h_sum = jnp.zeros_like(xc)
    for d, rev in ((0, False), (1, True)):
        r = jax.nn.sigmoid(jnp.einsum('bsni,nij->bsnj', xblk, w_a[d].astype(f32)).reshape(bsz, s, D_GROUP) + b_a[d].astype(f32))
        i = jax.nn.sigmoid(jnp.einsum('bsni,nij->bsnj', xblk, w_i[d].astype(f32)).reshape(bsz, s, D_GROUP) + b_i[d].astype(f32))
        log_a = -LRU_C * r * jax.nn.softplus(-lam[d].astype(f32))
        u = jnp.sqrt(-jnp.expm1(2.0 * log_a)) * (i * xc)
        h_sum = h_sum + _linear_scan(jnp.exp(log_a), u, rev)
    return h_sum * jax.nn.gelu(gate.astype(f32))


def _ssd_chunked(x, dt, a, bm, cm):
    bsz, s, h, p = x.shape
    L = SSD_CHUNK
    nc = s // L
    x = x.reshape(bsz, nc, L, SSD_GROUPS, SSD_HPG, p)
    dt = dt.reshape(bsz, nc, L, SSD_GROUPS, SSD_HPG)
    bm = bm.reshape(bsz, nc, L, SSD_GROUPS, SSD_STATE)
    cm = cm.reshape(bsz, nc, L, SSD_GROUPS, SSD_STATE)
    acum = jnp.cumsum(dt * a.reshape(SSD_GROUPS, SSD_HPG), axis=2)
    acum_t = jnp.moveaxis(acum, 2, -1)
    dt_t = jnp.moveaxis(dt, 2, -1)
    tril = jnp.tril(jnp.ones((L, L), dtype=bool))
    seg = acum_t[..., :, None] - acum_t[..., None, :]
    decay = jnp.exp(jnp.where(tril, seg, -jnp.inf))
    cb = jnp.einsum('bcign,bcjgn->bcgij', cm, bm)
    w = cb[:, :, :, None] * decay * dt_t[..., None, :]
    y_diag = jnp.einsum('bcgkij,bcjgkp->bcigkp', w, x)
    decay_states = jnp.exp(acum_t[..., -1:] - acum_t) * dt_t
    states = jnp.einsum('bcgkl,bclgn,bclgkp->bcgkpn', decay_states, bm, x)
    chunk_decay = jnp.exp(acum_t[..., -1])

    def step(carry, inp):
        st, ad = inp
        return carry * ad[..., None, None] + st, carry

    init = jnp.zeros((bsz, SSD_GROUPS, SSD_HPG, p, SSD_STATE), x.dtype)
    _, prev = lax.scan(step, init, (jnp.moveaxis(states, 1, 0), jnp.moveaxis(chunk_decay, 1, 0)))
    prev = jnp.moveaxis(prev, 0, 1)
    y_off = jnp.einsum('bclgn,bcgkpn,bcgkl->bclgkp', cm, prev, jnp.exp(acum_t))
    return (y_diag + y_off).reshape(bsz, s, h, p)


def _ssd_group(z, xbc, dt_raw, conv_w, conv_b, dt_bias, a_log, d_skip, norm_w):
    f32 = jnp.float32
    bsz, s, _ = xbc.shape
    nbc = SSD_GROUPS * SSD_STATE
    xbc = jax.nn.silu(_centred_dwconv(xbc, conv_w, conv_b).astype(f32))
    xs = xbc[..., :D_GROUP].reshape(bsz, s, SSD_HEADS, SSD_HEAD_DIM)
    bm = xbc[..., D_GROUP:D_GROUP + nbc].reshape(bsz, s, SSD_GROUPS, SSD_STATE)
    cm = xbc[..., D_GROUP + nbc:].reshape(bsz, s, SSD_GROUPS, SSD_STATE)
    dt = jax.nn.softplus(dt_raw.astype(f32).reshape(bsz, s, 2, SSD_HEADS) + dt_bias.astype(f32))
    a = -jnp.exp(a_log.astype(f32))
    flip = lambda t: jnp.flip(t, axis=1)
    y_f = _ssd_chunked(xs, dt[:, :, 0], a[0], bm, cm)
    y_b = flip(_ssd_chunked(flip(xs), flip(dt[:, :, 1]), a[1], flip(bm), flip(cm)))
    y = (y_f + y_b + d_skip.astype(f32)[:, None] * xs).reshape(bsz, s, D_GROUP)
    y = y * jax.nn.silu(z.astype(f32))
    y = y * lax.rsqrt(jnp.mean(y * y, axis=-1, keepdims=True) + EPS)
    return y * norm_w.astype(f32)


def _rope(t):
    s, d = t.shape[1], t.shape[-1]
    inv_freq = 1.0 / (ROPE_BASE ** (jnp.arange(0, d, 2, dtype=jnp.float32) / d))
    ang = jnp.arange(s, dtype=jnp.float32)[:, None] * inv_freq[None, :]
    cos = jnp.cos(ang)[None, :, None, :]
    sin = jnp.sin(ang)[None, :, None, :]
    t1, t2 = jnp.split(t, 2, axis=-1)
    return jnp.concatenate([t1 * cos - t2 * sin, t1 * sin + t2 * cos], axis=-1)


def _retention_group(q, k, v, g, norm_w):
    f32 = jnp.float32
    bsz, s, _ = q.shape
    L = RET_CHUNK
    nc = s // L
    shp = (bsz, s, RET_HEADS, RET_HEAD_DIM)
    cshp = (bsz, nc, L, RET_HEADS, RET_HEAD_DIM)
    q = _rope(q.astype(f32).reshape(shp)).reshape(cshp)
    k = (_rope(k.astype(f32).reshape(shp)) * RET_HEAD_DIM ** -0.5).reshape(cshp)
    v = v.astype(f32).reshape(cshp)
    log_gamma = jnp.log1p(-jnp.exp2(-5.0 - jnp.arange(RET_HEADS, dtype=f32)))
    pos = jnp.arange(L, dtype=f32)
    d_intra = jnp.exp(log_gamma[:, None, None] * jnp.abs(pos[:, None] - pos[None, :]))
    scores = jnp.einsum('bcihd,bcjhd->bchij', q, k) * d_intra
    y = jnp.einsum('bchij,bcjhe->bcihe', scores, v)
    kv_f = jnp.einsum('bclhd,bclhe,hl->bchde', k, v, jnp.exp(log_gamma[:, None] * (L - 1.0 - pos)[None]))
    kv_b = jnp.einsum('bclhd,bclhe,hl->bchde', k, v, jnp.exp(log_gamma[:, None] * pos[None]))
    cdec = jnp.exp(log_gamma * L)[:, None, None]

    def step(carry, kv):
        return carry * cdec + kv, carry

    init = jnp.zeros((bsz, RET_HEADS, RET_HEAD_DIM, RET_HEAD_DIM), f32)
    _, r_f = lax.scan(step, init, jnp.moveaxis(kv_f, 1, 0))
    _, r_b = lax.scan(step, init, jnp.moveaxis(kv_b, 1, 0), reverse=True)
    r_f = jnp.moveaxis(r_f, 0, 1)
    r_b = jnp.moveaxis(r_b, 0, 1)
    y = y + jnp.einsum('bclhd,bchde,hl->bclhe', q, r_f, jnp.exp(log_gamma[:, None] * (pos + 1.0)[None]))
    y = y + jnp.einsum('bclhd,bchde,hl->bclhe', q, r_b, jnp.exp(log_gamma[:, None] * (L - pos)[None]))
    y = y.reshape(shp)
    mu = jnp.mean(y, axis=-1, keepdims=True)
    var = jnp.mean(jnp.square(y - mu), axis=-1, keepdims=True)
    y = ((y - mu) * lax.rsqrt(var + EPS)).reshape(bsz, s, D_GROUP) * norm_w.astype(f32)
    return y * jax.nn.silu(g.astype(f32))


def _mixer(xn, l, p):
    offsets = [int(o) for o in np.cumsum(PROJ_SIZES)[:-1]]
    (lru_x, lru_gate, ssd_z, ssd_xbc, ssd_dt, ret_q, ret_k, ret_v, ret_g) = jnp.split(xn @ p['w_in'][l], offsets, axis=-1)
    y_lru = _rglru_group(lru_x, lru_gate, p['lru_conv_w'][l], p['lru_conv_b'][l], p['lru_w_a'][l], p['lru_b_a'][l], p['lru_w_i'][l], p['lru_b_i'][l], p['lru_lam'][l])
    y_ssd = _ssd_group(ssd_z, ssd_xbc, ssd_dt, p['ssd_conv_w'][l], p['ssd_conv_b'][l], p['ssd_dt_bias'][l], p['ssd_a_log'][l], p['ssd_d'][l], p['ssd_norm'][l])
    y_ret = _retention_group(ret_q, ret_k, ret_v, ret_g, p['ret_norm'][l])
    y = jnp.concatenate([y_lru, y_ssd, y_ret], axis=-1).astype(xn.dtype)
    return y @ p['w_out'][l]


def _trunk(x, p):
    for l in range(DEPTH):
        x = x + 0.5 * _swiglu(_rmsnorm(x, p['ffn1_norm'][l]), p['ffn1_w_gu'][l], p['ffn1_w_down'][l])
        x = x + _mixer(_rmsnorm(x, p['mix_norm'][l]), l, p)
        x = x + 0.5 * _swiglu(_rmsnorm(x, p['ffn2_norm'][l]), p['ffn2_w_gu'][l], p['ffn2_w_down'][l])
    return _rmsnorm(x, p['final_norm'])


def setup_inputs(seed: int = 0) -> dict:
    key = jax.random.key(seed)
    ks = jax.random.split(key, 26)
    f32 = jnp.float32

    def nrm(k, shape, scale):
        return jax.random.normal(k, shape, f32) * scale

    def gain(k, shape):
        return 1.0 + 0.02 * jax.random.normal(k, shape, f32)

    u = jax.random.uniform(ks[13], (DEPTH, 2, D_GROUP), f32, 0.9, 0.999)
    a0 = u ** (1.0 / LRU_C)
    dt0 = jnp.exp(jax.random.uniform(ks[16], (DEPTH, 2, SSD_HEADS), f32, math.log(1e-3), math.log(1e-1)))
    return {
        'x_prompt': jax.random.normal(ks[0], (BATCH, SEQ, D_MODEL), f32),
        'x_sample': jax.random.normal(ks[1], (DEC_BATCH, DEC_SEQ, D_MODEL), f32),
        'ffn1_norm': gain(ks[2], (DEPTH, D_MODEL)),
        'ffn1_w_gu': nrm(ks[3], (DEPTH, D_MODEL, 2 * D_FF), D_MODEL ** -0.5),
        'ffn1_w_down': nrm(ks[4], (DEPTH, D_FF, D_MODEL), D_FF ** -0.5),
        'mix_norm': gain(ks[5], (DEPTH, D_MODEL)),
        'w_in': nrm(ks[6], (DEPTH, D_MODEL, D_PROJ), D_MODEL ** -0.5),
        'lru_conv_w': nrm(ks[7], (DEPTH, CONV_W, D_GROUP), CONV_W ** -0.5),
        'lru_conv_b': nrm(ks[8], (DEPTH, D_GROUP), 0.02),
        'lru_w_a': nrm(ks[9], (DEPTH, 2, LRU_BLOCKS, LRU_BLOCK, LRU_BLOCK), LRU_BLOCK ** -0.5),
        'lru_b_a': nrm(ks[10], (DEPTH, 2, D_GROUP), 0.02),
        'lru_w_i': nrm(ks[11], (DEPTH, 2, LRU_BLOCKS, LRU_BLOCK, LRU_BLOCK), LRU_BLOCK ** -0.5),
        'lru_b_i': nrm(ks[12], (DEPTH, 2, D_GROUP), 0.02),
        'lru_lam': jnp.log(a0) - jnp.log1p(-a0),
        'ssd_conv_w': nrm(ks[14], (DEPTH, CONV_W, SSD_XBC), CONV_W ** -0.5),
        'ssd_conv_b': nrm(ks[15], (DEPTH, SSD_XBC), 0.02),
        'ssd_dt_bias': dt0 + jnp.log(-jnp.expm1(-dt0)),
        'ssd_a_log': jnp.log(jax.random.uniform(ks[17], (DEPTH, 2, SSD_HEADS), f32, 1.0, 16.0)),
        'ssd_d': gain(ks[18], (DEPTH, SSD_HEADS)),
        'ssd_norm': gain(ks[19], (DEPTH, D_GROUP)),
        'ret_norm': gain(ks[20], (DEPTH, D_GROUP)),
        'w_out': nrm(ks[21], (DEPTH, D_MIX, D_MODEL), D_MIX ** -0.5),
        'ffn2_norm': gain(ks[22], (DEPTH, D_MODEL)),
        'ffn2_w_gu': nrm(ks[23], (DEPTH, D_MODEL, 2 * D_FF), D_MODEL ** -0.5),
        'ffn2_w_down': nrm(ks[24], (DEPTH, D_FF, D_MODEL), D_FF ** -0.5),
        'final_norm': gain(ks[25], (D_MODEL,)),
    }


def reference(x_prompt, x_sample, ffn1_norm, ffn1_w_gu, ffn1_w_down, mix_norm, w_in,
              lru_conv_w, lru_conv_b, lru_w_a, lru_b_a, lru_w_i, lru_b_i, lru_lam,
              ssd_conv_w, ssd_conv_b, ssd_dt_bias, ssd_a_log, ssd_d, ssd_norm,
              ret_norm, w_out, ffn2_norm, ffn2_w_gu, ffn2_w_down, final_norm):
    p = {
        'ffn1_norm': ffn1_norm, 'ffn1_w_gu': ffn1_w_gu, 'ffn1_w_down': ffn1_w_down,
        'mix_norm': mix_norm, 'w_in': w_in,
        'lru_conv_w': lru_conv_w, 'lru_conv_b': lru_conv_b, 'lru_w_a': lru_w_a, 'lru_b_a': lru_b_a,
        'lru_w_i': lru_w_i, 'lru_b_i': lru_b_i, 'lru_lam': lru_lam,
        'ssd_conv_w': ssd_conv_w, 'ssd_conv_b': ssd_conv_b, 'ssd_dt_bias': ssd_dt_bias,
        'ssd_a_log': ssd_a_log, 'ssd_d': ssd_d, 'ssd_norm': ssd_norm,
        'ret_norm': ret_norm, 'w_out': w_out,
        'ffn2_norm': ffn2_norm, 'ffn2_w_gu': ffn2_w_gu, 'ffn2_w_down': ffn2_w_down,
        'final_norm': final_norm,
    }
    y_prompt = _trunk(x_prompt, p)
    y_sample = _trunk(x_sample, p)
    return (y_prompt, y_sample)
```

```cpp
#include <hip/hip_runtime.h>
#include <hip/hip_cooperative_groups.h>
#include <cstdio>
#include <cstdint>
namespace cg = cooperative_groups;
namespace pg8 {
#define PG8_LAS __attribute__((address_space(3)))
typedef unsigned short bf16_t;
typedef short bf16x8 __attribute__((ext_vector_type(8)));
typedef float f32x4 __attribute__((ext_vector_type(4)));
typedef unsigned u32x4 __attribute__((ext_vector_type(4)));
constexpr int BM = 256, BK = 64, HALF = 128, HTB = HALF * BK * 2  , STAGE_BYTES = 8 * HTB, NXCD = 8, WGM = 8;

__host__ __device__ __forceinline__ int lds_byte(int r, int c) { const int st = (r >> 4) * 2 + (c >> 5), rr = r & 15, cc = c & 31, ob = rr * 64 + cc * 2; return st * 1024 + (ob ^ (((ob >> 9) & 1) << 5)); }
__host__ __device__ __forceinline__ void stage_rc(int b, int& R, int& C) { const int st = b / 1024, sb = b % 1024, swz = sb ^ (((sb >> 9) & 1) << 5); R = (st >> 1) * 16 + swz / 64; C = (st & 1) * 32 + (swz % 64) / 2; }
__host__ __device__ __forceinline__ int perm32(int rho) { const int n = rho >> 4, i = rho & 15; return 8 * (i >> 2) + 4 * n + (i & 3); }

struct Unit { int pm, pn; };
struct Gemm { const bf16_t* A; const bf16_t* Bt; int M, N, K; };

struct StaticOrder {
    int nM, nN, nwg, G, c;
    __host__ __device__ void init(int M, int N, int G_, int c_) { nM = M / BM; nN = N / BM; nwg = nM * nN; G = G_; c = c_; }
    __host__ __device__ bool next(int i, Unit& u) const {
        const long L = (long)i * G + c; if (L >= nwg) return false;
        int wgid = (int)L; { const int q = nwg / NXCD, r = nwg % NXCD, xcd = wgid % NXCD, off = wgid / NXCD; wgid = (xcd < r ? xcd * (q + 1) : r * (q + 1) + (xcd - r) * q) + off; }
        const int nig = WGM * nN, gid = wgid / nig, fm = gid * WGM, gsz = (nM - fm) < WGM ? (nM - fm) : WGM;
        u.pm = fm + ((wgid % nig) % gsz); u.pn = (wgid % nig) / gsz; return true;
    }
    __device__ __forceinline__ void a_ready(const Unit&) const {}
    __device__ __forceinline__ void done(const Unit&) const {}
};

__device__ __forceinline__ unsigned cvt_pk_bf16(float lo, float hi) { unsigned r; asm volatile("v_cvt_pk_bf16_f32 %0, %1, %2" : "=v"(r) : "v"(lo), "v"(hi)); return r; }
typedef float f32x2 __attribute__((ext_vector_type(2)));
template <class Epi, class Sched, bool ALIGN_EPI = false, bool SP2 = false>
__device__ __forceinline__ void gemm_phase(PG8_LAS unsigned char* lds, const Gemm g, const Sched& S, const Epi& E) {
    int tid_l = threadIdx.x; asm volatile("" : "+v"(tid_l));
    const int tid = tid_l, wid = __builtin_amdgcn_readfirstlane(tid >> 6), lane = tid & 63, wr = wid >> 2, wc = wid & 3, fr = lane & 15, fq = lane >> 4;
    const int K = g.K, nt = K / BK;
    unsigned voffA[2], voffB[2];
#pragma unroll
    for (int i = 0; i < 2; ++i) { int R, C; stage_rc(tid * 16 + i * 8192, R, C); const int Rb = Epi::PERM ? ((R & ~31) + perm32(R & 31)) : R;
        voffA[i] = (unsigned)(R * K + C) * 2u; voffB[i] = (unsigned)(Rb * K + C) * 2u; }
    const size_t kstep = (size_t)(BK * 2);
    const size_t hstep = (size_t)HALF * K * 2;
    const size_t tstep = 2 * hstep;
    const unsigned ldsw = (unsigned)wid * 1024u;
    const int aoff = lds_byte(wr * 64 + fr, fq * 8), boff = lds_byte(wc * 32 + fr, fq * 8);
#define PG8_SA(b, h) (((b) * 2 + (h)) * HTB)
#define PG8_SB(b, h) ((4 + (b) * 2 + (h)) * HTB)
#define PG8_STAGE(bufoff, gbase, voff) do { _Pragma("unroll") for (int _i = 0; _i < 2; ++_i) \
        __builtin_amdgcn_global_load_lds((const unsigned*)((const char*)(gbase) + (voff)[_i]), (PG8_LAS unsigned*)(lds + (bufoff) + ldsw + _i * 8192), 16, 0, 0); } while (0)
#define PG8_LDA(dst, b, h) do { _Pragma("unroll") for (int m = 0; m < 4; ++m) _Pragma("unroll") for (int k = 0; k < 2; ++k) dst[m][k] = *(const PG8_LAS bf16x8*)(lds + PG8_SA(b, h) + aoff + m * 2048 + k * 1024); } while (0)
#define PG8_LDB(dst, b, h) do { _Pragma("unroll") for (int n = 0; n < 2; ++n) _Pragma("unroll") for (int k = 0; k < 2; ++k) dst[n][k] = *(const PG8_LAS bf16x8*)(lds + PG8_SB(b, h) + boff + n * 2048 + k * 1024); } while (0)
#define PG8_MMA(ai, bj, At, Bt) do { __builtin_amdgcn_s_setprio(1); _Pragma("unroll") for (int m = 0; m < 4; ++m) _Pragma("unroll") for (int n = 0; n < 2; ++n) _Pragma("unroll") for (int k = 0; k < 2; ++k) \
        acc[ai][bj][m][n] = __builtin_amdgcn_mfma_f32_16x16x32_bf16(Bt[n][k], At[m][k], acc[ai][bj][m][n], 0, 0, 0); __builtin_amdgcn_s_setprio(0); } while (0)
#define PG8_WAIT_V(n) asm volatile("s_waitcnt vmcnt(" #n ")" ::: "memory")
#define PG8_WAIT_L(n) asm volatile("s_waitcnt lgkmcnt(" #n ")" ::: "memory")
#define PG8_BAR __builtin_amdgcn_s_barrier()
#define PG8_SCHED __builtin_amdgcn_sched_barrier(0)
    Unit cur, nxt; int ui = 0;
    if (!S.next(0, cur)) return;
    f32x4 acc[2][2][4][2];
#pragma unroll
    for (int a = 0; a < 2; ++a)
#pragma unroll
        for (int b = 0; b < 2; ++b)
#pragma unroll
            for (int m = 0; m < 4; ++m)
#pragma unroll
                for (int n = 0; n < 2; ++n) acc[a][b][m][n] = (f32x4){0.f, 0.f, 0.f, 0.f};
    bf16x8 At[4][2], B0[2][2], B1[2][2];
    const char* cA = (const char*)g.A + (size_t)cur.pm * tstep; const char* cB = (const char*)g.Bt + (size_t)cur.pn * tstep;
    S.a_ready(cur);
    if constexpr (SP2) {
        PG8_STAGE(PG8_SB(0, 0), cB, voffB); PG8_STAGE(PG8_SB(0, 1), cB + hstep, voffB); PG8_STAGE(PG8_SA(0, 0), cA, voffA); PG8_STAGE(PG8_SA(0, 1), cA + hstep, voffA);
        if (wr == 1) PG8_BAR;
        PG8_WAIT_V(2); PG8_BAR;
        PG8_STAGE(PG8_SB(1, 0), cB + kstep, voffB); PG8_STAGE(PG8_SA(1, 0), cA + kstep, voffA); PG8_STAGE(PG8_SB(1, 1), cB + hstep + kstep, voffB);
        PG8_WAIT_V(6); PG8_BAR;
    } else {
        PG8_STAGE(PG8_SB(0, 0), cB, voffB); PG8_STAGE(PG8_SA(0, 0), cA, voffA); PG8_STAGE(PG8_SB(0, 1), cB + hstep, voffB); PG8_STAGE(PG8_SA(0, 1), cA + hstep, voffA);
        if (wr == 1) PG8_BAR;
        PG8_WAIT_V(4); PG8_BAR;
        PG8_STAGE(PG8_SB(1, 0), cB + kstep, voffB); PG8_STAGE(PG8_SA(1, 0), cA + kstep, voffA); PG8_STAGE(PG8_SB(1, 1), cB + hstep + kstep, voffB);
        PG8_WAIT_V(6); PG8_BAR;
    }
    for (;;) {
        const bool has_next = S.next(ui + 1, nxt);
        const char* nA = has_next ? (const char*)g.A + (size_t)nxt.pm * tstep : cA; const char* nB = has_next ? (const char*)g.Bt + (size_t)nxt.pn * tstep : cB;
        for (int t = 0; t < nt; t += 2) {
            const bool last = (t == nt - 2);
            const char* a1 = cA + (size_t)(t + 1) * kstep;
            const char* a2 = last ? nA : cA + (size_t)(t + 2) * kstep; const char* b2 = last ? nB : cB + (size_t)(t + 2) * kstep;
            const char* a3 = a2 + kstep; const char* b3 = b2 + kstep;
            if (last && has_next) S.a_ready(nxt);
            if constexpr (SP2) {
            PG8_LDB(B0, 0, 0); PG8_LDB(B1, 0, 1); PG8_SCHED; PG8_LDA(At, 0, 0); PG8_STAGE(PG8_SA(1, 1), a1 + hstep, voffA);
            PG8_WAIT_V(8); PG8_WAIT_L(0); PG8_BAR; PG8_MMA(0, 0, At, B0); PG8_MMA(0, 1, At, B1); PG8_BAR; PG8_SCHED;
            PG8_LDA(At, 0, 1); PG8_STAGE(PG8_SB(0, 0), b2, voffB); PG8_STAGE(PG8_SB(0, 1), b2 + hstep, voffB); PG8_STAGE(PG8_SA(0, 0), a2, voffA);
            PG8_WAIT_V(8); PG8_WAIT_L(0); PG8_BAR; PG8_MMA(1, 0, At, B0); PG8_MMA(1, 1, At, B1); PG8_BAR; PG8_SCHED;
            PG8_LDB(B0, 1, 0); PG8_LDB(B1, 1, 1); PG8_SCHED; PG8_LDA(At, 1, 0); PG8_STAGE(PG8_SA(0, 1), a2 + hstep, voffA);
            PG8_WAIT_V(8); PG8_WAIT_L(0); PG8_BAR; PG8_MMA(0, 0, At, B0); PG8_MMA(0, 1, At, B1); PG8_BAR; PG8_SCHED;
            PG8_LDA(At, 1, 1); PG8_STAGE(PG8_SB(1, 0), b3, voffB); PG8_STAGE(PG8_SB(1, 1), b3 + hstep, voffB); PG8_STAGE(PG8_SA(1, 0), a3, voffA);
            PG8_WAIT_V(8); PG8_WAIT_L(0); PG8_BAR; PG8_MMA(1, 0, At, B0); PG8_MMA(1, 1, At, B1); PG8_BAR; PG8_SCHED;
            } else {
            PG8_LDB(B0, 0, 0); PG8_SCHED; PG8_LDA(At, 0, 0); PG8_STAGE(PG8_SA(1, 1), a1 + hstep, voffA);
            PG8_WAIT_L(8); PG8_BAR; PG8_WAIT_L(0); PG8_MMA(0, 0, At, B0); PG8_BAR; PG8_SCHED;
            PG8_LDB(B1, 0, 1); PG8_STAGE(PG8_SB(0, 0), b2, voffB);
            PG8_BAR; PG8_WAIT_L(0); PG8_MMA(0, 1, At, B1); PG8_BAR;
            PG8_LDA(At, 0, 1); PG8_STAGE(PG8_SA(0, 0), a2, voffA);
            PG8_BAR; PG8_WAIT_L(0); PG8_MMA(1, 0, At, B0); PG8_BAR; PG8_SCHED;
            PG8_STAGE(PG8_SB(0, 1), b2 + hstep, voffB);
            PG8_WAIT_V(6); PG8_BAR; PG8_MMA(1, 1, At, B1); PG8_BAR;
            PG8_LDB(B0, 1, 0); PG8_SCHED; PG8_LDA(At, 1, 0); PG8_STAGE(PG8_SA(0, 1), a2 + hstep, voffA);
            PG8_WAIT_L(8); PG8_BAR; PG8_WAIT_L(0); PG8_MMA(0, 0, At, B0); PG8_BAR; PG8_SCHED;
            PG8_LDB(B1, 1, 1); PG8_STAGE(PG8_SB(1, 0), b3, voffB);
            PG8_BAR; PG8_WAIT_L(0); PG8_MMA(0, 1, At, B1); PG8_BAR;
            PG8_LDA(At, 1, 1); PG8_STAGE(PG8_SA(1, 0), a3, voffA);
            PG8_BAR; PG8_WAIT_L(0); PG8_MMA(1, 0, At, B0); PG8_BAR; PG8_SCHED;
            PG8_STAGE(PG8_SB(1, 1), b3 + hstep, voffB);
            PG8_WAIT_V(6); PG8_BAR; PG8_MMA(1, 1, At, B1); PG8_BAR;
            }
        }
        if constexpr (ALIGN_EPI) { if (wr == 0) PG8_BAR; }
        if constexpr (!Epi::AFTER_DRAIN) { E(acc, cur, wr, wc, fr, fq); S.done(cur); }
        if (!has_next) break;
#pragma unroll
        for (int a = 0; a < 2; ++a)
#pragma unroll
            for (int b = 0; b < 2; ++b)
#pragma unroll
                for (int m = 0; m < 4; ++m)
#pragma unroll
                    for (int n = 0; n < 2; ++n) acc[a][b][m][n] = (f32x4){0.f, 0.f, 0.f, 0.f};
        cur = nxt; cA = nA; cB = nB; ++ui;
        if constexpr (ALIGN_EPI) { if (wr == 1) PG8_BAR; }
    }
    PG8_WAIT_V(0);
    if constexpr (!ALIGN_EPI) { if (wr == 0) PG8_BAR; }
    PG8_BAR;
    if constexpr (Epi::AFTER_DRAIN) { E.fused(acc, cur, wr, wc, fr, fq, lds, wid, lane); S.done(cur); }
#undef PG8_SA
#undef PG8_SB
#undef PG8_STAGE
#undef PG8_LDA
#undef PG8_LDB
#undef PG8_MMA
#undef PG8_WAIT_V
#undef PG8_WAIT_L
#undef PG8_BAR
#undef PG8_SCHED
}
}
#ifndef PG8_SP2
#define PG8_SP2 true
#endif
#ifndef PG8_ALIGN
#define PG8_ALIGN true
#endif

#define LAS __attribute__((address_space(3)))
typedef unsigned short bf16;
typedef float f32x4 __attribute__((ext_vector_type(4)));
typedef float f32x8 __attribute__((ext_vector_type(8)));
typedef short bf16x8 __attribute__((ext_vector_type(8)));
typedef unsigned u32x4 __attribute__((ext_vector_type(4)));
typedef unsigned u32x2 __attribute__((ext_vector_type(2)));

constexpr int DM = 1024, DFF = 2816, NGU = 5632, NIN = 4608, NMIX = 1536, NLAYER = 4;
constexpr int TT = 81920, THALF = 40960, PLD = NIN  , YLD = NMIX;
constexpr int W_IN_SRC = 4368;
constexpr float EPSN = 1e-6f;
constexpr int PC_LRUX = 0, PC_GATE = 512, PC_Z = 1024, PC_XBC = 1536, PC_Q = 2304, PC_K = 2816, PC_V = 3328, PC_G = 3840, PC_DT = 4352;

constexpr size_t al256(size_t x) { return (x + 255) & ~(size_t)255; }
constexpr size_t SZ_WGU = (size_t)NGU * DM * 2, SZ_WD = (size_t)DM * DFF * 2, SZ_WIN = (size_t)NIN * DM * 2, SZ_WOUT = (size_t)DM * NMIX * 2;
constexpr size_t WS_WGU1 = 0;
constexpr size_t WS_WD1 = WS_WGU1 + NLAYER * SZ_WGU;
constexpr size_t WS_WIN = WS_WD1 + NLAYER * SZ_WD;
constexpr size_t WS_WOUT = WS_WIN + NLAYER * SZ_WIN;
constexpr size_t WS_WGU2 = WS_WOUT + NLAYER * SZ_WOUT;
constexpr size_t WS_WD2 = WS_WGU2 + NLAYER * SZ_WGU;
constexpr size_t WS_XB = al256(WS_WD2 + NLAYER * SZ_WD);
constexpr size_t WS_SSQ = al256(WS_XB + (size_t)TT * DM * 2);
constexpr size_t WS_ROPE = al256(WS_SSQ + (size_t)TT * 16 * 4);
constexpr size_t WS_BIG = al256(WS_ROPE + (size_t)8192 * 64 * 4 * 2);
constexpr size_t WS_PROJ = WS_BIG;
constexpr size_t WS_Y = al256(WS_PROJ + (size_t)THALF * PLD * 2);
constexpr size_t WS_YB = al256(WS_Y + (size_t)THALF * YLD * 2);
constexpr size_t WS_END1 = al256(WS_YB + (size_t)THALF * YLD * 2);
constexpr size_t WS_H = WS_BIG;
constexpr size_t WS_END2 = al256(WS_H + (size_t)TT * DFF * 2);
constexpr size_t WS_NEED = WS_END1 > WS_END2 ? WS_END1 : WS_END2;

constexpr int LDS_BYTES = 147456;

__device__ __forceinline__ float bflo(unsigned w) { return __builtin_bit_cast(float, w << 16); }
__device__ __forceinline__ float bfhi(unsigned w) { return __builtin_bit_cast(float, w & 0xffff0000u); }
__device__ __forceinline__ float bf2f(bf16 b) { return __builtin_bit_cast(float, (unsigned)b << 16); }
__device__ __forceinline__ bf16 f2bf(float f) { unsigned u = __builtin_bit_cast(unsigned, f); return (bf16)((u + 0x7fffu + ((u >> 16) & 1u)) >> 16); }
__device__ __forceinline__ unsigned pk2(float lo, float hi) { return pg8::cvt_pk_bf16(lo, hi); }
__device__ __forceinline__ f32x8 unpack8(u32x4 w) { f32x8 o; o[0] = bflo(w.x); o[1] = bfhi(w.x); o[2] = bflo(w.y); o[3] = bfhi(w.y); o[4] = bflo(w.z); o[5] = bfhi(w.z); o[6] = bflo(w.w); o[7] = bfhi(w.w); return o; }
__device__ __forceinline__ u32x4 pack8(f32x8 v) { u32x4 w; w.x = pk2(v[0], v[1]); w.y = pk2(v[2], v[3]); w.z = pk2(v[4], v[5]); w.w = pk2(v[6], v[7]); return w; }
__device__ __forceinline__ f32x8 ld8f(const float* p) { const f32x4 a = *(const f32x4*)p, b = *(const f32x4*)(p + 4); f32x8 o; o[0] = a[0]; o[1] = a[1]; o[2] = a[2]; o[3] = a[3]; o[4] = b[0]; o[5] = b[1]; o[6] = b[2]; o[7] = b[3]; return o; }
__device__ __forceinline__ float sigm(float x) { return __builtin_amdgcn_rcpf(1.0f + __expf(-x)); }
__device__ __forceinline__ float siluf(float x) { return x * sigm(x); }
__device__ __forceinline__ float softplusf(float x) { return fmaxf(x, 0.f) + log1pf(__expf(-fabsf(x))); }
__device__ __forceinline__ float gelu_tanh(float x) { const float y = 0.7978845608028654f * (x + 0.044715f * x * x * x); const float t = 1.0f - 2.0f * __builtin_amdgcn_rcpf(1.0f + __expf(2.0f * y)); return 0.5f * x * (1.0f + t); }
__device__ __forceinline__ float wave_sum(float v) {
#pragma unroll
    for (int o = 1; o < 64; o <<= 1) v += __shfl_xor(v, o);
    return v;
}
__device__ __forceinline__ float row_rs(const float* ssq, size_t row) {
    const f32x4 a = *(const f32x4*)(ssq + row * 16), b = *(const f32x4*)(ssq + row * 16 + 4), c = *(const f32x4*)(ssq + row * 16 + 8), d = *(const f32x4*)(ssq + row * 16 + 12);
    const float s = ((a[0] + a[1]) + (a[2] + a[3])) + ((b[0] + b[1]) + (b[2] + b[3])) + ((c[0] + c[1]) + (c[2] + c[3])) + ((d[0] + d[1]) + (d[2] + d[3]));
    return rsqrtf(s * (1.0f / DM) + EPSN);
}
__device__ __forceinline__ int launder_tid() { int t = threadIdx.x; asm volatile("" : "+v"(t)); return t; }
#define MFMA16(a, b, c) __builtin_amdgcn_mfma_f32_16x16x32_bf16((a), (b), (c), 0, 0, 0)
__device__ __forceinline__ bf16x8 ldfrag(const LAS bf16* p) { return *(const LAS bf16x8*)p; }

struct EpiGU {
    static constexpr bool PERM = true, AFTER_DRAIN = false;
    bf16* H; const float* ssq;
    __device__ __forceinline__ void operator()(const pg8::f32x4 (&acc)[2][2][4][2], const pg8::Unit& u, int wr, int wc, int fr, int fq) const {
        const int row0 = u.pm * 256 + wr * 64 + fr, col0 = u.pn * 128 + wc * 32 + 8 * fq;
#pragma unroll
        for (int ai = 0; ai < 2; ++ai)
#pragma unroll
            for (int m = 0; m < 4; ++m) {
                const size_t row = (size_t)(row0 + ai * 128 + m * 16);
                const float rs = row_rs(ssq, row);
                const pg8::f32x4 g0 = acc[ai][0][m][0] * rs, g1 = acc[ai][0][m][1] * rs, u0 = acc[ai][1][m][0] * rs, u1 = acc[ai][1][m][1] * rs;
                u32x4 w;
                w.x = pk2(siluf(g0[0]) * u0[0], siluf(g0[1]) * u0[1]); w.y = pk2(siluf(g0[2]) * u0[2], siluf(g0[3]) * u0[3]);
                w.z = pk2(siluf(g1[0]) * u1[0], siluf(g1[1]) * u1[1]); w.w = pk2(siluf(g1[2]) * u1[2], siluf(g1[3]) * u1[3]);
                *(u32x4*)(H + row * DFF + col0) = w;
                asm volatile("" ::: "memory");
            }
    }
};
struct EpiProj {
    static constexpr bool PERM = true, AFTER_DRAIN = false;
    bf16* P; const float* ssq; int row_off;
    __device__ __forceinline__ void operator()(const pg8::f32x4 (&acc)[2][2][4][2], const pg8::Unit& u, int wr, int wc, int fr, int fq) const {
        const int row0 = u.pm * 256 + wr * 64 + fr, col0 = u.pn * 256 + wc * 32 + 8 * fq;
#pragma unroll
        for (int ai = 0; ai < 2; ++ai)
#pragma unroll
            for (int m = 0; m < 4; ++m) {
                const size_t row = (size_t)(row0 + ai * 128 + m * 16);
                const float rs = row_rs(ssq, row + row_off);
#pragma unroll
                for (int bj = 0; bj < 2; ++bj) {
                    const pg8::f32x4 v0 = acc[ai][bj][m][0] * rs, v1 = acc[ai][bj][m][1] * rs;
                    u32x4 w; w.x = pk2(v0[0], v0[1]); w.y = pk2(v0[2], v0[3]); w.z = pk2(v1[0], v1[1]); w.w = pk2(v1[2], v1[3]);
                    *(u32x4*)(P + row * PLD + col0 + bj * 128) = w;
                }
                asm volatile("" ::: "memory");
            }
    }
};
struct EpiRes {
    static constexpr bool PERM = true, AFTER_DRAIN = false;
    float* X; bf16* XB; float* ssq; float coef; int row_off;
    __device__ __forceinline__ void operator()(const pg8::f32x4 (&acc)[2][2][4][2], const pg8::Unit& u, int wr, int wc, int fr, int fq) const {
        const int row0 = row_off + u.pm * 256 + wr * 64 + fr, col0 = u.pn * 256 + wc * 32 + 8 * fq;
#pragma unroll
        for (int ai = 0; ai < 2; ++ai)
#pragma unroll
            for (int m = 0; m < 4; ++m) {
                const size_t row = (size_t)(row0 + ai * 128 + m * 16);
                float s = 0.f;
#pragma unroll
                for (int bj = 0; bj < 2; ++bj) {
                    float* xp = X + row * DM + col0 + bj * 128;
                    pg8::f32x4 x0 = *(const pg8::f32x4*)xp, x1 = *(const pg8::f32x4*)(xp + 4);
                    x0 += acc[ai][bj][m][0] * coef; x1 += acc[ai][bj][m][1] * coef;
                    *(pg8::f32x4*)xp = x0; *(pg8::f32x4*)(xp + 4) = x1;
                    s += (x0[0] * x0[0] + x0[1] * x0[1]) + (x0[2] * x0[2] + x0[3] * x0[3]) + (x1[0] * x1[0] + x1[1] * x1[1]) + (x1[2] * x1[2] + x1[3] * x1[3]);
                    u32x4 w; w.x = pk2(x0[0], x0[1]); w.y = pk2(x0[2], x0[3]); w.z = pk2(x1[0], x1[1]); w.w = pk2(x1[2], x1[3]);
                    *(u32x4*)(XB + row * DM + col0 + bj * 128) = w;
                }
                s += __shfl_xor(s, 16); s += __shfl_xor(s, 32);
                if (fq == 0) ssq[row * 16 + u.pn * 4 + wc] = s;
                asm volatile("" ::: "memory");
            }
    }
};

__device__ __forceinline__ int colmap(int kind, int n) {
    if (kind == 0) return n;
    if (kind == 1) { const int t = n >> 8, w = n & 255; return w < 128 ? 128 * t + w : DFF + 128 * t + (w - 128); }
    return n < 2304 ? n : (n < 4352 ? n + 16 : (n < 4368 ? n - 4352 + 2304 : -1));
}
__device__ __forceinline__ void transpose_item(const float* W, int K, int Nsrc, int Ndst, const float* kscale, bf16* WT, int kind, int item, int lane, LAS float* scr) {
    const int nblk = Ndst / 32, kb = item / nblk, nb = item % nblk, k0 = 64 * kb, n0 = 32 * nb;
    const int sc = colmap(kind, n0 + (lane & 31));
#pragma unroll 8
    for (int i = 0; i < 32; ++i) { const int kk = 2 * i + (lane >> 5); float v = 0.f; if (sc >= 0) { v = W[(size_t)(k0 + kk) * Nsrc + sc]; if (kscale) v *= kscale[k0 + kk]; } scr[kk * 33 + (lane & 31)] = v; }
    asm volatile("s_waitcnt lgkmcnt(0)" ::: "memory");
    const int c = lane & 7;
#pragma unroll
    for (int j = 0; j < 4; ++j) { const int n = (lane >> 3) + 8 * j; const LAS float* s = scr + (8 * c) * 33 + n;
        u32x4 o; o.x = pk2(s[0 * 33], s[1 * 33]); o.y = pk2(s[2 * 33], s[3 * 33]); o.z = pk2(s[4 * 33], s[5 * 33]); o.w = pk2(s[6 * 33], s[7 * 33]);
        *(u32x4*)(WT + (size_t)(n0 + n) * K + k0 + 8 * c) = o; }
    asm volatile("s_waitcnt lgkmcnt(0)" ::: "memory");
}

struct Args { const float* in[26]; float* out; unsigned char* ws; };

__device__ __forceinline__ f32x8 conv8(const bf16* proj, int lrow, int pcol, int pos, int seqlen, const float* cw, int cw_ld, const float* cb, int ccol) {
    f32x8 acc = ld8f(cb + ccol);
#pragma unroll
    for (int k = 0; k < 4; ++k) {
        const int s = pos + k - 2;
        if (s >= 0 && s < seqlen) {
            const u32x4 raw = *(const u32x4*)(proj + (size_t)(lrow + k - 2) * PLD + pcol);
            acc += ld8f(cw + k * cw_ld + ccol) * unpack8(raw);
        }
    }
    return acc;
}

__device__ __forceinline__ void ret_item(LAS unsigned char* lds, const bf16* proj, bf16* yout, const float* rcos, const float* rsin, int gv, int vloc, int hd, int dir) {
    const int tid = launder_tid(), wid = __builtin_amdgcn_readfirstlane(tid >> 6), lane = tid & 63, fr = lane & 15, fq = lane >> 4;
    constexpr int LD = 136;
    LAS bf16* KN = (LAS bf16*)lds; LAS bf16* KTW = KN + 128 * LD; LAS bf16* VT = KTW + 128 * LD; LAS bf16* RT = VT + 128 * LD;
    const int seqlen = gv < 8 ? 8192 : 4096;
    const float l2g = log2f(1.0f - exp2f(-5.0f - (float)hd));
    const float cdec = exp2f(l2g * 128.0f);
    const float kscale = 0.08838834764831845f;
    f32x4 R[8];
#pragma unroll
    for (int i = 0; i < 8; ++i) R[i] = (f32x4){0.f, 0.f, 0.f, 0.f};
    for (int i = tid; i < 128 * LD / 2; i += 512) ((LAS unsigned*)RT)[i] = 0u;
    __syncthreads();
    for (int c = 0; c < 64; ++c) {
        const int cc = dir ? 63 - c : c;
        const int lrow0 = vloc * 8192 + cc * 128, pos0 = (cc * 128) % seqlen;
        bool next_reset = false;
        if (c < 63) { const int ncc = dir ? cc - 1 : cc + 1; const int np = (ncc * 128) % seqlen; next_reset = dir ? (np + 128 == seqlen) : (np == 0); }
        {
            const int r = tid >> 2, c4 = tid & 3, d1 = 16 * c4;
            const bf16* kb = proj + (size_t)(lrow0 + r) * PLD + PC_K + 128 * hd;
            const float wl = exp2f(l2g * (float)(dir ? r : 127 - r));
            const int pos = pos0 + r;
#pragma unroll
            for (int hf = 0; hf < 2; ++hf) {
                const f32x8 t1 = unpack8(*(const u32x4*)(kb + d1 + 8 * hf)), t2 = unpack8(*(const u32x4*)(kb + 64 + d1 + 8 * hf));
                const f32x8 cs = ld8f(rcos + (size_t)pos * 64 + d1 + 8 * hf), sn = ld8f(rsin + (size_t)pos * 64 + d1 + 8 * hf);
                const f32x8 o1 = (t1 * cs - t2 * sn) * kscale, o2 = (t1 * sn + t2 * cs) * kscale;
                if (dir == 0) { *(LAS u32x4*)(KN + r * LD + d1 + 8 * hf) = pack8(o1); *(LAS u32x4*)(KN + r * LD + 64 + d1 + 8 * hf) = pack8(o2); }
#pragma unroll
                for (int e = 0; e < 8; ++e) { KTW[(d1 + 8 * hf + e) * LD + r] = f2bf(o1[e] * wl); KTW[(64 + d1 + 8 * hf + e) * LD + r] = f2bf(o2[e] * wl); }
            }
            const bf16* vb = proj + (size_t)(lrow0 + r) * PLD + PC_V + 128 * hd + 32 * c4;
#pragma unroll
            for (int q4 = 0; q4 < 4; ++q4) {
                const u32x4 w = *(const u32x4*)(vb + 8 * q4);
                LAS bf16* vt = VT + (32 * c4 + 8 * q4) * LD + r;
                vt[0 * LD] = (bf16)(w.x & 0xffffu); vt[1 * LD] = (bf16)(w.x >> 16); vt[2 * LD] = (bf16)(w.y & 0xffffu); vt[3 * LD] = (bf16)(w.y >> 16);
                vt[4 * LD] = (bf16)(w.z & 0xffffu); vt[5 * LD] = (bf16)(w.z >> 16); vt[6 * LD] = (bf16)(w.w & 0xffffu); vt[7 * LD] = (bf16)(w.w >> 16);
            }
        }
        const int qi = 16 * wid + fr;
        bf16x8 qf[4];
        {
            const bf16* qb = proj + (size_t)(lrow0 + qi) * PLD + PC_Q + 128 * hd + 8 * fq;
            const int pos = pos0 + qi;
#pragma unroll
            for (int ks = 0; ks < 2; ++ks) {
                const f32x8 t1 = unpack8(*(const u32x4*)(qb + 32 * ks)), t2 = unpack8(*(const u32x4*)(qb + 64 + 32 * ks));
                const f32x8 cs = ld8f(rcos + (size_t)pos * 64 + 32 * ks + 8 * fq), sn = ld8f(rsin + (size_t)pos * 64 + 32 * ks + 8 * fq);
                qf[ks] = __builtin_bit_cast(bf16x8, pack8(t1 * cs - t2 * sn)); qf[ks + 2] = __builtin_bit_cast(bf16x8, pack8(t1 * sn + t2 * cs));
            }
        }
        __syncthreads();
        unsigned sp[8][2];
        if (dir == 0) {
#pragma unroll
            for (int ct = 0; ct < 8; ++ct) {
                f32x4 a = (f32x4){0.f, 0.f, 0.f, 0.f};
#pragma unroll
                for (int ks = 0; ks < 4; ++ks) a = MFMA16(ldfrag(KN + (16 * ct + fr) * LD + 32 * ks + 8 * fq), qf[ks], a);
                const int j0 = 16 * ct + 4 * fq;
                float dv[4];
#pragma unroll
                for (int e = 0; e < 4; ++e) { const int dd = qi - (j0 + e); dv[e] = a[e] * exp2f(l2g * (float)(dd < 0 ? -dd : dd)); }
                sp[ct][0] = pk2(dv[0], dv[1]); sp[ct][1] = pk2(dv[2], dv[3]);
            }
            __syncthreads();
#pragma unroll
            for (int ct = 0; ct < 8; ++ct) { u32x2 w; w.x = sp[ct][0]; w.y = sp[ct][1]; *(LAS u32x2*)(KN + qi * LD + 16 * ct + 4 * fq) = w; }
        }
        {
            const float rsc = exp2f(l2g * (float)(dir ? 128 - qi : qi + 1));
            f32x4 Y[8];
#pragma unroll
            for (int ct = 0; ct < 8; ++ct) {
                f32x4 a = (f32x4){0.f, 0.f, 0.f, 0.f};
#pragma unroll
                for (int ks = 0; ks < 4; ++ks) a = MFMA16(ldfrag(RT + (16 * ct + fr) * LD + 32 * ks + 8 * fq), qf[ks], a);
                Y[ct] = a * rsc;
            }
            if (dir == 0) {
#pragma unroll
                for (int ks = 0; ks < 4; ++ks) {
                    const bf16x8 pf = ldfrag(KN + qi * LD + 32 * ks + 8 * fq);
#pragma unroll
                    for (int ct = 0; ct < 8; ++ct) Y[ct] = MFMA16(ldfrag(VT + (16 * ct + fr) * LD + 32 * ks + 8 * fq), pf, Y[ct]);
                }
            }
            bf16* yo = yout + (size_t)(lrow0 + qi) * YLD + 1024 + 128 * hd + 4 * fq;
#pragma unroll
            for (int ct = 0; ct < 8; ++ct) { u32x2 w; w.x = pk2(Y[ct][0], Y[ct][1]); w.y = pk2(Y[ct][2], Y[ct][3]); *(u32x2*)(yo + 16 * ct) = w; }
        }
#pragma unroll
        for (int ct = 0; ct < 8; ++ct) R[ct] *= cdec;
#pragma unroll
        for (int ks = 0; ks < 4; ++ks) {
            const bf16x8 kf = ldfrag(KTW + (16 * wid + fr) * LD + 32 * ks + 8 * fq);
#pragma unroll
            for (int ct = 0; ct < 8; ++ct) R[ct] = MFMA16(kf, ldfrag(VT + (16 * ct + fr) * LD + 32 * ks + 8 * fq), R[ct]);
        }
        if (next_reset) {
#pragma unroll
            for (int ct = 0; ct < 8; ++ct) R[ct] = (f32x4){0.f, 0.f, 0.f, 0.f};
        }
        __syncthreads();
#pragma unroll
        for (int ct = 0; ct < 8; ++ct) { u32x2 w; w.x = pk2(R[ct][0], R[ct][1]); w.y = pk2(R[ct][2], R[ct][3]); *(LAS u32x2*)(RT + (16 * ct + fr) * LD + 16 * wid + 4 * fq) = w; }
    }
    __syncthreads();
}

__device__ __forceinline__ void ssd_item(LAS unsigned char* lds, const bf16* proj, bf16* yout, const float* cw, const float* cb, const float* dt_bias, const float* a_log, const float* dskip,
                                         int gv, int vloc, int hh, int dir) {
    const int tid = launder_tid(), wid = __builtin_amdgcn_readfirstlane(tid >> 6), lane = tid & 63, fr = lane & 15, fq = lane >> 4;
    constexpr int LDL = 136, LDS_ = 72;
    LAS bf16* XST = (LAS bf16*)lds;
    LAS bf16* CN = XST + 64 * LDL;
    LAS bf16* BN = CN + 128 * LDS_;
    LAS bf16* BTW = BN + 128 * LDS_;
    LAS bf16* PP = BTW + 64 * LDL;
    LAS bf16* HL = PP + 128 * LDL;
    LAS float* DT = (LAS float*)(HL + 64 * LDS_);
    LAS float* ACUM = DT + 128;
    const int seqlen = gv < 8 ? 8192 : 4096, grp = hh >> 2;
    const float aneg = -__expf(a_log[dir * 8 + hh]), dtb = dt_bias[dir * 8 + hh], dsk = dskip[hh];
    f32x4 Hc[2];
    Hc[0] = (f32x4){0.f, 0.f, 0.f, 0.f}; Hc[1] = (f32x4){0.f, 0.f, 0.f, 0.f};
    for (int i = tid; i < 64 * LDS_ / 2; i += 512) ((LAS unsigned*)HL)[i] = 0u;
    __syncthreads();
    for (int c = 0; c < 64; ++c) {
        const int cc = dir ? 63 - c : c;
        const int lrow0 = vloc * 8192 + cc * 128, pos0 = (cc * 128) % seqlen;
        bool next_reset = false;
        if (c < 63) { const int ncc = dir ? cc - 1 : cc + 1; const int np = (ncc * 128) % seqlen; next_reset = dir ? (np + 128 == seqlen) : (np == 0); }
        if (tid < 128) { const float raw = bf2f(proj[(size_t)(lrow0 + tid) * PLD + PC_DT + dir * 8 + hh]); DT[tid] = softplusf(raw + dtb); }
        __syncthreads();
        if (wid == 0) {
            const float x0 = DT[2 * lane] * aneg, x1 = DT[2 * lane + 1] * aneg;
            float s = x0 + x1;
#pragma unroll
            for (int o = 1; o < 64; o <<= 1) { const float t = __shfl_up(s, o); if (lane >= o) s += t; }
            const float tot = __shfl(s, 63);
            const float p1 = s, p0 = s - x1;
            if (dir == 0) { ACUM[2 * lane] = p0; ACUM[2 * lane + 1] = p1; }
            else { ACUM[2 * lane] = tot - p0 + x0; ACUM[2 * lane + 1] = tot - p1 + x1; }
            if (lane == 0) ACUM[128] = tot;
        }
        __syncthreads();
        const float tot = ACUM[128];
#pragma unroll 1
        for (int k6 = 0; k6 < 6; ++k6) {
            const int item = tid + 512 * k6, i = item / 24, cg8 = item % 24;
            const int sec = cg8 >> 3, c8 = (cg8 & 7) * 8;
            const int xc = sec == 0 ? 64 * hh + c8 : (sec == 1 ? 512 + 64 * grp + c8 : 640 + 64 * grp + c8);
            f32x8 v = conv8(proj, lrow0 + i, PC_XBC + xc, pos0 + i, seqlen, cw, 768, cb, xc);
#pragma unroll
            for (int e = 0; e < 8; ++e) v[e] = siluf(v[e]);
            if (sec == 0) {
#pragma unroll
                for (int e = 0; e < 8; ++e) XST[(c8 + e) * LDL + i] = f2bf(v[e]);
            } else if (sec == 1) {
                *(LAS u32x4*)(BN + i * LDS_ + c8) = pack8(v);
                const float w = __expf(tot - ACUM[i]) * DT[i];
#pragma unroll
                for (int e = 0; e < 8; ++e) BTW[(c8 + e) * LDL + i] = f2bf(v[e] * w);
            } else {
                *(LAS u32x4*)(CN + i * LDS_ + c8) = pack8(v);
            }
        }
        __syncthreads();
        const int qi = 16 * wid + fr;
        bf16x8 cf[2];
        cf[0] = ldfrag(CN + qi * LDS_ + 8 * fq); cf[1] = ldfrag(CN + qi * LDS_ + 32 + 8 * fq);
        const float aci = ACUM[qi];
#pragma unroll
        for (int ct = 0; ct < 8; ++ct) {
            f32x4 a = (f32x4){0.f, 0.f, 0.f, 0.f};
#pragma unroll
            for (int ks = 0; ks < 2; ++ks) a = MFMA16(ldfrag(BN + (16 * ct + fr) * LDS_ + 32 * ks + 8 * fq), cf[ks], a);
            const int j0 = 16 * ct + 4 * fq;
            float wv[4];
#pragma unroll
            for (int e = 0; e < 4; ++e) { const int j = j0 + e; const bool ok = dir ? (j >= qi) : (j <= qi); wv[e] = ok ? a[e] * __expf(aci - ACUM[j]) * DT[j] : 0.f; }
            u32x2 w; w.x = pk2(wv[0], wv[1]); w.y = pk2(wv[2], wv[3]);
            *(LAS u32x2*)(PP + qi * LDL + j0) = w;
        }
        {
            const float ea = __expf(aci);
            f32x4 Y[4];
#pragma unroll
            for (int pt = 0; pt < 4; ++pt) {
                f32x4 a = (f32x4){0.f, 0.f, 0.f, 0.f};
#pragma unroll
                for (int ks = 0; ks < 2; ++ks) a = MFMA16(ldfrag(HL + (16 * pt + fr) * LDS_ + 32 * ks + 8 * fq), cf[ks], a);
                Y[pt] = a * ea;
            }
#pragma unroll
            for (int ks = 0; ks < 4; ++ks) {
                const bf16x8 pf = ldfrag(PP + qi * LDL + 32 * ks + 8 * fq);
#pragma unroll
                for (int pt = 0; pt < 4; ++pt) Y[pt] = MFMA16(ldfrag(XST + (16 * pt + fr) * LDL + 32 * ks + 8 * fq), pf, Y[pt]);
            }
            bf16* yo = yout + (size_t)(lrow0 + qi) * YLD + 512 + 64 * hh + 4 * fq;
#pragma unroll
            for (int pt = 0; pt < 4; ++pt) {
                if (dir == 0) {
#pragma unroll
                    for (int e = 0; e < 4; ++e) Y[pt][e] += dsk * bf2f(XST[(16 * pt + 4 * fq + e) * LDL + qi]);
                }
                u32x2 w; w.x = pk2(Y[pt][0], Y[pt][1]); w.y = pk2(Y[pt][2], Y[pt][3]); *(u32x2*)(yo + 16 * pt) = w;
            }
        }
        {
            const float et = __expf(tot);
            Hc[0] *= et; Hc[1] *= et;
#pragma unroll
            for (int ks = 0; ks < 4; ++ks) {
                const bf16x8 xf = ldfrag(XST + (16 * (wid & 3) + fr) * LDL + 32 * ks + 8 * fq);
#pragma unroll
                for (int j2 = 0; j2 < 2; ++j2) Hc[j2] = MFMA16(ldfrag(BTW + (16 * (2 * (wid >> 2) + j2) + fr) * LDL + 32 * ks + 8 * fq), xf, Hc[j2]);
            }
            if (next_reset) { Hc[0] = (f32x4){0.f, 0.f, 0.f, 0.f}; Hc[1] = (f32x4){0.f, 0.f, 0.f, 0.f}; }
        }
        __syncthreads();
#pragma unroll
        for (int j2 = 0; j2 < 2; ++j2) { u32x2 w; w.x = pk2(Hc[j2][0], Hc[j2][1]); w.y = pk2(Hc[j2][2], Hc[j2][3]);
            *(LAS u32x2*)(HL + (16 * (wid & 3) + fr) * LDS_ + 16 * (2 * (wid >> 2) + j2) + 4 * fq) = w; }
    }
    __syncthreads();
}

__device__ __forceinline__ void lru_item(LAS unsigned char* lds, const bf16* proj, bf16* yout, const float* cw, const float* cb, const float* w_a, const float* b_a, const float* w_i, const float* b_i,
                                         const float* lam, int gv, int vloc, int nb, int dir) {
    const int tid = launder_tid(), wid = __builtin_amdgcn_readfirstlane(tid >> 6), lane = tid & 63, fr = lane & 15, fq = lane >> 4;
    constexpr int LDX = 72;
    LAS bf16* XCB = (LAS bf16*)lds;
    LAS bf16* WT = XCB + 128 * LDX;
    LAS float* AA = (LAS float*)(WT + 128 * LDX);
    LAS float* UU = AA + 128 * 64;
    LAS float* AGG = UU + 128 * 64;
    LAS float* CARRY = AGG + 8 * 64 * 2;
    LAS float* BA = CARRY + 64;
    LAS float* BI = BA + 64;
    LAS float* SP = BI + 64;
    const int seqlen = gv < 8 ? 8192 : 4096;
    for (int idx = tid; idx < 8192; idx += 512) {
        const int mat = idx >> 12, rem = idx & 4095, i = rem >> 6, j = rem & 63;
        const float* w = (mat ? w_i : w_a) + (size_t)((dir * 8 + nb) * 64 + i) * 64 + j;
        WT[(64 * mat + j) * LDX + i] = f2bf(*w);
    }
    if (tid < 64) { CARRY[tid] = 0.f; BA[tid] = b_a[dir * 512 + 64 * nb + tid]; BI[tid] = b_i[dir * 512 + 64 * nb + tid]; SP[tid] = 8.0f * softplusf(-lam[dir * 512 + 64 * nb + tid]); }
    __syncthreads();
    for (int c = 0; c < 64; ++c) {
        const int cc = dir ? 63 - c : c;
        const int lrow0 = vloc * 8192 + cc * 128, pos0 = (cc * 128) % seqlen;
        bool next_reset = false;
        if (c < 63) { const int ncc = dir ? cc - 1 : cc + 1; const int np = (ncc * 128) % seqlen; next_reset = dir ? (np + 128 == seqlen) : (np == 0); }
#pragma unroll 1
        for (int k2 = 0; k2 < 2; ++k2) {
            const int item = tid + 512 * k2, i = item >> 3, c8 = (item & 7) * 8;
            const f32x8 v = conv8(proj, lrow0 + i, PC_LRUX + 64 * nb + c8, pos0 + i, seqlen, cw, 512, cb, 64 * nb + c8);
            *(LAS u32x4*)(XCB + i * LDX + c8) = pack8(v);
        }
        __syncthreads();
        const int t = 16 * wid + fr;
        {
            bf16x8 xf[2];
            xf[0] = ldfrag(XCB + t * LDX + 8 * fq); xf[1] = ldfrag(XCB + t * LDX + 32 + 8 * fq);
            f32x4 Gt[8];
#pragma unroll
            for (int ct = 0; ct < 8; ++ct) {
                f32x4 a = (f32x4){0.f, 0.f, 0.f, 0.f};
#pragma unroll
                for (int ks = 0; ks < 2; ++ks) a = MFMA16(ldfrag(WT + (16 * ct + fr) * LDX + 32 * ks + 8 * fq), xf[ks], a);
                Gt[ct] = a;
            }
#pragma unroll
            for (int ct = 0; ct < 4; ++ct) {
                const int c0 = 16 * ct + 4 * fq;
                const f32x4 ba = *(const LAS f32x4*)(BA + c0), bi = *(const LAS f32x4*)(BI + c0), sp = *(const LAS f32x4*)(SP + c0);
                const u32x2 xw = *(const LAS u32x2*)(XCB + t * LDX + c0);
                const float xv[4] = {bflo(xw.x), bfhi(xw.x), bflo(xw.y), bfhi(xw.y)};
                f32x4 av, uv;
#pragma unroll
                for (int e = 0; e < 4; ++e) {
                    const float r = sigm(Gt[ct][e] + ba[e]), ig = sigm(Gt[ct + 4][e] + bi[e]);
                    const float la = -r * sp[e];
                    av[e] = __expf(la);
                    uv[e] = sqrtf(fmaxf(-expm1f(2.0f * la), 0.f)) * ig * xv[e];
                }
                *(LAS f32x4*)(AA + t * 64 + c0) = av; *(LAS f32x4*)(UU + t * 64 + c0) = uv;
            }
        }
        __syncthreads();
        {
            const int ch = tid & 63, seg = tid >> 6;
            float Pp = 1.f, h = 0.f;
#pragma unroll
            for (int k = 0; k < 16; ++k) { const int o = seg * 16 + k, tt = dir ? 127 - o : o; const float a = AA[tt * 64 + ch], u = UU[tt * 64 + ch]; h = a * h + u; Pp *= a; }
            AGG[(seg * 64 + ch) * 2] = Pp; AGG[(seg * 64 + ch) * 2 + 1] = h;
            __syncthreads();
            float cin = CARRY[ch];
            for (int s = 0; s < seg; ++s) cin = AGG[(s * 64 + ch) * 2] * cin + AGG[(s * 64 + ch) * 2 + 1];
            h = cin;
            bf16* yo = yout + (size_t)lrow0 * YLD + 64 * nb + ch;
#pragma unroll
            for (int k = 0; k < 16; ++k) { const int o = seg * 16 + k, tt = dir ? 127 - o : o; const float a = AA[tt * 64 + ch], u = UU[tt * 64 + ch]; h = a * h + u; yo[(size_t)tt * YLD] = f2bf(h); }
            __syncthreads();
            if (seg == 7) CARRY[ch] = next_reset ? 0.f : h;
        }
    }
    __syncthreads();
}

__global__ void __launch_bounds__(512, 2) mega_fwd(Args args) {
    extern __shared__ __attribute__((aligned(16))) unsigned char lds_raw[];
    LAS unsigned char* lds = (LAS unsigned char*)lds_raw;
    cg::grid_group grid = cg::this_grid();
    const int tid = threadIdx.x, lane = tid & 63, wid = __builtin_amdgcn_readfirstlane(tid >> 6), G = gridDim.x, bx = blockIdx.x;
    unsigned char* ws = args.ws;
    float* X = args.out;
    bf16* XB = (bf16*)(ws + WS_XB); float* SSQ = (float*)(ws + WS_SSQ);
    float* RCOS = (float*)(ws + WS_ROPE); float* RSIN = RCOS + 8192 * 64;
    bf16* PROJ = (bf16*)(ws + WS_PROJ); bf16* YF = (bf16*)(ws + WS_Y); bf16* YBK = (bf16*)(ws + WS_YB); bf16* HB = (bf16*)(ws + WS_H);
    const int gw = bx * 8 + wid, NGW = G * 8;

    {
        LAS float* scr = (LAS float*)(lds + wid * 16384);
        constexpr int I_GU = (DM / 64) * (NGU / 32), I_D = (DFF / 64) * (DM / 32), I_IN = (DM / 64) * (NIN / 32), I_OUT = (NMIX / 64) * (DM / 32);
        constexpr int I_LAYER = 2 * I_GU + 2 * I_D + I_IN + I_OUT;
        for (int it = gw; it < NLAYER * I_LAYER; it += NGW) {
            const int l = it / I_LAYER; int r = it % I_LAYER;
            if (r < I_GU) { transpose_item(args.in[3] + (size_t)l * DM * NGU, DM, NGU, NGU, args.in[2] + l * DM, (bf16*)(ws + WS_WGU1 + l * SZ_WGU), 1, r, lane, scr); continue; } r -= I_GU;
            if (r < I_GU) { transpose_item(args.in[23] + (size_t)l * DM * NGU, DM, NGU, NGU, args.in[22] + l * DM, (bf16*)(ws + WS_WGU2 + l * SZ_WGU), 1, r, lane, scr); continue; } r -= I_GU;
            if (r < I_D) { transpose_item(args.in[4] + (size_t)l * DFF * DM, DFF, DM, DM, nullptr, (bf16*)(ws + WS_WD1 + l * SZ_WD), 0, r, lane, scr); continue; } r -= I_D;
            if (r < I_D) { transpose_item(args.in[24] + (size_t)l * DFF * DM, DFF, DM, DM, nullptr, (bf16*)(ws + WS_WD2 + l * SZ_WD), 0, r, lane, scr); continue; } r -= I_D;
            if (r < I_IN) { transpose_item(args.in[6] + (size_t)l * DM * W_IN_SRC, DM, W_IN_SRC, NIN, args.in[5] + l * DM, (bf16*)(ws + WS_WIN + l * SZ_WIN), 2, r, lane, scr); continue; } r -= I_IN;
            transpose_item(args.in[21] + (size_t)l * NMIX * DM, NMIX, DM, DM, nullptr, (bf16*)(ws + WS_WOUT + l * SZ_WOUT), 0, r, lane, scr);
        }
        for (int m = gw; m < TT; m += NGW) {
            const float* src = m < 65536 ? args.in[0] + (size_t)m * DM : args.in[1] + (size_t)(m - 65536) * DM;
            float s = 0.f;
#pragma unroll
            for (int j = 0; j < 4; ++j) {
                const f32x4 v = *(const f32x4*)(src + 256 * j + 4 * lane);
                *(f32x4*)(X + (size_t)m * DM + 256 * j + 4 * lane) = v;
                u32x2 w; w.x = pk2(v[0], v[1]); w.y = pk2(v[2], v[3]);
                *(u32x2*)(XB + (size_t)m * DM + 256 * j + 4 * lane) = w;
                s += (v[0] * v[0] + v[1] * v[1]) + (v[2] * v[2] + v[3] * v[3]);
            }
            s = wave_sum(s);
            if (lane < 16) SSQ[(size_t)m * 16 + lane] = lane == 0 ? s : 0.f;
        }
        for (int i = bx * 512 + tid; i < 8192 * 64; i += G * 512) {
            const int pos = i >> 6, f = i & 63;
            const float inv = 1.0f / powf(10000.0f, (float)(2 * f) / 128.0f);
            const float ang = (float)pos * inv;
            RCOS[i] = cosf(ang); RSIN[i] = sinf(ang);
        }
    }
    grid.sync();

    for (int l = 0; l < NLAYER; ++l) {
        for (int st = 0; st < 3; ++st) {
            const int nsub = st == 1 ? 2 : 1;
            for (int sub = 0; sub < nsub; ++sub) {
                if (st != 1) {
                    const bf16* Wgu = (const bf16*)(ws + (st == 0 ? WS_WGU1 : WS_WGU2) + l * SZ_WGU);
                    pg8::Gemm g{XB, Wgu, TT, NGU, DM}; pg8::StaticOrder S; S.init(TT, NGU, G, bx);
                    EpiGU E{HB, SSQ};
#ifndef NO_GU
                    pg8::gemm_phase<EpiGU, pg8::StaticOrder, PG8_ALIGN, PG8_SP2>(lds, g, S, E);
#endif
                } else {
                    const bf16* Win = (const bf16*)(ws + WS_WIN + l * SZ_WIN);
                    pg8::Gemm g{XB + (size_t)sub * THALF * DM, Win, THALF, NIN, DM}; pg8::StaticOrder S; S.init(THALF, NIN, G, bx);
                    EpiProj E{PROJ, SSQ, sub * THALF};
#ifndef NO_PROJ
                    pg8::gemm_phase<EpiProj, pg8::StaticOrder, PG8_ALIGN, PG8_SP2>(lds, g, S, E);
#endif
                }
                grid.sync();
                if (st == 1) {
                    for (int item = bx; item < 200; item += G) {
                        if (item < 40) {
                            const int vloc = item >> 3, hd = (item & 7) >> 1, dir = item & 1;
#ifndef NO_RET
                            ret_item(lds, PROJ, dir ? YBK : YF, RCOS, RSIN, sub * 5 + vloc, vloc, hd, dir);
#endif
                        } else if (item < 120) {
                            const int q = item - 40, vloc = q >> 4, hh = (q & 15) >> 1, dir = q & 1;
#ifndef NO_SSD
                            ssd_item(lds, PROJ, dir ? YBK : YF, args.in[14] + (size_t)l * 4 * 768, args.in[15] + l * 768, args.in[16] + l * 16, args.in[17] + l * 16, args.in[18] + l * 8,
                                     sub * 5 + vloc, vloc, hh, dir);
#endif
                        } else {
                            const int q = item - 120, vloc = q >> 4, nb = (q & 15) >> 1, dir = q & 1;
#ifndef NO_LRU
                            lru_item(lds, PROJ, dir ? YBK : YF, args.in[7] + (size_t)l * 4 * 512, args.in[8] + l * 512, args.in[9] + (size_t)l * 2 * 8 * 64 * 64, args.in[10] + l * 1024,
                                     args.in[11] + (size_t)l * 2 * 8 * 64 * 64, args.in[12] + l * 1024, args.in[13] + l * 1024, sub * 5 + vloc, vloc, nb, dir);
#endif
                        }
                    }
                    grid.sync();
                    {
                        const float* ssd_norm = args.in[19] + l * 512; const float* ret_norm = args.in[20] + l * 512;
                        const f32x8 nw_s = ld8f(ssd_norm + 8 * lane), nw_r = ld8f(ret_norm + 8 * lane);
                        for (int row = gw; row < THALF; row += NGW) {
                            bf16* yr = YF + (size_t)row * YLD; const bf16* yb = YBK + (size_t)row * YLD; const bf16* pr = PROJ + (size_t)row * PLD;
                            {
                                const f32x8 a = unpack8(*(const u32x4*)(yr + 8 * lane)), b = unpack8(*(const u32x4*)(yb + 8 * lane)), gt = unpack8(*(const u32x4*)(pr + PC_GATE + 8 * lane));
                                f32x8 o;
#pragma unroll
                                for (int e = 0; e < 8; ++e) o[e] = (a[e] + b[e]) * gelu_tanh(gt[e]);
                                *(u32x4*)(yr + 8 * lane) = pack8(o);
                            }
                            {
                                const f32x8 a = unpack8(*(const u32x4*)(yr + 512 + 8 * lane)), b = unpack8(*(const u32x4*)(yb + 512 + 8 * lane)), z = unpack8(*(const u32x4*)(pr + PC_Z + 8 * lane));
                                f32x8 v; float ss = 0.f;
#pragma unroll
                                for (int e = 0; e < 8; ++e) { v[e] = (a[e] + b[e]) * siluf(z[e]); ss += v[e] * v[e]; }
                                ss = wave_sum(ss);
                                const float rs = rsqrtf(ss * (1.0f / 512.0f) + EPSN);
                                *(u32x4*)(yr + 512 + 8 * lane) = pack8(v * rs * nw_s);
                            }
                            {
                                const f32x8 a = unpack8(*(const u32x4*)(yr + 1024 + 8 * lane)), b = unpack8(*(const u32x4*)(yb + 1024 + 8 * lane)), gg = unpack8(*(const u32x4*)(pr + PC_G + 8 * lane));
                                f32x8 v = a + b; float s1 = 0.f;
#pragma unroll
                                for (int e = 0; e < 8; ++e) s1 += v[e];
                                s1 += __shfl_xor(s1, 1); s1 += __shfl_xor(s1, 2); s1 += __shfl_xor(s1, 4); s1 += __shfl_xor(s1, 8);
                                const float mu = s1 * (1.0f / 128.0f); float s2 = 0.f;
#pragma unroll
                                for (int e = 0; e < 8; ++e) { v[e] -= mu; s2 += v[e] * v[e]; }
                                s2 += __shfl_xor(s2, 1); s2 += __shfl_xor(s2, 2); s2 += __shfl_xor(s2, 4); s2 += __shfl_xor(s2, 8);
                                const float rs = rsqrtf(s2 * (1.0f / 128.0f) + EPSN);
                                f32x8 o;
#pragma unroll
                                for (int e = 0; e < 8; ++e) o[e] = v[e] * rs * nw_r[e] * siluf(gg[e]);
                                *(u32x4*)(yr + 1024 + 8 * lane) = pack8(o);
                            }
                        }
                    }
                    grid.sync();
                }
                {
                    pg8::Gemm g; float coef; int roff;
                    if (st != 1) { g = pg8::Gemm{HB, (const bf16*)(ws + (st == 0 ? WS_WD1 : WS_WD2) + l * SZ_WD), TT, DM, DFF}; coef = 0.5f; roff = 0; }
                    else { g = pg8::Gemm{YF, (const bf16*)(ws + WS_WOUT + l * SZ_WOUT), THALF, DM, NMIX}; coef = 1.0f; roff = sub * THALF; }
                    pg8::StaticOrder S; S.init(g.M, g.N, G, bx);
                    EpiRes E{X, XB, SSQ, coef, roff};
#ifndef NO_RES
                    pg8::gemm_phase<EpiRes, pg8::StaticOrder, PG8_ALIGN, PG8_SP2>(lds, g, S, E);
#endif
                }
                grid.sync();
            }
        }
    }
    {
        const float* fw = args.in[25];
        for (int m = gw; m < TT; m += NGW) {
            const float rs = row_rs(SSQ, (size_t)m);
#pragma unroll
            for (int j = 0; j < 4; ++j) {
                float* p = X + (size_t)m * DM + 256 * j + 4 * lane;
                const f32x4 v = *(const f32x4*)p, w = *(const f32x4*)(fw + 256 * j + 4 * lane);
                *(f32x4*)p = v * rs * w;
            }
        }
    }
}

extern "C" void kernel_launch(void* const* d_in, const int* in_sizes, int n_in, void* d_out, int out_size, void* d_ws, size_t ws_size, hipStream_t stream) {
    static int grid = 0;
    if (grid == 0) {
        if (n_in != 26 || out_size != TT * DM || ws_size < WS_NEED) { fprintf(stderr, "kernel_launch: unexpected problem (n_in %d, out %d, ws %zu, need %zu)\n", n_in, out_size, ws_size, (size_t)WS_NEED); grid = -1; return; }
        int dev = 0, cus = 0, per_cu = 0;
        if (hipGetDevice(&dev) != hipSuccess || hipDeviceGetAttribute(&cus, hipDeviceAttributeMultiprocessorCount, dev) != hipSuccess) { grid = -1; return; }
        if (hipFuncSetAttribute((const void*)mega_fwd, hipFuncAttributeMaxDynamicSharedMemorySize, LDS_BYTES) != hipSuccess) { fprintf(stderr, "kernel_launch: hipFuncSetAttribute failed\n"); grid = -1; return; }
        if (hipOccupancyMaxActiveBlocksPerMultiprocessor(&per_cu, (const void*)mega_fwd, 512, LDS_BYTES) != hipSuccess || per_cu < 1) { fprintf(stderr, "kernel_launch: occupancy query says %d\n", per_cu); per_cu = 1; }
        (void)hipGetLastError();
        grid = cus;
    }
    if (grid < 0) return;
    Args a{};
    for (int i = 0; i < 26; ++i) a.in[i] = (const float*)d_in[i];
    a.out = (float*)d_out; a.ws = (unsigned char*)d_ws;
    void* kargs[] = {&a};
    hipError_t e = hipLaunchCooperativeKernel((const void*)mega_fwd, dim3(grid), dim3(512), kargs, LDS_BYTES, stream);
    if (e != hipSuccess) fprintf(stderr, "kernel_launch: cooperative launch failed: %s (grid %d)\n", hipGetErrorString(e), grid);
}
```

```cpp
#include <hip/hip_runtime.h>
#include <hip/hip_cooperative_groups.h>
#include <cstdio>
#include <cstdint>
namespace cg = cooperative_groups;
namespace pg8 {
#define PG8_LAS __attribute__((address_space(3)))
typedef unsigned short bf16_t;
typedef short bf16x8 __attribute__((ext_vector_type(8)));
typedef float f32x4 __attribute__((ext_vector_type(4)));
typedef unsigned u32x4 __attribute__((ext_vector_type(4)));
constexpr int BM = 256, BK = 64, HALF = 128, HTB = HALF * BK * 2  , STAGE_BYTES = 8 * HTB, NXCD = 8, WGM = 8;

__host__ __device__ __forceinline__ int lds_byte(int r, int c) { const int st = (r >> 4) * 2 + (c >> 5), rr = r & 15, cc = c & 31, ob = rr * 64 + cc * 2; return st * 1024 + (ob ^ (((ob >> 9) & 1) << 5)); }
__host__ __device__ __forceinline__ void stage_rc(int b, int& R, int& C) { const int st = b / 1024, sb = b % 1024, swz = sb ^ (((sb >> 9) & 1) << 5); R = (st >> 1) * 16 + swz / 64; C = (st & 1) * 32 + (swz % 64) / 2; }
__host__ __device__ __forceinline__ int perm32(int rho) { const int n = rho >> 4, i = rho & 15; return 8 * (i >> 2) + 4 * n + (i & 3); }

struct Unit { int pm, pn; };
struct Gemm { const bf16_t* A; const bf16_t* Bt; int M, N, K; };

struct StaticOrder {
    int nM, nN, nwg, G, c;
    __host__ __device__ void init(int M, int N, int G_, int c_) { nM = M / BM; nN = N / BM; nwg = nM * nN; G = G_; c = c_; }
    __host__ __device__ bool next(int i, Unit& u) const {
        const long L = (long)i * G + c; if (L >= nwg) return false;
        int wgid = (int)L; { const int q = nwg / NXCD, r = nwg % NXCD, xcd = wgid % NXCD, off = wgid / NXCD; wgid = (xcd < r ? xcd * (q + 1) : r * (q + 1) + (xcd - r) * q) + off; }
        const int nig = WGM * nN, gid = wgid / nig, fm = gid * WGM, gsz = (nM - fm) < WGM ? (nM - fm) : WGM;
        u.pm = fm + ((wgid % nig) % gsz); u.pn = (wgid % nig) / gsz; return true;
    }
    __device__ __forceinline__ void a_ready(const Unit&) const {}
    __device__ __forceinline__ void done(const Unit&) const {}
};

__device__ __forceinline__ unsigned cvt_pk_bf16(float lo, float hi) { unsigned r; asm volatile("v_cvt_pk_bf16_f32 %0, %1, %2" : "=v"(r) : "v"(lo), "v"(hi)); return r; }
typedef float f32x2 __attribute__((ext_vector_type(2)));
template <class Epi, class Sched, bool ALIGN_EPI = false, bool SP2 = false>
__device__ __forceinline__ void gemm_phase(PG8_LAS unsigned char* lds, const Gemm g, const Sched& S, const Epi& E) {
    int tid_l = threadIdx.x; asm volatile("" : "+v"(tid_l));
    const int tid = tid_l, wid = __builtin_amdgcn_readfirstlane(tid >> 6), lane = tid & 63, wr = wid >> 2, wc = wid & 3, fr = lane & 15, fq = lane >> 4;
    const int K = g.K, nt = K / BK;
    unsigned voffA[2], voffB[2];
#pragma unroll
    for (int i = 0; i < 2; ++i) { int R, C; stage_rc(tid * 16 + i * 8192, R, C); const int Rb = Epi::PERM ? ((R & ~31) + perm32(R & 31)) : R;
        voffA[i] = (unsigned)(R * K + C) * 2u; voffB[i] = (unsigned)(Rb * K + C) * 2u; }
    const size_t kstep = (size_t)(BK * 2);
    const size_t hstep = (size_t)HALF * K * 2;
    const size_t tstep = 2 * hstep;
    const unsigned ldsw = (unsigned)wid * 1024u;
    const int aoff = lds_byte(wr * 64 + fr, fq * 8), boff = lds_byte(wc * 32 + fr, fq * 8);
#define PG8_SA(b, h) (((b) * 2 + (h)) * HTB)
#define PG8_SB(b, h) ((4 + (b) * 2 + (h)) * HTB)
#define PG8_STAGE(bufoff, gbase, voff) do { _Pragma("unroll") for (int _i = 0; _i < 2; ++_i) \
        __builtin_amdgcn_global_load_lds((const unsigned*)((const char*)(gbase) + (voff)[_i]), (PG8_LAS unsigned*)(lds + (bufoff) + ldsw + _i * 8192), 16, 0, 0); } while (0)
#define PG8_LDA(dst, b, h) do { _Pragma("unroll") for (int m = 0; m < 4; ++m) _Pragma("unroll") for (int k = 0; k < 2; ++k) dst[m][k] = *(const PG8_LAS bf16x8*)(lds + PG8_SA(b, h) + aoff + m * 2048 + k * 1024); } while (0)
#define PG8_LDB(dst, b, h) do { _Pragma("unroll") for (int n = 0; n < 2; ++n) _Pragma("unroll") for (int k = 0; k < 2; ++k) dst[n][k] = *(const PG8_LAS bf16x8*)(lds + PG8_SB(b, h) + boff + n * 2048 + k * 1024); } while (0)
#define PG8_MMA(ai, bj, At, Bt) do { __builtin_amdgcn_s_setprio(1); _Pragma("unroll") for (int m = 0; m < 4; ++m) _Pragma("unroll") for (int n = 0; n < 2; ++n) _Pragma("unroll") for (int k = 0; k < 2; ++k) \
        acc[ai][bj][m][n] = __builtin_amdgcn_mfma_f32_16x16x32_bf16(Bt[n][k], At[m][k], acc[ai][bj][m][n], 0, 0, 0); __builtin_amdgcn_s_setprio(0); } while (0)
#define PG8_WAIT_V(n) asm volatile("s_waitcnt vmcnt(" #n ")" ::: "memory")
#define PG8_WAIT_L(n) asm volatile("s_waitcnt lgkmcnt(" #n ")" ::: "memory")
#define PG8_BAR __builtin_amdgcn_s_barrier()
#define PG8_SCHED __builtin_amdgcn_sched_barrier(0)
    Unit cur, nxt; int ui = 0;
    if (!S.next(0, cur)) return;
    f32x4 acc[2][2][4][2];
#pragma unroll
    for (int a = 0; a < 2; ++a)
#pragma unroll
        for (int b = 0; b < 2; ++b)
#pragma unroll
            for (int m = 0; m < 4; ++m)
#pragma unroll
                for (int n = 0; n < 2; ++n) acc[a][b][m][n] = (f32x4){0.f, 0.f, 0.f, 0.f};
    bf16x8 At[4][2], B0[2][2], B1[2][2];
    const char* cA = (const char*)g.A + (size_t)cur.pm * tstep; const char* cB = (const char*)g.Bt + (size_t)cur.pn * tstep;
    S.a_ready(cur);
    if constexpr (SP2) {
        PG8_STAGE(PG8_SB(0, 0), cB, voffB); PG8_STAGE(PG8_SB(0, 1), cB + hstep, voffB); PG8_STAGE(PG8_SA(0, 0), cA, voffA); PG8_STAGE(PG8_SA(0, 1), cA + hstep, voffA);
        if (wr == 1) PG8_BAR;
        PG8_WAIT_V(2); PG8_BAR;
        PG8_STAGE(PG8_SB(1, 0), cB + kstep, voffB); PG8_STAGE(PG8_SA(1, 0), cA + kstep, voffA); PG8_STAGE(PG8_SB(1, 1), cB + hstep + kstep, voffB);
        PG8_WAIT_V(6); PG8_BAR;
    } else {
        PG8_STAGE(PG8_SB(0, 0), cB, voffB); PG8_STAGE(PG8_SA(0, 0), cA, voffA); PG8_STAGE(PG8_SB(0, 1), cB + hstep, voffB); PG8_STAGE(PG8_SA(0, 1), cA + hstep, voffA);
        if (wr == 1) PG8_BAR;
        PG8_WAIT_V(4); PG8_BAR;
        PG8_STAGE(PG8_SB(1, 0), cB + kstep, voffB); PG8_STAGE(PG8_SA(1, 0), cA + kstep, voffA); PG8_STAGE(PG8_SB(1, 1), cB + hstep + kstep, voffB);
        PG8_WAIT_V(6); PG8_BAR;
    }
    for (;;) {
        const bool has_next = S.next(ui + 1, nxt);
        const char* nA = has_next ? (const char*)g.A + (size_t)nxt.pm * tstep : cA; const char* nB = has_next ? (const char*)g.Bt + (size_t)nxt.pn * tstep : cB;
        for (int t = 0; t < nt; t += 2) {
            const bool last = (t == nt - 2);
            const char* a1 = cA + (size_t)(t + 1) * kstep;
            const char* a2 = last ? nA : cA + (size_t)(t + 2) * kstep; const char* b2 = last ? nB : cB + (size_t)(t + 2) * kstep;
            const char* a3 = a2 + kstep; const char* b3 = b2 + kstep;
            if (last && has_next) S.a_ready(nxt);
            if constexpr (SP2) {
            PG8_LDB(B0, 0, 0); PG8_LDB(B1, 0, 1); PG8_SCHED; PG8_LDA(At, 0, 0); PG8_STAGE(PG8_SA(1, 1), a1 + hstep, voffA);
            PG8_WAIT_V(8); PG8_WAIT_L(0); PG8_BAR; PG8_MMA(0, 0, At, B0); PG8_MMA(0, 1, At, B1); PG8_BAR; PG8_SCHED;
            PG8_LDA(At, 0, 1); PG8_STAGE(PG8_SB(0, 0), b2, voffB); PG8_STAGE(PG8_SB(0, 1), b2 + hstep, voffB); PG8_STAGE(PG8_SA(0, 0), a2, voffA);
            PG8_WAIT_V(8); PG8_WAIT_L(0); PG8_BAR; PG8_MMA(1, 0, At, B0); PG8_MMA(1, 1, At, B1); PG8_BAR; PG8_SCHED;
            PG8_LDB(B0, 1, 0); PG8_LDB(B1, 1, 1); PG8_SCHED; PG8_LDA(At, 1, 0); PG8_STAGE(PG8_SA(0, 1), a2 + hstep, voffA);
            PG8_WAIT_V(8); PG8_WAIT_L(0); PG8_BAR; PG8_MMA(0, 0, At, B0); PG8_MMA(0, 1, At, B1); PG8_BAR; PG8_SCHED;
            PG8_LDA(At, 1, 1); PG8_STAGE(PG8_SB(1, 0), b3, voffB); PG8_STAGE(PG8_SB(1, 1), b3 + hstep, voffB); PG8_STAGE(PG8_SA(1, 0), a3, voffA);
            PG8_WAIT_V(8); PG8_WAIT_L(0); PG8_BAR; PG8_MMA(1, 0, At, B0); PG8_MMA(1, 1, At, B1); PG8_BAR; PG8_SCHED;
            } else {
            PG8_LDB(B0, 0, 0); PG8_SCHED; PG8_LDA(At, 0, 0); PG8_STAGE(PG8_SA(1, 1), a1 + hstep, voffA);
            PG8_WAIT_L(8); PG8_BAR; PG8_WAIT_L(0); PG8_MMA(0, 0, At, B0); PG8_BAR; PG8_SCHED;
            PG8_LDB(B1, 0, 1); PG8_STAGE(PG8_SB(0, 0), b2, voffB);
            PG8_BAR; PG8_WAIT_L(0); PG8_MMA(0, 1, At, B1); PG8_BAR;
            PG8_LDA(At, 0, 1); PG8_STAGE(PG8_SA(0, 0), a2, voffA);
            PG8_BAR; PG8_WAIT_L(0); PG8_MMA(1, 0, At, B0); PG8_BAR; PG8_SCHED;
            PG8_STAGE(PG8_SB(0, 1), b2 + hstep, voffB);
            PG8_WAIT_V(6); PG8_BAR; PG8_MMA(1, 1, At, B1); PG8_BAR;
            PG8_LDB(B0, 1, 0); PG8_SCHED; PG8_LDA(At, 1, 0); PG8_STAGE(PG8_SA(0, 1), a2 + hstep, voffA);
            PG8_WAIT_L(8); PG8_BAR; PG8_WAIT_L(0); PG8_MMA(0, 0, At, B0); PG8_BAR; PG8_SCHED;
            PG8_LDB(B1, 1, 1); PG8_STAGE(PG8_SB(1, 0), b3, voffB);
            PG8_BAR; PG8_WAIT_L(0); PG8_MMA(0, 1, At, B1); PG8_BAR;
            PG8_LDA(At, 1, 1); PG8_STAGE(PG8_SA(1, 0), a3, voffA);
            PG8_BAR; PG8_WAIT_L(0); PG8_MMA(1, 0, At, B0); PG8_BAR; PG8_SCHED;
            PG8_STAGE(PG8_SB(1, 1), b3 + hstep, voffB);
            PG8_WAIT_V(6); PG8_BAR; PG8_MMA(1, 1, At, B1); PG8_BAR;
            }
        }
        if constexpr (ALIGN_EPI) { if (wr == 0) PG8_BAR; }
        if constexpr (!Epi::AFTER_DRAIN) { E(acc, cur, wr, wc, fr, fq); S.done(cur); }
        if (!has_next) break;
#pragma unroll
        for (int a = 0; a < 2; ++a)
#pragma unroll
            for (int b = 0; b < 2; ++b)
#pragma unroll
                for (int m = 0; m < 4; ++m)
#pragma unroll
                    for (int n = 0; n < 2; ++n) acc[a][b][m][n] = (f32x4){0.f, 0.f, 0.f, 0.f};
        cur = nxt; cA = nA; cB = nB; ++ui;
        if constexpr (ALIGN_EPI) { if (wr == 1) PG8_BAR; }
    }
    PG8_WAIT_V(0);
    if constexpr (!ALIGN_EPI) { if (wr == 0) PG8_BAR; }
    PG8_BAR;
    if constexpr (Epi::AFTER_DRAIN) { E.fused(acc, cur, wr, wc, fr, fq, lds, wid, lane); S.done(cur); }
#undef PG8_SA
#undef PG8_SB
#undef PG8_STAGE
#undef PG8_LDA
#undef PG8_LDB
#undef PG8_MMA
#undef PG8_WAIT_V
#undef PG8_WAIT_L
#undef PG8_BAR
#undef PG8_SCHED
}
}
#ifndef PG8_SP2
#define PG8_SP2 true
#endif
#ifndef PG8_ALIGN
#define PG8_ALIGN true
#endif

#define LAS __attribute__((address_space(3)))
typedef unsigned short bf16;
typedef float f32x4 __attribute__((ext_vector_type(4)));
typedef float f32x8 __attribute__((ext_vector_type(8)));
typedef short bf16x8 __attribute__((ext_vector_type(8)));
typedef unsigned u32x4 __attribute__((ext_vector_type(4)));
typedef unsigned u32x2 __attribute__((ext_vector_type(2)));

constexpr int DM = 1024, DFF = 2816, NGU = 5632, NIN = 4608, NMIX = 1536, NLAYER = 4;
constexpr int TT = 81920, THALF = 40960, PLD = NIN  , YLD = NMIX;
constexpr int W_IN_SRC = 4368;
constexpr float EPSN = 1e-6f;
constexpr int PC_LRUX = 0, PC_GATE = 512, PC_Z = 1024, PC_XBC = 1536, PC_Q = 2304, PC_K = 2816, PC_V = 3328, PC_G = 3840, PC_DT = 4352;

constexpr size_t al256(size_t x) { return (x + 255) & ~(size_t)255; }
constexpr size_t SZ_WGU = (size_t)NGU * DM * 2, SZ_WD = (size_t)DM * DFF * 2, SZ_WIN = (size_t)NIN * DM * 2, SZ_WOUT = (size_t)DM * NMIX * 2;
constexpr size_t WS_WGU1 = 0;
constexpr size_t WS_WD1 = WS_WGU1 + NLAYER * SZ_WGU;
constexpr size_t WS_WIN = WS_WD1 + NLAYER * SZ_WD;
constexpr size_t WS_WOUT = WS_WIN + NLAYER * SZ_WIN;
constexpr size_t WS_WGU2 = WS_WOUT + NLAYER * SZ_WOUT;
constexpr size_t WS_WD2 = WS_WGU2 + NLAYER * SZ_WGU;
constexpr size_t WS_XB = al256(WS_WD2 + NLAYER * SZ_WD);
constexpr size_t WS_SSQ = al256(WS_XB + (size_t)TT * DM * 2);
constexpr size_t WS_ROPE = al256(WS_SSQ + (size_t)TT * 16 * 4);
constexpr size_t WS_BIG = al256(WS_ROPE + (size_t)8192 * 64 * 4 * 2);
constexpr size_t WS_PROJ = WS_BIG;
constexpr size_t WS_Y = al256(WS_PROJ + (size_t)THALF * PLD * 2);
constexpr size_t WS_YB = al256(WS_Y + (size_t)THALF * YLD * 2);
constexpr size_t WS_END1 = al256(WS_YB + (size_t)THALF * YLD * 2);
constexpr size_t WS_H = WS_BIG;
constexpr size_t WS_END2 = al256(WS_H + (size_t)TT * DFF * 2);
constexpr size_t WS_NEED = WS_END1 > WS_END2 ? WS_END1 : WS_END2;

constexpr int LDS_BYTES = 147456;

__device__ __forceinline__ float bflo(unsigned w) { return __builtin_bit_cast(float, w << 16); }
__device__ __forceinline__ float bfhi(unsigned w) { return __builtin_bit_cast(float, w & 0xffff0000u); }
__device__ __forceinline__ float bf2f(bf16 b) { return __builtin_bit_cast(float, (unsigned)b << 16); }
__device__ __forceinline__ bf16 f2bf(float f) { unsigned u = __builtin_bit_cast(unsigned, f); return (bf16)((u + 0x7fffu + ((u >> 16) & 1u)) >> 16); }
__device__ __forceinline__ unsigned pk2(float lo, float hi) { return pg8::cvt_pk_bf16(lo, hi); }
__device__ __forceinline__ f32x8 unpack8(u32x4 w) { f32x8 o; o[0] = bflo(w.x); o[1] = bfhi(w.x); o[2] = bflo(w.y); o[3] = bfhi(w.y); o[4] = bflo(w.z); o[5] = bfhi(w.z); o[6] = bflo(w.w); o[7] = bfhi(w.w); return o; }
__device__ __forceinline__ u32x4 pack8(f32x8 v) { u32x4 w; w.x = pk2(v[0], v[1]); w.y = pk2(v[2], v[3]); w.z = pk2(v[4], v[5]); w.w = pk2(v[6], v[7]); return w; }
__device__ __forceinline__ f32x8 ld8f(const float* p) { const f32x4 a = *(const f32x4*)p, b = *(const f32x4*)(p + 4); f32x8 o; o[0] = a[0]; o[1] = a[1]; o[2] = a[2]; o[3] = a[3]; o[4] = b[0]; o[5] = b[1]; o[6] = b[2]; o[7] = b[3]; return o; }
__device__ __forceinline__ float sigm(float x) { return __builtin_amdgcn_rcpf(1.0f + __expf(-x)); }
__device__ __forceinline__ float siluf(float x) { return x * sigm(x); }
__device__ __forceinline__ float softplusf(float x) { return fmaxf(x, 0.f) + log1pf(__expf(-fabsf(x))); }
__device__ __forceinline__ float gelu_tanh(float x) { const float y = 0.7978845608028654f * (x + 0.044715f * x * x * x); const float t = 1.0f - 2.0f * __builtin_amdgcn_rcpf(1.0f + __expf(2.0f * y)); return 0.5f * x * (1.0f + t); }
__device__ __forceinline__ float wave_sum(float v) {
#pragma unroll
    for (int o = 1; o < 64; o <<= 1) v += __shfl_xor(v, o);
    return v;
}
__device__ __forceinline__ float row_rs(const float* ssq, size_t row) {
    const f32x4 a = *(const f32x4*)(ssq + row * 16), b = *(const f32x4*)(ssq + row * 16 + 4), c = *(const f32x4*)(ssq + row * 16 + 8), d = *(const f32x4*)(ssq + row * 16 + 12);
    const float s = ((a[0] + a[1]) + (a[2] + a[3])) + ((b[0] + b[1]) + (b[2] + b[3])) + ((c[0] + c[1]) + (c[2] + c[3])) + ((d[0] + d[1]) + (d[2] + d[3]));
    return rsqrtf(s * (1.0f / DM) + EPSN);
}
__device__ __forceinline__ int launder_tid() { int t = threadIdx.x; asm volatile("" : "+v"(t)); return t; }
#define MFMA16(a, b, c) __builtin_amdgcn_mfma_f32_16x16x32_bf16((a), (b), (c), 0, 0, 0)
__device__ __forceinline__ bf16x8 ldfrag(const LAS bf16* p) { return *(const LAS bf16x8*)p; }

struct EpiGU {
    static constexpr bool PERM = true, AFTER_DRAIN = false;
    bf16* H; const float* ssq;
    __device__ __forceinline__ void operator()(const pg8::f32x4 (&acc)[2][2][4][2], const pg8::Unit& u, int wr, int wc, int fr, int fq) const {
        const int row0 = u.pm * 256 + wr * 64 + fr, col0 = u.pn * 128 + wc * 32 + 8 * fq;
#pragma unroll
        for (int ai = 0; ai < 2; ++ai)
#pragma unroll
            for (int m = 0; m < 4; ++m) {
                const size_t row = (size_t)(row0 + ai * 128 + m * 16);
                const float rs = row_rs(ssq, row);
                const pg8::f32x4 g0 = acc[ai][0][m][0] * rs, g1 = acc[ai][0][m][1] * rs, u0 = acc[ai][1][m][0] * rs, u1 = acc[ai][1][m][1] * rs;
                u32x4 w;
                w.x = pk2(siluf(g0[0]) * u0[0], siluf(g0[1]) * u0[1]); w.y = pk2(siluf(g0[2]) * u0[2], siluf(g0[3]) * u0[3]);
                w.z = pk2(siluf(g1[0]) * u1[0], siluf(g1[1]) * u1[1]); w.w = pk2(siluf(g1[2]) * u1[2], siluf(g1[3]) * u1[3]);
                *(u32x4*)(H + row * DFF + col0) = w;
                asm volatile("" ::: "memory");
            }
    }
};
struct EpiProj {
    static constexpr bool PERM = true, AFTER_DRAIN = false;
    bf16* P; const float* ssq; int row_off;
    __device__ __forceinline__ void operator()(const pg8::f32x4 (&acc)[2][2][4][2], const pg8::Unit& u, int wr, int wc, int fr, int fq) const {
        const int row0 = u.pm * 256 + wr * 64 + fr, col0 = u.pn * 256 + wc * 32 + 8 * fq;
#pragma unroll
        for (int ai = 0; ai < 2; ++ai)
#pragma unroll
            for (int m = 0; m < 4; ++m) {
                const size_t row = (size_t)(row0 + ai * 128 + m * 16);
                const float rs = row_rs(ssq, row + row_off);
#pragma unroll
                for (int bj = 0; bj < 2; ++bj) {
                    const pg8::f32x4 v0 = acc[ai][bj][m][0] * rs, v1 = acc[ai][bj][m][1] * rs;
                    u32x4 w; w.x = pk2(v0[0], v0[1]); w.y = pk2(v0[2], v0[3]); w.z = pk2(v1[0], v1[1]); w.w = pk2(v1[2], v1[3]);
                    *(u32x4*)(P + row * PLD + col0 + bj * 128) = w;
                }
                asm volatile("" ::: "memory");
            }
    }
};
struct EpiRes {
    static constexpr bool PERM = true, AFTER_DRAIN = false;
    float* X; bf16* XB; float* ssq; float coef; int row_off;
    __device__ __forceinline__ void operator()(const pg8::f32x4 (&acc)[2][2][4][2], const pg8::Unit& u, int wr, int wc, int fr, int fq) const {
        const int row0 = row_off + u.pm * 256 + wr * 64 + fr, col0 = u.pn * 256 + wc * 32 + 8 * fq;
#pragma unroll
        for (int ai = 0; ai < 2; ++ai)
#pragma unroll
            for (int m = 0; m < 4; ++m) {
                const size_t row = (size_t)(row0 + ai * 128 + m * 16);
                float s = 0.f;
#pragma unroll
                for (int bj = 0; bj < 2; ++bj) {
                    float* xp = X + row * DM + col0 + bj * 128;
                    pg8::f32x4 x0 = *(const pg8::f32x4*)xp, x1 = *(const pg8::f32x4*)(xp + 4);
                    x0 += acc[ai][bj][m][0] * coef; x1 += acc[ai][bj][m][1] * coef;
                    *(pg8::f32x4*)xp = x0; *(pg8::f32x4*)(xp + 4) = x1;
                    s += (x0[0] * x0[0] + x0[1] * x0[1]) + (x0[2] * x0[2] + x0[3] * x0[3]) + (x1[0] * x1[0] + x1[1] * x1[1]) + (x1[2] * x1[2] + x1[3] * x1[3]);
                    u32x4 w; w.x = pk2(x0[0], x0[1]); w.y = pk2(x0[2], x0[3]); w.z = pk2(x1[0], x1[1]); w.w = pk2(x1[2], x1[3]);
                    *(u32x4*)(XB + row * DM + col0 + bj * 128) = w;
                }
                s += __shfl_xor(s, 16); s += __shfl_xor(s, 32);
                if (fq == 0) ssq[row * 16 + u.pn * 4 + wc] = s;
                asm volatile("" ::: "memory");
            }
    }
};

__device__ __forceinline__ int colmap(int kind, int n) {
    if (kind == 0) return n;
    if (kind == 1) { const int t = n >> 8, w = n & 255; return w < 128 ? 128 * t + w : DFF + 128 * t + (w - 128); }
    return n < 2304 ? n : (n < 4352 ? n + 16 : (n < 4368 ? n - 4352 + 2304 : -1));
}
__device__ __forceinline__ void transpose_item(const float* W, int K, int Nsrc, int Ndst, const float* kscale, bf16* WT, int kind, int item, int lane, LAS float* scr) {
    const int nblk = Ndst / 32, kb = item / nblk, nb = item % nblk, k0 = 64 * kb, n0 = 32 * nb;
    const int sc = colmap(kind, n0 + (lane & 31));
#pragma unroll 8
    for (int i = 0; i < 32; ++i) { const int kk = 2 * i + (lane >> 5); float v = 0.f; if (sc >= 0) { v = W[(size_t)(k0 + kk) * Nsrc + sc]; if (kscale) v *= kscale[k0 + kk]; } scr[kk * 33 + (lane & 31)] = v; }
    asm volatile("s_waitcnt lgkmcnt(0)" ::: "memory");
    const int c = lane & 7;
#pragma unroll
    for (int j = 0; j < 4; ++j) { const int n = (lane >> 3) + 8 * j; const LAS float* s = scr + (8 * c) * 33 + n;
        u32x4 o; o.x = pk2(s[0 * 33], s[1 * 33]); o.y = pk2(s[2 * 33], s[3 * 33]); o.z = pk2(s[4 * 33], s[5 * 33]); o.w = pk2(s[6 * 33], s[7 * 33]);
        *(u32x4*)(WT + (size_t)(n0 + n) * K + k0 + 8 * c) = o; }
    asm volatile("s_waitcnt lgkmcnt(0)" ::: "memory");
}

struct Args { const float* in[26]; float* out; unsigned char* ws; };

__device__ __forceinline__ f32x8 conv8(const bf16* proj, int lrow, int pcol, int pos, int seqlen, const float* cw, int cw_ld, const float* cb, int ccol) {
    f32x8 acc = ld8f(cb + ccol);
#pragma unroll
    for (int k = 0; k < 4; ++k) {
        const int s = pos + k - 2;
        if (s >= 0 && s < seqlen) {
            const u32x4 raw = *(const u32x4*)(proj + (size_t)(lrow + k - 2) * PLD + pcol);
            acc += ld8f(cw + k * cw_ld + ccol) * unpack8(raw);
        }
    }
    return acc;
}

__device__ __forceinline__ void ret_item(LAS unsigned char* lds, const bf16* proj, bf16* yout, const float* rcos, const float* rsin, int gv, int vloc, int hd, int dir) {
    const int tid = launder_tid(), wid = __builtin_amdgcn_readfirstlane(tid >> 6), lane = tid & 63, fr = lane & 15, fq = lane >> 4;
    constexpr int LD = 136;
    LAS bf16* KN = (LAS bf16*)lds; LAS bf16* KTW = KN + 128 * LD; LAS bf16* VT = KTW + 128 * LD; LAS bf16* RT = VT + 128 * LD;
    const int seqlen = gv < 8 ? 8192 : 4096;
    const float l2g = log2f(1.0f - exp2f(-5.0f - (float)hd));
    const float cdec = exp2f(l2g * 128.0f);
    const float kscale = 0.08838834764831845f;
    f32x4 R[8];
#pragma unroll
    for (int i = 0; i < 8; ++i) R[i] = (f32x4){0.f, 0.f, 0.f, 0.f};
    for (int i = tid; i < 128 * LD / 2; i += 512) ((LAS unsigned*)RT)[i] = 0u;
    __syncthreads();
    for (int c = 0; c < 64; ++c) {
        const int cc = dir ? 63 - c : c;
        const int lrow0 = vloc * 8192 + cc * 128, pos0 = (cc * 128) % seqlen;
        bool next_reset = false;
        if (c < 63) { const int ncc = dir ? cc - 1 : cc + 1; const int np = (ncc * 128) % seqlen; next_reset = dir ? (np + 128 == seqlen) : (np == 0); }
        {
            const int r = tid >> 2, c4 = tid & 3, d1 = 16 * c4;
            const bf16* kb = proj + (size_t)(lrow0 + r) * PLD + PC_K + 128 * hd;
            const float wl = exp2f(l2g * (float)(dir ? r : 127 - r));
            const int pos = pos0 + r;
#pragma unroll
            for (int hf = 0; hf < 2; ++hf) {
                const f32x8 t1 = unpack8(*(const u32x4*)(kb + d1 + 8 * hf)), t2 = unpack8(*(const u32x4*)(kb + 64 + d1 + 8 * hf));
                const f32x8 cs = ld8f(rcos + (size_t)pos * 64 + d1 + 8 * hf), sn = ld8f(rsin + (size_t)pos * 64 + d1 + 8 * hf);
                const f32x8 o1 = (t1 * cs - t2 * sn) * kscale, o2 = (t1 * sn + t2 * cs) * kscale;
                if (dir == 0) { *(LAS u32x4*)(KN + r * LD + d1 + 8 * hf) = pack8(o1); *(LAS u32x4*)(KN + r * LD + 64 + d1 + 8 * hf) = pack8(o2); }
#pragma unroll
                for (int e = 0; e < 8; ++e) { KTW[(d1 + 8 * hf + e) * LD + r] = f2bf(o1[e] * wl); KTW[(64 + d1 + 8 * hf + e) * LD + r] = f2bf(o2[e] * wl); }
            }
            const bf16* vb = proj + (size_t)(lrow0 + r) * PLD + PC_V + 128 * hd + 32 * c4;
#pragma unroll
            for (int q4 = 0; q4 < 4; ++q4) {
                const u32x4 w = *(const u32x4*)(vb + 8 * q4);
                LAS bf16* vt = VT + (32 * c4 + 8 * q4) * LD + r;
                vt[0 * LD] = (bf16)(w.x & 0xffffu); vt[1 * LD] = (bf16)(w.x >> 16); vt[2 * LD] = (bf16)(w.y & 0xffffu); vt[3 * LD] = (bf16)(w.y >> 16);
                vt[4 * LD] = (bf16)(w.z & 0xffffu); vt[5 * LD] = (bf16)(w.z >> 16); vt[6 * LD] = (bf16)(w.w & 0xffffu); vt[7 * LD] = (bf16)(w.w >> 16);
            }
        }
        const int qi = 16 * wid + fr;
        bf16x8 qf[4];
        {
            const bf16* qb = proj + (size_t)(lrow0 + qi) * PLD + PC_Q + 128 * hd + 8 * fq;
            const int pos = pos0 + qi;
#pragma unroll
            for (int ks = 0; ks < 2; ++ks) {
                const f32x8 t1 = unpack8(*(const u32x4*)(qb + 32 * ks)), t2 = unpack8(*(const u32x4*)(qb + 64 + 32 * ks));
                const f32x8 cs = ld8f(rcos + (size_t)pos * 64 + 32 * ks + 8 * fq), sn = ld8f(rsin + (size_t)pos * 64 + 32 * ks + 8 * fq);
                qf[ks] = __builtin_bit_cast(bf16x8, pack8(t1 * cs - t2 * sn)); qf[ks + 2] = __builtin_bit_cast(bf16x8, pack8(t1 * sn + t2 * cs));
            }
        }
        __syncthreads();
        unsigned sp[8][2];
        if (dir == 0) {
#pragma unroll
            for (int ct = 0; ct < 8; ++ct) {
                f32x4 a = (f32x4){0.f, 0.f, 0.f, 0.f};
#pragma unroll
                for (int ks = 0; ks < 4; ++ks) a = MFMA16(ldfrag(KN + (16 * ct + fr) * LD + 32 * ks + 8 * fq), qf[ks], a);
                const int j0 = 16 * ct + 4 * fq;
                float dv[4];
#pragma unroll
                for (int e = 0; e < 4; ++e) { const int dd = qi - (j0 + e); dv[e] = a[e] * exp2f(l2g * (float)(dd < 0 ? -dd : dd)); }
                sp[ct][0] = pk2(dv[0], dv[1]); sp[ct][1] = pk2(dv[2], dv[3]);
            }
            __syncthreads();
#pragma unroll
            for (int ct = 0; ct < 8; ++ct) { u32x2 w; w.x = sp[ct][0]; w.y = sp[ct][1]; *(LAS u32x2*)(KN + qi * LD + 16 * ct + 4 * fq) = w; }
        }
        {
            const float rsc = exp2f(l2g * (float)(dir ? 128 - qi : qi + 1));
            f32x4 Y[8];
#pragma unroll
            for (int ct = 0; ct < 8; ++ct) {
                f32x4 a = (f32x4){0.f, 0.f, 0.f, 0.f};
#pragma unroll
                for (int ks = 0; ks < 4; ++ks) a = MFMA16(ldfrag(RT + (16 * ct + fr) * LD + 32 * ks + 8 * fq), qf[ks], a);
                Y[ct] = a * rsc;
            }
            if (dir == 0) {
#pragma unroll
                for (int ks = 0; ks < 4; ++ks) {
                    const bf16x8 pf = ldfrag(KN + qi * LD + 32 * ks + 8 * fq);
#pragma unroll
                    for (int ct = 0; ct < 8; ++ct) Y[ct] = MFMA16(ldfrag(VT + (16 * ct + fr) * LD + 32 * ks + 8 * fq), pf, Y[ct]);
                }
            }
            bf16* yo = yout + (size_t)(lrow0 + qi) * YLD + 1024 + 128 * hd + 4 * fq;
#pragma unroll
            for (int ct = 0; ct < 8; ++ct) { u32x2 w; w.x = pk2(Y[ct][0], Y[ct][1]); w.y = pk2(Y[ct][2], Y[ct][3]); *(u32x2*)(yo + 16 * ct) = w; }
        }
#pragma unroll
        for (int ct = 0; ct < 8; ++ct) R[ct] *= cdec;
#pragma unroll
        for (int ks = 0; ks < 4; ++ks) {
            const bf16x8 kf = ldfrag(KTW + (16 * wid + fr) * LD + 32 * ks + 8 * fq);
#pragma unroll
            for (int ct = 0; ct < 8; ++ct) R[ct] = MFMA16(kf, ldfrag(VT + (16 * ct + fr) * LD + 32 * ks + 8 * fq), R[ct]);
        }
        if (next_reset) {
#pragma unroll
            for (int ct = 0; ct < 8; ++ct) R[ct] = (f32x4){0.f, 0.f, 0.f, 0.f};
        }
        __syncthreads();
#pragma unroll
        for (int ct = 0; ct < 8; ++ct) { u32x2 w; w.x = pk2(R[ct][0], R[ct][1]); w.y = pk2(R[ct][2], R[ct][3]); *(LAS u32x2*)(RT + (16 * ct + fr) * LD + 16 * wid + 4 * fq) = w; }
    }
    __syncthreads();
}

__device__ __forceinline__ void ssd_item(LAS unsigned char* lds, const bf16* proj, bf16* yout, const float* cw, const float* cb, const float* dt_bias, const float* a_log, const float* dskip,
                                         int gv, int vloc, int hh, int dir) {
    const int tid = launder_tid(), wid = __builtin_amdgcn_readfirstlane(tid >> 6), lane = tid & 63, fr = lane & 15, fq = lane >> 4;
    constexpr int LDL = 136, LDS_ = 72;
    LAS bf16* XST = (LAS bf16*)lds;
    LAS bf16* CN = XST + 64 * LDL;
    LAS bf16* BN = CN + 128 * LDS_;
    LAS bf16* BTW = BN + 128 * LDS_;
    LAS bf16* PP = BTW + 64 * LDL;
    LAS bf16* HL = PP + 128 * LDL;
    LAS float* DT = (LAS float*)(HL + 64 * LDS_);
    LAS float* ACUM = DT + 128;
    LAS float* CWL = ACUM + 128;
    const int seqlen = gv < 8 ? 8192 : 4096, grp = hh >> 2;
    const float aneg = -__expf(a_log[dir * 8 + hh]), dtb = dt_bias[dir * 8 + hh], dsk = dskip[hh];
    const int cg8 = tid % 24, rb = tid / 24, sec = cg8 >> 3, c8 = (cg8 & 7) * 8, i0 = 8 * rb;
    const int xc = sec == 0 ? 64 * hh + c8 : (sec == 1 ? 512 + 64 * grp + c8 : 640 + 64 * grp + c8);
    const bool stager = tid < 384;
    f32x4 Hc[2];
    Hc[0] = (f32x4){0.f, 0.f, 0.f, 0.f}; Hc[1] = (f32x4){0.f, 0.f, 0.f, 0.f};
    for (int i = tid; i < 64 * LDS_ / 2; i += 512) ((LAS unsigned*)HL)[i] = 0u;
    for (int i = tid; i < 5 * 192; i += 512) { const int k = i / 192, cc2 = i % 192, s2 = cc2 >> 6, o = cc2 & 63; const int col = s2 == 0 ? 64 * hh + o : (s2 == 1 ? 512 + 64 * grp + o : 640 + 64 * grp + o);
        CWL[i] = k < 4 ? cw[k * 768 + col] : cb[col]; }
    u32x4 raw[11]; float dtraw = 0.f;
#define SSD_LOAD(CC) do { const int lr0_ = vloc * 8192 + (CC) * 128, p0_ = ((CC) * 128) % seqlen; \
        if (stager) { _Pragma("unroll") for (int r = 0; r < 11; ++r) { const int s_ = p0_ + i0 - 2 + r; raw[r] = (u32x4){0u, 0u, 0u, 0u}; \
            if (s_ >= 0 && s_ < seqlen) raw[r] = *(const u32x4*)(proj + (size_t)(lr0_ + i0 - 2 + r) * PLD + PC_XBC + xc); } } \
        if (tid < 128) dtraw = bf2f(proj[(size_t)(lr0_ + tid) * PLD + PC_DT + dir * 8 + hh]); } while (0)
    SSD_LOAD(dir ? 63 : 0);
    __syncthreads();
    for (int c = 0; c < 64; ++c) {
        const int cc = dir ? 63 - c : c;
        const int lrow0 = vloc * 8192 + cc * 128;
        bool next_reset = false;
        if (c < 63) { const int ncc = dir ? cc - 1 : cc + 1; const int np = (ncc * 128) % seqlen; next_reset = dir ? (np + 128 == seqlen) : (np == 0); }
        if (tid < 128) DT[tid] = softplusf(dtraw + dtb);
        __syncthreads();
        float tot;
        {
            const float x0 = DT[2 * lane] * aneg, x1 = DT[2 * lane + 1] * aneg;
            float s = x0 + x1;
#pragma unroll
            for (int o = 1; o < 64; o <<= 1) { const float t = __shfl_up(s, o); if (lane >= o) s += t; }
            tot = __shfl(s, 63);
            const float p1 = s, p0 = s - x1;
            if (dir == 0) { ACUM[2 * lane] = p0; ACUM[2 * lane + 1] = p1; }
            else { ACUM[2 * lane] = tot - p0 + x0; ACUM[2 * lane + 1] = tot - p1 + x1; }
        }
        if (stager) {
#pragma unroll
            for (int hc = 0; hc < 2; ++hc) {
                const int cl = 8 * cg8 + 4 * hc;
                const f32x4 w0 = *(const LAS f32x4*)(CWL + 0 * 192 + cl), w1 = *(const LAS f32x4*)(CWL + 1 * 192 + cl), w2 = *(const LAS f32x4*)(CWL + 2 * 192 + cl),
                            w3 = *(const LAS f32x4*)(CWL + 3 * 192 + cl), bb = *(const LAS f32x4*)(CWL + 4 * 192 + cl);
                f32x4 ring[4] = {bb, bb, bb, bb};
                u32x2 pv[4];
#pragma unroll
                for (int r = 0; r < 11; ++r) {
                    const unsigned xa = raw[r][2 * hc], xb = raw[r][2 * hc + 1];
                    const f32x4 x = (f32x4){bflo(xa), bfhi(xa), bflo(xb), bfhi(xb)};
                    if (r <= 7) ring[r & 3] += w0 * x;
                    if (r >= 1 && r <= 8) ring[(r - 1) & 3] += w1 * x;
                    if (r >= 2 && r <= 9) ring[(r - 2) & 3] += w2 * x;
                    if (r >= 3) {
                        const int od = r - 3;
                        f32x4 t = ring[od & 3] + w3 * x;
                        ring[od & 3] = bb;
#pragma unroll
                        for (int e = 0; e < 4; ++e) t[e] = siluf(t[e]);
                        u32x2 pk; pk.x = pk2(t[0], t[1]); pk.y = pk2(t[2], t[3]);
                        if (sec == 0) pv[od & 3] = pk;
                        else if (sec == 1) { *(LAS u32x2*)(BN + (i0 + od) * LDS_ + c8 + 4 * hc) = pk; const float wr = __expf(tot - ACUM[i0 + od]) * DT[i0 + od];
                            u32x2 pw; pw.x = pk2(t[0] * wr, t[1] * wr); pw.y = pk2(t[2] * wr, t[3] * wr); pv[od & 3] = pw; }
                        else *(LAS u32x2*)(CN + (i0 + od) * LDS_ + c8 + 4 * hc) = pk;
                        if ((od & 3) == 3 && sec != 2) {
                            LAS bf16* dstT = (sec == 0 ? XST : BTW) + (c8 + 4 * hc) * LDL + i0 + (od - 3);
#pragma unroll
                            for (int m = 0; m < 2; ++m) {
                                u32x2 we, wo;
                                we.x = (pv[0][m] & 0xffffu) | (pv[1][m] << 16); we.y = (pv[2][m] & 0xffffu) | (pv[3][m] << 16);
                                wo.x = (pv[0][m] >> 16) | (pv[1][m] & 0xffff0000u); wo.y = (pv[2][m] >> 16) | (pv[3][m] & 0xffff0000u);
                                *(LAS u32x2*)(dstT + (2 * m) * LDL) = we; *(LAS u32x2*)(dstT + (2 * m + 1) * LDL) = wo;
                            }
                        }
                    }
                }
            }
        }
        if (c < 63) { const int ncc = dir ? cc - 1 : cc + 1; SSD_LOAD(ncc); }
        __syncthreads();
        const int qi = 16 * wid + fr;
        bf16x8 cf[2];
        cf[0] = ldfrag(CN + qi * LDS_ + 8 * fq); cf[1] = ldfrag(CN + qi * LDS_ + 32 + 8 * fq);
        const float aci = ACUM[qi];
#pragma unroll
        for (int ct = 0; ct < 8; ++ct) {
            f32x4 a = (f32x4){0.f, 0.f, 0.f, 0.f};
#pragma unroll
            for (int ks = 0; ks < 2; ++ks) a = MFMA16(ldfrag(BN + (16 * ct + fr) * LDS_ + 32 * ks + 8 * fq), cf[ks], a);
            const int j0 = 16 * ct + 4 * fq;
            const f32x4 acj = *(const LAS f32x4*)(ACUM + j0), dtj = *(const LAS f32x4*)(DT + j0);
            float wv[4];
#pragma unroll
            for (int e = 0; e < 4; ++e) { const int j = j0 + e; const bool ok = dir ? (j >= qi) : (j <= qi); wv[e] = ok ? a[e] * __expf(aci - acj[e]) * dtj[e] : 0.f; }
            u32x2 w; w.x = pk2(wv[0], wv[1]); w.y = pk2(wv[2], wv[3]);
            *(LAS u32x2*)(PP + qi * LDL + j0) = w;
        }
        {
            const float ea = __expf(aci);
            f32x4 Y[4];
#pragma unroll
            for (int pt = 0; pt < 4; ++pt) {
                f32x4 a = (f32x4){0.f, 0.f, 0.f, 0.f};
#pragma unroll
                for (int ks = 0; ks < 2; ++ks) a = MFMA16(ldfrag(HL + (16 * pt + fr) * LDS_ + 32 * ks + 8 * fq), cf[ks], a);
                Y[pt] = a * ea;
            }
#pragma unroll
            for (int ks = 0; ks < 4; ++ks) {
                const bf16x8 pf = ldfrag(PP + qi * LDL + 32 * ks + 8 * fq);
#pragma unroll
                for (int pt = 0; pt < 4; ++pt) Y[pt] = MFMA16(ldfrag(XST + (16 * pt + fr) * LDL + 32 * ks + 8 * fq), pf, Y[pt]);
            }
            bf16* yo = yout + (size_t)(lrow0 + qi) * YLD + 512 + 64 * hh + 4 * fq;
#pragma unroll
            for (int pt = 0; pt < 4; ++pt) {
                if (dir == 0) {
#pragma unroll
                    for (int e = 0; e < 4; ++e) Y[pt][e] += dsk * bf2f(XST[(16 * pt + 4 * fq + e) * LDL + qi]);
                }
                u32x2 w; w.x = pk2(Y[pt][0], Y[pt][1]); w.y = pk2(Y[pt][2], Y[pt][3]); *(u32x2*)(yo + 16 * pt) = w;
            }
        }
        {
            const float et = __expf(tot);
            Hc[0] *= et; Hc[1] *= et;
#pragma unroll
            for (int ks = 0; ks < 4; ++ks) {
                const bf16x8 xf = ldfrag(XST + (16 * (wid & 3) + fr) * LDL + 32 * ks + 8 * fq);
#pragma unroll
                for (int j2 = 0; j2 < 2; ++j2) Hc[j2] = MFMA16(ldfrag(BTW + (16 * (2 * (wid >> 2) + j2) + fr) * LDL + 32 * ks + 8 * fq), xf, Hc[j2]);
            }
            if (next_reset) { Hc[0] = (f32x4){0.f, 0.f, 0.f, 0.f}; Hc[1] = (f32x4){0.f, 0.f, 0.f, 0.f}; }
        }
        __syncthreads();
#pragma unroll
        for (int j2 = 0; j2 < 2; ++j2) { u32x2 w; w.x = pk2(Hc[j2][0], Hc[j2][1]); w.y = pk2(Hc[j2][2], Hc[j2][3]);
            *(LAS u32x2*)(HL + (16 * (wid & 3) + fr) * LDS_ + 16 * (2 * (wid >> 2) + j2) + 4 * fq) = w; }
    }
#undef SSD_LOAD
    __syncthreads();
}

__device__ __forceinline__ void lru_item(LAS unsigned char* lds, const bf16* proj, bf16* yout, const float* cw, const float* cb, const float* w_a, const float* b_a, const float* w_i, const float* b_i,
                                         const float* lam, int gv, int vloc, int nb, int dir) {
    const int tid = launder_tid(), wid = __builtin_amdgcn_readfirstlane(tid >> 6), lane = tid & 63, fr = lane & 15, fq = lane >> 4;
    constexpr int LDX = 72;
    LAS bf16* XCB = (LAS bf16*)lds;
    LAS bf16* WT = XCB + 128 * LDX;
    LAS float* AA = (LAS float*)(WT + 128 * LDX);
    LAS float* UU = AA + 128 * 64;
    LAS float* AGG = UU + 128 * 64;
    LAS float* CARRY = AGG + 8 * 64 * 2;
    LAS float* BA = CARRY + 128;
    LAS float* BI = BA + 64;
    LAS float* SP = BI + 64;
    const int seqlen = gv < 8 ? 8192 : 4096;
    for (int idx = tid; idx < 8192; idx += 512) {
        const int mat = idx >> 12, rem = idx & 4095, i = rem >> 6, j = rem & 63;
        const float* w = (mat ? w_i : w_a) + (size_t)((dir * 8 + nb) * 64 + i) * 64 + j;
        WT[(64 * mat + j) * LDX + i] = f2bf(*w);
    }
    if (tid < 64) { CARRY[tid] = 0.f; CARRY[64 + tid] = 0.f; BA[tid] = b_a[dir * 512 + 64 * nb + tid]; BI[tid] = b_i[dir * 512 + 64 * nb + tid]; SP[tid] = 8.0f * softplusf(-lam[dir * 512 + 64 * nb + tid]); }
    const int c8 = (tid & 7) * 8, i0 = 2 * (tid >> 3), ccol = 64 * nb + c8;
    const f32x8 w0 = ld8f(cw + 0 * 512 + ccol), w1 = ld8f(cw + 1 * 512 + ccol), w2 = ld8f(cw + 2 * 512 + ccol), w3 = ld8f(cw + 3 * 512 + ccol), bb = ld8f(cb + ccol);
    u32x4 raw[5];
#define LRU_LOAD(CC) do { const int lr0_ = vloc * 8192 + (CC) * 128, p0_ = ((CC) * 128) % seqlen; \
        _Pragma("unroll") for (int r = 0; r < 5; ++r) { const int s_ = p0_ + i0 - 2 + r; raw[r] = (u32x4){0u, 0u, 0u, 0u}; \
            if (s_ >= 0 && s_ < seqlen) raw[r] = *(const u32x4*)(proj + (size_t)(lr0_ + i0 - 2 + r) * PLD + PC_LRUX + ccol); } } while (0)
    LRU_LOAD(dir ? 63 : 0);
    __syncthreads();
    for (int c = 0; c < 64; ++c) {
        const int cc = dir ? 63 - c : c;
        const int lrow0 = vloc * 8192 + cc * 128;
        bool next_reset = false;
        if (c < 63) { const int ncc = dir ? cc - 1 : cc + 1; const int np = (ncc * 128) % seqlen; next_reset = dir ? (np + 128 == seqlen) : (np == 0); }
#pragma unroll
        for (int r = 0; r < 2; ++r) {
            const f32x8 v = bb + w0 * unpack8(raw[r]) + w1 * unpack8(raw[r + 1]) + w2 * unpack8(raw[r + 2]) + w3 * unpack8(raw[r + 3]);
            *(LAS u32x4*)(XCB + (i0 + r) * LDX + c8) = pack8(v);
        }
        if (c < 63) { const int ncc = dir ? cc - 1 : cc + 1; LRU_LOAD(ncc); }
        __syncthreads();
        const int t = 16 * wid + fr;
        {
            bf16x8 xf[2];
            xf[0] = ldfrag(XCB + t * LDX + 8 * fq); xf[1] = ldfrag(XCB + t * LDX + 32 + 8 * fq);
            f32x4 Gt[8];
#pragma unroll
            for (int ct = 0; ct < 8; ++ct) {
                f32x4 a = (f32x4){0.f, 0.f, 0.f, 0.f};
#pragma unroll
                for (int ks = 0; ks < 2; ++ks) a = MFMA16(ldfrag(WT + (16 * ct + fr) * LDX + 32 * ks + 8 * fq), xf[ks], a);
                Gt[ct] = a;
            }
#pragma unroll
            for (int ct = 0; ct < 4; ++ct) {
                const int c0 = 16 * ct + 4 * fq;
                const f32x4 ba = *(const LAS f32x4*)(BA + c0), bi = *(const LAS f32x4*)(BI + c0), sp = *(const LAS f32x4*)(SP + c0);
                const u32x2 xw = *(const LAS u32x2*)(XCB + t * LDX + c0);
                const float xv[4] = {bflo(xw.x), bfhi(xw.x), bflo(xw.y), bfhi(xw.y)};
                f32x4 av, uv;
#pragma unroll
                for (int e = 0; e < 4; ++e) {
                    const float r = sigm(Gt[ct][e] + ba[e]), ig = sigm(Gt[ct + 4][e] + bi[e]);
                    const float la = -r * sp[e];
                    const float a = __expf(la);
                    av[e] = a;
                    uv[e] = sqrtf(fmaxf((1.0f - a) * (1.0f + a), 0.f)) * ig * xv[e];
                }
                *(LAS f32x4*)(AA + t * 64 + c0) = av; *(LAS f32x4*)(UU + t * 64 + c0) = uv;
            }
        }
        __syncthreads();
        {
            const int ch = tid & 63, seg = tid >> 6;
            float Pp = 1.f, h = 0.f;
#pragma unroll
            for (int k = 0; k < 16; ++k) { const int o = seg * 16 + k, tt = dir ? 127 - o : o; const float a = AA[tt * 64 + ch], u = UU[tt * 64 + ch]; h = a * h + u; Pp *= a; }
            AGG[(seg * 64 + ch) * 2] = Pp; AGG[(seg * 64 + ch) * 2 + 1] = h;
            __syncthreads();
            float cin = CARRY[(c & 1) * 64 + ch];
            for (int s = 0; s < seg; ++s) cin = AGG[(s * 64 + ch) * 2] * cin + AGG[(s * 64 + ch) * 2 + 1];
            h = cin;
            bf16* yo = yout + (size_t)lrow0 * YLD + 64 * nb + ch;
#pragma unroll
            for (int k = 0; k < 16; ++k) { const int o = seg * 16 + k, tt = dir ? 127 - o : o; const float a = AA[tt * 64 + ch], u = UU[tt * 64 + ch]; h = a * h + u; yo[(size_t)tt * YLD] = f2bf(h); }
            if (seg == 7) CARRY[((c + 1) & 1) * 64 + ch] = next_reset ? 0.f : h;
        }
    }
#undef LRU_LOAD
    __syncthreads();
}

__global__ void __launch_bounds__(512, 2) mega_fwd(Args args) {
    extern __shared__ __attribute__((aligned(16))) unsigned char lds_raw[];
    LAS unsigned char* lds = (LAS unsigned char*)lds_raw;
    cg::grid_group grid = cg::this_grid();
    const int tid = threadIdx.x, lane = tid & 63, wid = __builtin_amdgcn_readfirstlane(tid >> 6), G = gridDim.x, bx = blockIdx.x;
    unsigned char* ws = args.ws;
    float* X = args.out;
    bf16* XB = (bf16*)(ws + WS_XB); float* SSQ = (float*)(ws + WS_SSQ);
    float* RCOS = (float*)(ws + WS_ROPE); float* RSIN = RCOS + 8192 * 64;
    bf16* PROJ = (bf16*)(ws + WS_PROJ); bf16* YF = (bf16*)(ws + WS_Y); bf16* YBK = (bf16*)(ws + WS_YB); bf16* HB = (bf16*)(ws + WS_H);
    const int gw = bx * 8 + wid, NGW = G * 8;

    {
        LAS float* scr = (LAS float*)(lds + wid * 16384);
        constexpr int I_GU = (DM / 64) * (NGU / 32), I_D = (DFF / 64) * (DM / 32), I_IN = (DM / 64) * (NIN / 32), I_OUT = (NMIX / 64) * (DM / 32);
        constexpr int I_LAYER = 2 * I_GU + 2 * I_D + I_IN + I_OUT;
        for (int it = gw; it < NLAYER * I_LAYER; it += NGW) {
            const int l = it / I_LAYER; int r = it % I_LAYER;
            if (r < I_GU) { transpose_item(args.in[3] + (size_t)l * DM * NGU, DM, NGU, NGU, args.in[2] + l * DM, (bf16*)(ws + WS_WGU1 + l * SZ_WGU), 1, r, lane, scr); continue; } r -= I_GU;
            if (r < I_GU) { transpose_item(args.in[23] + (size_t)l * DM * NGU, DM, NGU, NGU, args.in[22] + l * DM, (bf16*)(ws + WS_WGU2 + l * SZ_WGU), 1, r, lane, scr); continue; } r -= I_GU;
            if (r < I_D) { transpose_item(args.in[4] + (size_t)l * DFF * DM, DFF, DM, DM, nullptr, (bf16*)(ws + WS_WD1 + l * SZ_WD), 0, r, lane, scr); continue; } r -= I_D;
            if (r < I_D) { transpose_item(args.in[24] + (size_t)l * DFF * DM, DFF, DM, DM, nullptr, (bf16*)(ws + WS_WD2 + l * SZ_WD), 0, r, lane, scr); continue; } r -= I_D;
            if (r < I_IN) { transpose_item(args.in[6] + (size_t)l * DM * W_IN_SRC, DM, W_IN_SRC, NIN, args.in[5] + l * DM, (bf16*)(ws + WS_WIN + l * SZ_WIN), 2, r, lane, scr); continue; } r -= I_IN;
            transpose_item(args.in[21] + (size_t)l * NMIX * DM, NMIX, DM, DM, nullptr, (bf16*)(ws + WS_WOUT + l * SZ_WOUT), 0, r, lane, scr);
        }
        for (int m = gw; m < TT; m += NGW) {
            const float* src = m < 65536 ? args.in[0] + (size_t)m * DM : args.in[1] + (size_t)(m - 65536) * DM;
            float s = 0.f;
#pragma unroll
            for (int j = 0; j < 4; ++j) {
                const f32x4 v = *(const f32x4*)(src + 256 * j + 4 * lane);
                *(f32x4*)(X + (size_t)m * DM + 256 * j + 4 * lane) = v;
                u32x2 w; w.x = pk2(v[0], v[1]); w.y = pk2(v[2], v[3]);
                *(u32x2*)(XB + (size_t)m * DM + 256 * j + 4 * lane) = w;
                s += (v[0] * v[0] + v[1] * v[1]) + (v[2] * v[2] + v[3] * v[3]);
            }
            s = wave_sum(s);
            if (lane < 16) SSQ[(size_t)m * 16 + lane] = lane == 0 ? s : 0.f;
        }
        for (int i = bx * 512 + tid; i < 8192 * 64; i += G * 512) {
            const int pos = i >> 6, f = i & 63;
            const float inv = 1.0f / powf(10000.0f, (float)(2 * f) / 128.0f);
            const float ang = (float)pos * inv;
            RCOS[i] = cosf(ang); RSIN[i] = sinf(ang);
        }
    }
    grid.sync();

    for (int l = 0; l < NLAYER; ++l) {
        for (int st = 0; st < 3; ++st) {
            const int nsub = st == 1 ? 2 : 1;
            for (int sub = 0; sub < nsub; ++sub) {
                if (st != 1) {
                    const bf16* Wgu = (const bf16*)(ws + (st == 0 ? WS_WGU1 : WS_WGU2) + l * SZ_WGU);
                    pg8::Gemm g{XB, Wgu, TT, NGU, DM}; pg8::StaticOrder S; S.init(TT, NGU, G, bx);
                    EpiGU E{HB, SSQ};
#ifndef NO_GU
                    pg8::gemm_phase<EpiGU, pg8::StaticOrder, PG8_ALIGN, PG8_SP2>(lds, g, S, E);
#endif
                } else {
                    const bf16* Win = (const bf16*)(ws + WS_WIN + l * SZ_WIN);
                    pg8::Gemm g{XB + (size_t)sub * THALF * DM, Win, THALF, NIN, DM}; pg8::StaticOrder S; S.init(THALF, NIN, G, bx);
                    EpiProj E{PROJ, SSQ, sub * THALF};
#ifndef NO_PROJ
                    pg8::gemm_phase<EpiProj, pg8::StaticOrder, PG8_ALIGN, PG8_SP2>(lds, g, S, E);
#endif
                }
                grid.sync();
                if (st == 1) {
                    for (int item = bx; item < 200; item += G) {
                        if (item < 40) {
                            const int vloc = item >> 3, hd = (item & 7) >> 1, dir = item & 1;
#ifndef NO_RET
                            ret_item(lds, PROJ, dir ? YBK : YF, RCOS, RSIN, sub * 5 + vloc, vloc, hd, dir);
#endif
                        } else if (item < 120) {
                            const int q = item - 40, vloc = q >> 4, hh = (q & 15) >> 1, dir = q & 1;
#ifndef NO_SSD
                            ssd_item(lds, PROJ, dir ? YBK : YF, args.in[14] + (size_t)l * 4 * 768, args.in[15] + l * 768, args.in[16] + l * 16, args.in[17] + l * 16, args.in[18] + l * 8,
                                     sub * 5 + vloc, vloc, hh, dir);
#endif
                        } else {
                            const int q = item - 120, vloc = q >> 4, nb = (q & 15) >> 1, dir = q & 1;
#ifndef NO_LRU
                            lru_item(lds, PROJ, dir ? YBK : YF, args.in[7] + (size_t)l * 4 * 512, args.in[8] + l * 512, args.in[9] + (size_t)l * 2 * 8 * 64 * 64, args.in[10] + l * 1024,
                                     args.in[11] + (size_t)l * 2 * 8 * 64 * 64, args.in[12] + l * 1024, args.in[13] + l * 1024, sub * 5 + vloc, vloc, nb, dir);
#endif
                        }
                    }
                    grid.sync();
                    {
                        const float* ssd_norm = args.in[19] + l * 512; const float* ret_norm = args.in[20] + l * 512;
                        const f32x8 nw_s = ld8f(ssd_norm + 8 * lane), nw_r = ld8f(ret_norm + 8 * lane);
                        for (int row = gw; row < THALF; row += NGW) {
                            bf16* yr = YF + (size_t)row * YLD; const bf16* yb = YBK + (size_t)row * YLD; const bf16* pr = PROJ + (size_t)row * PLD;
                            {
                                const f32x8 a = unpack8(*(const u32x4*)(yr + 8 * lane)), b = unpack8(*(const u32x4*)(yb + 8 * lane)), gt = unpack8(*(const u32x4*)(pr + PC_GATE + 8 * lane));
                                f32x8 o;
#pragma unroll
                                for (int e = 0; e < 8; ++e) o[e] = (a[e] + b[e]) * gelu_tanh(gt[e]);
                                *(u32x4*)(yr + 8 * lane) = pack8(o);
                            }
                            {
                                const f32x8 a = unpack8(*(const u32x4*)(yr + 512 + 8 * lane)), b = unpack8(*(const u32x4*)(yb + 512 + 8 * lane)), z = unpack8(*(const u32x4*)(pr + PC_Z + 8 * lane));
                                f32x8 v; float ss = 0.f;
#pragma unroll
                                for (int e = 0; e < 8; ++e) { v[e] = (a[e] + b[e]) * siluf(z[e]); ss += v[e] * v[e]; }
                                ss = wave_sum(ss);
                                const float rs = rsqrtf(ss * (1.0f / 512.0f) + EPSN);
                                *(u32x4*)(yr + 512 + 8 * lane) = pack8(v * rs * nw_s);
                            }
                            {
                                const f32x8 a = unpack8(*(const u32x4*)(yr + 1024 + 8 * lane)), b = unpack8(*(const u32x4*)(yb + 1024 + 8 * lane)), gg = unpack8(*(const u32x4*)(pr + PC_G + 8 * lane));
                                f32x8 v = a + b; float s1 = 0.f;
#pragma unroll
                                for (int e = 0; e < 8; ++e) s1 += v[e];
                                s1 += __shfl_xor(s1, 1); s1 += __shfl_xor(s1, 2); s1 += __shfl_xor(s1, 4); s1 += __shfl_xor(s1, 8);
                                const float mu = s1 * (1.0f / 128.0f); float s2 = 0.f;
#pragma unroll
                                for (int e = 0; e < 8; ++e) { v[e] -= mu; s2 += v[e] * v[e]; }
                                s2 += __shfl_xor(s2, 1); s2 += __shfl_xor(s2, 2); s2 += __shfl_xor(s2, 4); s2 += __shfl_xor(s2, 8);
                                const float rs = rsqrtf(s2 * (1.0f / 128.0f) + EPSN);
                                f32x8 o;
#pragma unroll
                                for (int e = 0; e < 8; ++e) o[e] = v[e] * rs * nw_r[e] * siluf(gg[e]);
                                *(u32x4*)(yr + 1024 + 8 * lane) = pack8(o);
                            }
                        }
                    }
                    grid.sync();
                }
                {
                    pg8::Gemm g; float coef; int roff;
                    if (st != 1) { g = pg8::Gemm{HB, (const bf16*)(ws + (st == 0 ? WS_WD1 : WS_WD2) + l * SZ_WD), TT, DM, DFF}; coef = 0.5f; roff = 0; }
                    else { g = pg8::Gemm{YF, (const bf16*)(ws + WS_WOUT + l * SZ_WOUT), THALF, DM, NMIX}; coef = 1.0f; roff = sub * THALF; }
                    pg8::StaticOrder S; S.init(g.M, g.N, G, bx);
                    EpiRes E{X, XB, SSQ, coef, roff};
#ifndef NO_RES
                    pg8::gemm_phase<EpiRes, pg8::StaticOrder, PG8_ALIGN, PG8_SP2>(lds, g, S, E);
#endif
                }
                grid.sync();
            }
        }
    }
    {
        const float* fw = args.in[25];
        for (int m = gw; m < TT; m += NGW) {
            const float rs = row_rs(SSQ, (size_t)m);
#pragma unroll
            for (int j = 0; j < 4; ++j) {
                float* p = X + (size_t)m * DM + 256 * j + 4 * lane;
                const f32x4 v = *(const f32x4*)p, w = *(const f32x4*)(fw + 256 * j + 4 * lane);
                *(f32x4*)p = v * rs * w;
            }
        }
    }
}

extern "C" void kernel_launch(void* const* d_in, const int* in_sizes, int n_in, void* d_out, int out_size, void* d_ws, size_t ws_size, hipStream_t stream) {
    static int grid = 0;
    if (grid == 0) {
        if (n_in != 26 || out_size != TT * DM || ws_size < WS_NEED) { fprintf(stderr, "kernel_launch: unexpected problem (n_in %d, out %d, ws %zu, need %zu)\n", n_in, out_size, ws_size, (size_t)WS_NEED); grid = -1; return; }
        int dev = 0, cus = 0, per_cu = 0;
        if (hipGetDevice(&dev) != hipSuccess || hipDeviceGetAttribute(&cus, hipDeviceAttributeMultiprocessorCount, dev) != hipSuccess) { grid = -1; return; }
        if (hipFuncSetAttribute((const void*)mega_fwd, hipFuncAttributeMaxDynamicSharedMemorySize, LDS_BYTES) != hipSuccess) { fprintf(stderr, "kernel_launch: hipFuncSetAttribute failed\n"); grid = -1; return; }
        if (hipOccupancyMaxActiveBlocksPerMultiprocessor(&per_cu, (const void*)mega_fwd, 512, LDS_BYTES) != hipSuccess || per_cu < 1) { fprintf(stderr, "kernel_launch: occupancy query says %d\n", per_cu); per_cu = 1; }
        (void)hipGetLastError();
        grid = cus;
    }
    if (grid < 0) return;
    Args a{};
    for (int i = 0; i < 26; ++i) a.in[i] = (const float*)d_in[i];
    a.out = (float*)d_out; a.ws = (unsigned char*)d_ws;
    void* kargs[] = {&a};
    hipError_t e = hipLaunchCooperativeKernel((const void*)mega_fwd, dim3(grid), dim3(512), kargs, LDS_BYTES, stream);
    if (e != hipSuccess) fprintf(stderr, "kernel_launch: cooperative launch failed: %s (grid %d)\n", hipGetErrorString(e), grid);
}
```

```cpp
#include <hip/hip_runtime.h>
#include <hip/hip_cooperative_groups.h>
#include <cstdio>
#include <cstdint>
namespace cg = cooperative_groups;
namespace pg8 {
#define PG8_LAS __attribute__((address_space(3)))
typedef unsigned short bf16_t;
typedef short bf16x8 __attribute__((ext_vector_type(8)));
typedef float f32x4 __attribute__((ext_vector_type(4)));
typedef unsigned u32x4 __attribute__((ext_vector_type(4)));
constexpr int BM = 256, BK = 64, HALF = 128, HTB = HALF * BK * 2  , STAGE_BYTES = 8 * HTB, NXCD = 8, WGM = 8;

__host__ __device__ __forceinline__ int lds_byte(int r, int c) { const int st = (r >> 4) * 2 + (c >> 5), rr = r & 15, cc = c & 31, ob = rr * 64 + cc * 2; return st * 1024 + (ob ^ (((ob >> 9) & 1) << 5)); }
__host__ __device__ __forceinline__ void stage_rc(int b, int& R, int& C) { const int st = b / 1024, sb = b % 1024, swz = sb ^ (((sb >> 9) & 1) << 5); R = (st >> 1) * 16 + swz / 64; C = (st & 1) * 32 + (swz % 64) / 2; }
__host__ __device__ __forceinline__ int perm32(int rho) { const int n = rho >> 4, i = rho & 15; return 8 * (i >> 2) + 4 * n + (i & 3); }

struct Unit { int pm, pn; };
struct Gemm { const bf16_t* A; const bf16_t* Bt; int M, N, K; };

struct StaticOrder {
    int nM, nN, nwg, G, c;
    __host__ __device__ void init(int M, int N, int G_, int c_) { nM = M / BM; nN = N / BM; nwg = nM * nN; G = G_; c = c_; }
    __host__ __device__ bool next(int i, Unit& u) const {
        const long L = (long)i * G + c; if (L >= nwg) return false;
        int wgid = (int)L; { const int q = nwg / NXCD, r = nwg % NXCD, xcd = wgid % NXCD, off = wgid / NXCD; wgid = (xcd < r ? xcd * (q + 1) : r * (q + 1) + (xcd - r) * q) + off; }
        const int nig = WGM * nN, gid = wgid / nig, fm = gid * WGM, gsz = (nM - fm) < WGM ? (nM - fm) : WGM;
        u.pm = fm + ((wgid % nig) % gsz); u.pn = (wgid % nig) / gsz; return true;
    }
    __device__ __forceinline__ void a_ready(const Unit&) const {}
    __device__ __forceinline__ void done(const Unit&) const {}
};

__device__ __forceinline__ unsigned cvt_pk_bf16(float lo, float hi) { unsigned r; asm volatile("v_cvt_pk_bf16_f32 %0, %1, %2" : "=v"(r) : "v"(lo), "v"(hi)); return r; }
typedef float f32x2 __attribute__((ext_vector_type(2)));
template <class Epi, class Sched, bool ALIGN_EPI = false, bool SP2 = false>
__device__ __forceinline__ void gemm_phase(PG8_LAS unsigned char* lds, const Gemm g, const Sched& S, const Epi& E) {
    int tid_l = threadIdx.x; asm volatile("" : "+v"(tid_l));
    const int tid = tid_l, wid = __builtin_amdgcn_readfirstlane(tid >> 6), lane = tid & 63, wr = wid >> 2, wc = wid & 3, fr = lane & 15, fq = lane >> 4;
    const int K = g.K, nt = K / BK;
    unsigned voffA[2], voffB[2];
#pragma unroll
    for (int i = 0; i < 2; ++i) { int R, C; stage_rc(tid * 16 + i * 8192, R, C); const int Rb = Epi::PERM ? ((R & ~31) + perm32(R & 31)) : R;
        voffA[i] = (unsigned)(R * K + C) * 2u; voffB[i] = (unsigned)(Rb * K + C) * 2u; }
    const size_t kstep = (size_t)(BK * 2);
    const size_t hstep = (size_t)HALF * K * 2;
    const size_t tstep = 2 * hstep;
    const unsigned ldsw = (unsigned)wid * 1024u;
    const int aoff = lds_byte(wr * 64 + fr, fq * 8), boff = lds_byte(wc * 32 + fr, fq * 8);
#define PG8_SA(b, h) (((b) * 2 + (h)) * HTB)
#define PG8_SB(b, h) ((4 + (b) * 2 + (h)) * HTB)
#define PG8_STAGE(bufoff, gbase, voff) do { _Pragma("unroll") for (int _i = 0; _i < 2; ++_i) \
        __builtin_amdgcn_global_load_lds((const unsigned*)((const char*)(gbase) + (voff)[_i]), (PG8_LAS unsigned*)(lds + (bufoff) + ldsw + _i * 8192), 16, 0, 0); } while (0)
#define PG8_LDA(dst, b, h) do { _Pragma("unroll") for (int m = 0; m < 4; ++m) _Pragma("unroll") for (int k = 0; k < 2; ++k) dst[m][k] = *(const PG8_LAS bf16x8*)(lds + PG8_SA(b, h) + aoff + m * 2048 + k * 1024); } while (0)
#define PG8_LDB(dst, b, h) do { _Pragma("unroll") for (int n = 0; n < 2; ++n) _Pragma("unroll") for (int k = 0; k < 2; ++k) dst[n][k] = *(const PG8_LAS bf16x8*)(lds + PG8_SB(b, h) + boff + n * 2048 + k * 1024); } while (0)
#define PG8_MMA(ai, bj, At, Bt) do { __builtin_amdgcn_s_setprio(1); _Pragma("unroll") for (int m = 0; m < 4; ++m) _Pragma("unroll") for (int n = 0; n < 2; ++n) _Pragma("unroll") for (int k = 0; k < 2; ++k) \
        acc[ai][bj][m][n] = __builtin_amdgcn_mfma_f32_16x16x32_bf16(Bt[n][k], At[m][k], acc[ai][bj][m][n], 0, 0, 0); __builtin_amdgcn_s_setprio(0); } while (0)
#define PG8_WAIT_V(n) asm volatile("s_waitcnt vmcnt(" #n ")" ::: "memory")
#define PG8_WAIT_L(n) asm volatile("s_waitcnt lgkmcnt(" #n ")" ::: "memory")
#define PG8_BAR __builtin_amdgcn_s_barrier()
#define PG8_SCHED __builtin_amdgcn_sched_barrier(0)
    Unit cur, nxt; int ui = 0;
    if (!S.next(0, cur)) return;
    f32x4 acc[2][2][4][2];
#pragma unroll
    for (int a = 0; a < 2; ++a)
#pragma unroll
        for (int b = 0; b < 2; ++b)
#pragma unroll
            for (int m = 0; m < 4; ++m)
#pragma unroll
                for (int n = 0; n < 2; ++n) acc[a][b][m][n] = (f32x4){0.f, 0.f, 0.f, 0.f};
    bf16x8 At[4][2], B0[2][2], B1[2][2];
    const char* cA = (const char*)g.A + (size_t)cur.pm * tstep; const char* cB = (const char*)g.Bt + (size_t)cur.pn * tstep;
    S.a_ready(cur);
    if constexpr (SP2) {
        PG8_STAGE(PG8_SB(0, 0), cB, voffB); PG8_STAGE(PG8_SB(0, 1), cB + hstep, voffB); PG8_STAGE(PG8_SA(0, 0), cA, voffA); PG8_STAGE(PG8_SA(0, 1), cA + hstep, voffA);
        if (wr == 1) PG8_BAR;
        PG8_WAIT_V(2); PG8_BAR;
        PG8_STAGE(PG8_SB(1, 0), cB + kstep, voffB); PG8_STAGE(PG8_SA(1, 0), cA + kstep, voffA); PG8_STAGE(PG8_SB(1, 1), cB + hstep + kstep, voffB);
        PG8_WAIT_V(6); PG8_BAR;
    } else {
        PG8_STAGE(PG8_SB(0, 0), cB, voffB); PG8_STAGE(PG8_SA(0, 0), cA, voffA); PG8_STAGE(PG8_SB(0, 1), cB + hstep, voffB); PG8_STAGE(PG8_SA(0, 1), cA + hstep, voffA);
        if (wr == 1) PG8_BAR;
        PG8_WAIT_V(4); PG8_BAR;
        PG8_STAGE(PG8_SB(1, 0), cB + kstep, voffB); PG8_STAGE(PG8_SA(1, 0), cA + kstep, voffA); PG8_STAGE(PG8_SB(1, 1), cB + hstep + kstep, voffB);
        PG8_WAIT_V(6); PG8_BAR;
    }
    for (;;) {
        const bool has_next = S.next(ui + 1, nxt);
        const char* nA = has_next ? (const char*)g.A + (size_t)nxt.pm * tstep : cA; const char* nB = has_next ? (const char*)g.Bt + (size_t)nxt.pn * tstep : cB;
        for (int t = 0; t < nt; t += 2) {
            const bool last = (t == nt - 2);
            const char* a1 = cA + (size_t)(t + 1) * kstep;
            const char* a2 = last ? nA : cA + (size_t)(t + 2) * kstep; const char* b2 = last ? nB : cB + (size_t)(t + 2) * kstep;
            const char* a3 = a2 + kstep; const char* b3 = b2 + kstep;
            if (last && has_next) S.a_ready(nxt);
            if constexpr (SP2) {
            PG8_LDB(B0, 0, 0); PG8_LDB(B1, 0, 1); PG8_SCHED; PG8_LDA(At, 0, 0); PG8_STAGE(PG8_SA(1, 1), a1 + hstep, voffA);
            PG8_WAIT_V(8); PG8_WAIT_L(0); PG8_BAR; PG8_MMA(0, 0, At, B0); PG8_MMA(0, 1, At, B1); PG8_BAR; PG8_SCHED;
            PG8_LDA(At, 0, 1); PG8_STAGE(PG8_SB(0, 0), b2, voffB); PG8_STAGE(PG8_SB(0, 1), b2 + hstep, voffB); PG8_STAGE(PG8_SA(0, 0), a2, voffA);
            PG8_WAIT_V(8); PG8_WAIT_L(0); PG8_BAR; PG8_MMA(1, 0, At, B0); PG8_MMA(1, 1, At, B1); PG8_BAR; PG8_SCHED;
            PG8_LDB(B0, 1, 0); PG8_LDB(B1, 1, 1); PG8_SCHED; PG8_LDA(At, 1, 0); PG8_STAGE(PG8_SA(0, 1), a2 + hstep, voffA);
            PG8_WAIT_V(8); PG8_WAIT_L(0); PG8_BAR; PG8_MMA(0, 0, At, B0); PG8_MMA(0, 1, At, B1); PG8_BAR; PG8_SCHED;
            PG8_LDA(At, 1, 1); PG8_STAGE(PG8_SB(1, 0), b3, voffB); PG8_STAGE(PG8_SB(1, 1), b3 + hstep, voffB); PG8_STAGE(PG8_SA(1, 0), a3, voffA);
            PG8_WAIT_V(8); PG8_WAIT_L(0); PG8_BAR; PG8_MMA(1, 0, At, B0); PG8_MMA(1, 1, At, B1); PG8_BAR; PG8_SCHED;
            } else {
            PG8_LDB(B0, 0, 0); PG8_SCHED; PG8_LDA(At, 0, 0); PG8_STAGE(PG8_SA(1, 1), a1 + hstep, voffA);
            PG8_WAIT_L(8); PG8_BAR; PG8_WAIT_L(0); PG8_MMA(0, 0, At, B0); PG8_BAR; PG8_SCHED;
            PG8_LDB(B1, 0, 1); PG8_STAGE(PG8_SB(0, 0), b2, voffB);
            PG8_BAR; PG8_WAIT_L(0); PG8_MMA(0, 1, At, B1); PG8_BAR;
            PG8_LDA(At, 0, 1); PG8_STAGE(PG8_SA(0, 0), a2, voffA);
            PG8_BAR; PG8_WAIT_L(0); PG8_MMA(1, 0, At, B0); PG8_BAR; PG8_SCHED;
            PG8_STAGE(PG8_SB(0, 1), b2 + hstep, voffB);
            PG8_WAIT_V(6); PG8_BAR; PG8_MMA(1, 1, At, B1); PG8_BAR;
            PG8_LDB(B0, 1, 0); PG8_SCHED; PG8_LDA(At, 1, 0); PG8_STAGE(PG8_SA(0, 1), a2 + hstep, voffA);
            PG8_WAIT_L(8); PG8_BAR; PG8_WAIT_L(0); PG8_MMA(0, 0, At, B0); PG8_BAR; PG8_SCHED;
            PG8_LDB(B1, 1, 1); PG8_STAGE(PG8_SB(1, 0), b3, voffB);
            PG8_BAR; PG8_WAIT_L(0); PG8_MMA(0, 1, At, B1); PG8_BAR;
            PG8_LDA(At, 1, 1); PG8_STAGE(PG8_SA(1, 0), a3, voffA);
            PG8_BAR; PG8_WAIT_L(0); PG8_MMA(1, 0, At, B0); PG8_BAR; PG8_SCHED;
            PG8_STAGE(PG8_SB(1, 1), b3 + hstep, voffB);
            PG8_WAIT_V(6); PG8_BAR; PG8_MMA(1, 1, At, B1); PG8_BAR;
            }
        }
        if constexpr (ALIGN_EPI) { if (wr == 0) PG8_BAR; }
        if constexpr (!Epi::AFTER_DRAIN) { E(acc, cur, wr, wc, fr, fq); S.done(cur); }
        if (!has_next) break;
#pragma unroll
        for (int a = 0; a < 2; ++a)
#pragma unroll
            for (int b = 0; b < 2; ++b)
#pragma unroll
                for (int m = 0; m < 4; ++m)
#pragma unroll
                    for (int n = 0; n < 2; ++n) acc[a][b][m][n] = (f32x4){0.f, 0.f, 0.f, 0.f};
        cur = nxt; cA = nA; cB = nB; ++ui;
        if constexpr (ALIGN_EPI) { if (wr == 1) PG8_BAR; }
    }
    PG8_WAIT_V(0);
    if constexpr (!ALIGN_EPI) { if (wr == 0) PG8_BAR; }
    PG8_BAR;
    if constexpr (Epi::AFTER_DRAIN) { E.fused(acc, cur, wr, wc, fr, fq, lds, wid, lane); S.done(cur); }
#undef PG8_SA
#undef PG8_SB
#undef PG8_STAGE
#undef PG8_LDA
#undef PG8_LDB
#undef PG8_MMA
#undef PG8_WAIT_V
#undef PG8_WAIT_L
#undef PG8_BAR
#undef PG8_SCHED
}
}
#ifndef PG8_SP2
#define PG8_SP2 true
#endif
#ifndef PG8_ALIGN
#define PG8_ALIGN true
#endif

#define LAS __attribute__((address_space(3)))
typedef unsigned short bf16;
typedef float f32x4 __attribute__((ext_vector_type(4)));
typedef float f32x8 __attribute__((ext_vector_type(8)));
typedef short bf16x8 __attribute__((ext_vector_type(8)));
typedef unsigned u32x4 __attribute__((ext_vector_type(4)));
typedef unsigned u32x2 __attribute__((ext_vector_type(2)));

constexpr int DM = 1024, DFF = 2816, NGU = 5632, NIN = 4608, NMIX = 1536, NLAYER = 4;
constexpr int TT = 81920, THALF = 40960, PLD = NIN  , YLD = NMIX;
constexpr int W_IN_SRC = 4368;
constexpr float EPSN = 1e-6f;
constexpr int PC_LRUX = 0, PC_GATE = 512, PC_Z = 1024, PC_XBC = 1536, PC_Q = 2304, PC_K = 2816, PC_V = 3328, PC_G = 3840, PC_DT = 4352;

constexpr size_t al256(size_t x) { return (x + 255) & ~(size_t)255; }
constexpr size_t SZ_WGU = (size_t)NGU * DM * 2, SZ_WD = (size_t)DM * DFF * 2, SZ_WIN = (size_t)NIN * DM * 2, SZ_WOUT = (size_t)DM * NMIX * 2;
constexpr size_t WS_WGU1 = 0;
constexpr size_t WS_WD1 = WS_WGU1 + NLAYER * SZ_WGU;
constexpr size_t WS_WIN = WS_WD1 + NLAYER * SZ_WD;
constexpr size_t WS_WOUT = WS_WIN + NLAYER * SZ_WIN;
constexpr size_t WS_WGU2 = WS_WOUT + NLAYER * SZ_WOUT;
constexpr size_t WS_WD2 = WS_WGU2 + NLAYER * SZ_WGU;
constexpr size_t WS_XB = al256(WS_WD2 + NLAYER * SZ_WD);
constexpr size_t WS_SSQ = al256(WS_XB + (size_t)TT * DM * 2);
constexpr size_t WS_ROPE = al256(WS_SSQ + (size_t)TT * 16 * 4);
constexpr size_t WS_BIG = al256(WS_ROPE + (size_t)8192 * 64 * 4 * 2);
constexpr size_t WS_PROJ = WS_BIG;
constexpr size_t WS_Y = al256(WS_PROJ + (size_t)THALF * PLD * 2);
constexpr size_t WS_YB = al256(WS_Y + (size_t)THALF * YLD * 2);
constexpr size_t WS_END1 = al256(WS_YB + (size_t)THALF * YLD * 2);
constexpr size_t WS_H = WS_BIG;
constexpr size_t WS_END2 = al256(WS_H + (size_t)TT * DFF * 2);
constexpr size_t WS_NEED = WS_END1 > WS_END2 ? WS_END1 : WS_END2;

constexpr int LDS_BYTES = 147456;

__device__ __forceinline__ float bflo(unsigned w) { return __builtin_bit_cast(float, w << 16); }
__device__ __forceinline__ float bfhi(unsigned w) { return __builtin_bit_cast(float, w & 0xffff0000u); }
__device__ __forceinline__ float bf2f(bf16 b) { return __builtin_bit_cast(float, (unsigned)b << 16); }
__device__ __forceinline__ bf16 f2bf(float f) { unsigned u = __builtin_bit_cast(unsigned, f); return (bf16)((u + 0x7fffu + ((u >> 16) & 1u)) >> 16); }
__device__ __forceinline__ unsigned pk2(float lo, float hi) { return pg8::cvt_pk_bf16(lo, hi); }
__device__ __forceinline__ f32x8 unpack8(u32x4 w) { f32x8 o; o[0] = bflo(w.x); o[1] = bfhi(w.x); o[2] = bflo(w.y); o[3] = bfhi(w.y); o[4] = bflo(w.z); o[5] = bfhi(w.z); o[6] = bflo(w.w); o[7] = bfhi(w.w); return o; }
__device__ __forceinline__ u32x4 pack8(f32x8 v) { u32x4 w; w.x = pk2(v[0], v[1]); w.y = pk2(v[2], v[3]); w.z = pk2(v[4], v[5]); w.w = pk2(v[6], v[7]); return w; }
__device__ __forceinline__ f32x8 ld8f(const float* p) { const f32x4 a = *(const f32x4*)p, b = *(const f32x4*)(p + 4); f32x8 o; o[0] = a[0]; o[1] = a[1]; o[2] = a[2]; o[3] = a[3]; o[4] = b[0]; o[5] = b[1]; o[6] = b[2]; o[7] = b[3]; return o; }
__device__ __forceinline__ float sigm(float x) { return __builtin_amdgcn_rcpf(1.0f + __expf(-x)); }
__device__ __forceinline__ float siluf(float x) { return x * sigm(x); }
__device__ __forceinline__ float softplusf(float x) { return fmaxf(x, 0.f) + log1pf(__expf(-fabsf(x))); }
__device__ __forceinline__ float gelu_tanh(float x) { const float y = 0.7978845608028654f * (x + 0.044715f * x * x * x); const float t = 1.0f - 2.0f * __builtin_amdgcn_rcpf(1.0f + __expf(2.0f * y)); return 0.5f * x * (1.0f + t); }
__device__ __forceinline__ float wave_sum(float v) {
#pragma unroll
    for (int o = 1; o < 64; o <<= 1) v += __shfl_xor(v, o);
    return v;
}
__device__ __forceinline__ float row_rs(const float* ssq, size_t row) {
    const f32x4 a = *(const f32x4*)(ssq + row * 16), b = *(const f32x4*)(ssq + row * 16 + 4), c = *(const f32x4*)(ssq + row * 16 + 8), d = *(const f32x4*)(ssq + row * 16 + 12);
    const float s = ((a[0] + a[1]) + (a[2] + a[3])) + ((b[0] + b[1]) + (b[2] + b[3])) + ((c[0] + c[1]) + (c[2] + c[3])) + ((d[0] + d[1]) + (d[2] + d[3]));
    return rsqrtf(s * (1.0f / DM) + EPSN);
}
__device__ __forceinline__ int launder_tid() { int t = threadIdx.x; asm volatile("" : "+v"(t)); return t; }
#define MFMA16(a, b, c) __builtin_amdgcn_mfma_f32_16x16x32_bf16((a), (b), (c), 0, 0, 0)
__device__ __forceinline__ bf16x8 ldfrag(const LAS bf16* p) { return *(const LAS bf16x8*)p; }

struct EpiGU {
    static constexpr bool PERM = true, AFTER_DRAIN = false;
    bf16* H; const float* ssq;
    __device__ __forceinline__ void operator()(const pg8::f32x4 (&acc)[2][2][4][2], const pg8::Unit& u, int wr, int wc, int fr, int fq) const {
        const int row0 = u.pm * 256 + wr * 64 + fr, col0 = u.pn * 128 + wc * 32 + 8 * fq;
#pragma unroll
        for (int ai = 0; ai < 2; ++ai)
#pragma unroll
            for (int m = 0; m < 4; ++m) {
                const size_t row = (size_t)(row0 + ai * 128 + m * 16);
                const float rs = row_rs(ssq, row);
                const pg8::f32x4 g0 = acc[ai][0][m][0] * rs, g1 = acc[ai][0][m][1] * rs, u0 = acc[ai][1][m][0] * rs, u1 = acc[ai][1][m][1] * rs;
                u32x4 w;
                w.x = pk2(siluf(g0[0]) * u0[0], siluf(g0[1]) * u0[1]); w.y = pk2(siluf(g0[2]) * u0[2], siluf(g0[3]) * u0[3]);
                w.z = pk2(siluf(g1[0]) * u1[0], siluf(g1[1]) * u1[1]); w.w = pk2(siluf(g1[2]) * u1[2], siluf(g1[3]) * u1[3]);
                *(u32x4*)(H + row * DFF + col0) = w;
                asm volatile("" ::: "memory");
            }
    }
};
struct EpiProj {
    static constexpr bool PERM = true, AFTER_DRAIN = false;
    bf16* P; const float* ssq; int row_off; const float* rcos; const float* rsin;
    __device__ __forceinline__ void operator()(const pg8::f32x4 (&acc)[2][2][4][2], const pg8::Unit& u, int wr, int wc, int fr, int fq) const {
        const int row0 = u.pm * 256 + wr * 64 + fr, col0 = u.pn * 256 + wc * 32 + 8 * fq;
        if (u.pn >= 9 && u.pn <= 12) {
            const float ksc = u.pn >= 11 ? 0.08838834764831845f : 1.0f;
            const int d0 = 32 * (wc & 1) + 8 * fq, colr = u.pn * 256 + 128 * (wc >> 1) + d0;
#pragma unroll
            for (int ai = 0; ai < 2; ++ai)
#pragma unroll
                for (int m = 0; m < 4; ++m) {
                    const size_t row = (size_t)(row0 + ai * 128 + m * 16);
                    const int gr = (int)row + row_off, pos = gr < 65536 ? (gr & 8191) : (gr & 4095);
                    const float rs = row_rs(ssq, (size_t)gr) * ksc;
                    u32x4 w1, w2;
#pragma unroll
                    for (int n = 0; n < 2; ++n) {
                        const pg8::f32x4 cs = *(const pg8::f32x4*)(rcos + (size_t)pos * 64 + d0 + 4 * n), sn = *(const pg8::f32x4*)(rsin + (size_t)pos * 64 + d0 + 4 * n);
                        const pg8::f32x4 t1 = acc[ai][0][m][n] * rs, t2 = acc[ai][1][m][n] * rs;
                        const pg8::f32x4 o1 = t1 * cs - t2 * sn, o2 = t1 * sn + t2 * cs;
                        if (n == 0) { w1.x = pk2(o1[0], o1[1]); w1.y = pk2(o1[2], o1[3]); w2.x = pk2(o2[0], o2[1]); w2.y = pk2(o2[2], o2[3]); }
                        else { w1.z = pk2(o1[0], o1[1]); w1.w = pk2(o1[2], o1[3]); w2.z = pk2(o2[0], o2[1]); w2.w = pk2(o2[2], o2[3]); }
                    }
                    *(u32x4*)(P + row * PLD + colr) = w1; *(u32x4*)(P + row * PLD + colr + 64) = w2;
                    asm volatile("" ::: "memory");
                }
            return;
        }
#pragma unroll
        for (int ai = 0; ai < 2; ++ai)
#pragma unroll
            for (int m = 0; m < 4; ++m) {
                const size_t row = (size_t)(row0 + ai * 128 + m * 16);
                const float rs = row_rs(ssq, row + row_off);
#pragma unroll
                for (int bj = 0; bj < 2; ++bj) {
                    const pg8::f32x4 v0 = acc[ai][bj][m][0] * rs, v1 = acc[ai][bj][m][1] * rs;
                    u32x4 w; w.x = pk2(v0[0], v0[1]); w.y = pk2(v0[2], v0[3]); w.z = pk2(v1[0], v1[1]); w.w = pk2(v1[2], v1[3]);
                    *(u32x4*)(P + row * PLD + col0 + bj * 128) = w;
                }
                asm volatile("" ::: "memory");
            }
    }
};
struct EpiRes {
    static constexpr bool PERM = true, AFTER_DRAIN = false;
    float* X; bf16* XB; float* ssq; float coef; int row_off;
    __device__ __forceinline__ void operator()(const pg8::f32x4 (&acc)[2][2][4][2], const pg8::Unit& u, int wr, int wc, int fr, int fq) const {
        const int row0 = row_off + u.pm * 256 + wr * 64 + fr, col0 = u.pn * 256 + wc * 32 + 8 * fq;
#pragma unroll
        for (int ai = 0; ai < 2; ++ai)
#pragma unroll
            for (int m = 0; m < 4; ++m) {
                const size_t row = (size_t)(row0 + ai * 128 + m * 16);
                float s = 0.f;
#pragma unroll
                for (int bj = 0; bj < 2; ++bj) {
                    float* xp = X + row * DM + col0 + bj * 128;
                    pg8::f32x4 x0 = *(const pg8::f32x4*)xp, x1 = *(const pg8::f32x4*)(xp + 4);
                    x0 += acc[ai][bj][m][0] * coef; x1 += acc[ai][bj][m][1] * coef;
                    *(pg8::f32x4*)xp = x0; *(pg8::f32x4*)(xp + 4) = x1;
                    s += (x0[0] * x0[0] + x0[1] * x0[1]) + (x0[2] * x0[2] + x0[3] * x0[3]) + (x1[0] * x1[0] + x1[1] * x1[1]) + (x1[2] * x1[2] + x1[3] * x1[3]);
                    u32x4 w; w.x = pk2(x0[0], x0[1]); w.y = pk2(x0[2], x0[3]); w.z = pk2(x1[0], x1[1]); w.w = pk2(x1[2], x1[3]);
                    *(u32x4*)(XB + row * DM + col0 + bj * 128) = w;
                }
                s += __shfl_xor(s, 16); s += __shfl_xor(s, 32);
                if (fq == 0) ssq[row * 16 + u.pn * 4 + wc] = s;
                asm volatile("" ::: "memory");
            }
    }
};

__device__ __forceinline__ int colmap(int kind, int n) {
    if (kind == 0) return n;
    if (kind == 1) { const int t = n >> 8, w = n & 255; return w < 128 ? 128 * t + w : DFF + 128 * t + (w - 128); }
    if (n < 2304) return n;
    if (n < 3328) { const int t = n >> 8, w = n & 255, bj = w >> 7, o = w & 127; return 256 * t + 128 * (o >> 6) + (o & 63) + 64 * bj + 16; }
    return n < 4352 ? n + 16 : (n < 4368 ? n - 4352 + 2304 : -1);
}
__device__ __forceinline__ void transpose_item(const float* W, int K, int Nsrc, int Ndst, const float* kscale, bf16* WT, int kind, int item, int lane, LAS float* scr) {
    const int nblk = Ndst / 32, kb = item / nblk, nb = item % nblk, k0 = 64 * kb, n0 = 32 * nb;
    const int sc = colmap(kind, n0 + (lane & 31));
#pragma unroll 8
    for (int i = 0; i < 32; ++i) { const int kk = 2 * i + (lane >> 5); float v = 0.f; if (sc >= 0) { v = W[(size_t)(k0 + kk) * Nsrc + sc]; if (kscale) v *= kscale[k0 + kk]; } scr[kk * 33 + (lane & 31)] = v; }
    asm volatile("s_waitcnt lgkmcnt(0)" ::: "memory");
    const int c = lane & 7;
#pragma unroll
    for (int j = 0; j < 4; ++j) { const int n = (lane >> 3) + 8 * j; const LAS float* s = scr + (8 * c) * 33 + n;
        u32x4 o; o.x = pk2(s[0 * 33], s[1 * 33]); o.y = pk2(s[2 * 33], s[3 * 33]); o.z = pk2(s[4 * 33], s[5 * 33]); o.w = pk2(s[6 * 33], s[7 * 33]);
        *(u32x4*)(WT + (size_t)(n0 + n) * K + k0 + 8 * c) = o; }
    asm volatile("s_waitcnt lgkmcnt(0)" ::: "memory");
}

struct Args { const float* in[26]; float* out; unsigned char* ws; };
typedef const __attribute__((address_space(4))) Args* KArgsPtr;
__device__ __forceinline__ KArgsPtr kargs() { KArgsPtr p = (KArgsPtr)__builtin_amdgcn_kernarg_segment_ptr(); asm volatile("" : "+s"(p)); return p; }

__device__ __forceinline__ f32x8 conv8(const bf16* proj, int lrow, int pcol, int pos, int seqlen, const float* cw, int cw_ld, const float* cb, int ccol) {
    f32x8 acc = ld8f(cb + ccol);
#pragma unroll
    for (int k = 0; k < 4; ++k) {
        const int s = pos + k - 2;
        if (s >= 0 && s < seqlen) {
            const u32x4 raw = *(const u32x4*)(proj + (size_t)(lrow + k - 2) * PLD + pcol);
            acc += ld8f(cw + k * cw_ld + ccol) * unpack8(raw);
        }
    }
    return acc;
}

__device__ __forceinline__ void ret_item(LAS unsigned char* lds, const bf16* proj, bf16* yout, int gv, int vloc, int hd, int dir) {
    const int tid = launder_tid(), wid = __builtin_amdgcn_readfirstlane(tid >> 6), lane = tid & 63, fr = lane & 15, fq = lane >> 4;
    constexpr int LD = 136;
    LAS bf16* KN = (LAS bf16*)lds; LAS bf16* KTW = KN + 128 * LD; LAS bf16* VT = KTW + 128 * LD; LAS bf16* RT = VT + 128 * LD;
    const int seqlen = gv < 8 ? 8192 : 4096;
    const float l2g = log2f(1.0f - exp2f(-5.0f - (float)hd));
    const float cdec = exp2f(l2g * 128.0f);
    const int i0 = 4 * (tid >> 4), c8 = 8 * (tid & 15), qi = 16 * wid + fr;
    float wl[4];
#pragma unroll
    for (int r = 0; r < 4; ++r) wl[r] = exp2f(l2g * (float)(dir ? i0 + r : 127 - (i0 + r)));
    const float rsc = exp2f(l2g * (float)(dir ? 128 - qi : qi + 1));
    f32x4 R[8];
#pragma unroll
    for (int i = 0; i < 8; ++i) R[i] = (f32x4){0.f, 0.f, 0.f, 0.f};
    for (int i = tid; i < 128 * LD / 2; i += 512) ((LAS unsigned*)RT)[i] = 0u;
    u32x4 kraw[4], vraw[4], qraw[4];
#define RET_LOAD(CC) do { const int lr0_ = vloc * 8192 + (CC) * 128; \
        _Pragma("unroll") for (int r = 0; r < 4; ++r) { const bf16* rp_ = proj + (size_t)(lr0_ + i0 + r) * PLD + 128 * hd + c8; kraw[r] = *(const u32x4*)(rp_ + PC_K); vraw[r] = *(const u32x4*)(rp_ + PC_V); } \
        _Pragma("unroll") for (int ks = 0; ks < 4; ++ks) qraw[ks] = *(const u32x4*)(proj + (size_t)(lr0_ + qi) * PLD + PC_Q + 128 * hd + 32 * ks + 8 * fq); } while (0)
    RET_LOAD(dir ? 63 : 0);
    __syncthreads();
    for (int c = 0; c < 64; ++c) {
        const int cc = dir ? 63 - c : c;
        const int lrow0 = vloc * 8192 + cc * 128;
        bool next_reset = false;
        if (c < 63) { const int ncc = dir ? cc - 1 : cc + 1; const int np = (ncc * 128) % seqlen; next_reset = dir ? (np + 128 == seqlen) : (np == 0); }
        {
            if (dir == 0) {
#pragma unroll
                for (int r = 0; r < 4; ++r) *(LAS u32x4*)(KN + (i0 + r) * LD + c8) = kraw[r];
            }
            LAS bf16* kt = KTW + c8 * LD + i0; LAS bf16* vt = VT + c8 * LD + i0;
#pragma unroll
            for (int m = 0; m < 4; ++m) {
                u32x2 we, wo;
                we.x = pk2(bflo(kraw[0][m]) * wl[0], bflo(kraw[1][m]) * wl[1]); we.y = pk2(bflo(kraw[2][m]) * wl[2], bflo(kraw[3][m]) * wl[3]);
                wo.x = pk2(bfhi(kraw[0][m]) * wl[0], bfhi(kraw[1][m]) * wl[1]); wo.y = pk2(bfhi(kraw[2][m]) * wl[2], bfhi(kraw[3][m]) * wl[3]);
                *(LAS u32x2*)(kt + (2 * m) * LD) = we; *(LAS u32x2*)(kt + (2 * m + 1) * LD) = wo;
                u32x2 ve, vo;
                ve.x = (vraw[0][m] & 0xffffu) | (vraw[1][m] << 16); ve.y = (vraw[2][m] & 0xffffu) | (vraw[3][m] << 16);
                vo.x = (vraw[0][m] >> 16) | (vraw[1][m] & 0xffff0000u); vo.y = (vraw[2][m] >> 16) | (vraw[3][m] & 0xffff0000u);
                *(LAS u32x2*)(vt + (2 * m) * LD) = ve; *(LAS u32x2*)(vt + (2 * m + 1) * LD) = vo;
            }
        }
        bf16x8 qf[4];
#pragma unroll
        for (int ks = 0; ks < 4; ++ks) qf[ks] = __builtin_bit_cast(bf16x8, qraw[ks]);
        if (c < 63) { const int ncc = dir ? cc - 1 : cc + 1; RET_LOAD(ncc); }
        __syncthreads();
        unsigned sp[8][2];
        if (dir == 0) {
#pragma unroll
            for (int ct = 0; ct < 8; ++ct) {
                f32x4 a = (f32x4){0.f, 0.f, 0.f, 0.f};
#pragma unroll
                for (int ks = 0; ks < 4; ++ks) a = MFMA16(ldfrag(KN + (16 * ct + fr) * LD + 32 * ks + 8 * fq), qf[ks], a);
                const int j0 = 16 * ct + 4 * fq;
                float dv[4];
#pragma unroll
                for (int e = 0; e < 4; ++e) { const int dd = qi - (j0 + e); dv[e] = a[e] * exp2f(l2g * (float)(dd < 0 ? -dd : dd)); }
                sp[ct][0] = pk2(dv[0], dv[1]); sp[ct][1] = pk2(dv[2], dv[3]);
            }
            __syncthreads();
#pragma unroll
            for (int ct = 0; ct < 8; ++ct) { u32x2 w; w.x = sp[ct][0]; w.y = sp[ct][1]; *(LAS u32x2*)(KN + qi * LD + 16 * ct + 4 * fq) = w; }
        }
        {
            f32x4 Y[8];
#pragma unroll
            for (int ct = 0; ct < 8; ++ct) {
                f32x4 a = (f32x4){0.f, 0.f, 0.f, 0.f};
#pragma unroll
                for (int ks = 0; ks < 4; ++ks) a = MFMA16(ldfrag(RT + (16 * ct + fr) * LD + 32 * ks + 8 * fq), qf[ks], a);
                Y[ct] = a * rsc;
            }
            if (dir == 0) {
#pragma unroll
                for (int ks = 0; ks < 4; ++ks) {
                    const bf16x8 pf = ldfrag(KN + qi * LD + 32 * ks + 8 * fq);
#pragma unroll
                    for (int ct = 0; ct < 8; ++ct) Y[ct] = MFMA16(ldfrag(VT + (16 * ct + fr) * LD + 32 * ks + 8 * fq), pf, Y[ct]);
                }
            }
            bf16* yo = yout + (size_t)(lrow0 + qi) * YLD + 1024 + 128 * hd + 4 * fq;
#pragma unroll
            for (int ct = 0; ct < 8; ++ct) { u32x2 w; w.x = pk2(Y[ct][0], Y[ct][1]); w.y = pk2(Y[ct][2], Y[ct][3]); *(u32x2*)(yo + 16 * ct) = w; }
        }
#pragma unroll
        for (int ct = 0; ct < 8; ++ct) R[ct] *= cdec;
#pragma unroll
        for (int ks = 0; ks < 4; ++ks) {
            const bf16x8 kf = ldfrag(KTW + (16 * wid + fr) * LD + 32 * ks + 8 * fq);
#pragma unroll
            for (int ct = 0; ct < 8; ++ct) R[ct] = MFMA16(kf, ldfrag(VT + (16 * ct + fr) * LD + 32 * ks + 8 * fq), R[ct]);
        }
        if (next_reset) {
#pragma unroll
            for (int ct = 0; ct < 8; ++ct) R[ct] = (f32x4){0.f, 0.f, 0.f, 0.f};
        }
        __syncthreads();
#pragma unroll
        for (int ct = 0; ct < 8; ++ct) { u32x2 w; w.x = pk2(R[ct][0], R[ct][1]); w.y = pk2(R[ct][2], R[ct][3]); *(LAS u32x2*)(RT + (16 * ct + fr) * LD + 16 * wid + 4 * fq) = w; }
    }
#undef RET_LOAD
    __syncthreads();
}

__device__ __forceinline__ void ssd_item(LAS unsigned char* lds, const bf16* proj, bf16* yout, const float* cw, const float* cb, const float* dt_bias, const float* a_log, const float* dskip,
                                         int gv, int vloc, int hh, int dir) {
    const int tid = launder_tid(), wid = __builtin_amdgcn_readfirstlane(tid >> 6), lane = tid & 63, fr = lane & 15, fq = lane >> 4;
    constexpr int LDL = 136, LDS_ = 72;
    LAS bf16* XST = (LAS bf16*)lds;
    LAS bf16* CN = XST + 64 * LDL;
    LAS bf16* BN = CN + 128 * LDS_;
    LAS bf16* BTW = BN + 128 * LDS_;
    LAS bf16* PP = BTW + 64 * LDL;
    LAS bf16* HL = PP + 128 * LDL;
    LAS float* DT = (LAS float*)(HL + 64 * LDS_);
    LAS float* ACUM = DT + 128;
    LAS float* CWL = ACUM + 128;
    const int seqlen = gv < 8 ? 8192 : 4096, grp = hh >> 2;
    const float aneg = -__expf(a_log[dir * 8 + hh]), dtb = dt_bias[dir * 8 + hh], dsk = dskip[hh];
    const int cg8 = tid % 24, rb = tid / 24, sec = cg8 >> 3, c8 = (cg8 & 7) * 8, i0 = 8 * rb;
    const int xc = sec == 0 ? 64 * hh + c8 : (sec == 1 ? 512 + 64 * grp + c8 : 640 + 64 * grp + c8);
    const bool stager = tid < 384;
    f32x4 Hc[2];
    Hc[0] = (f32x4){0.f, 0.f, 0.f, 0.f}; Hc[1] = (f32x4){0.f, 0.f, 0.f, 0.f};
    for (int i = tid; i < 64 * LDS_ / 2; i += 512) ((LAS unsigned*)HL)[i] = 0u;
    for (int i = tid; i < 5 * 192; i += 512) { const int k = i / 192, cc2 = i % 192, s2 = cc2 >> 6, o = cc2 & 63; const int col = s2 == 0 ? 64 * hh + o : (s2 == 1 ? 512 + 64 * grp + o : 640 + 64 * grp + o);
        CWL[i] = k < 4 ? cw[k * 768 + col] : cb[col]; }
    u32x4 raw[11]; float dtraw = 0.f;
#define SSD_LOAD(CC) do { const int lr0_ = vloc * 8192 + (CC) * 128, p0_ = ((CC) * 128) % seqlen; \
        if (stager) { _Pragma("unroll") for (int r = 0; r < 11; ++r) { const int s_ = p0_ + i0 - 2 + r; raw[r] = (u32x4){0u, 0u, 0u, 0u}; \
            if (s_ >= 0 && s_ < seqlen) raw[r] = *(const u32x4*)(proj + (size_t)(lr0_ + i0 - 2 + r) * PLD + PC_XBC + xc); } } \
        if (tid < 128) dtraw = bf2f(proj[(size_t)(lr0_ + tid) * PLD + PC_DT + dir * 8 + hh]); } while (0)
    SSD_LOAD(dir ? 63 : 0);
    __syncthreads();
    for (int c = 0; c < 64; ++c) {
        const int cc = dir ? 63 - c : c;
        const int lrow0 = vloc * 8192 + cc * 128;
        bool next_reset = false;
        if (c < 63) { const int ncc = dir ? cc - 1 : cc + 1; const int np = (ncc * 128) % seqlen; next_reset = dir ? (np + 128 == seqlen) : (np == 0); }
        if (tid < 128) DT[tid] = softplusf(dtraw + dtb);
        __syncthreads();
        float tot;
        {
            const float x0 = DT[2 * lane] * aneg, x1 = DT[2 * lane + 1] * aneg;
            float s = x0 + x1;
#pragma unroll
            for (int o = 1; o < 64; o <<= 1) { const float t = __shfl_up(s, o); if (lane >= o) s += t; }
            tot = __shfl(s, 63);
            const float p1 = s, p0 = s - x1;
            if (dir == 0) { ACUM[2 * lane] = p0; ACUM[2 * lane + 1] = p1; }
            else { ACUM[2 * lane] = tot - p0 + x0; ACUM[2 * lane + 1] = tot - p1 + x1; }
        }
        if (stager) {
#pragma unroll
            for (int hc = 0; hc < 2; ++hc) {
                const int cl = 8 * cg8 + 4 * hc;
                const f32x4 w0 = *(const LAS f32x4*)(CWL + 0 * 192 + cl), w1 = *(const LAS f32x4*)(CWL + 1 * 192 + cl), w2 = *(const LAS f32x4*)(CWL + 2 * 192 + cl),
                            w3 = *(const LAS f32x4*)(CWL + 3 * 192 + cl), bb = *(const LAS f32x4*)(CWL + 4 * 192 + cl);
                f32x4 ring[4] = {bb, bb, bb, bb};
                u32x2 pv[4];
#pragma unroll
                for (int r = 0; r < 11; ++r) {
                    const unsigned xa = raw[r][2 * hc], xb = raw[r][2 * hc + 1];
                    const f32x4 x = (f32x4){bflo(xa), bfhi(xa), bflo(xb), bfhi(xb)};
                    if (r <= 7) ring[r & 3] += w0 * x;
                    if (r >= 1 && r <= 8) ring[(r - 1) & 3] += w1 * x;
                    if (r >= 2 && r <= 9) ring[(r - 2) & 3] += w2 * x;
                    if (r >= 3) {
                        const int od = r - 3;
                        f32x4 t = ring[od & 3] + w3 * x;
                        ring[od & 3] = bb;
#pragma unroll
                        for (int e = 0; e < 4; ++e) t[e] = siluf(t[e]);
                        u32x2 pk; pk.x = pk2(t[0], t[1]); pk.y = pk2(t[2], t[3]);
                        if (sec == 0) pv[od & 3] = pk;
                        else if (sec == 1) { *(LAS u32x2*)(BN + (i0 + od) * LDS_ + c8 + 4 * hc) = pk; const float wr = __expf(tot - ACUM[i0 + od]) * DT[i0 + od];
                            u32x2 pw; pw.x = pk2(t[0] * wr, t[1] * wr); pw.y = pk2(t[2] * wr, t[3] * wr); pv[od & 3] = pw; }
                        else *(LAS u32x2*)(CN + (i0 + od) * LDS_ + c8 + 4 * hc) = pk;
                        if ((od & 3) == 3 && sec != 2) {
                            LAS bf16* dstT = (sec == 0 ? XST : BTW) + (c8 + 4 * hc) * LDL + i0 + (od - 3);
#pragma unroll
                            for (int m = 0; m < 2; ++m) {
                                u32x2 we, wo;
                                we.x = (pv[0][m] & 0xffffu) | (pv[1][m] << 16); we.y = (pv[2][m] & 0xffffu) | (pv[3][m] << 16);
                                wo.x = (pv[0][m] >> 16) | (pv[1][m] & 0xffff0000u); wo.y = (pv[2][m] >> 16) | (pv[3][m] & 0xffff0000u);
                                *(LAS u32x2*)(dstT + (2 * m) * LDL) = we; *(LAS u32x2*)(dstT + (2 * m + 1) * LDL) = wo;
                            }
                        }
                    }
                }
            }
        }
        if (c < 63) { const int ncc = dir ? cc - 1 : cc + 1; SSD_LOAD(ncc); }
        __syncthreads();
        const int qi = 16 * wid + fr;
        bf16x8 cf[2];
        cf[0] = ldfrag(CN + qi * LDS_ + 8 * fq); cf[1] = ldfrag(CN + qi * LDS_ + 32 + 8 * fq);
        const float aci = ACUM[qi];
#pragma unroll
        for (int ct = 0; ct < 8; ++ct) {
            f32x4 a = (f32x4){0.f, 0.f, 0.f, 0.f};
#pragma unroll
            for (int ks = 0; ks < 2; ++ks) a = MFMA16(ldfrag(BN + (16 * ct + fr) * LDS_ + 32 * ks + 8 * fq), cf[ks], a);
            const int j0 = 16 * ct + 4 * fq;
            const f32x4 acj = *(const LAS f32x4*)(ACUM + j0), dtj = *(const LAS f32x4*)(DT + j0);
            float wv[4];
#pragma unroll
            for (int e = 0; e < 4; ++e) { const int j = j0 + e; const bool ok = dir ? (j >= qi) : (j <= qi); wv[e] = ok ? a[e] * __expf(aci - acj[e]) * dtj[e] : 0.f; }
            u32x2 w; w.x = pk2(wv[0], wv[1]); w.y = pk2(wv[2], wv[3]);
            *(LAS u32x2*)(PP + qi * LDL + j0) = w;
        }
        {
            const float ea = __expf(aci);
            f32x4 Y[4];
#pragma unroll
            for (int pt = 0; pt < 4; ++pt) {
                f32x4 a = (f32x4){0.f, 0.f, 0.f, 0.f};
#pragma unroll
                for (int ks = 0; ks < 2; ++ks) a = MFMA16(ldfrag(HL + (16 * pt + fr) * LDS_ + 32 * ks + 8 * fq), cf[ks], a);
                Y[pt] = a * ea;
            }
#pragma unroll
            for (int ks = 0; ks < 4; ++ks) {
                const bf16x8 pf = ldfrag(PP + qi * LDL + 32 * ks + 8 * fq);
#pragma unroll
                for (int pt = 0; pt < 4; ++pt) Y[pt] = MFMA16(ldfrag(XST + (16 * pt + fr) * LDL + 32 * ks + 8 * fq), pf, Y[pt]);
            }
            bf16* yo = yout + (size_t)(lrow0 + qi) * YLD + 512 + 64 * hh + 4 * fq;
#pragma unroll
            for (int pt = 0; pt < 4; ++pt) {
                if (dir == 0) {
#pragma unroll
                    for (int e = 0; e < 4; ++e) Y[pt][e] += dsk * bf2f(XST[(16 * pt + 4 * fq + e) * LDL + qi]);
                }
                u32x2 w; w.x = pk2(Y[pt][0], Y[pt][1]); w.y = pk2(Y[pt][2], Y[pt][3]); *(u32x2*)(yo + 16 * pt) = w;
            }
        }
        {
            const float et = __expf(tot);
            Hc[0] *= et; Hc[1] *= et;
#pragma unroll
            for (int ks = 0; ks < 4; ++ks) {
                const bf16x8 xf = ldfrag(XST + (16 * (wid & 3) + fr) * LDL + 32 * ks + 8 * fq);
#pragma unroll
                for (int j2 = 0; j2 < 2; ++j2) Hc[j2] = MFMA16(ldfrag(BTW + (16 * (2 * (wid >> 2) + j2) + fr) * LDL + 32 * ks + 8 * fq), xf, Hc[j2]);
            }
            if (next_reset) { Hc[0] = (f32x4){0.f, 0.f, 0.f, 0.f}; Hc[1] = (f32x4){0.f, 0.f, 0.f, 0.f}; }
        }
        __syncthreads();
#pragma unroll
        for (int j2 = 0; j2 < 2; ++j2) { u32x2 w; w.x = pk2(Hc[j2][0], Hc[j2][1]); w.y = pk2(Hc[j2][2], Hc[j2][3]);
            *(LAS u32x2*)(HL + (16 * (wid & 3) + fr) * LDS_ + 16 * (2 * (wid >> 2) + j2) + 4 * fq) = w; }
    }
#undef SSD_LOAD
    __syncthreads();
}

__device__ __forceinline__ void lru_item(LAS unsigned char* lds, const bf16* proj, bf16* yout, const float* cw, const float* cb, const float* w_a, const float* b_a, const float* w_i, const float* b_i,
                                         const float* lam, int gv, int vloc, int nb, int dir) {
    const int tid = launder_tid(), wid = __builtin_amdgcn_readfirstlane(tid >> 6), lane = tid & 63, fr = lane & 15, fq = lane >> 4;
    constexpr int LDX = 72;
    LAS bf16* XCB = (LAS bf16*)lds;
    LAS bf16* WT = XCB + 128 * LDX;
    LAS float* AA = (LAS float*)(WT + 128 * LDX);
    LAS float* UU = AA + 128 * 64;
    LAS float* AGG = UU + 128 * 64;
    LAS float* CARRY = AGG + 8 * 64 * 2;
    LAS float* BA = CARRY + 128;
    LAS float* BI = BA + 64;
    LAS float* SP = BI + 64;
    const int seqlen = gv < 8 ? 8192 : 4096;
    for (int idx = tid; idx < 8192; idx += 512) {
        const int mat = idx >> 12, rem = idx & 4095, i = rem >> 6, j = rem & 63;
        const float* w = (mat ? w_i : w_a) + (size_t)((dir * 8 + nb) * 64 + i) * 64 + j;
        WT[(64 * mat + j) * LDX + i] = f2bf(*w);
    }
    if (tid < 64) { CARRY[tid] = 0.f; CARRY[64 + tid] = 0.f; BA[tid] = b_a[dir * 512 + 64 * nb + tid]; BI[tid] = b_i[dir * 512 + 64 * nb + tid]; SP[tid] = 8.0f * softplusf(-lam[dir * 512 + 64 * nb + tid]); }
    const int c8 = (tid & 7) * 8, i0 = 2 * (tid >> 3), ccol = 64 * nb + c8;
    const f32x8 w0 = ld8f(cw + 0 * 512 + ccol), w1 = ld8f(cw + 1 * 512 + ccol), w2 = ld8f(cw + 2 * 512 + ccol), w3 = ld8f(cw + 3 * 512 + ccol), bb = ld8f(cb + ccol);
    u32x4 raw[5];
#define LRU_LOAD(CC) do { const int lr0_ = vloc * 8192 + (CC) * 128, p0_ = ((CC) * 128) % seqlen; \
        _Pragma("unroll") for (int r = 0; r < 5; ++r) { const int s_ = p0_ + i0 - 2 + r; raw[r] = (u32x4){0u, 0u, 0u, 0u}; \
            if (s_ >= 0 && s_ < seqlen) raw[r] = *(const u32x4*)(proj + (size_t)(lr0_ + i0 - 2 + r) * PLD + PC_LRUX + ccol); } } while (0)
    LRU_LOAD(dir ? 63 : 0);
    __syncthreads();
    for (int c = 0; c < 64; ++c) {
        const int cc = dir ? 63 - c : c;
        const int lrow0 = vloc * 8192 + cc * 128;
        bool next_reset = false;
        if (c < 63) { const int ncc = dir ? cc - 1 : cc + 1; const int np = (ncc * 128) % seqlen; next_reset = dir ? (np + 128 == seqlen) : (np == 0); }
#pragma unroll
        for (int r = 0; r < 2; ++r) {
            const f32x8 v = bb + w0 * unpack8(raw[r]) + w1 * unpack8(raw[r + 1]) + w2 * unpack8(raw[r + 2]) + w3 * unpack8(raw[r + 3]);
            *(LAS u32x4*)(XCB + (i0 + r) * LDX + c8) = pack8(v);
        }
        if (c < 63) { const int ncc = dir ? cc - 1 : cc + 1; LRU_LOAD(ncc); }
        __syncthreads();
        const int t = 16 * wid + fr;
        {
            bf16x8 xf[2];
            xf[0] = ldfrag(XCB + t * LDX + 8 * fq); xf[1] = ldfrag(XCB + t * LDX + 32 + 8 * fq);
            f32x4 Gt[8];
#pragma unroll
            for (int ct = 0; ct < 8; ++ct) {
                f32x4 a = (f32x4){0.f, 0.f, 0.f, 0.f};
#pragma unroll
                for (int ks = 0; ks < 2; ++ks) a = MFMA16(ldfrag(WT + (16 * ct + fr) * LDX + 32 * ks + 8 * fq), xf[ks], a);
                Gt[ct] = a;
            }
#pragma unroll
            for (int ct = 0; ct < 4; ++ct) {
                const int c0 = 16 * ct + 4 * fq;
                const f32x4 ba = *(const LAS f32x4*)(BA + c0), bi = *(const LAS f32x4*)(BI + c0), sp = *(const LAS f32x4*)(SP + c0);
                const u32x2 xw = *(const LAS u32x2*)(XCB + t * LDX + c0);
                const float xv[4] = {bflo(xw.x), bfhi(xw.x), bflo(xw.y), bfhi(xw.y)};
                f32x4 av, uv;
#pragma unroll
                for (int e = 0; e < 4; ++e) {
                    const float r = sigm(Gt[ct][e] + ba[e]), ig = sigm(Gt[ct + 4][e] + bi[e]);
                    const float la = -r * sp[e];
                    const float a = __expf(la);
                    av[e] = a;
                    uv[e] = sqrtf(fmaxf((1.0f - a) * (1.0f + a), 0.f)) * ig * xv[e];
                }
                *(LAS f32x4*)(AA + t * 64 + c0) = av; *(LAS f32x4*)(UU + t * 64 + c0) = uv;
            }
        }
        __syncthreads();
        {
            const int ch = tid & 63, seg = tid >> 6;
            float Pp = 1.f, h = 0.f;
#pragma unroll
            for (int k = 0; k < 16; ++k) { const int o = seg * 16 + k, tt = dir ? 127 - o : o; const float a = AA[tt * 64 + ch], u = UU[tt * 64 + ch]; h = a * h + u; Pp *= a; }
            AGG[(seg * 64 + ch) * 2] = Pp; AGG[(seg * 64 + ch) * 2 + 1] = h;
            __syncthreads();
            float cin = CARRY[(c & 1) * 64 + ch];
            for (int s = 0; s < seg; ++s) cin = AGG[(s * 64 + ch) * 2] * cin + AGG[(s * 64 + ch) * 2 + 1];
            h = cin;
            bf16* yo = yout + (size_t)lrow0 * YLD + 64 * nb + ch;
#pragma unroll
            for (int k = 0; k < 16; ++k) { const int o = seg * 16 + k, tt = dir ? 127 - o : o; const float a = AA[tt * 64 + ch], u = UU[tt * 64 + ch]; h = a * h + u; yo[(size_t)tt * YLD] = f2bf(h); }
            if (seg == 7) CARRY[((c + 1) & 1) * 64 + ch] = next_reset ? 0.f : h;
        }
    }
#undef LRU_LOAD
    __syncthreads();
}

__global__ void __launch_bounds__(512, 2) mega_fwd(Args args) {
    extern __shared__ __attribute__((aligned(16))) unsigned char lds_raw[];
    LAS unsigned char* lds = (LAS unsigned char*)lds_raw;
    cg::grid_group grid = cg::this_grid();
    const int tid = threadIdx.x, lane = tid & 63, wid = __builtin_amdgcn_readfirstlane(tid >> 6), G = gridDim.x, bx = blockIdx.x;
    unsigned char* ws; float* X;
    { KArgsPtr KA0 = kargs(); ws = KA0->ws; X = KA0->out; }
    bf16* XB = (bf16*)(ws + WS_XB); float* SSQ = (float*)(ws + WS_SSQ);
    float* RCOS = (float*)(ws + WS_ROPE); float* RSIN = RCOS + 8192 * 64;
    bf16* PROJ = (bf16*)(ws + WS_PROJ); bf16* YF = (bf16*)(ws + WS_Y); bf16* YBK = (bf16*)(ws + WS_YB); bf16* HB = (bf16*)(ws + WS_H);
    const int gw = bx * 8 + wid, NGW = G * 8;

    {
        KArgsPtr KA = kargs();
        LAS float* scr = (LAS float*)(lds + wid * 16384);
        constexpr int I_GU = (DM / 64) * (NGU / 32), I_D = (DFF / 64) * (DM / 32), I_IN = (DM / 64) * (NIN / 32), I_OUT = (NMIX / 64) * (DM / 32);
        constexpr int I_LAYER = 2 * I_GU + 2 * I_D + I_IN + I_OUT;
        for (int it = gw; it < NLAYER * I_LAYER; it += NGW) {
            const int l = it / I_LAYER; int r = it % I_LAYER;
            if (r < I_GU) { transpose_item(KA->in[3] + (size_t)l * DM * NGU, DM, NGU, NGU, KA->in[2] + l * DM, (bf16*)(ws + WS_WGU1 + l * SZ_WGU), 1, r, lane, scr); continue; } r -= I_GU;
            if (r < I_GU) { transpose_item(KA->in[23] + (size_t)l * DM * NGU, DM, NGU, NGU, KA->in[22] + l * DM, (bf16*)(ws + WS_WGU2 + l * SZ_WGU), 1, r, lane, scr); continue; } r -= I_GU;
            if (r < I_D) { transpose_item(KA->in[4] + (size_t)l * DFF * DM, DFF, DM, DM, nullptr, (bf16*)(ws + WS_WD1 + l * SZ_WD), 0, r, lane, scr); continue; } r -= I_D;
            if (r < I_D) { transpose_item(KA->in[24] + (size_t)l * DFF * DM, DFF, DM, DM, nullptr, (bf16*)(ws + WS_WD2 + l * SZ_WD), 0, r, lane, scr); continue; } r -= I_D;
            if (r < I_IN) { transpose_item(KA->in[6] + (size_t)l * DM * W_IN_SRC, DM, W_IN_SRC, NIN, KA->in[5] + l * DM, (bf16*)(ws + WS_WIN + l * SZ_WIN), 2, r, lane, scr); continue; } r -= I_IN;
            transpose_item(KA->in[21] + (size_t)l * NMIX * DM, NMIX, DM, DM, nullptr, (bf16*)(ws + WS_WOUT + l * SZ_WOUT), 0, r, lane, scr);
        }
        for (int m = gw; m < TT; m += NGW) {
            const float* src = m < 65536 ? KA->in[0] + (size_t)m * DM : KA->in[1] + (size_t)(m - 65536) * DM;
            float s = 0.f;
#pragma unroll
            for (int j = 0; j < 4; ++j) {
                const f32x4 v = *(const f32x4*)(src + 256 * j + 4 * lane);
                *(f32x4*)(X + (size_t)m * DM + 256 * j + 4 * lane) = v;
                u32x2 w; w.x = pk2(v[0], v[1]); w.y = pk2(v[2], v[3]);
                *(u32x2*)(XB + (size_t)m * DM + 256 * j + 4 * lane) = w;
                s += (v[0] * v[0] + v[1] * v[1]) + (v[2] * v[2] + v[3] * v[3]);
            }
            s = wave_sum(s);
            if (lane < 16) SSQ[(size_t)m * 16 + lane] = lane == 0 ? s : 0.f;
        }
        for (int i = bx * 512 + tid; i < 8192 * 64; i += G * 512) {
            const int pos = i >> 6, f = i & 63;
            const float inv = 1.0f / powf(10000.0f, (float)(2 * f) / 128.0f);
            const float ang = (float)pos * inv;
            RCOS[i] = cosf(ang); RSIN[i] = sinf(ang);
        }
    }
    grid.sync();

    for (int l = 0; l < NLAYER; ++l) {
        for (int st = 0; st < 3; ++st) {
            const int nsub = st == 1 ? 2 : 1;
            for (int sub = 0; sub < nsub; ++sub) {
                if (st != 1) {
                    const bf16* Wgu = (const bf16*)(ws + (st == 0 ? WS_WGU1 : WS_WGU2) + l * SZ_WGU);
                    pg8::Gemm g{XB, Wgu, TT, NGU, DM}; pg8::StaticOrder S; S.init(TT, NGU, G, bx);
                    EpiGU E{HB, SSQ};
#ifndef NO_GU
                    pg8::gemm_phase<EpiGU, pg8::StaticOrder, PG8_ALIGN, PG8_SP2>(lds, g, S, E);
#endif
                } else {
                    const bf16* Win = (const bf16*)(ws + WS_WIN + l * SZ_WIN);
                    pg8::Gemm g{XB + (size_t)sub * THALF * DM, Win, THALF, NIN, DM}; pg8::StaticOrder S; S.init(THALF, NIN, G, bx);
                    EpiProj E{PROJ, SSQ, sub * THALF, RCOS, RSIN};
#ifndef NO_PROJ
                    pg8::gemm_phase<EpiProj, pg8::StaticOrder, PG8_ALIGN, PG8_SP2>(lds, g, S, E);
#endif
                }
                grid.sync();
                if (st == 1) {
                    for (int item = bx; item < 200; item += G) {
                        KArgsPtr KA = kargs();
                        if (item < 40) {
                            const int vloc = item >> 3, hd = (item & 7) >> 1, dir = item & 1;
#ifndef NO_RET
                            ret_item(lds, PROJ, dir ? YBK : YF, sub * 5 + vloc, vloc, hd, dir);
#endif
                        } else if (item < 120) {
                            const int q = item - 40, vloc = q >> 4, hh = (q & 15) >> 1, dir = q & 1;
#ifndef NO_SSD
                            ssd_item(lds, PROJ, dir ? YBK : YF, KA->in[14] + (size_t)l * 4 * 768, KA->in[15] + l * 768, KA->in[16] + l * 16, KA->in[17] + l * 16, KA->in[18] + l * 8,
                                     sub * 5 + vloc, vloc, hh, dir);
#endif
                        } else {
                            const int q = item - 120, vloc = q >> 4, nb = (q & 15) >> 1, dir = q & 1;
#ifndef NO_LRU
                            lru_item(lds, PROJ, dir ? YBK : YF, KA->in[7] + (size_t)l * 4 * 512, KA->in[8] + l * 512, KA->in[9] + (size_t)l * 2 * 8 * 64 * 64, KA->in[10] + l * 1024,
                                     KA->in[11] + (size_t)l * 2 * 8 * 64 * 64, KA->in[12] + l * 1024, KA->in[13] + l * 1024, sub * 5 + vloc, vloc, nb, dir);
#endif
                        }
                    }
                    grid.sync();
                    {
                        KArgsPtr KA = kargs();
                        const float* ssd_norm = KA->in[19] + l * 512; const float* ret_norm = KA->in[20] + l * 512;
                        const f32x8 nw_s = ld8f(ssd_norm + 8 * lane), nw_r = ld8f(ret_norm + 8 * lane);
                        for (int row = gw; row < THALF; row += NGW) {
                            bf16* yr = YF + (size_t)row * YLD; const bf16* yb = YBK + (size_t)row * YLD; const bf16* pr = PROJ + (size_t)row * PLD;
                            {
                                const f32x8 a = unpack8(*(const u32x4*)(yr + 8 * lane)), b = unpack8(*(const u32x4*)(yb + 8 * lane)), gt = unpack8(*(const u32x4*)(pr + PC_GATE + 8 * lane));
                                f32x8 o;
#pragma unroll
                                for (int e = 0; e < 8; ++e) o[e] = (a[e] + b[e]) * gelu_tanh(gt[e]);
                                *(u32x4*)(yr + 8 * lane) = pack8(o);
                            }
                            {
                                const f32x8 a = unpack8(*(const u32x4*)(yr + 512 + 8 * lane)), b = unpack8(*(const u32x4*)(yb + 512 + 8 * lane)), z = unpack8(*(const u32x4*)(pr + PC_Z + 8 * lane));
                                f32x8 v; float ss = 0.f;
#pragma unroll
                                for (int e = 0; e < 8; ++e) { v[e] = (a[e] + b[e]) * siluf(z[e]); ss += v[e] * v[e]; }
                                ss = wave_sum(ss);
                                const float rs = rsqrtf(ss * (1.0f / 512.0f) + EPSN);
                                *(u32x4*)(yr + 512 + 8 * lane) = pack8(v * rs * nw_s);
                            }
                            {
                                const f32x8 a = unpack8(*(const u32x4*)(yr + 1024 + 8 * lane)), b = unpack8(*(const u32x4*)(yb + 1024 + 8 * lane)), gg = unpack8(*(const u32x4*)(pr + PC_G + 8 * lane));
                                f32x8 v = a + b; float s1 = 0.f;
#pragma unroll
                                for (int e = 0; e < 8; ++e) s1 += v[e];
                                s1 += __shfl_xor(s1, 1); s1 += __shfl_xor(s1, 2); s1 += __shfl_xor(s1, 4); s1 += __shfl_xor(s1, 8);
                                const float mu = s1 * (1.0f / 128.0f); float s2 = 0.f;
#pragma unroll
                                for (int e = 0; e < 8; ++e) { v[e] -= mu; s2 += v[e] * v[e]; }
                                s2 += __shfl_xor(s2, 1); s2 += __shfl_xor(s2, 2); s2 += __shfl_xor(s2, 4); s2 += __shfl_xor(s2, 8);
                                const float rs = rsqrtf(s2 * (1.0f / 128.0f) + EPSN);
                                f32x8 o;
#pragma unroll
                                for (int e = 0; e < 8; ++e) o[e] = v[e] * rs * nw_r[e] * siluf(gg[e]);
                                *(u32x4*)(yr + 1024 + 8 * lane) = pack8(o);
                            }
                        }
                    }
                    grid.sync();
                }
                {
                    pg8::Gemm g; float coef; int roff;
                    if (st != 1) { g = pg8::Gemm{HB, (const bf16*)(ws + (st == 0 ? WS_WD1 : WS_WD2) + l * SZ_WD), TT, DM, DFF}; coef = 0.5f; roff = 0; }
                    else { g = pg8::Gemm{YF, (const bf16*)(ws + WS_WOUT + l * SZ_WOUT), THALF, DM, NMIX}; coef = 1.0f; roff = sub * THALF; }
                    pg8::StaticOrder S; S.init(g.M, g.N, G, bx);
                    EpiRes E{X, XB, SSQ, coef, roff};
#ifndef NO_RES
                    pg8::gemm_phase<EpiRes, pg8::StaticOrder, PG8_ALIGN, PG8_SP2>(lds, g, S, E);
#endif
                }
                grid.sync();
            }
        }
    }
    {
        KArgsPtr KA = kargs();
        const float* fw = KA->in[25];
        for (int m = gw; m < TT; m += NGW) {
            const float rs = row_rs(SSQ, (size_t)m);
#pragma unroll
            for (int j = 0; j < 4; ++j) {
                float* p = X + (size_t)m * DM + 256 * j + 4 * lane;
                const f32x4 v = *(const f32x4*)p, w = *(const f32x4*)(fw + 256 * j + 4 * lane);
                *(f32x4*)p = v * rs * w;
            }
        }
    }
}

extern "C" void kernel_launch(void* const* d_in, const int* in_sizes, int n_in, void* d_out, int out_size, void* d_ws, size_t ws_size, hipStream_t stream) {
    static int grid = 0;
    if (grid == 0) {
        if (n_in != 26 || out_size != TT * DM || ws_size < WS_NEED) { fprintf(stderr, "kernel_launch: unexpected problem (n_in %d, out %d, ws %zu, need %zu)\n", n_in, out_size, ws_size, (size_t)WS_NEED); grid = -1; return; }
        int dev = 0, cus = 0, per_cu = 0;
        if (hipGetDevice(&dev) != hipSuccess || hipDeviceGetAttribute(&cus, hipDeviceAttributeMultiprocessorCount, dev) != hipSuccess) { grid = -1; return; }
        if (hipFuncSetAttribute((const void*)mega_fwd, hipFuncAttributeMaxDynamicSharedMemorySize, LDS_BYTES) != hipSuccess) { fprintf(stderr, "kernel_launch: hipFuncSetAttribute failed\n"); grid = -1; return; }
        if (hipOccupancyMaxActiveBlocksPerMultiprocessor(&per_cu, (const void*)mega_fwd, 512, LDS_BYTES) != hipSuccess || per_cu < 1) { fprintf(stderr, "kernel_launch: occupancy query says %d\n", per_cu); per_cu = 1; }
        (void)hipGetLastError();
        grid = cus;
    }
    if (grid < 0) return;
    Args a{};
    for (int i = 0; i < 26; ++i) a.in[i] = (const float*)d_in[i];
    a.out = (float*)d_out; a.ws = (unsigned char*)d_ws;
    void* kargs[] = {&a};
    hipError_t e = hipLaunchCooperativeKernel((const void*)mega_fwd, dim3(grid), dim3(512), kargs, LDS_BYTES, stream);
    if (e != hipSuccess) fprintf(stderr, "kernel_launch: cooperative launch failed: %s (grid %d)\n", hipGetErrorString(e), grid);
}
```

```cpp
#include <hip/hip_runtime.h>
#include <hip/hip_cooperative_groups.h>
#include <cstdio>
#include <cstdint>
namespace cg = cooperative_groups;
namespace pg8 {
#define PG8_LAS __attribute__((address_space(3)))
typedef unsigned short bf16_t;
typedef short bf16x8 __attribute__((ext_vector_type(8)));
typedef float f32x4 __attribute__((ext_vector_type(4)));
typedef unsigned u32x4 __attribute__((ext_vector_type(4)));
constexpr int BM = 256, BK = 64, HALF = 128, HTB = HALF * BK * 2  , STAGE_BYTES = 8 * HTB, NXCD = 8, WGM = 8;

__host__ __device__ __forceinline__ int lds_byte(int r, int c) { const int st = (r >> 4) * 2 + (c >> 5), rr = r & 15, cc = c & 31, ob = rr * 64 + cc * 2; return st * 1024 + (ob ^ (((ob >> 9) & 1) << 5)); }
__host__ __device__ __forceinline__ void stage_rc(int b, int& R, int& C) { const int st = b / 1024, sb = b % 1024, swz = sb ^ (((sb >> 9) & 1) << 5); R = (st >> 1) * 16 + swz / 64; C = (st & 1) * 32 + (swz % 64) / 2; }
__host__ __device__ __forceinline__ int perm32(int rho) { const int n = rho >> 4, i = rho & 15; return 8 * (i >> 2) + 4 * n + (i & 3); }

struct Unit { int pm, pn; };
struct Gemm { const bf16_t* A; const bf16_t* Bt; int M, N, K; };

struct StaticOrder {
    int nM, nN, nwg, G, c;
    __host__ __device__ void init(int M, int N, int G_, int c_) { nM = M / BM; nN = N / BM; nwg = nM * nN; G = G_; c = c_; }
    __host__ __device__ bool next(int i, Unit& u) const {
        const long L = (long)i * G + c; if (L >= nwg) return false;
        int wgid = (int)L; { const int q = nwg / NXCD, r = nwg % NXCD, xcd = wgid % NXCD, off = wgid / NXCD; wgid = (xcd < r ? xcd * (q + 1) : r * (q + 1) + (xcd - r) * q) + off; }
        const int nig = WGM * nN, gid = wgid / nig, fm = gid * WGM, gsz = (nM - fm) < WGM ? (nM - fm) : WGM;
        u.pm = fm + ((wgid % nig) % gsz); u.pn = (wgid % nig) / gsz; return true;
    }
    __device__ __forceinline__ void a_ready(const Unit&) const {}
    __device__ __forceinline__ void done(const Unit&) const {}
};

__device__ __forceinline__ unsigned cvt_pk_bf16(float lo, float hi) { unsigned r; asm volatile("v_cvt_pk_bf16_f32 %0, %1, %2" : "=v"(r) : "v"(lo), "v"(hi)); return r; }
typedef float f32x2 __attribute__((ext_vector_type(2)));
template <class Epi, class Sched, bool ALIGN_EPI = false, bool SP2 = false>
__device__ __forceinline__ void gemm_phase(PG8_LAS unsigned char* lds, const Gemm g, const Sched& S, const Epi& E) {
    int tid_l = threadIdx.x; asm volatile("" : "+v"(tid_l));
    const int tid = tid_l, wid = __builtin_amdgcn_readfirstlane(tid >> 6), lane = tid & 63, wr = wid >> 2, wc = wid & 3, fr = lane & 15, fq = lane >> 4;
    const int K = g.K, nt = K / BK;
    unsigned voffA[2], voffB[2];
#pragma unroll
    for (int i = 0; i < 2; ++i) { int R, C; stage_rc(tid * 16 + i * 8192, R, C); const int Rb = Epi::PERM ? ((R & ~31) + perm32(R & 31)) : R;
        voffA[i] = (unsigned)(R * K + C) * 2u; voffB[i] = (unsigned)(Rb * K + C) * 2u; }
    const size_t kstep = (size_t)(BK * 2);
    const size_t hstep = (size_t)HALF * K * 2;
    const size_t tstep = 2 * hstep;
    const unsigned ldsw = (unsigned)wid * 1024u;
    const int aoff = lds_byte(wr * 64 + fr, fq * 8), boff = lds_byte(wc * 32 + fr, fq * 8);
#define PG8_SA(b, h) (((b) * 2 + (h)) * HTB)
#define PG8_SB(b, h) ((4 + (b) * 2 + (h)) * HTB)
#define PG8_STAGE(bufoff, gbase, voff) do { _Pragma("unroll") for (int _i = 0; _i < 2; ++_i) \
        __builtin_amdgcn_global_load_lds((const unsigned*)((const char*)(gbase) + (voff)[_i]), (PG8_LAS unsigned*)(lds + (bufoff) + ldsw + _i * 8192), 16, 0, 0); } while (0)
#define PG8_LDA(dst, b, h) do { _Pragma("unroll") for (int m = 0; m < 4; ++m) _Pragma("unroll") for (int k = 0; k < 2; ++k) dst[m][k] = *(const PG8_LAS bf16x8*)(lds + PG8_SA(b, h) + aoff + m * 2048 + k * 1024); } while (0)
#define PG8_LDB(dst, b, h) do { _Pragma("unroll") for (int n = 0; n < 2; ++n) _Pragma("unroll") for (int k = 0; k < 2; ++k) dst[n][k] = *(const PG8_LAS bf16x8*)(lds + PG8_SB(b, h) + boff + n * 2048 + k * 1024); } while (0)
#define PG8_MMA(ai, bj, At, Bt) do { __builtin_amdgcn_s_setprio(1); _Pragma("unroll") for (int m = 0; m < 4; ++m) _Pragma("unroll") for (int n = 0; n < 2; ++n) _Pragma("unroll") for (int k = 0; k < 2; ++k) \
        acc[ai][bj][m][n] = __builtin_amdgcn_mfma_f32_16x16x32_bf16(Bt[n][k], At[m][k], acc[ai][bj][m][n], 0, 0, 0); __builtin_amdgcn_s_setprio(0); } while (0)
#define PG8_WAIT_V(n) asm volatile("s_waitcnt vmcnt(" #n ")" ::: "memory")
#define PG8_WAIT_L(n) asm volatile("s_waitcnt lgkmcnt(" #n ")" ::: "memory")
#define PG8_BAR __builtin_amdgcn_s_barrier()
#define PG8_SCHED __builtin_amdgcn_sched_barrier(0)
    Unit cur, nxt; int ui = 0;
    if (!S.next(0, cur)) return;
    f32x4 acc[2][2][4][2];
#pragma unroll
    for (int a = 0; a < 2; ++a)
#pragma unroll
        for (int b = 0; b < 2; ++b)
#pragma unroll
            for (int m = 0; m < 4; ++m)
#pragma unroll
                for (int n = 0; n < 2; ++n) acc[a][b][m][n] = (f32x4){0.f, 0.f, 0.f, 0.f};
    bf16x8 At[4][2], B0[2][2], B1[2][2];
    const char* cA = (const char*)g.A + (size_t)cur.pm * tstep; const char* cB = (const char*)g.Bt + (size_t)cur.pn * tstep;
    S.a_ready(cur);
    if constexpr (SP2) {
        PG8_STAGE(PG8_SB(0, 0), cB, voffB); PG8_STAGE(PG8_SB(0, 1), cB + hstep, voffB); PG8_STAGE(PG8_SA(0, 0), cA, voffA); PG8_STAGE(PG8_SA(0, 1), cA + hstep, voffA);
        if (wr == 1) PG8_BAR;
        PG8_WAIT_V(2); PG8_BAR;
        PG8_STAGE(PG8_SB(1, 0), cB + kstep, voffB); PG8_STAGE(PG8_SA(1, 0), cA + kstep, voffA); PG8_STAGE(PG8_SB(1, 1), cB + hstep + kstep, voffB);
        PG8_WAIT_V(6); PG8_BAR;
    } else {
        PG8_STAGE(PG8_SB(0, 0), cB, voffB); PG8_STAGE(PG8_SA(0, 0), cA, voffA); PG8_STAGE(PG8_SB(0, 1), cB + hstep, voffB); PG8_STAGE(PG8_SA(0, 1), cA + hstep, voffA);
        if (wr == 1) PG8_BAR;
        PG8_WAIT_V(4); PG8_BAR;
        PG8_STAGE(PG8_SB(1, 0), cB + kstep, voffB); PG8_STAGE(PG8_SA(1, 0), cA + kstep, voffA); PG8_STAGE(PG8_SB(1, 1), cB + hstep + kstep, voffB);
        PG8_WAIT_V(6); PG8_BAR;
    }
    for (;;) {
        const bool has_next = S.next(ui + 1, nxt);
        const char* nA = has_next ? (const char*)g.A + (size_t)nxt.pm * tstep : cA; const char* nB = has_next ? (const char*)g.Bt + (size_t)nxt.pn * tstep : cB;
        for (int t = 0; t < nt; t += 2) {
            const bool last = (t == nt - 2);
            const char* a1 = cA + (size_t)(t + 1) * kstep;
            const char* a2 = last ? nA : cA + (size_t)(t + 2) * kstep; const char* b2 = last ? nB : cB + (size_t)(t + 2) * kstep;
            const char* a3 = a2 + kstep; const char* b3 = b2 + kstep;
            if (last && has_next) S.a_ready(nxt);
            if constexpr (SP2) {
            PG8_LDB(B0, 0, 0); PG8_LDB(B1, 0, 1); PG8_SCHED; PG8_LDA(At, 0, 0); PG8_STAGE(PG8_SA(1, 1), a1 + hstep, voffA);
            PG8_WAIT_V(8); PG8_WAIT_L(0); PG8_BAR; PG8_MMA(0, 0, At, B0); PG8_MMA(0, 1, At, B1); PG8_BAR; PG8_SCHED;
            PG8_LDA(At, 0, 1); PG8_STAGE(PG8_SB(0, 0), b2, voffB); PG8_STAGE(PG8_SB(0, 1), b2 + hstep, voffB); PG8_STAGE(PG8_SA(0, 0), a2, voffA);
            PG8_WAIT_V(8); PG8_WAIT_L(0); PG8_BAR; PG8_MMA(1, 0, At, B0); PG8_MMA(1, 1, At, B1); PG8_BAR; PG8_SCHED;
            PG8_LDB(B0, 1, 0); PG8_LDB(B1, 1, 1); PG8_SCHED; PG8_LDA(At, 1, 0); PG8_STAGE(PG8_SA(0, 1), a2 + hstep, voffA);
            PG8_WAIT_V(8); PG8_WAIT_L(0); PG8_BAR; PG8_MMA(0, 0, At, B0); PG8_MMA(0, 1, At, B1); PG8_BAR; PG8_SCHED;
            PG8_LDA(At, 1, 1); PG8_STAGE(PG8_SB(1, 0), b3, voffB); PG8_STAGE(PG8_SB(1, 1), b3 + hstep, voffB); PG8_STAGE(PG8_SA(1, 0), a3, voffA);
            PG8_WAIT_V(8); PG8_WAIT_L(0); PG8_BAR; PG8_MMA(1, 0, At, B0); PG8_MMA(1, 1, At, B1); PG8_BAR; PG8_SCHED;
            } else {
            PG8_LDB(B0, 0, 0); PG8_SCHED; PG8_LDA(At, 0, 0); PG8_STAGE(PG8_SA(1, 1), a1 + hstep, voffA);
            PG8_WAIT_L(8); PG8_BAR; PG8_WAIT_L(0); PG8_MMA(0, 0, At, B0); PG8_BAR; PG8_SCHED;
            PG8_LDB(B1, 0, 1); PG8_STAGE(PG8_SB(0, 0), b2, voffB);
            PG8_BAR; PG8_WAIT_L(0); PG8_MMA(0, 1, At, B1); PG8_BAR;
            PG8_LDA(At, 0, 1); PG8_STAGE(PG8_SA(0, 0), a2, voffA);
            PG8_BAR; PG8_WAIT_L(0); PG8_MMA(1, 0, At, B0); PG8_BAR; PG8_SCHED;
            PG8_STAGE(PG8_SB(0, 1), b2 + hstep, voffB);
            PG8_WAIT_V(6); PG8_BAR; PG8_MMA(1, 1, At, B1); PG8_BAR;
            PG8_LDB(B0, 1, 0); PG8_SCHED; PG8_LDA(At, 1, 0); PG8_STAGE(PG8_SA(0, 1), a2 + hstep, voffA);
            PG8_WAIT_L(8); PG8_BAR; PG8_WAIT_L(0); PG8_MMA(0, 0, At, B0); PG8_BAR; PG8_SCHED;
            PG8_LDB(B1, 1, 1); PG8_STAGE(PG8_SB(1, 0), b3, voffB);
            PG8_BAR; PG8_WAIT_L(0); PG8_MMA(0, 1, At, B1); PG8_BAR;
            PG8_LDA(At, 1, 1); PG8_STAGE(PG8_SA(1, 0), a3, voffA);
            PG8_BAR; PG8_WAIT_L(0); PG8_MMA(1, 0, At, B0); PG8_BAR; PG8_SCHED;
            PG8_STAGE(PG8_SB(1, 1), b3 + hstep, voffB);
            PG8_WAIT_V(6); PG8_BAR; PG8_MMA(1, 1, At, B1); PG8_BAR;
            }
        }
        if constexpr (ALIGN_EPI) { if (wr == 0) PG8_BAR; }
        if constexpr (!Epi::AFTER_DRAIN) { E(acc, cur, wr, wc, fr, fq); S.done(cur); }
        if (!has_next) break;
#pragma unroll
        for (int a = 0; a < 2; ++a)
#pragma unroll
            for (int b = 0; b < 2; ++b)
#pragma unroll
                for (int m = 0; m < 4; ++m)
#pragma unroll
                    for (int n = 0; n < 2; ++n) acc[a][b][m][n] = (f32x4){0.f, 0.f, 0.f, 0.f};
        cur = nxt; cA = nA; cB = nB; ++ui;
        if constexpr (ALIGN_EPI) { if (wr == 1) PG8_BAR; }
    }
    PG8_WAIT_V(0);
    if constexpr (!ALIGN_EPI) { if (wr == 0) PG8_BAR; }
    PG8_BAR;
    if constexpr (Epi::AFTER_DRAIN) { E.fused(acc, cur, wr, wc, fr, fq, lds, wid, lane); S.done(cur); }
#undef PG8_SA
#undef PG8_SB
#undef PG8_STAGE
#undef PG8_LDA
#undef PG8_LDB
#undef PG8_MMA
#undef PG8_WAIT_V
#undef PG8_WAIT_L
#undef PG8_BAR
#undef PG8_SCHED
}
}
#ifndef PG8_SP2
#define PG8_SP2 true
#endif
#ifndef PG8_ALIGN
#define PG8_ALIGN true
#endif

#define LAS __attribute__((address_space(3)))
typedef unsigned short bf16;
typedef float f32x4 __attribute__((ext_vector_type(4)));
typedef float f32x8 __attribute__((ext_vector_type(8)));
typedef short bf16x8 __attribute__((ext_vector_type(8)));
typedef unsigned u32x4 __attribute__((ext_vector_type(4)));
typedef unsigned u32x2 __attribute__((ext_vector_type(2)));

constexpr int DM = 1024, DFF = 2816, NGU = 5632, NIN = 4608, NMIX = 1536, NLAYER = 4;
constexpr int TT = 81920, THALF = 40960, PLD = NIN  , YLD = NMIX;
constexpr int W_IN_SRC = 4368;
constexpr float EPSN = 1e-6f;
constexpr int PC_LRUX = 0, PC_GATE = 512, PC_Z = 1024, PC_XBC = 1536, PC_Q = 2304, PC_K = 2816, PC_V = 3328, PC_G = 3840, PC_DT = 4352;

constexpr size_t al256(size_t x) { return (x + 255) & ~(size_t)255; }
constexpr size_t SZ_WGU = (size_t)NGU * DM * 2, SZ_WD = (size_t)DM * DFF * 2, SZ_WIN = (size_t)NIN * DM * 2, SZ_WOUT = (size_t)DM * NMIX * 2;
constexpr size_t WS_WGU1 = 0;
constexpr size_t WS_WD1 = WS_WGU1 + NLAYER * SZ_WGU;
constexpr size_t WS_WIN = WS_WD1 + NLAYER * SZ_WD;
constexpr size_t WS_WOUT = WS_WIN + NLAYER * SZ_WIN;
constexpr size_t WS_WGU2 = WS_WOUT + NLAYER * SZ_WOUT;
constexpr size_t WS_WD2 = WS_WGU2 + NLAYER * SZ_WGU;
constexpr size_t WS_XB = al256(WS_WD2 + NLAYER * SZ_WD);
constexpr size_t WS_SSQ = al256(WS_XB + (size_t)TT * DM * 2);
constexpr size_t WS_ROPE = al256(WS_SSQ + (size_t)TT * 16 * 4);
constexpr size_t WS_BIG = al256(WS_ROPE + (size_t)8192 * 64 * 4 * 2);
constexpr size_t WS_PROJ = WS_BIG;
constexpr size_t WS_Y = al256(WS_PROJ + (size_t)THALF * PLD * 2);
constexpr size_t WS_YB = al256(WS_Y + (size_t)THALF * YLD * 2);
constexpr size_t WS_CXB = al256(WS_YB + (size_t)THALF * YLD * 2);
constexpr size_t WS_END1 = al256(WS_CXB + (size_t)THALF * 768 * 2);
constexpr size_t WS_H = WS_BIG;
constexpr size_t WS_END2 = al256(WS_H + (size_t)TT * DFF * 2);
constexpr size_t WS_NEED = WS_END1 > WS_END2 ? WS_END1 : WS_END2;

constexpr int LDS_BYTES = 147456;

__device__ __forceinline__ float bflo(unsigned w) { return __builtin_bit_cast(float, w << 16); }
__device__ __forceinline__ float bfhi(unsigned w) { return __builtin_bit_cast(float, w & 0xffff0000u); }
__device__ __forceinline__ float bf2f(bf16 b) { return __builtin_bit_cast(float, (unsigned)b << 16); }
__device__ __forceinline__ bf16 f2bf(float f) { unsigned u = __builtin_bit_cast(unsigned, f); return (bf16)((u + 0x7fffu + ((u >> 16) & 1u)) >> 16); }
__device__ __forceinline__ unsigned pk2(float lo, float hi) { return pg8::cvt_pk_bf16(lo, hi); }
__device__ __forceinline__ f32x8 unpack8(u32x4 w) { f32x8 o; o[0] = bflo(w.x); o[1] = bfhi(w.x); o[2] = bflo(w.y); o[3] = bfhi(w.y); o[4] = bflo(w.z); o[5] = bfhi(w.z); o[6] = bflo(w.w); o[7] = bfhi(w.w); return o; }
__device__ __forceinline__ u32x4 pack8(f32x8 v) { u32x4 w; w.x = pk2(v[0], v[1]); w.y = pk2(v[2], v[3]); w.z = pk2(v[4], v[5]); w.w = pk2(v[6], v[7]); return w; }
__device__ __forceinline__ f32x8 ld8f(const float* p) { const f32x4 a = *(const f32x4*)p, b = *(const f32x4*)(p + 4); f32x8 o; o[0] = a[0]; o[1] = a[1]; o[2] = a[2]; o[3] = a[3]; o[4] = b[0]; o[5] = b[1]; o[6] = b[2]; o[7] = b[3]; return o; }
__device__ __forceinline__ float sigm(float x) { return __builtin_amdgcn_rcpf(1.0f + __expf(-x)); }
__device__ __forceinline__ float siluf(float x) { return x * sigm(x); }
__device__ __forceinline__ float softplusf(float x) { return fmaxf(x, 0.f) + log1pf(__expf(-fabsf(x))); }
__device__ __forceinline__ float gelu_tanh(float x) { const float y = 0.7978845608028654f * (x + 0.044715f * x * x * x); const float t = 1.0f - 2.0f * __builtin_amdgcn_rcpf(1.0f + __expf(2.0f * y)); return 0.5f * x * (1.0f + t); }
__device__ __forceinline__ float wave_sum(float v) {
#pragma unroll
    for (int o = 1; o < 64; o <<= 1) v += __shfl_xor(v, o);
    return v;
}
__device__ __forceinline__ float row_rs(const float* ssq, size_t row) {
    const f32x4 a = *(const f32x4*)(ssq + row * 16), b = *(const f32x4*)(ssq + row * 16 + 4), c = *(const f32x4*)(ssq + row * 16 + 8), d = *(const f32x4*)(ssq + row * 16 + 12);
    const float s = ((a[0] + a[1]) + (a[2] + a[3])) + ((b[0] + b[1]) + (b[2] + b[3])) + ((c[0] + c[1]) + (c[2] + c[3])) + ((d[0] + d[1]) + (d[2] + d[3]));
    return rsqrtf(s * (1.0f / DM) + EPSN);
}
__device__ __forceinline__ int launder_tid() { int t = threadIdx.x; asm volatile("" : "+v"(t)); return t; }
#define MFMA16(a, b, c) __builtin_amdgcn_mfma_f32_16x16x32_bf16((a), (b), (c), 0, 0, 0)
__device__ __forceinline__ bf16x8 ldfrag(const LAS bf16* p) { return *(const LAS bf16x8*)p; }

struct EpiGU {
    static constexpr bool PERM = true, AFTER_DRAIN = false;
    bf16* H; const float* ssq;
    __device__ __forceinline__ void operator()(const pg8::f32x4 (&acc)[2][2][4][2], const pg8::Unit& u, int wr, int wc, int fr, int fq) const {
        const int row0 = u.pm * 256 + wr * 64 + fr, col0 = u.pn * 128 + wc * 32 + 8 * fq;
#pragma unroll
        for (int ai = 0; ai < 2; ++ai)
#pragma unroll
            for (int m = 0; m < 4; ++m) {
                const size_t row = (size_t)(row0 + ai * 128 + m * 16);
                const float rs = row_rs(ssq, row);
                const pg8::f32x4 g0 = acc[ai][0][m][0] * rs, g1 = acc[ai][0][m][1] * rs, u0 = acc[ai][1][m][0] * rs, u1 = acc[ai][1][m][1] * rs;
                u32x4 w;
                w.x = pk2(siluf(g0[0]) * u0[0], siluf(g0[1]) * u0[1]); w.y = pk2(siluf(g0[2]) * u0[2], siluf(g0[3]) * u0[3]);
                w.z = pk2(siluf(g1[0]) * u1[0], siluf(g1[1]) * u1[1]); w.w = pk2(siluf(g1[2]) * u1[2], siluf(g1[3]) * u1[3]);
                *(u32x4*)(H + row * DFF + col0) = w;
                asm volatile("" ::: "memory");
            }
    }
};
struct EpiProj {
    static constexpr bool PERM = true, AFTER_DRAIN = false;
    bf16* P; const float* ssq; int row_off; const float* rcos; const float* rsin;
    __device__ __forceinline__ void operator()(const pg8::f32x4 (&acc)[2][2][4][2], const pg8::Unit& u, int wr, int wc, int fr, int fq) const {
        const int row0 = u.pm * 256 + wr * 64 + fr, col0 = u.pn * 256 + wc * 32 + 8 * fq;
        if (u.pn >= 9 && u.pn <= 12) {
            const float ksc = u.pn >= 11 ? 0.08838834764831845f : 1.0f;
            const int d0 = 32 * (wc & 1) + 8 * fq, colr = u.pn * 256 + 128 * (wc >> 1) + d0;
#pragma unroll
            for (int ai = 0; ai < 2; ++ai)
#pragma unroll
                for (int m = 0; m < 4; ++m) {
                    const size_t row = (size_t)(row0 + ai * 128 + m * 16);
                    const int gr = (int)row + row_off, pos = gr < 65536 ? (gr & 8191) : (gr & 4095);
                    const float rs = row_rs(ssq, (size_t)gr) * ksc;
                    u32x4 w1, w2;
#pragma unroll
                    for (int n = 0; n < 2; ++n) {
                        const pg8::f32x4 cs = *(const pg8::f32x4*)(rcos + (size_t)pos * 64 + d0 + 4 * n), sn = *(const pg8::f32x4*)(rsin + (size_t)pos * 64 + d0 + 4 * n);
                        const pg8::f32x4 t1 = acc[ai][0][m][n] * rs, t2 = acc[ai][1][m][n] * rs;
                        const pg8::f32x4 o1 = t1 * cs - t2 * sn, o2 = t1 * sn + t2 * cs;
                        if (n == 0) { w1.x = pk2(o1[0], o1[1]); w1.y = pk2(o1[2], o1[3]); w2.x = pk2(o2[0], o2[1]); w2.y = pk2(o2[2], o2[3]); }
                        else { w1.z = pk2(o1[0], o1[1]); w1.w = pk2(o1[2], o1[3]); w2.z = pk2(o2[0], o2[1]); w2.w = pk2(o2[2], o2[3]); }
                    }
                    *(u32x4*)(P + row * PLD + colr) = w1; *(u32x4*)(P + row * PLD + colr + 64) = w2;
                    asm volatile("" ::: "memory");
                }
            return;
        }
#pragma unroll
        for (int ai = 0; ai < 2; ++ai)
#pragma unroll
            for (int m = 0; m < 4; ++m) {
                const size_t row = (size_t)(row0 + ai * 128 + m * 16);
                const float rs = row_rs(ssq, row + row_off);
#pragma unroll
                for (int bj = 0; bj < 2; ++bj) {
                    const pg8::f32x4 v0 = acc[ai][bj][m][0] * rs, v1 = acc[ai][bj][m][1] * rs;
                    u32x4 w; w.x = pk2(v0[0], v0[1]); w.y = pk2(v0[2], v0[3]); w.z = pk2(v1[0], v1[1]); w.w = pk2(v1[2], v1[3]);
                    *(u32x4*)(P + row * PLD + col0 + bj * 128) = w;
                }
                asm volatile("" ::: "memory");
            }
    }
};
struct EpiRes {
    static constexpr bool PERM = true, AFTER_DRAIN = false;
    float* X; bf16* XB; float* ssq; float coef; int row_off;
    __device__ __forceinline__ void operator()(const pg8::f32x4 (&acc)[2][2][4][2], const pg8::Unit& u, int wr, int wc, int fr, int fq) const {
        const int row0 = row_off + u.pm * 256 + wr * 64 + fr, col0 = u.pn * 256 + wc * 32 + 8 * fq;
#pragma unroll
        for (int ai = 0; ai < 2; ++ai)
#pragma unroll
            for (int m = 0; m < 4; ++m) {
                const size_t row = (size_t)(row0 + ai * 128 + m * 16);
                float s = 0.f;
#pragma unroll
                for (int bj = 0; bj < 2; ++bj) {
                    float* xp = X + row * DM + col0 + bj * 128;
                    pg8::f32x4 x0 = *(const pg8::f32x4*)xp, x1 = *(const pg8::f32x4*)(xp + 4);
                    x0 += acc[ai][bj][m][0] * coef; x1 += acc[ai][bj][m][1] * coef;
                    *(pg8::f32x4*)xp = x0; *(pg8::f32x4*)(xp + 4) = x1;
                    s += (x0[0] * x0[0] + x0[1] * x0[1]) + (x0[2] * x0[2] + x0[3] * x0[3]) + (x1[0] * x1[0] + x1[1] * x1[1]) + (x1[2] * x1[2] + x1[3] * x1[3]);
                    u32x4 w; w.x = pk2(x0[0], x0[1]); w.y = pk2(x0[2], x0[3]); w.z = pk2(x1[0], x1[1]); w.w = pk2(x1[2], x1[3]);
                    *(u32x4*)(XB + row * DM + col0 + bj * 128) = w;
                }
                s += __shfl_xor(s, 16); s += __shfl_xor(s, 32);
                if (fq == 0) ssq[row * 16 + u.pn * 4 + wc] = s;
                asm volatile("" ::: "memory");
            }
    }
};

__device__ __forceinline__ int colmap(int kind, int n) {
    if (kind == 0) return n;
    if (kind == 1) { const int t = n >> 8, w = n & 255; return w < 128 ? 128 * t + w : DFF + 128 * t + (w - 128); }
    if (n < 2304) return n;
    if (n < 3328) { const int t = n >> 8, w = n & 255, bj = w >> 7, o = w & 127; return 256 * t + 128 * (o >> 6) + (o & 63) + 64 * bj + 16; }
    return n < 4352 ? n + 16 : (n < 4368 ? n - 4352 + 2304 : -1);
}
__device__ __forceinline__ void transpose_item(const float* W, int K, int Nsrc, int Ndst, const float* kscale, bf16* WT, int kind, int item, int lane, LAS float* scr) {
    const int nblk = Ndst / 32, kb = item / nblk, nb = item % nblk, k0 = 64 * kb, n0 = 32 * nb;
    const int sc = colmap(kind, n0 + (lane & 31));
#pragma unroll 8
    for (int i = 0; i < 32; ++i) { const int kk = 2 * i + (lane >> 5); float v = 0.f; if (sc >= 0) { v = W[(size_t)(k0 + kk) * Nsrc + sc]; if (kscale) v *= kscale[k0 + kk]; } scr[kk * 33 + (lane & 31)] = v; }
    asm volatile("s_waitcnt lgkmcnt(0)" ::: "memory");
    const int c = lane & 7;
#pragma unroll
    for (int j = 0; j < 4; ++j) { const int n = (lane >> 3) + 8 * j; const LAS float* s = scr + (8 * c) * 33 + n;
        u32x4 o; o.x = pk2(s[0 * 33], s[1 * 33]); o.y = pk2(s[2 * 33], s[3 * 33]); o.z = pk2(s[4 * 33], s[5 * 33]); o.w = pk2(s[6 * 33], s[7 * 33]);
        *(u32x4*)(WT + (size_t)(n0 + n) * K + k0 + 8 * c) = o; }
    asm volatile("s_waitcnt lgkmcnt(0)" ::: "memory");
}

struct Args { const float* in[26]; float* out; unsigned char* ws; };
typedef const __attribute__((address_space(4))) Args* KArgsPtr;
__device__ __forceinline__ KArgsPtr kargs() { KArgsPtr p = (KArgsPtr)__builtin_amdgcn_kernarg_segment_ptr(); asm volatile("" : "+s"(p)); return p; }

__device__ __forceinline__ f32x8 conv8(const bf16* proj, int lrow, int pcol, int pos, int seqlen, const float* cw, int cw_ld, const float* cb, int ccol) {
    f32x8 acc = ld8f(cb + ccol);
#pragma unroll
    for (int k = 0; k < 4; ++k) {
        const int s = pos + k - 2;
        if (s >= 0 && s < seqlen) {
            const u32x4 raw = *(const u32x4*)(proj + (size_t)(lrow + k - 2) * PLD + pcol);
            acc += ld8f(cw + k * cw_ld + ccol) * unpack8(raw);
        }
    }
    return acc;
}

__device__ __forceinline__ void ret_item(LAS unsigned char* lds, const bf16* proj, bf16* yout, int gv, int vloc, int hd, int dir) {
    const int tid = launder_tid(), wid = __builtin_amdgcn_readfirstlane(tid >> 6), lane = tid & 63, fr = lane & 15, fq = lane >> 4;
    constexpr int LD = 136;
    LAS bf16* KN = (LAS bf16*)lds; LAS bf16* KTW = KN + 128 * LD; LAS bf16* VT = KTW + 128 * LD; LAS bf16* RT = VT + 128 * LD;
    const int seqlen = gv < 8 ? 8192 : 4096;
    const float l2g = log2f(1.0f - exp2f(-5.0f - (float)hd));
    const float cdec = exp2f(l2g * 128.0f);
    const int i0 = 4 * (tid >> 4), c8 = 8 * (tid & 15), qi = 16 * wid + fr;
    float wl[4];
#pragma unroll
    for (int r = 0; r < 4; ++r) wl[r] = exp2f(l2g * (float)(dir ? i0 + r : 127 - (i0 + r)));
    const float rsc = exp2f(l2g * (float)(dir ? 128 - qi : qi + 1));
    f32x4 R[8];
#pragma unroll
    for (int i = 0; i < 8; ++i) R[i] = (f32x4){0.f, 0.f, 0.f, 0.f};
    for (int i = tid; i < 128 * LD / 2; i += 512) ((LAS unsigned*)RT)[i] = 0u;
    u32x4 kraw[4], vraw[4], qraw[4];
#define RET_LOAD(CC) do { const int lr0_ = vloc * 8192 + (CC) * 128; \
        _Pragma("unroll") for (int r = 0; r < 4; ++r) { const bf16* rp_ = proj + (size_t)(lr0_ + i0 + r) * PLD + 128 * hd + c8; kraw[r] = *(const u32x4*)(rp_ + PC_K); vraw[r] = *(const u32x4*)(rp_ + PC_V); } \
        _Pragma("unroll") for (int ks = 0; ks < 4; ++ks) qraw[ks] = *(const u32x4*)(proj + (size_t)(lr0_ + qi) * PLD + PC_Q + 128 * hd + 32 * ks + 8 * fq); } while (0)
    RET_LOAD(dir ? 63 : 0);
    __syncthreads();
    for (int c = 0; c < 64; ++c) {
        const int cc = dir ? 63 - c : c;
        const int lrow0 = vloc * 8192 + cc * 128;
        const bool do_intra = ((cc & 1) == dir);
        bool next_reset = false;
        if (c < 63) { const int ncc = dir ? cc - 1 : cc + 1; const int np = (ncc * 128) % seqlen; next_reset = dir ? (np + 128 == seqlen) : (np == 0); }
        {
            if (do_intra) {
#pragma unroll
                for (int r = 0; r < 4; ++r) *(LAS u32x4*)(KN + (i0 + r) * LD + c8) = kraw[r];
            }
            LAS bf16* kt = KTW + c8 * LD + i0; LAS bf16* vt = VT + c8 * LD + i0;
#pragma unroll
            for (int m = 0; m < 4; ++m) {
                u32x2 we, wo;
                we.x = pk2(bflo(kraw[0][m]) * wl[0], bflo(kraw[1][m]) * wl[1]); we.y = pk2(bflo(kraw[2][m]) * wl[2], bflo(kraw[3][m]) * wl[3]);
                wo.x = pk2(bfhi(kraw[0][m]) * wl[0], bfhi(kraw[1][m]) * wl[1]); wo.y = pk2(bfhi(kraw[2][m]) * wl[2], bfhi(kraw[3][m]) * wl[3]);
                *(LAS u32x2*)(kt + (2 * m) * LD) = we; *(LAS u32x2*)(kt + (2 * m + 1) * LD) = wo;
                u32x2 ve, vo;
                ve.x = (vraw[0][m] & 0xffffu) | (vraw[1][m] << 16); ve.y = (vraw[2][m] & 0xffffu) | (vraw[3][m] << 16);
                vo.x = (vraw[0][m] >> 16) | (vraw[1][m] & 0xffff0000u); vo.y = (vraw[2][m] >> 16) | (vraw[3][m] & 0xffff0000u);
                *(LAS u32x2*)(vt + (2 * m) * LD) = ve; *(LAS u32x2*)(vt + (2 * m + 1) * LD) = vo;
            }
        }
        bf16x8 qf[4];
#pragma unroll
        for (int ks = 0; ks < 4; ++ks) qf[ks] = __builtin_bit_cast(bf16x8, qraw[ks]);
        if (c < 63) { const int ncc = dir ? cc - 1 : cc + 1; RET_LOAD(ncc); }
        __syncthreads();
        unsigned sp[8][2];
        if (do_intra) {
#pragma unroll
            for (int ct = 0; ct < 8; ++ct) {
                f32x4 a = (f32x4){0.f, 0.f, 0.f, 0.f};
#pragma unroll
                for (int ks = 0; ks < 4; ++ks) a = MFMA16(ldfrag(KN + (16 * ct + fr) * LD + 32 * ks + 8 * fq), qf[ks], a);
                const int j0 = 16 * ct + 4 * fq;
                float dv[4];
#pragma unroll
                for (int e = 0; e < 4; ++e) { const int dd = qi - (j0 + e); dv[e] = a[e] * exp2f(l2g * (float)(dd < 0 ? -dd : dd)); }
                sp[ct][0] = pk2(dv[0], dv[1]); sp[ct][1] = pk2(dv[2], dv[3]);
            }
            __syncthreads();
#pragma unroll
            for (int ct = 0; ct < 8; ++ct) { u32x2 w; w.x = sp[ct][0]; w.y = sp[ct][1]; *(LAS u32x2*)(KN + qi * LD + 16 * ct + 4 * fq) = w; }
        }
        {
            f32x4 Y[8];
#pragma unroll
            for (int ct = 0; ct < 8; ++ct) {
                f32x4 a = (f32x4){0.f, 0.f, 0.f, 0.f};
#pragma unroll
                for (int ks = 0; ks < 4; ++ks) a = MFMA16(ldfrag(RT + (16 * ct + fr) * LD + 32 * ks + 8 * fq), qf[ks], a);
                Y[ct] = a * rsc;
            }
            if (do_intra) {
#pragma unroll
                for (int ks = 0; ks < 4; ++ks) {
                    const bf16x8 pf = ldfrag(KN + qi * LD + 32 * ks + 8 * fq);
#pragma unroll
                    for (int ct = 0; ct < 8; ++ct) Y[ct] = MFMA16(ldfrag(VT + (16 * ct + fr) * LD + 32 * ks + 8 * fq), pf, Y[ct]);
                }
            }
            bf16* yo = yout + (size_t)(lrow0 + qi) * YLD + 1024 + 128 * hd + 4 * fq;
#pragma unroll
            for (int ct = 0; ct < 8; ++ct) { u32x2 w; w.x = pk2(Y[ct][0], Y[ct][1]); w.y = pk2(Y[ct][2], Y[ct][3]); *(u32x2*)(yo + 16 * ct) = w; }
        }
#pragma unroll
        for (int ct = 0; ct < 8; ++ct) R[ct] *= cdec;
#pragma unroll
        for (int ks = 0; ks < 4; ++ks) {
            const bf16x8 kf = ldfrag(KTW + (16 * wid + fr) * LD + 32 * ks + 8 * fq);
#pragma unroll
            for (int ct = 0; ct < 8; ++ct) R[ct] = MFMA16(kf, ldfrag(VT + (16 * ct + fr) * LD + 32 * ks + 8 * fq), R[ct]);
        }
        if (next_reset) {
#pragma unroll
            for (int ct = 0; ct < 8; ++ct) R[ct] = (f32x4){0.f, 0.f, 0.f, 0.f};
        }
        __syncthreads();
#pragma unroll
        for (int ct = 0; ct < 8; ++ct) { u32x2 w; w.x = pk2(R[ct][0], R[ct][1]); w.y = pk2(R[ct][2], R[ct][3]); *(LAS u32x2*)(RT + (16 * ct + fr) * LD + 16 * wid + 4 * fq) = w; }
    }
#undef RET_LOAD
    __syncthreads();
}

__device__ __forceinline__ void ssd_item(LAS unsigned char* lds, const bf16* proj, const bf16* cxb, bf16* yout, const float* dt_bias, const float* a_log, const float* dskip,
                                         int gv, int vloc, int hh, int dir) {
    const int tid = launder_tid(), wid = __builtin_amdgcn_readfirstlane(tid >> 6), lane = tid & 63, fr = lane & 15, fq = lane >> 4;
    constexpr int LDL = 136, LDS_ = 72;
    LAS bf16* XST = (LAS bf16*)lds;
    LAS bf16* CN = XST + 64 * LDL;
    LAS bf16* BN = CN + 128 * LDS_;
    LAS bf16* BTW = BN + 128 * LDS_;
    LAS bf16* PP = BTW + 64 * LDL;
    LAS bf16* HL = PP + 128 * LDL;
    LAS float* DT = (LAS float*)(HL + 64 * LDS_);
    LAS float* ACUM = DT + 128;
    LAS float* CWL = ACUM + 128;
    const int seqlen = gv < 8 ? 8192 : 4096, grp = hh >> 2;
    const float aneg = -__expf(a_log[dir * 8 + hh]), dtb = dt_bias[dir * 8 + hh], dsk = dskip[hh];
    const int cg8 = tid % 24, rb = tid / 24, sec = cg8 >> 3, c8 = (cg8 & 7) * 8, i0 = 8 * rb;
    const int xc = sec == 0 ? 64 * hh + c8 : (sec == 1 ? 512 + 64 * grp + c8 : 640 + 64 * grp + c8);
    const bool stager = tid < 384;
    f32x4 Hc[2];
    Hc[0] = (f32x4){0.f, 0.f, 0.f, 0.f}; Hc[1] = (f32x4){0.f, 0.f, 0.f, 0.f};
    for (int i = tid; i < 64 * LDS_ / 2; i += 512) ((LAS unsigned*)HL)[i] = 0u;
    u32x4 raw[8]; float dtraw = 0.f;
#define SSD_LOAD(CC) do { const int lr0_ = vloc * 8192 + (CC) * 128; \
        if (stager) { _Pragma("unroll") for (int r = 0; r < 8; ++r) raw[r] = *(const u32x4*)(cxb + (size_t)(lr0_ + i0 + r) * 768 + xc); } \
        if (tid < 128) dtraw = bf2f(proj[(size_t)(lr0_ + tid) * PLD + PC_DT + dir * 8 + hh]); } while (0)
    SSD_LOAD(dir ? 63 : 0);
    __syncthreads();
    for (int c = 0; c < 64; ++c) {
        const int cc = dir ? 63 - c : c;
        const int lrow0 = vloc * 8192 + cc * 128;
        bool next_reset = false;
        if (c < 63) { const int ncc = dir ? cc - 1 : cc + 1; const int np = (ncc * 128) % seqlen; next_reset = dir ? (np + 128 == seqlen) : (np == 0); }
        if (tid < 128) DT[tid] = softplusf(dtraw + dtb);
        __syncthreads();
        float tot;
        {
            const float x0 = DT[2 * lane] * aneg, x1 = DT[2 * lane + 1] * aneg;
            float s = x0 + x1;
#pragma unroll
            for (int o = 1; o < 64; o <<= 1) { const float t = __shfl_up(s, o); if (lane >= o) s += t; }
            tot = __shfl(s, 63);
            const float p1 = s, p0 = s - x1;
            if (dir == 0) { ACUM[2 * lane] = p0; ACUM[2 * lane + 1] = p1; }
            else { ACUM[2 * lane] = tot - p0 + x0; ACUM[2 * lane + 1] = tot - p1 + x1; }
        }
        if (stager) {
#pragma unroll
            for (int hc = 0; hc < 2; ++hc) {
                u32x2 pv[4];
#pragma unroll
                for (int od = 0; od < 8; ++od) {
                    u32x2 pk; pk.x = raw[od][2 * hc]; pk.y = raw[od][2 * hc + 1];
                    if (sec == 0) pv[od & 3] = pk;
                    else if (sec == 1) { *(LAS u32x2*)(BN + (i0 + od) * LDS_ + c8 + 4 * hc) = pk; const float wr = __expf(tot - ACUM[i0 + od]) * DT[i0 + od];
                        u32x2 pw; pw.x = pk2(bflo(pk.x) * wr, bfhi(pk.x) * wr); pw.y = pk2(bflo(pk.y) * wr, bfhi(pk.y) * wr); pv[od & 3] = pw; }
                    else *(LAS u32x2*)(CN + (i0 + od) * LDS_ + c8 + 4 * hc) = pk;
                    if ((od & 3) == 3 && sec != 2) {
                        LAS bf16* dstT = (sec == 0 ? XST : BTW) + (c8 + 4 * hc) * LDL + i0 + (od - 3);
#pragma unroll
                        for (int m = 0; m < 2; ++m) {
                            u32x2 we, wo;
                            we.x = (pv[0][m] & 0xffffu) | (pv[1][m] << 16); we.y = (pv[2][m] & 0xffffu) | (pv[3][m] << 16);
                            wo.x = (pv[0][m] >> 16) | (pv[1][m] & 0xffff0000u); wo.y = (pv[2][m] >> 16) | (pv[3][m] & 0xffff0000u);
                            *(LAS u32x2*)(dstT + (2 * m) * LDL) = we; *(LAS u32x2*)(dstT + (2 * m + 1) * LDL) = wo;
                        }
                    }
                }
            }
        }
        if (c < 63) { const int ncc = dir ? cc - 1 : cc + 1; SSD_LOAD(ncc); }
        __syncthreads();
        const int qi = 16 * wid + fr;
        bf16x8 cf[2];
        cf[0] = ldfrag(CN + qi * LDS_ + 8 * fq); cf[1] = ldfrag(CN + qi * LDS_ + 32 + 8 * fq);
        const float aci = ACUM[qi];
#pragma unroll
        for (int ct = 0; ct < 8; ++ct) {
            f32x4 a = (f32x4){0.f, 0.f, 0.f, 0.f};
#pragma unroll
            for (int ks = 0; ks < 2; ++ks) a = MFMA16(ldfrag(BN + (16 * ct + fr) * LDS_ + 32 * ks + 8 * fq), cf[ks], a);
            const int j0 = 16 * ct + 4 * fq;
            const f32x4 acj = *(const LAS f32x4*)(ACUM + j0), dtj = *(const LAS f32x4*)(DT + j0);
            float wv[4];
#pragma unroll
            for (int e = 0; e < 4; ++e) { const int j = j0 + e; const bool ok = dir ? (j >= qi) : (j <= qi); wv[e] = ok ? a[e] * __expf(aci - acj[e]) * dtj[e] : 0.f; }
            u32x2 w; w.x = pk2(wv[0], wv[1]); w.y = pk2(wv[2], wv[3]);
            *(LAS u32x2*)(PP + qi * LDL + j0) = w;
        }
        {
            const float ea = __expf(aci);
            f32x4 Y[4];
#pragma unroll
            for (int pt = 0; pt < 4; ++pt) {
                f32x4 a = (f32x4){0.f, 0.f, 0.f, 0.f};
#pragma unroll
                for (int ks = 0; ks < 2; ++ks) a = MFMA16(ldfrag(HL + (16 * pt + fr) * LDS_ + 32 * ks + 8 * fq), cf[ks], a);
                Y[pt] = a * ea;
            }
#pragma unroll
            for (int ks = 0; ks < 4; ++ks) {
                const bf16x8 pf = ldfrag(PP + qi * LDL + 32 * ks + 8 * fq);
#pragma unroll
                for (int pt = 0; pt < 4; ++pt) Y[pt] = MFMA16(ldfrag(XST + (16 * pt + fr) * LDL + 32 * ks + 8 * fq), pf, Y[pt]);
            }
            bf16* yo = yout + (size_t)(lrow0 + qi) * YLD + 512 + 64 * hh + 4 * fq;
#pragma unroll
            for (int pt = 0; pt < 4; ++pt) {
                if (dir == 0) {
#pragma unroll
                    for (int e = 0; e < 4; ++e) Y[pt][e] += dsk * bf2f(XST[(16 * pt + 4 * fq + e) * LDL + qi]);
                }
                u32x2 w; w.x = pk2(Y[pt][0], Y[pt][1]); w.y = pk2(Y[pt][2], Y[pt][3]); *(u32x2*)(yo + 16 * pt) = w;
            }
        }
        {
            const float et = __expf(tot);
            Hc[0] *= et; Hc[1] *= et;
#pragma unroll
            for (int ks = 0; ks < 4; ++ks) {
                const bf16x8 xf = ldfrag(XST + (16 * (wid & 3) + fr) * LDL + 32 * ks + 8 * fq);
#pragma unroll
                for (int j2 = 0; j2 < 2; ++j2) Hc[j2] = MFMA16(ldfrag(BTW + (16 * (2 * (wid >> 2) + j2) + fr) * LDL + 32 * ks + 8 * fq), xf, Hc[j2]);
            }
            if (next_reset) { Hc[0] = (f32x4){0.f, 0.f, 0.f, 0.f}; Hc[1] = (f32x4){0.f, 0.f, 0.f, 0.f}; }
        }
        __syncthreads();
#pragma unroll
        for (int j2 = 0; j2 < 2; ++j2) { u32x2 w; w.x = pk2(Hc[j2][0], Hc[j2][1]); w.y = pk2(Hc[j2][2], Hc[j2][3]);
            *(LAS u32x2*)(HL + (16 * (wid & 3) + fr) * LDS_ + 16 * (2 * (wid >> 2) + j2) + 4 * fq) = w; }
    }
#undef SSD_LOAD
    __syncthreads();
}

__device__ __forceinline__ void lru_item(LAS unsigned char* lds, const bf16* proj, bf16* yout, const float* cw, const float* cb, const float* w_a, const float* b_a, const float* w_i, const float* b_i,
                                         const float* lam, int gv, int vloc, int nb, int dir) {
    const int tid = launder_tid(), wid = __builtin_amdgcn_readfirstlane(tid >> 6), lane = tid & 63, fr = lane & 15, fq = lane >> 4;
    constexpr int LDX = 72;
    LAS bf16* XCB = (LAS bf16*)lds;
    LAS bf16* WT = XCB + 128 * LDX;
    LAS float* AA = (LAS float*)(WT + 128 * LDX);
    LAS float* UU = AA + 128 * 64;
    LAS float* AGG = UU + 128 * 64;
    LAS float* CARRY = AGG + 8 * 64 * 2;
    LAS float* BA = CARRY + 128;
    LAS float* BI = BA + 64;
    LAS float* SP = BI + 64;
    const int seqlen = gv < 8 ? 8192 : 4096;
    for (int idx = tid; idx < 8192; idx += 512) {
        const int mat = idx >> 12, rem = idx & 4095, i = rem >> 6, j = rem & 63;
        const float* w = (mat ? w_i : w_a) + (size_t)((dir * 8 + nb) * 64 + i) * 64 + j;
        WT[(64 * mat + j) * LDX + i] = f2bf(*w);
    }
    if (tid < 64) { CARRY[tid] = 0.f; CARRY[64 + tid] = 0.f; BA[tid] = b_a[dir * 512 + 64 * nb + tid]; BI[tid] = b_i[dir * 512 + 64 * nb + tid]; SP[tid] = 8.0f * softplusf(-lam[dir * 512 + 64 * nb + tid]); }
    const int c8 = (tid & 7) * 8, i0 = 2 * (tid >> 3), ccol = 64 * nb + c8;
    const f32x8 w0 = ld8f(cw + 0 * 512 + ccol), w1 = ld8f(cw + 1 * 512 + ccol), w2 = ld8f(cw + 2 * 512 + ccol), w3 = ld8f(cw + 3 * 512 + ccol), bb = ld8f(cb + ccol);
    u32x4 raw[5];
#define LRU_LOAD(CC) do { const int lr0_ = vloc * 8192 + (CC) * 128, p0_ = ((CC) * 128) % seqlen; \
        _Pragma("unroll") for (int r = 0; r < 5; ++r) { const int s_ = p0_ + i0 - 2 + r; raw[r] = (u32x4){0u, 0u, 0u, 0u}; \
            if (s_ >= 0 && s_ < seqlen) raw[r] = *(const u32x4*)(proj + (size_t)(lr0_ + i0 - 2 + r) * PLD + PC_LRUX + ccol); } } while (0)
    LRU_LOAD(dir ? 63 : 0);
    __syncthreads();
    for (int c = 0; c < 64; ++c) {
        const int cc = dir ? 63 - c : c;
        const int lrow0 = vloc * 8192 + cc * 128;
        bool next_reset = false;
        if (c < 63) { const int ncc = dir ? cc - 1 : cc + 1; const int np = (ncc * 128) % seqlen; next_reset = dir ? (np + 128 == seqlen) : (np == 0); }
#pragma unroll
        for (int r = 0; r < 2; ++r) {
            const f32x8 v = bb + w0 * unpack8(raw[r]) + w1 * unpack8(raw[r + 1]) + w2 * unpack8(raw[r + 2]) + w3 * unpack8(raw[r + 3]);
            *(LAS u32x4*)(XCB + (i0 + r) * LDX + c8) = pack8(v);
        }
        if (c < 63) { const int ncc = dir ? cc - 1 : cc + 1; LRU_LOAD(ncc); }
        __syncthreads();
        const int t = 16 * wid + fr;
        {
            bf16x8 xf[2];
            xf[0] = ldfrag(XCB + t * LDX + 8 * fq); xf[1] = ldfrag(XCB + t * LDX + 32 + 8 * fq);
            f32x4 Gt[8];
#pragma unroll
            for (int ct = 0; ct < 8; ++ct) {
                f32x4 a = (f32x4){0.f, 0.f, 0.f, 0.f};
#pragma unroll
                for (int ks = 0; ks < 2; ++ks) a = MFMA16(ldfrag(WT + (16 * ct + fr) * LDX + 32 * ks + 8 * fq), xf[ks], a);
                Gt[ct] = a;
            }
#pragma unroll
            for (int ct = 0; ct < 4; ++ct) {
                const int c0 = 16 * ct + 4 * fq;
                const f32x4 ba = *(const LAS f32x4*)(BA + c0), bi = *(const LAS f32x4*)(BI + c0), sp = *(const LAS f32x4*)(SP + c0);
                const u32x2 xw = *(const LAS u32x2*)(XCB + t * LDX + c0);
                const float xv[4] = {bflo(xw.x), bfhi(xw.x), bflo(xw.y), bfhi(xw.y)};
                f32x4 av, uv;
#pragma unroll
                for (int e = 0; e < 4; ++e) {
                    const float r = sigm(Gt[ct][e] + ba[e]), ig = sigm(Gt[ct + 4][e] + bi[e]);
                    const float la = -r * sp[e];
                    const float a = __expf(la);
                    av[e] = a;
                    uv[e] = sqrtf(fmaxf((1.0f - a) * (1.0f + a), 0.f)) * ig * xv[e];
                }
                *(LAS f32x4*)(AA + t * 64 + c0) = av; *(LAS f32x4*)(UU + t * 64 + c0) = uv;
            }
        }
        __syncthreads();
        {
            const int ch = tid & 63, seg = tid >> 6;
            float Pp = 1.f, h = 0.f;
#pragma unroll
            for (int k = 0; k < 16; ++k) { const int o = seg * 16 + k, tt = dir ? 127 - o : o; const float a = AA[tt * 64 + ch], u = UU[tt * 64 + ch]; h = a * h + u; Pp *= a; }
            AGG[(seg * 64 + ch) * 2] = Pp; AGG[(seg * 64 + ch) * 2 + 1] = h;
            __syncthreads();
            float cin = CARRY[(c & 1) * 64 + ch];
            for (int s = 0; s < seg; ++s) cin = AGG[(s * 64 + ch) * 2] * cin + AGG[(s * 64 + ch) * 2 + 1];
            h = cin;
            bf16* yo = yout + (size_t)lrow0 * YLD + 64 * nb + ch;
#pragma unroll
            for (int k = 0; k < 16; ++k) { const int o = seg * 16 + k, tt = dir ? 127 - o : o; const float a = AA[tt * 64 + ch], u = UU[tt * 64 + ch]; h = a * h + u; yo[(size_t)tt * YLD] = f2bf(h); }
            if (seg == 7) CARRY[((c + 1) & 1) * 64 + ch] = next_reset ? 0.f : h;
        }
    }
#undef LRU_LOAD
    __syncthreads();
}

__device__ __forceinline__ void conv_prepass(const bf16* proj, bf16* cxb, const float* cw, const float* cb, int sub, int bx, int G) {
    const int tid = launder_tid();
    for (int id = bx * 512 + tid; id < 96 * (THALF / 32); id += G * 512) {
        const int cgp = id % 96, seg = id / 96, xc = 8 * cgp;
        const int row0 = seg * 32, gv = sub * 5 + (row0 >> 13), seqlen = gv < 8 ? 8192 : 4096, posb = row0 % seqlen;
#pragma unroll 1
        for (int blk = 0; blk < 4; ++blk) {
            const int r0 = row0 + 8 * blk, p0 = posb + 8 * blk;
            u32x4 raw[11];
#pragma unroll
            for (int r = 0; r < 11; ++r) { const int s_ = p0 - 2 + r; raw[r] = (u32x4){0u, 0u, 0u, 0u}; if (s_ >= 0 && s_ < seqlen) raw[r] = *(const u32x4*)(proj + (size_t)(r0 - 2 + r) * PLD + PC_XBC + xc); }
#pragma unroll
            for (int hc = 0; hc < 2; ++hc) {
                const int cl = xc + 4 * hc;
                const f32x4 w0 = *(const f32x4*)(cw + 0 * 768 + cl), w1 = *(const f32x4*)(cw + 1 * 768 + cl), w2 = *(const f32x4*)(cw + 2 * 768 + cl), w3 = *(const f32x4*)(cw + 3 * 768 + cl), bb = *(const f32x4*)(cb + cl);
                f32x4 ring[4] = {bb, bb, bb, bb};
#pragma unroll
                for (int r = 0; r < 11; ++r) {
                    const unsigned xa = raw[r][2 * hc], xb = raw[r][2 * hc + 1];
                    const f32x4 x = (f32x4){bflo(xa), bfhi(xa), bflo(xb), bfhi(xb)};
                    if (r <= 7) ring[r & 3] += w0 * x;
                    if (r >= 1 && r <= 8) ring[(r - 1) & 3] += w1 * x;
                    if (r >= 2 && r <= 9) ring[(r - 2) & 3] += w2 * x;
                    if (r >= 3) {
                        const int od = r - 3;
                        f32x4 t = ring[od & 3] + w3 * x;
                        ring[od & 3] = bb;
#pragma unroll
                        for (int e = 0; e < 4; ++e) t[e] = siluf(t[e]);
                        u32x2 pk; pk.x = pk2(t[0], t[1]); pk.y = pk2(t[2], t[3]);
                        *(u32x2*)(cxb + (size_t)(r0 + od) * 768 + cl) = pk;
                    }
                }
            }
        }
    }
}

__global__ void __launch_bounds__(512, 2) mega_fwd(Args args) {
    extern __shared__ __attribute__((aligned(16))) unsigned char lds_raw[];
    LAS unsigned char* lds = (LAS unsigned char*)lds_raw;
    cg::grid_group grid = cg::this_grid();
    const int wid = __builtin_amdgcn_readfirstlane(launder_tid() >> 6), G = gridDim.x, bx = blockIdx.x;
    unsigned char* ws; float* X;
    { KArgsPtr KA0 = kargs(); ws = KA0->ws; X = KA0->out; }
    bf16* XB = (bf16*)(ws + WS_XB); float* SSQ = (float*)(ws + WS_SSQ);
    float* RCOS = (float*)(ws + WS_ROPE); float* RSIN = RCOS + 8192 * 64;
    bf16* PROJ = (bf16*)(ws + WS_PROJ); bf16* YF = (bf16*)(ws + WS_Y); bf16* YBK = (bf16*)(ws + WS_YB); bf16* HB = (bf16*)(ws + WS_H);
    const int gw = bx * 8 + wid, NGW = G * 8;

    {
        KArgsPtr KA = kargs();
        const int tid = launder_tid(), lane = tid & 63;
        LAS float* scr = (LAS float*)(lds + wid * 16384);
        constexpr int I_GU = (DM / 64) * (NGU / 32), I_D = (DFF / 64) * (DM / 32), I_IN = (DM / 64) * (NIN / 32), I_OUT = (NMIX / 64) * (DM / 32);
        constexpr int I_LAYER = 2 * I_GU + 2 * I_D + I_IN + I_OUT;
        for (int it = gw; it < NLAYER * I_LAYER; it += NGW) {
            const int l = it / I_LAYER; int r = it % I_LAYER;
            if (r < I_GU) { transpose_item(KA->in[3] + (size_t)l * DM * NGU, DM, NGU, NGU, KA->in[2] + l * DM, (bf16*)(ws + WS_WGU1 + l * SZ_WGU), 1, r, lane, scr); continue; } r -= I_GU;
            if (r < I_GU) { transpose_item(KA->in[23] + (size_t)l * DM * NGU, DM, NGU, NGU, KA->in[22] + l * DM, (bf16*)(ws + WS_WGU2 + l * SZ_WGU), 1, r, lane, scr); continue; } r -= I_GU;
            if (r < I_D) { transpose_item(KA->in[4] + (size_t)l * DFF * DM, DFF, DM, DM, nullptr, (bf16*)(ws + WS_WD1 + l * SZ_WD), 0, r, lane, scr); continue; } r -= I_D;
            if (r < I_D) { transpose_item(KA->in[24] + (size_t)l * DFF * DM, DFF, DM, DM, nullptr, (bf16*)(ws + WS_WD2 + l * SZ_WD), 0, r, lane, scr); continue; } r -= I_D;
            if (r < I_IN) { transpose_item(KA->in[6] + (size_t)l * DM * W_IN_SRC, DM, W_IN_SRC, NIN, KA->in[5] + l * DM, (bf16*)(ws + WS_WIN + l * SZ_WIN), 2, r, lane, scr); continue; } r -= I_IN;
            transpose_item(KA->in[21] + (size_t)l * NMIX * DM, NMIX, DM, DM, nullptr, (bf16*)(ws + WS_WOUT + l * SZ_WOUT), 0, r, lane, scr);
        }
        for (int m = gw; m < TT; m += NGW) {
            const float* src = m < 65536 ? KA->in[0] + (size_t)m * DM : KA->in[1] + (size_t)(m - 65536) * DM;
            float s = 0.f;
#pragma unroll
            for (int j = 0; j < 4; ++j) {
                const f32x4 v = *(const f32x4*)(src + 256 * j + 4 * lane);
                *(f32x4*)(X + (size_t)m * DM + 256 * j + 4 * lane) = v;
                u32x2 w; w.x = pk2(v[0], v[1]); w.y = pk2(v[2], v[3]);
                *(u32x2*)(XB + (size_t)m * DM + 256 * j + 4 * lane) = w;
                s += (v[0] * v[0] + v[1] * v[1]) + (v[2] * v[2] + v[3] * v[3]);
            }
            s = wave_sum(s);
            if (lane < 16) SSQ[(size_t)m * 16 + lane] = lane == 0 ? s : 0.f;
        }
        for (int i = bx * 512 + tid; i < 8192 * 64; i += G * 512) {
            const int pos = i >> 6, f = i & 63;
            const float inv = 1.0f / powf(10000.0f, (float)(2 * f) / 128.0f);
            const float ang = (float)pos * inv;
            RCOS[i] = cosf(ang); RSIN[i] = sinf(ang);
        }
    }
    grid.sync();

    for (int l = 0; l < NLAYER; ++l) {
        for (int st = 0; st < 3; ++st) {
            const int nsub = st == 1 ? 2 : 1;
            for (int sub = 0; sub < nsub; ++sub) {
                if (st != 1) {
                    const bf16* Wgu = (const bf16*)(ws + (st == 0 ? WS_WGU1 : WS_WGU2) + l * SZ_WGU);
                    pg8::Gemm g{XB, Wgu, TT, NGU, DM}; pg8::StaticOrder S; S.init(TT, NGU, G, bx);
                    EpiGU E{HB, SSQ};
#ifndef NO_GU
                    pg8::gemm_phase<EpiGU, pg8::StaticOrder, PG8_ALIGN, PG8_SP2>(lds, g, S, E);
#endif
                } else {
                    const bf16* Win = (const bf16*)(ws + WS_WIN + l * SZ_WIN);
                    pg8::Gemm g{XB + (size_t)sub * THALF * DM, Win, THALF, NIN, DM}; pg8::StaticOrder S; S.init(THALF, NIN, G, bx);
                    EpiProj E{PROJ, SSQ, sub * THALF, RCOS, RSIN};
#ifndef NO_PROJ
                    pg8::gemm_phase<EpiProj, pg8::StaticOrder, PG8_ALIGN, PG8_SP2>(lds, g, S, E);
#endif
                }
                grid.sync();
                if (st == 1) {
                    bf16* CXB = (bf16*)(ws + WS_CXB);
                    { KArgsPtr KA = kargs(); conv_prepass(PROJ, CXB, KA->in[14] + (size_t)l * 4 * 768, KA->in[15] + l * 768, sub, bx, G); }
                    grid.sync();
                    for (int item = bx; item < 200; item += G) {
                        KArgsPtr KA = kargs();
                        if (item < 40) {
                            const int vloc = item >> 3, hd = (item & 7) >> 1, dir = item & 1;
#ifndef NO_RET
                            ret_item(lds, PROJ, dir ? YBK : YF, sub * 5 + vloc, vloc, hd, dir);
#endif
                        } else if (item < 120) {
                            const int q = item - 40, vloc = q >> 4, hh = (q & 15) >> 1, dir = q & 1;
#ifndef NO_SSD
                            ssd_item(lds, PROJ, CXB, dir ? YBK : YF, KA->in[16] + l * 16, KA->in[17] + l * 16, KA->in[18] + l * 8,
                                     sub * 5 + vloc, vloc, hh, dir);
#endif
                        } else {
                            const int q = item - 120, vloc = q >> 4, nb = (q & 15) >> 1, dir = q & 1;
#ifndef NO_LRU
                            lru_item(lds, PROJ, dir ? YBK : YF, KA->in[7] + (size_t)l * 4 * 512, KA->in[8] + l * 512, KA->in[9] + (size_t)l * 2 * 8 * 64 * 64, KA->in[10] + l * 1024,
                                     KA->in[11] + (size_t)l * 2 * 8 * 64 * 64, KA->in[12] + l * 1024, KA->in[13] + l * 1024, sub * 5 + vloc, vloc, nb, dir);
#endif
                        }
                    }
                    grid.sync();
                    {
                        KArgsPtr KA = kargs();
                        const int tid = launder_tid(), lane = tid & 63;
                        const float* ssd_norm = KA->in[19] + l * 512; const float* ret_norm = KA->in[20] + l * 512;
                        const f32x8 nw_s = ld8f(ssd_norm + 8 * lane), nw_r = ld8f(ret_norm + 8 * lane);
                        for (int row = gw; row < THALF; row += NGW) {
                            bf16* yr = YF + (size_t)row * YLD; const bf16* yb = YBK + (size_t)row * YLD; const bf16* pr = PROJ + (size_t)row * PLD;
                            {
                                const f32x8 a = unpack8(*(const u32x4*)(yr + 8 * lane)), b = unpack8(*(const u32x4*)(yb + 8 * lane)), gt = unpack8(*(const u32x4*)(pr + PC_GATE + 8 * lane));
                                f32x8 o;
#pragma unroll
                                for (int e = 0; e < 8; ++e) o[e] = (a[e] + b[e]) * gelu_tanh(gt[e]);
                                *(u32x4*)(yr + 8 * lane) = pack8(o);
                            }
                            {
                                const f32x8 a = unpack8(*(const u32x4*)(yr + 512 + 8 * lane)), b = unpack8(*(const u32x4*)(yb + 512 + 8 * lane)), z = unpack8(*(const u32x4*)(pr + PC_Z + 8 * lane));
                                f32x8 v; float ss = 0.f;
#pragma unroll
                                for (int e = 0; e < 8; ++e) { v[e] = (a[e] + b[e]) * siluf(z[e]); ss += v[e] * v[e]; }
                                ss = wave_sum(ss);
                                const float rs = rsqrtf(ss * (1.0f / 512.0f) + EPSN);
                                *(u32x4*)(yr + 512 + 8 * lane) = pack8(v * rs * nw_s);
                            }
                            {
                                const f32x8 a = unpack8(*(const u32x4*)(yr + 1024 + 8 * lane)), b = unpack8(*(const u32x4*)(yb + 1024 + 8 * lane)), gg = unpack8(*(const u32x4*)(pr + PC_G + 8 * lane));
                                f32x8 v = a + b; float s1 = 0.f;
#pragma unroll
                                for (int e = 0; e < 8; ++e) s1 += v[e];
                                s1 += __shfl_xor(s1, 1); s1 += __shfl_xor(s1, 2); s1 += __shfl_xor(s1, 4); s1 += __shfl_xor(s1, 8);
                                const float mu = s1 * (1.0f / 128.0f); float s2 = 0.f;
#pragma unroll
                                for (int e = 0; e < 8; ++e) { v[e] -= mu; s2 += v[e] * v[e]; }
                                s2 += __shfl_xor(s2, 1); s2 += __shfl_xor(s2, 2); s2 += __shfl_xor(s2, 4); s2 += __shfl_xor(s2, 8);
                                const float rs = rsqrtf(s2 * (1.0f / 128.0f) + EPSN);
                                f32x8 o;
#pragma unroll
                                for (int e = 0; e < 8; ++e) o[e] = v[e] * rs * nw_r[e] * siluf(gg[e]);
                                *(u32x4*)(yr + 1024 + 8 * lane) = pack8(o);
                            }
                        }
                    }
                    grid.sync();
                }
                {
                    pg8::Gemm g; float coef; int roff;
                    if (st != 1) { g = pg8::Gemm{HB, (const bf16*)(ws + (st == 0 ? WS_WD1 : WS_WD2) + l * SZ_WD), TT, DM, DFF}; coef = 0.5f; roff = 0; }
                    else { g = pg8::Gemm{YF, (const bf16*)(ws + WS_WOUT + l * SZ_WOUT), THALF, DM, NMIX}; coef = 1.0f; roff = sub * THALF; }
                    pg8::StaticOrder S; S.init(g.M, g.N, G, bx);
                    EpiRes E{X, XB, SSQ, coef, roff};
#ifndef NO_RES
                    pg8::gemm_phase<EpiRes, pg8::StaticOrder, PG8_ALIGN, PG8_SP2>(lds, g, S, E);
#endif
                }
                grid.sync();
            }
        }
    }
    {
        KArgsPtr KA = kargs();
        const int tid = launder_tid(), lane = tid & 63;
        const float* fw = KA->in[25];
        for (int m = gw; m < TT; m += NGW) {
            const float rs = row_rs(SSQ, (size_t)m);
#pragma unroll
            for (int j = 0; j < 4; ++j) {
                float* p = X + (size_t)m * DM + 256 * j + 4 * lane;
                const f32x4 v = *(const f32x4*)p, w = *(const f32x4*)(fw + 256 * j + 4 * lane);
                *(f32x4*)p = v * rs * w;
            }
        }
    }
}

extern "C" void kernel_launch(void* const* d_in, const int* in_sizes, int n_in, void* d_out, int out_size, void* d_ws, size_t ws_size, hipStream_t stream) {
    static int grid = 0;
    if (grid == 0) {
        if (n_in != 26 || out_size != TT * DM || ws_size < WS_NEED) { fprintf(stderr, "kernel_launch: unexpected problem (n_in %d, out %d, ws %zu, need %zu)\n", n_in, out_size, ws_size, (size_t)WS_NEED); grid = -1; return; }
        int dev = 0, cus = 0, per_cu = 0;
        if (hipGetDevice(&dev) != hipSuccess || hipDeviceGetAttribute(&cus, hipDeviceAttributeMultiprocessorCount, dev) != hipSuccess) { grid = -1; return; }
        if (hipFuncSetAttribute((const void*)mega_fwd, hipFuncAttributeMaxDynamicSharedMemorySize, LDS_BYTES) != hipSuccess) { fprintf(stderr, "kernel_launch: hipFuncSetAttribute failed\n"); grid = -1; return; }
        if (hipOccupancyMaxActiveBlocksPerMultiprocessor(&per_cu, (const void*)mega_fwd, 512, LDS_BYTES) != hipSuccess || per_cu < 1) { fprintf(stderr, "kernel_launch: occupancy query says %d\n", per_cu); per_cu = 1; }
        (void)hipGetLastError();
        grid = cus;
    }
    if (grid < 0) return;
    Args a{};
    for (int i = 0; i < 26; ++i) a.in[i] = (const float*)d_in[i];
    a.out = (float*)d_out; a.ws = (unsigned char*)d_ws;
    void* kargs[] = {&a};
    hipError_t e = hipLaunchCooperativeKernel((const void*)mega_fwd, dim3(grid), dim3(512), kargs, LDS_BYTES, stream);
    if (e != hipSuccess) fprintf(stderr, "kernel_launch: cooperative launch failed: %s (grid %d)\n", hipGetErrorString(e), grid);
}
```

```cpp
#include <hip/hip_runtime.h>
#include <hip/hip_cooperative_groups.h>
#include <cstdio>
#include <cstdint>
namespace cg = cooperative_groups;
namespace pg8 {
#define PG8_LAS __attribute__((address_space(3)))
typedef unsigned short bf16_t;
typedef short bf16x8 __attribute__((ext_vector_type(8)));
typedef float f32x4 __attribute__((ext_vector_type(4)));
typedef unsigned u32x4 __attribute__((ext_vector_type(4)));
constexpr int BM = 256, BK = 64, HALF = 128, HTB = HALF * BK * 2  , STAGE_BYTES = 8 * HTB, NXCD = 8, WGM = 8;

__host__ __device__ __forceinline__ int lds_byte(int r, int c) { const int st = (r >> 4) * 2 + (c >> 5), rr = r & 15, cc = c & 31, ob = rr * 64 + cc * 2; return st * 1024 + (ob ^ (((ob >> 9) & 1) << 5)); }
__host__ __device__ __forceinline__ void stage_rc(int b, int& R, int& C) { const int st = b / 1024, sb = b % 1024, swz = sb ^ (((sb >> 9) & 1) << 5); R = (st >> 1) * 16 + swz / 64; C = (st & 1) * 32 + (swz % 64) / 2; }
__host__ __device__ __forceinline__ int perm32(int rho) { const int n = rho >> 4, i = rho & 15; return 8 * (i >> 2) + 4 * n + (i & 3); }

struct Unit { int pm, pn; };
struct Gemm { const bf16_t* A; const bf16_t* Bt; int M, N, K; };

struct StaticOrder {
    int nM, nN, nwg, G, c;
    __host__ __device__ void init(int M, int N, int G_, int c_) { nM = M / BM; nN = N / BM; nwg = nM * nN; G = G_; c = c_; }
    __host__ __device__ bool next(int i, Unit& u) const {
        const long L = (long)i * G + c; if (L >= nwg) return false;
        int wgid = (int)L; { const int q = nwg / NXCD, r = nwg % NXCD, xcd = wgid % NXCD, off = wgid / NXCD; wgid = (xcd < r ? xcd * (q + 1) : r * (q + 1) + (xcd - r) * q) + off; }
        const int nig = WGM * nN, gid = wgid / nig, fm = gid * WGM, gsz = (nM - fm) < WGM ? (nM - fm) : WGM;
        u.pm = fm + ((wgid % nig) % gsz); u.pn = (wgid % nig) / gsz; return true;
    }
    __device__ __forceinline__ void a_ready(const Unit&) const {}
    __device__ __forceinline__ void done(const Unit&) const {}
};

__device__ __forceinline__ unsigned cvt_pk_bf16(float lo, float hi) { unsigned r; asm volatile("v_cvt_pk_bf16_f32 %0, %1, %2" : "=v"(r) : "v"(lo), "v"(hi)); return r; }
typedef float f32x2 __attribute__((ext_vector_type(2)));
template <class Epi, class Sched, bool ALIGN_EPI = false, bool SP2 = false>
__device__ __forceinline__ void gemm_phase(PG8_LAS unsigned char* lds, const Gemm g, const Sched& S, const Epi& E) {
    int tid_l = threadIdx.x; asm volatile("" : "+v"(tid_l));
    const int tid = tid_l, wid = __builtin_amdgcn_readfirstlane(tid >> 6), lane = tid & 63, wr = wid >> 2, wc = wid & 3, fr = lane & 15, fq = lane >> 4;
    const int K = g.K, nt = K / BK;
    unsigned voffA[2], voffB[2];
#pragma unroll
    for (int i = 0; i < 2; ++i) { int R, C; stage_rc(tid * 16 + i * 8192, R, C); const int Rb = Epi::PERM ? ((R & ~31) + perm32(R & 31)) : R;
        voffA[i] = (unsigned)(R * K + C) * 2u; voffB[i] = (unsigned)(Rb * K + C) * 2u; }
    const size_t kstep = (size_t)(BK * 2);
    const size_t hstep = (size_t)HALF * K * 2;
    const size_t tstep = 2 * hstep;
    const unsigned ldsw = (unsigned)wid * 1024u;
    const int aoff = lds_byte(wr * 64 + fr, fq * 8), boff = lds_byte(wc * 32 + fr, fq * 8);
#define PG8_SA(b, h) (((b) * 2 + (h)) * HTB)
#define PG8_SB(b, h) ((4 + (b) * 2 + (h)) * HTB)
#define PG8_STAGE(bufoff, gbase, voff) do { _Pragma("unroll") for (int _i = 0; _i < 2; ++_i) \
        __builtin_amdgcn_global_load_lds((const unsigned*)((const char*)(gbase) + (voff)[_i]), (PG8_LAS unsigned*)(lds + (bufoff) + ldsw + _i * 8192), 16, 0, 0); } while (0)
#define PG8_LDA(dst, b, h) do { _Pragma("unroll") for (int m = 0; m < 4; ++m) _Pragma("unroll") for (int k = 0; k < 2; ++k) dst[m][k] = *(const PG8_LAS bf16x8*)(lds + PG8_SA(b, h) + aoff + m * 2048 + k * 1024); } while (0)
#define PG8_LDB(dst, b, h) do { _Pragma("unroll") for (int n = 0; n < 2; ++n) _Pragma("unroll") for (int k = 0; k < 2; ++k) dst[n][k] = *(const PG8_LAS bf16x8*)(lds + PG8_SB(b, h) + boff + n * 2048 + k * 1024); } while (0)
#define PG8_MMA(ai, bj, At, Bt) do { __builtin_amdgcn_s_setprio(1); _Pragma("unroll") for (int m = 0; m < 4; ++m) _Pragma("unroll") for (int n = 0; n < 2; ++n) _Pragma("unroll") for (int k = 0; k < 2; ++k) \
        acc[ai][bj][m][n] = __builtin_amdgcn_mfma_f32_16x16x32_bf16(Bt[n][k], At[m][k], acc[ai][bj][m][n], 0, 0, 0); __builtin_amdgcn_s_setprio(0); } while (0)
#define PG8_WAIT_V(n) asm volatile("s_waitcnt vmcnt(" #n ")" ::: "memory")
#define PG8_WAIT_L(n) asm volatile("s_waitcnt lgkmcnt(" #n ")" ::: "memory")
#define PG8_BAR __builtin_amdgcn_s_barrier()
#define PG8_SCHED __builtin_amdgcn_sched_barrier(0)
    Unit cur, nxt; int ui = 0;
    if (!S.next(0, cur)) return;
    f32x4 acc[2][2][4][2];
#pragma unroll
    for (int a = 0; a < 2; ++a)
#pragma unroll
        for (int b = 0; b < 2; ++b)
#pragma unroll
            for (int m = 0; m < 4; ++m)
#pragma unroll
                for (int n = 0; n < 2; ++n) acc[a][b][m][n] = (f32x4){0.f, 0.f, 0.f, 0.f};
    bf16x8 At[4][2], B0[2][2], B1[2][2];
    const char* cA = (const char*)g.A + (size_t)cur.pm * tstep; const char* cB = (const char*)g.Bt + (size_t)cur.pn * tstep;
    S.a_ready(cur);
    if constexpr (SP2) {
        PG8_STAGE(PG8_SB(0, 0), cB, voffB); PG8_STAGE(PG8_SB(0, 1), cB + hstep, voffB); PG8_STAGE(PG8_SA(0, 0), cA, voffA); PG8_STAGE(PG8_SA(0, 1), cA + hstep, voffA);
        if (wr == 1) PG8_BAR;
        PG8_WAIT_V(2); PG8_BAR;
        PG8_STAGE(PG8_SB(1, 0), cB + kstep, voffB); PG8_STAGE(PG8_SA(1, 0), cA + kstep, voffA); PG8_STAGE(PG8_SB(1, 1), cB + hstep + kstep, voffB);
        PG8_WAIT_V(6); PG8_BAR;
    } else {
        PG8_STAGE(PG8_SB(0, 0), cB, voffB); PG8_STAGE(PG8_SA(0, 0), cA, voffA); PG8_STAGE(PG8_SB(0, 1), cB + hstep, voffB); PG8_STAGE(PG8_SA(0, 1), cA + hstep, voffA);
        if (wr == 1) PG8_BAR;
        PG8_WAIT_V(4); PG8_BAR;
        PG8_STAGE(PG8_SB(1, 0), cB + kstep, voffB); PG8_STAGE(PG8_SA(1, 0), cA + kstep, voffA); PG8_STAGE(PG8_SB(1, 1), cB + hstep + kstep, voffB);
        PG8_WAIT_V(6); PG8_BAR;
    }
    for (;;) {
        const bool has_next = S.next(ui + 1, nxt);
        const char* nA = has_next ? (const char*)g.A + (size_t)nxt.pm * tstep : cA; const char* nB = has_next ? (const char*)g.Bt + (size_t)nxt.pn * tstep : cB;
        for (int t = 0; t < nt; t += 2) {
            const bool last = (t == nt - 2);
            const char* a1 = cA + (size_t)(t + 1) * kstep;
            const char* a2 = last ? nA : cA + (size_t)(t + 2) * kstep; const char* b2 = last ? nB : cB + (size_t)(t + 2) * kstep;
            const char* a3 = a2 + kstep; const char* b3 = b2 + kstep;
            if (last && has_next) S.a_ready(nxt);
            if constexpr (SP2) {
            PG8_LDB(B0, 0, 0); PG8_LDB(B1, 0, 1); PG8_SCHED; PG8_LDA(At, 0, 0); PG8_STAGE(PG8_SA(1, 1), a1 + hstep, voffA);
            PG8_WAIT_V(8); PG8_WAIT_L(0); PG8_BAR; PG8_MMA(0, 0, At, B0); PG8_MMA(0, 1, At, B1); PG8_BAR; PG8_SCHED;
            PG8_LDA(At, 0, 1); PG8_STAGE(PG8_SB(0, 0), b2, voffB); PG8_STAGE(PG8_SB(0, 1), b2 + hstep, voffB); PG8_STAGE(PG8_SA(0, 0), a2, voffA);
            PG8_WAIT_V(8); PG8_WAIT_L(0); PG8_BAR; PG8_MMA(1, 0, At, B0); PG8_MMA(1, 1, At, B1); PG8_BAR; PG8_SCHED;
            PG8_LDB(B0, 1, 0); PG8_LDB(B1, 1, 1); PG8_SCHED; PG8_LDA(At, 1, 0); PG8_STAGE(PG8_SA(0, 1), a2 + hstep, voffA);
            PG8_WAIT_V(8); PG8_WAIT_L(0); PG8_BAR; PG8_MMA(0, 0, At, B0); PG8_MMA(0, 1, At, B1); PG8_BAR; PG8_SCHED;
            PG8_LDA(At, 1, 1); PG8_STAGE(PG8_SB(1, 0), b3, voffB); PG8_STAGE(PG8_SB(1, 1), b3 + hstep, voffB); PG8_STAGE(PG8_SA(1, 0), a3, voffA);
            PG8_WAIT_V(8); PG8_WAIT_L(0); PG8_BAR; PG8_MMA(1, 0, At, B0); PG8_MMA(1, 1, At, B1); PG8_BAR; PG8_SCHED;
            } else {
            PG8_LDB(B0, 0, 0); PG8_SCHED; PG8_LDA(At, 0, 0); PG8_STAGE(PG8_SA(1, 1), a1 + hstep, voffA);
            PG8_WAIT_L(8); PG8_BAR; PG8_WAIT_L(0); PG8_MMA(0, 0, At, B0); PG8_BAR; PG8_SCHED;
            PG8_LDB(B1, 0, 1); PG8_STAGE(PG8_SB(0, 0), b2, voffB);
            PG8_BAR; PG8_WAIT_L(0); PG8_MMA(0, 1, At, B1); PG8_BAR;
            PG8_LDA(At, 0, 1); PG8_STAGE(PG8_SA(0, 0), a2, voffA);
            PG8_BAR; PG8_WAIT_L(0); PG8_MMA(1, 0, At, B0); PG8_BAR; PG8_SCHED;
            PG8_STAGE(PG8_SB(0, 1), b2 + hstep, voffB);
            PG8_WAIT_V(6); PG8_BAR; PG8_MMA(1, 1, At, B1); PG8_BAR;
            PG8_LDB(B0, 1, 0); PG8_SCHED; PG8_LDA(At, 1, 0); PG8_STAGE(PG8_SA(0, 1), a2 + hstep, voffA);
            PG8_WAIT_L(8); PG8_BAR; PG8_WAIT_L(0); PG8_MMA(0, 0, At, B0); PG8_BAR; PG8_SCHED;
            PG8_LDB(B1, 1, 1); PG8_STAGE(PG8_SB(1, 0), b3, voffB);
            PG8_BAR; PG8_WAIT_L(0); PG8_MMA(0, 1, At, B1); PG8_BAR;
            PG8_LDA(At, 1, 1); PG8_STAGE(PG8_SA(1, 0), a3, voffA);
            PG8_BAR; PG8_WAIT_L(0); PG8_MMA(1, 0, At, B0); PG8_BAR; PG8_SCHED;
            PG8_STAGE(PG8_SB(1, 1), b3 + hstep, voffB);
            PG8_WAIT_V(6); PG8_BAR; PG8_MMA(1, 1, At, B1); PG8_BAR;
            }
        }
        if constexpr (ALIGN_EPI) { if (wr == 0) PG8_BAR; }
        if constexpr (!Epi::AFTER_DRAIN) { E(acc, cur, wr, wc, fr, fq); S.done(cur); }
        if (!has_next) break;
#pragma unroll
        for (int a = 0; a < 2; ++a)
#pragma unroll
            for (int b = 0; b < 2; ++b)
#pragma unroll
                for (int m = 0; m < 4; ++m)
#pragma unroll
                    for (int n = 0; n < 2; ++n) acc[a][b][m][n] = (f32x4){0.f, 0.f, 0.f, 0.f};
        cur = nxt; cA = nA; cB = nB; ++ui;
        if constexpr (ALIGN_EPI) { if (wr == 1) PG8_BAR; }
    }
    PG8_WAIT_V(0);
    if constexpr (!ALIGN_EPI) { if (wr == 0) PG8_BAR; }
    PG8_BAR;
    if constexpr (Epi::AFTER_DRAIN) { E.fused(acc, cur, wr, wc, fr, fq, lds, wid, lane); S.done(cur); }
#undef PG8_SA
#undef PG8_SB
#undef PG8_STAGE
#undef PG8_LDA
#undef PG8_LDB
#undef PG8_MMA
#undef PG8_WAIT_V
#undef PG8_WAIT_L
#undef PG8_BAR
#undef PG8_SCHED
}
}
#ifndef PG8_SP2
#define PG8_SP2 true
#endif
#ifndef PG8_ALIGN
#define PG8_ALIGN true
#endif

#define LAS __attribute__((address_space(3)))
typedef unsigned short bf16;
typedef float f32x4 __attribute__((ext_vector_type(4)));
typedef float f32x8 __attribute__((ext_vector_type(8)));
typedef short bf16x8 __attribute__((ext_vector_type(8)));
typedef unsigned u32x4 __attribute__((ext_vector_type(4)));
typedef unsigned u32x2 __attribute__((ext_vector_type(2)));

constexpr int DM = 1024, DFF = 2816, NGU = 5632, NIN = 4608, NMIX = 1536, NLAYER = 4;
constexpr int TT = 81920, THALF = 40960, PLD = NIN  , YLD = NMIX;
constexpr int W_IN_SRC = 4368;
constexpr float EPSN = 1e-6f;
constexpr int PC_LRUX = 0, PC_GATE = 512, PC_Z = 1024, PC_XBC = 1536, PC_Q = 2304, PC_K = 2816, PC_V = 3328, PC_G = 3840, PC_DT = 4352;

constexpr size_t al256(size_t x) { return (x + 255) & ~(size_t)255; }
constexpr size_t SZ_WGU = (size_t)NGU * DM * 2, SZ_WD = (size_t)DM * DFF * 2, SZ_WIN = (size_t)NIN * DM * 2, SZ_WOUT = (size_t)DM * NMIX * 2;
constexpr size_t WS_WGU1 = 0;
constexpr size_t WS_WD1 = WS_WGU1 + NLAYER * SZ_WGU;
constexpr size_t WS_WIN = WS_WD1 + NLAYER * SZ_WD;
constexpr size_t WS_WOUT = WS_WIN + NLAYER * SZ_WIN;
constexpr size_t WS_WGU2 = WS_WOUT + NLAYER * SZ_WOUT;
constexpr size_t WS_WD2 = WS_WGU2 + NLAYER * SZ_WGU;
constexpr size_t WS_XB = al256(WS_WD2 + NLAYER * SZ_WD);
constexpr size_t WS_SSQ = al256(WS_XB + (size_t)TT * DM * 2);
constexpr size_t WS_ROPE = al256(WS_SSQ + (size_t)TT * 16 * 4);
constexpr size_t WS_BIG = al256(WS_ROPE + (size_t)8192 * 64 * 4 * 2);
constexpr size_t WS_PROJ = WS_BIG;
constexpr size_t WS_Y = al256(WS_PROJ + (size_t)THALF * PLD * 2);
constexpr size_t WS_YB = al256(WS_Y + (size_t)THALF * YLD * 2);
constexpr size_t WS_CXB = al256(WS_YB + (size_t)THALF * YLD * 2);
constexpr size_t WS_END1 = al256(WS_CXB + (size_t)THALF * 768 * 2);
constexpr size_t WS_H = WS_BIG;
constexpr size_t WS_END2 = al256(WS_H + (size_t)TT * DFF * 2);
constexpr size_t WS_NEED = WS_END1 > WS_END2 ? WS_END1 : WS_END2;

constexpr int LDS_BYTES = 147456;

__device__ __forceinline__ float bflo(unsigned w) { return __builtin_bit_cast(float, w << 16); }
__device__ __forceinline__ float bfhi(unsigned w) { return __builtin_bit_cast(float, w & 0xffff0000u); }
__device__ __forceinline__ float bf2f(bf16 b) { return __builtin_bit_cast(float, (unsigned)b << 16); }
__device__ __forceinline__ bf16 f2bf(float f) { unsigned u = __builtin_bit_cast(unsigned, f); return (bf16)((u + 0x7fffu + ((u >> 16) & 1u)) >> 16); }
__device__ __forceinline__ unsigned pk2(float lo, float hi) { return pg8::cvt_pk_bf16(lo, hi); }
__device__ __forceinline__ f32x8 unpack8(u32x4 w) { f32x8 o; o[0] = bflo(w.x); o[1] = bfhi(w.x); o[2] = bflo(w.y); o[3] = bfhi(w.y); o[4] = bflo(w.z); o[5] = bfhi(w.z); o[6] = bflo(w.w); o[7] = bfhi(w.w); return o; }
__device__ __forceinline__ u32x4 pack8(f32x8 v) { u32x4 w; w.x = pk2(v[0], v[1]); w.y = pk2(v[2], v[3]); w.z = pk2(v[4], v[5]); w.w = pk2(v[6], v[7]); return w; }
__device__ __forceinline__ f32x8 ld8f(const float* p) { const f32x4 a = *(const f32x4*)p, b = *(const f32x4*)(p + 4); f32x8 o; o[0] = a[0]; o[1] = a[1]; o[2] = a[2]; o[3] = a[3]; o[4] = b[0]; o[5] = b[1]; o[6] = b[2]; o[7] = b[3]; return o; }
__device__ __forceinline__ float sigm(float x) { return __builtin_amdgcn_rcpf(1.0f + __expf(-x)); }
__device__ __forceinline__ float siluf(float x) { return x * sigm(x); }
__device__ __forceinline__ float softplusf(float x) { return fmaxf(x, 0.f) + log1pf(__expf(-fabsf(x))); }
__device__ __forceinline__ float gelu_tanh(float x) { const float y = 0.7978845608028654f * (x + 0.044715f * x * x * x); const float t = 1.0f - 2.0f * __builtin_amdgcn_rcpf(1.0f + __expf(2.0f * y)); return 0.5f * x * (1.0f + t); }
__device__ __forceinline__ float wave_sum(float v) {
#pragma unroll
    for (int o = 1; o < 64; o <<= 1) v += __shfl_xor(v, o);
    return v;
}
__device__ __forceinline__ float row_rs(const float* ssq, size_t row) {
    const f32x4 a = *(const f32x4*)(ssq + row * 16), b = *(const f32x4*)(ssq + row * 16 + 4), c = *(const f32x4*)(ssq + row * 16 + 8), d = *(const f32x4*)(ssq + row * 16 + 12);
    const float s = ((a[0] + a[1]) + (a[2] + a[3])) + ((b[0] + b[1]) + (b[2] + b[3])) + ((c[0] + c[1]) + (c[2] + c[3])) + ((d[0] + d[1]) + (d[2] + d[3]));
    return rsqrtf(s * (1.0f / DM) + EPSN);
}
__device__ __forceinline__ int launder_tid() { int t = threadIdx.x; asm volatile("" : "+v"(t)); return t; }
#define MFMA16(a, b, c) __builtin_amdgcn_mfma_f32_16x16x32_bf16((a), (b), (c), 0, 0, 0)
__device__ __forceinline__ bf16x8 ldfrag(const LAS bf16* p) { return *(const LAS bf16x8*)p; }

struct EpiGU {
    static constexpr bool PERM = true, AFTER_DRAIN = false;
    bf16* H; const float* ssq;
    __device__ __forceinline__ void operator()(const pg8::f32x4 (&acc)[2][2][4][2], const pg8::Unit& u, int wr, int wc, int fr, int fq) const {
        const int row0 = u.pm * 256 + wr * 64 + fr, col0 = u.pn * 128 + wc * 32 + 8 * fq;
#pragma unroll
        for (int ai = 0; ai < 2; ++ai)
#pragma unroll
            for (int m = 0; m < 4; ++m) {
                const size_t row = (size_t)(row0 + ai * 128 + m * 16);
                const float rs = row_rs(ssq, row);
                const pg8::f32x4 g0 = acc[ai][0][m][0] * rs, g1 = acc[ai][0][m][1] * rs, u0 = acc[ai][1][m][0] * rs, u1 = acc[ai][1][m][1] * rs;
                u32x4 w;
                w.x = pk2(siluf(g0[0]) * u0[0], siluf(g0[1]) * u0[1]); w.y = pk2(siluf(g0[2]) * u0[2], siluf(g0[3]) * u0[3]);
                w.z = pk2(siluf(g1[0]) * u1[0], siluf(g1[1]) * u1[1]); w.w = pk2(siluf(g1[2]) * u1[2], siluf(g1[3]) * u1[3]);
                *(u32x4*)(H + row * DFF + col0) = w;
                asm volatile("" ::: "memory");
            }
    }
};
struct EpiProj {
    static constexpr bool PERM = true, AFTER_DRAIN = false;
    bf16* P; const float* ssq; int row_off; const float* rcos; const float* rsin;
    __device__ __forceinline__ void operator()(const pg8::f32x4 (&acc)[2][2][4][2], const pg8::Unit& u, int wr, int wc, int fr, int fq) const {
        const int row0 = u.pm * 256 + wr * 64 + fr, col0 = u.pn * 256 + wc * 32 + 8 * fq;
        if (u.pn >= 9 && u.pn <= 12) {
            const float ksc = u.pn >= 11 ? 0.08838834764831845f : 1.0f;
            const int d0 = 32 * (wc & 1) + 8 * fq, colr = u.pn * 256 + 128 * (wc >> 1) + d0;
#pragma unroll
            for (int ai = 0; ai < 2; ++ai)
#pragma unroll
                for (int m = 0; m < 4; ++m) {
                    const size_t row = (size_t)(row0 + ai * 128 + m * 16);
                    const int gr = (int)row + row_off, pos = gr < 65536 ? (gr & 8191) : (gr & 4095);
                    const float rs = row_rs(ssq, (size_t)gr) * ksc;
                    u32x4 w1, w2;
#pragma unroll
                    for (int n = 0; n < 2; ++n) {
                        const pg8::f32x4 cs = *(const pg8::f32x4*)(rcos + (size_t)pos * 64 + d0 + 4 * n), sn = *(const pg8::f32x4*)(rsin + (size_t)pos * 64 + d0 + 4 * n);
                        const pg8::f32x4 t1 = acc[ai][0][m][n] * rs, t2 = acc[ai][1][m][n] * rs;
                        const pg8::f32x4 o1 = t1 * cs - t2 * sn, o2 = t1 * sn + t2 * cs;
                        if (n == 0) { w1.x = pk2(o1[0], o1[1]); w1.y = pk2(o1[2], o1[3]); w2.x = pk2(o2[0], o2[1]); w2.y = pk2(o2[2], o2[3]); }
                        else { w1.z = pk2(o1[0], o1[1]); w1.w = pk2(o1[2], o1[3]); w2.z = pk2(o2[0], o2[1]); w2.w = pk2(o2[2], o2[3]); }
                    }
                    *(u32x4*)(P + row * PLD + colr) = w1; *(u32x4*)(P + row * PLD + colr + 64) = w2;
                    asm volatile("" ::: "memory");
                }
            return;
        }
#pragma unroll
        for (int ai = 0; ai < 2; ++ai)
#pragma unroll
            for (int m = 0; m < 4; ++m) {
                const size_t row = (size_t)(row0 + ai * 128 + m * 16);
                const float rs = row_rs(ssq, row + row_off);
#pragma unroll
                for (int bj = 0; bj < 2; ++bj) {
                    const pg8::f32x4 v0 = acc[ai][bj][m][0] * rs, v1 = acc[ai][bj][m][1] * rs;
                    u32x4 w; w.x = pk2(v0[0], v0[1]); w.y = pk2(v0[2], v0[3]); w.z = pk2(v1[0], v1[1]); w.w = pk2(v1[2], v1[3]);
                    *(u32x4*)(P + row * PLD + col0 + bj * 128) = w;
                }
                asm volatile("" ::: "memory");
            }
    }
};
struct EpiRes {
    static constexpr bool PERM = true, AFTER_DRAIN = false;
    float* X; bf16* XB; float* ssq; float coef; int row_off;
    __device__ __forceinline__ void operator()(const pg8::f32x4 (&acc)[2][2][4][2], const pg8::Unit& u, int wr, int wc, int fr, int fq) const {
        const int row0 = row_off + u.pm * 256 + wr * 64 + fr, col0 = u.pn * 256 + wc * 32 + 8 * fq;
#pragma unroll
        for (int ai = 0; ai < 2; ++ai)
#pragma unroll
            for (int m = 0; m < 4; ++m) {
                const size_t row = (size_t)(row0 + ai * 128 + m * 16);
                float s = 0.f;
#pragma unroll
                for (int bj = 0; bj < 2; ++bj) {
                    float* xp = X + row * DM + col0 + bj * 128;
                    pg8::f32x4 x0 = *(const pg8::f32x4*)xp, x1 = *(const pg8::f32x4*)(xp + 4);
                    x0 += acc[ai][bj][m][0] * coef; x1 += acc[ai][bj][m][1] * coef;
                    *(pg8::f32x4*)xp = x0; *(pg8::f32x4*)(xp + 4) = x1;
                    s += (x0[0] * x0[0] + x0[1] * x0[1]) + (x0[2] * x0[2] + x0[3] * x0[3]) + (x1[0] * x1[0] + x1[1] * x1[1]) + (x1[2] * x1[2] + x1[3] * x1[3]);
                    u32x4 w; w.x = pk2(x0[0], x0[1]); w.y = pk2(x0[2], x0[3]); w.z = pk2(x1[0], x1[1]); w.w = pk2(x1[2], x1[3]);
                    *(u32x4*)(XB + row * DM + col0 + bj * 128) = w;
                }
                s += __shfl_xor(s, 16); s += __shfl_xor(s, 32);
                if (fq == 0) ssq[row * 16 + u.pn * 4 + wc] = s;
                asm volatile("" ::: "memory");
            }
    }
};

__device__ __forceinline__ int colmap(int kind, int n) {
    if (kind == 0) return n;
    if (kind == 1) { const int t = n >> 8, w = n & 255; return w < 128 ? 128 * t + w : DFF + 128 * t + (w - 128); }
    if (n < 2304) return n;
    if (n < 3328) { const int t = n >> 8, w = n & 255, bj = w >> 7, o = w & 127; return 256 * t + 128 * (o >> 6) + (o & 63) + 64 * bj + 16; }
    return n < 4352 ? n + 16 : (n < 4368 ? n - 4352 + 2304 : -1);
}
__device__ __forceinline__ void transpose_item(const float* W, int K, int Nsrc, int Ndst, const float* kscale, bf16* WT, int kind, int item, int lane, LAS float* scr) {
    const int nblk = Ndst / 32, kb = item / nblk, nb = item % nblk, k0 = 64 * kb, n0 = 32 * nb;
    const int sc = colmap(kind, n0 + (lane & 31));
#pragma unroll 8
    for (int i = 0; i < 32; ++i) { const int kk = 2 * i + (lane >> 5); float v = 0.f; if (sc >= 0) { v = W[(size_t)(k0 + kk) * Nsrc + sc]; if (kscale) v *= kscale[k0 + kk]; } scr[kk * 33 + (lane & 31)] = v; }
    asm volatile("s_waitcnt lgkmcnt(0)" ::: "memory");
    const int c = lane & 7;
#pragma unroll
    for (int j = 0; j < 4; ++j) { const int n = (lane >> 3) + 8 * j; const LAS float* s = scr + (8 * c) * 33 + n;
        u32x4 o; o.x = pk2(s[0 * 33], s[1 * 33]); o.y = pk2(s[2 * 33], s[3 * 33]); o.z = pk2(s[4 * 33], s[5 * 33]); o.w = pk2(s[6 * 33], s[7 * 33]);
        *(u32x4*)(WT + (size_t)(n0 + n) * K + k0 + 8 * c) = o; }
    asm volatile("s_waitcnt lgkmcnt(0)" ::: "memory");
}

struct Args { const float* in[26]; float* out; unsigned char* ws; };
typedef const __attribute__((address_space(4))) Args* KArgsPtr;
__device__ __forceinline__ KArgsPtr kargs() { KArgsPtr p = (KArgsPtr)__builtin_amdgcn_kernarg_segment_ptr(); asm volatile("" : "+s"(p)); return p; }

__device__ __forceinline__ f32x8 conv8(const bf16* proj, int lrow, int pcol, int pos, int seqlen, const float* cw, int cw_ld, const float* cb, int ccol) {
    f32x8 acc = ld8f(cb + ccol);
#pragma unroll
    for (int k = 0; k < 4; ++k) {
        const int s = pos + k - 2;
        if (s >= 0 && s < seqlen) {
            const u32x4 raw = *(const u32x4*)(proj + (size_t)(lrow + k - 2) * PLD + pcol);
            acc += ld8f(cw + k * cw_ld + ccol) * unpack8(raw);
        }
    }
    return acc;
}

__device__ __forceinline__ void ret_item(LAS unsigned char* lds, const bf16* proj, bf16* yout, int gv, int vloc, int hd, int dir) {
    const int tid = launder_tid(), wid = __builtin_amdgcn_readfirstlane(tid >> 6), lane = tid & 63, fr = lane & 15, fq = lane >> 4;
    constexpr int LD = 136;
    LAS bf16* KN = (LAS bf16*)lds; LAS bf16* KTW = KN + 128 * LD; LAS bf16* VT = KTW + 128 * LD; LAS bf16* RT = VT + 128 * LD;
    const int seqlen = gv < 8 ? 8192 : 4096;
    const float l2g = log2f(1.0f - exp2f(-5.0f - (float)hd));
    const float cdec = exp2f(l2g * 128.0f);
    const int i0 = 4 * (tid >> 4), c8 = 8 * (tid & 15), qi = 16 * wid + fr;
    float wl[4];
#pragma unroll
    for (int r = 0; r < 4; ++r) wl[r] = exp2f(l2g * (float)(dir ? i0 + r : 127 - (i0 + r)));
    const float rsc = exp2f(l2g * (float)(dir ? 128 - qi : qi + 1));
    f32x4 R[8];
#pragma unroll
    for (int i = 0; i < 8; ++i) R[i] = (f32x4){0.f, 0.f, 0.f, 0.f};
    for (int i = tid; i < 128 * LD / 2; i += 512) ((LAS unsigned*)RT)[i] = 0u;
    u32x4 kraw[4], vraw[4], qraw[4];
#define RET_LOAD(CC) do { const int lr0_ = vloc * 8192 + (CC) * 128; \
        _Pragma("unroll") for (int r = 0; r < 4; ++r) { const bf16* rp_ = proj + (size_t)(lr0_ + i0 + r) * PLD + 128 * hd + c8; kraw[r] = *(const u32x4*)(rp_ + PC_K); vraw[r] = *(const u32x4*)(rp_ + PC_V); } \
        _Pragma("unroll") for (int ks = 0; ks < 4; ++ks) qraw[ks] = *(const u32x4*)(proj + (size_t)(lr0_ + qi) * PLD + PC_Q + 128 * hd + 32 * ks + 8 * fq); } while (0)
    RET_LOAD(dir ? 63 : 0);
    __syncthreads();
    for (int c = 0; c < 64; ++c) {
        const int cc = dir ? 63 - c : c;
        const int lrow0 = vloc * 8192 + cc * 128;
        const bool do_intra = ((cc & 1) == dir);
        bool next_reset = false;
        if (c < 63) { const int ncc = dir ? cc - 1 : cc + 1; const int np = (ncc * 128) % seqlen; next_reset = dir ? (np + 128 == seqlen) : (np == 0); }
        {
            if (do_intra) {
#pragma unroll
                for (int r = 0; r < 4; ++r) *(LAS u32x4*)(KN + (i0 + r) * LD + c8) = kraw[r];
            }
            LAS bf16* kt = KTW + c8 * LD + i0; LAS bf16* vt = VT + c8 * LD + i0;
#pragma unroll
            for (int m = 0; m < 4; ++m) {
                u32x2 we, wo;
                we.x = pk2(bflo(kraw[0][m]) * wl[0], bflo(kraw[1][m]) * wl[1]); we.y = pk2(bflo(kraw[2][m]) * wl[2], bflo(kraw[3][m]) * wl[3]);
                wo.x = pk2(bfhi(kraw[0][m]) * wl[0], bfhi(kraw[1][m]) * wl[1]); wo.y = pk2(bfhi(kraw[2][m]) * wl[2], bfhi(kraw[3][m]) * wl[3]);
                *(LAS u32x2*)(kt + (2 * m) * LD) = we; *(LAS u32x2*)(kt + (2 * m + 1) * LD) = wo;
                u32x2 ve, vo;
                ve.x = (vraw[0][m] & 0xffffu) | (vraw[1][m] << 16); ve.y = (vraw[2][m] & 0xffffu) | (vraw[3][m] << 16);
                vo.x = (vraw[0][m] >> 16) | (vraw[1][m] & 0xffff0000u); vo.y = (vraw[2][m] >> 16) | (vraw[3][m] & 0xffff0000u);
                *(LAS u32x2*)(vt + (2 * m) * LD) = ve; *(LAS u32x2*)(vt + (2 * m + 1) * LD) = vo;
            }
        }
        bf16x8 qf[4];
#pragma unroll
        for (int ks = 0; ks < 4; ++ks) qf[ks] = __builtin_bit_cast(bf16x8, qraw[ks]);
        if (c < 63) { const int ncc = dir ? cc - 1 : cc + 1; RET_LOAD(ncc); }
        __syncthreads();
        unsigned sp[8][2];
        if (do_intra) {
#pragma unroll
            for (int ct = 0; ct < 8; ++ct) {
                f32x4 a = (f32x4){0.f, 0.f, 0.f, 0.f};
#pragma unroll
                for (int ks = 0; ks < 4; ++ks) a = MFMA16(ldfrag(KN + (16 * ct + fr) * LD + 32 * ks + 8 * fq), qf[ks], a);
                const int j0 = 16 * ct + 4 * fq;
                float dv[4];
#pragma unroll
                for (int e = 0; e < 4; ++e) { const int dd = qi - (j0 + e); dv[e] = a[e] * exp2f(l2g * (float)(dd < 0 ? -dd : dd)); }
                sp[ct][0] = pk2(dv[0], dv[1]); sp[ct][1] = pk2(dv[2], dv[3]);
            }
            __syncthreads();
#pragma unroll
            for (int ct = 0; ct < 8; ++ct) { u32x2 w; w.x = sp[ct][0]; w.y = sp[ct][1]; *(LAS u32x2*)(KN + qi * LD + 16 * ct + 4 * fq) = w; }
        }
        {
            f32x4 Y[8];
#pragma unroll
            for (int ct = 0; ct < 8; ++ct) {
                f32x4 a = (f32x4){0.f, 0.f, 0.f, 0.f};
#pragma unroll
                for (int ks = 0; ks < 4; ++ks) a = MFMA16(ldfrag(RT + (16 * ct + fr) * LD + 32 * ks + 8 * fq), qf[ks], a);
                Y[ct] = a * rsc;
            }
            if (do_intra) {
#pragma unroll
                for (int ks = 0; ks < 4; ++ks) {
                    const bf16x8 pf = ldfrag(KN + qi * LD + 32 * ks + 8 * fq);
#pragma unroll
                    for (int ct = 0; ct < 8; ++ct) Y[ct] = MFMA16(ldfrag(VT + (16 * ct + fr) * LD + 32 * ks + 8 * fq), pf, Y[ct]);
                }
            }
            bf16* yo = yout + (size_t)(lrow0 + qi) * YLD + 1024 + 128 * hd + 4 * fq;
#pragma unroll
            for (int ct = 0; ct < 8; ++ct) { u32x2 w; w.x = pk2(Y[ct][0], Y[ct][1]); w.y = pk2(Y[ct][2], Y[ct][3]); *(u32x2*)(yo + 16 * ct) = w; }
        }
#pragma unroll
        for (int ct = 0; ct < 8; ++ct) R[ct] *= cdec;
#pragma unroll
        for (int ks = 0; ks < 4; ++ks) {
            const bf16x8 kf = ldfrag(KTW + (16 * wid + fr) * LD + 32 * ks + 8 * fq);
#pragma unroll
            for (int ct = 0; ct < 8; ++ct) R[ct] = MFMA16(kf, ldfrag(VT + (16 * ct + fr) * LD + 32 * ks + 8 * fq), R[ct]);
        }
        if (next_reset) {
#pragma unroll
            for (int ct = 0; ct < 8; ++ct) R[ct] = (f32x4){0.f, 0.f, 0.f, 0.f};
        }
        __syncthreads();
#pragma unroll
        for (int ct = 0; ct < 8; ++ct) { u32x2 w; w.x = pk2(R[ct][0], R[ct][1]); w.y = pk2(R[ct][2], R[ct][3]); *(LAS u32x2*)(RT + (16 * ct + fr) * LD + 16 * wid + 4 * fq) = w; }
    }
#undef RET_LOAD
    __syncthreads();
}

__device__ __forceinline__ void ssd_item(LAS unsigned char* lds, const bf16* proj, const bf16* cxb, bf16* yout, const float* dt_bias, const float* a_log, const float* dskip,
                                         int gv, int vloc, int hh, int dir) {
    const int tid = launder_tid(), wid = __builtin_amdgcn_readfirstlane(tid >> 6), lane = tid & 63, fr = lane & 15, fq = lane >> 4;
    constexpr int LDL = 136, LDS_ = 72;
    LAS bf16* XST = (LAS bf16*)lds;
    LAS bf16* CN = XST + 64 * LDL;
    LAS bf16* BN = CN + 128 * LDS_;
    LAS bf16* BTW = BN + 128 * LDS_;
    LAS bf16* PP = BTW + 64 * LDL;
    LAS bf16* HL = PP + 128 * LDL;
    LAS float* DT = (LAS float*)(HL + 64 * LDS_);
    LAS float* ACUM = DT + 128;
    LAS float* CWL = ACUM + 128;
    const int seqlen = gv < 8 ? 8192 : 4096, grp = hh >> 2;
    const float aneg = -__expf(a_log[dir * 8 + hh]), dtb = dt_bias[dir * 8 + hh], dsk = dskip[hh];
    const int cg8 = tid % 24, rb = tid / 24, sec = cg8 >> 3, c8 = (cg8 & 7) * 8, i0 = 8 * rb;
    const int xc = sec == 0 ? 64 * hh + c8 : (sec == 1 ? 512 + 64 * grp + c8 : 640 + 64 * grp + c8);
    const bool stager = tid < 384;
    f32x4 Hc[2];
    Hc[0] = (f32x4){0.f, 0.f, 0.f, 0.f}; Hc[1] = (f32x4){0.f, 0.f, 0.f, 0.f};
    for (int i = tid; i < 64 * LDS_ / 2; i += 512) ((LAS unsigned*)HL)[i] = 0u;
    u32x4 raw[8]; float dtraw = 0.f;
#define SSD_LOAD(CC) do { const int lr0_ = vloc * 8192 + (CC) * 128; \
        if (stager) { _Pragma("unroll") for (int r = 0; r < 8; ++r) raw[r] = *(const u32x4*)(cxb + (size_t)(lr0_ + i0 + r) * 768 + xc); } \
        if (tid < 128) dtraw = bf2f(proj[(size_t)(lr0_ + tid) * PLD + PC_DT + dir * 8 + hh]); } while (0)
    SSD_LOAD(dir ? 63 : 0);
    __syncthreads();
    for (int c = 0; c < 64; ++c) {
        const int cc = dir ? 63 - c : c;
        const int lrow0 = vloc * 8192 + cc * 128;
        bool next_reset = false;
        if (c < 63) { const int ncc = dir ? cc - 1 : cc + 1; const int np = (ncc * 128) % seqlen; next_reset = dir ? (np + 128 == seqlen) : (np == 0); }
        if (tid < 128) DT[tid] = softplusf(dtraw + dtb);
        __syncthreads();
        float tot;
        {
            const float x0 = DT[2 * lane] * aneg, x1 = DT[2 * lane + 1] * aneg;
            float s = x0 + x1;
#pragma unroll
            for (int o = 1; o < 64; o <<= 1) { const float t = __shfl_up(s, o); if (lane >= o) s += t; }
            tot = __shfl(s, 63);
            const float p1 = s, p0 = s - x1;
            if (dir == 0) { ACUM[2 * lane] = p0; ACUM[2 * lane + 1] = p1; }
            else { ACUM[2 * lane] = tot - p0 + x0; ACUM[2 * lane + 1] = tot - p1 + x1; }
        }
        if (stager) {
#pragma unroll
            for (int hc = 0; hc < 2; ++hc) {
                u32x2 pv[4];
#pragma unroll
                for (int od = 0; od < 8; ++od) {
                    u32x2 pk; pk.x = raw[od][2 * hc]; pk.y = raw[od][2 * hc + 1];
                    if (sec == 0) pv[od & 3] = pk;
                    else if (sec == 1) { *(LAS u32x2*)(BN + (i0 + od) * LDS_ + c8 + 4 * hc) = pk; const float wr = __expf(tot - ACUM[i0 + od]) * DT[i0 + od];
                        u32x2 pw; pw.x = pk2(bflo(pk.x) * wr, bfhi(pk.x) * wr); pw.y = pk2(bflo(pk.y) * wr, bfhi(pk.y) * wr); pv[od & 3] = pw; }
                    else *(LAS u32x2*)(CN + (i0 + od) * LDS_ + c8 + 4 * hc) = pk;
                    if ((od & 3) == 3 && sec != 2) {
                        LAS bf16* dstT = (sec == 0 ? XST : BTW) + (c8 + 4 * hc) * LDL + i0 + (od - 3);
#pragma unroll
                        for (int m = 0; m < 2; ++m) {
                            u32x2 we, wo;
                            we.x = (pv[0][m] & 0xffffu) | (pv[1][m] << 16); we.y = (pv[2][m] & 0xffffu) | (pv[3][m] << 16);
                            wo.x = (pv[0][m] >> 16) | (pv[1][m] & 0xffff0000u); wo.y = (pv[2][m] >> 16) | (pv[3][m] & 0xffff0000u);
                            *(LAS u32x2*)(dstT + (2 * m) * LDL) = we; *(LAS u32x2*)(dstT + (2 * m + 1) * LDL) = wo;
                        }
                    }
                }
            }
        }
        if (c < 63) { const int ncc = dir ? cc - 1 : cc + 1; SSD_LOAD(ncc); }
        __syncthreads();
        const int qi = 16 * wid + fr;
        bf16x8 cf[2];
        cf[0] = ldfrag(CN + qi * LDS_ + 8 * fq); cf[1] = ldfrag(CN + qi * LDS_ + 32 + 8 * fq);
        const float aci = ACUM[qi];
#pragma unroll
        for (int ct = 0; ct < 8; ++ct) {
            f32x4 a = (f32x4){0.f, 0.f, 0.f, 0.f};
#pragma unroll
            for (int ks = 0; ks < 2; ++ks) a = MFMA16(ldfrag(BN + (16 * ct + fr) * LDS_ + 32 * ks + 8 * fq), cf[ks], a);
            const int j0 = 16 * ct + 4 * fq;
            const f32x4 acj = *(const LAS f32x4*)(ACUM + j0), dtj = *(const LAS f32x4*)(DT + j0);
            float wv[4];
#pragma unroll
            for (int e = 0; e < 4; ++e) { const int j = j0 + e; const bool ok = dir ? (j >= qi) : (j <= qi); wv[e] = ok ? a[e] * __expf(aci - acj[e]) * dtj[e] : 0.f; }
            u32x2 w; w.x = pk2(wv[0], wv[1]); w.y = pk2(wv[2], wv[3]);
            *(LAS u32x2*)(PP + qi * LDL + j0) = w;
        }
        {
            const float ea = __expf(aci);
            f32x4 Y[4];
#pragma unroll
            for (int pt = 0; pt < 4; ++pt) {
                f32x4 a = (f32x4){0.f, 0.f, 0.f, 0.f};
#pragma unroll
                for (int ks = 0; ks < 2; ++ks) a = MFMA16(ldfrag(HL + (16 * pt + fr) * LDS_ + 32 * ks + 8 * fq), cf[ks], a);
                Y[pt] = a * ea;
            }
#pragma unroll
            for (int ks = 0; ks < 4; ++ks) {
                const bf16x8 pf = ldfrag(PP + qi * LDL + 32 * ks + 8 * fq);
#pragma unroll
                for (int pt = 0; pt < 4; ++pt) Y[pt] = MFMA16(ldfrag(XST + (16 * pt + fr) * LDL + 32 * ks + 8 * fq), pf, Y[pt]);
            }
            bf16* yo = yout + (size_t)(lrow0 + qi) * YLD + 512 + 64 * hh + 4 * fq;
#pragma unroll
            for (int pt = 0; pt < 4; ++pt) {
                if (dir == 0) {
#pragma unroll
                    for (int e = 0; e < 4; ++e) Y[pt][e] += dsk * bf2f(XST[(16 * pt + 4 * fq + e) * LDL + qi]);
                }
                u32x2 w; w.x = pk2(Y[pt][0], Y[pt][1]); w.y = pk2(Y[pt][2], Y[pt][3]); *(u32x2*)(yo + 16 * pt) = w;
            }
        }
        {
            const float et = __expf(tot);
            Hc[0] *= et; Hc[1] *= et;
#pragma unroll
            for (int ks = 0; ks < 4; ++ks) {
                const bf16x8 xf = ldfrag(XST + (16 * (wid & 3) + fr) * LDL + 32 * ks + 8 * fq);
#pragma unroll
                for (int j2 = 0; j2 < 2; ++j2) Hc[j2] = MFMA16(ldfrag(BTW + (16 * (2 * (wid >> 2) + j2) + fr) * LDL + 32 * ks + 8 * fq), xf, Hc[j2]);
            }
            if (next_reset) { Hc[0] = (f32x4){0.f, 0.f, 0.f, 0.f}; Hc[1] = (f32x4){0.f, 0.f, 0.f, 0.f}; }
        }
        __syncthreads();
#pragma unroll
        for (int j2 = 0; j2 < 2; ++j2) { u32x2 w; w.x = pk2(Hc[j2][0], Hc[j2][1]); w.y = pk2(Hc[j2][2], Hc[j2][3]);
            *(LAS u32x2*)(HL + (16 * (wid & 3) + fr) * LDS_ + 16 * (2 * (wid >> 2) + j2) + 4 * fq) = w; }
    }
#undef SSD_LOAD
    __syncthreads();
}

__device__ __forceinline__ void lru_item(LAS unsigned char* lds, const bf16* proj, bf16* yout, const float* cw, const float* cb, const float* w_a, const float* b_a, const float* w_i, const float* b_i,
                                         const float* lam, int gv, int vloc, int nb, int dir) {
    const int tid = launder_tid(), wid = __builtin_amdgcn_readfirstlane(tid >> 6), lane = tid & 63, fr = lane & 15, fq = lane >> 4;
    constexpr int LDX = 72;
    LAS bf16* XCB = (LAS bf16*)lds;
    LAS bf16* WT = XCB + 128 * LDX;
    LAS float* AA = (LAS float*)(WT + 128 * LDX);
    LAS float* UU = AA + 128 * 64;
    LAS float* AGG = UU + 128 * 64;
    LAS float* CARRY = AGG + 8 * 64 * 2;
    LAS float* BA = CARRY + 128;
    LAS float* BI = BA + 64;
    LAS float* SP = BI + 64;
    const int seqlen = gv < 8 ? 8192 : 4096;
    for (int idx = tid; idx < 8192; idx += 512) {
        const int mat = idx >> 12, rem = idx & 4095, i = rem >> 6, j = rem & 63;
        const float* w = (mat ? w_i : w_a) + (size_t)((dir * 8 + nb) * 64 + i) * 64 + j;
        WT[(64 * mat + j) * LDX + i] = f2bf(*w);
    }
    if (tid < 64) { CARRY[tid] = 0.f; CARRY[64 + tid] = 0.f; BA[tid] = b_a[dir * 512 + 64 * nb + tid]; BI[tid] = b_i[dir * 512 + 64 * nb + tid]; SP[tid] = 8.0f * softplusf(-lam[dir * 512 + 64 * nb + tid]); }
    const int c8 = (tid & 7) * 8, i0 = 2 * (tid >> 3), ccol = 64 * nb + c8;
    const f32x8 w0 = ld8f(cw + 0 * 512 + ccol), w1 = ld8f(cw + 1 * 512 + ccol), w2 = ld8f(cw + 2 * 512 + ccol), w3 = ld8f(cw + 3 * 512 + ccol), bb = ld8f(cb + ccol);
    u32x4 raw[5];
#define LRU_LOAD(CC) do { const int lr0_ = vloc * 8192 + (CC) * 128, p0_ = ((CC) * 128) % seqlen; \
        _Pragma("unroll") for (int r = 0; r < 5; ++r) { const int s_ = p0_ + i0 - 2 + r; raw[r] = (u32x4){0u, 0u, 0u, 0u}; \
            if (s_ >= 0 && s_ < seqlen) raw[r] = *(const u32x4*)(proj + (size_t)(lr0_ + i0 - 2 + r) * PLD + PC_LRUX + ccol); } } while (0)
    LRU_LOAD(dir ? 63 : 0);
    __syncthreads();
    for (int c = 0; c < 64; ++c) {
        const int cc = dir ? 63 - c : c;
        const int lrow0 = vloc * 8192 + cc * 128;
        bool next_reset = false;
        if (c < 63) { const int ncc = dir ? cc - 1 : cc + 1; const int np = (ncc * 128) % seqlen; next_reset = dir ? (np + 128 == seqlen) : (np == 0); }
#pragma unroll
        for (int r = 0; r < 2; ++r) {
            const f32x8 v = bb + w0 * unpack8(raw[r]) + w1 * unpack8(raw[r + 1]) + w2 * unpack8(raw[r + 2]) + w3 * unpack8(raw[r + 3]);
            *(LAS u32x4*)(XCB + (i0 + r) * LDX + c8) = pack8(v);
        }
        if (c < 63) { const int ncc = dir ? cc - 1 : cc + 1; LRU_LOAD(ncc); }
        __syncthreads();
        const int t = 16 * wid + fr;
        {
            bf16x8 xf[2];
            xf[0] = ldfrag(XCB + t * LDX + 8 * fq); xf[1] = ldfrag(XCB + t * LDX + 32 + 8 * fq);
            f32x4 Gt[8];
#pragma unroll
            for (int ct = 0; ct < 8; ++ct) {
                f32x4 a = (f32x4){0.f, 0.f, 0.f, 0.f};
#pragma unroll
                for (int ks = 0; ks < 2; ++ks) a = MFMA16(ldfrag(WT + (16 * ct + fr) * LDX + 32 * ks + 8 * fq), xf[ks], a);
                Gt[ct] = a;
            }
#pragma unroll
            for (int ct = 0; ct < 4; ++ct) {
                const int c0 = 16 * ct + 4 * fq;
                const f32x4 ba = *(const LAS f32x4*)(BA + c0), bi = *(const LAS f32x4*)(BI + c0), sp = *(const LAS f32x4*)(SP + c0);
                const u32x2 xw = *(const LAS u32x2*)(XCB + t * LDX + c0);
                const float xv[4] = {bflo(xw.x), bfhi(xw.x), bflo(xw.y), bfhi(xw.y)};
                f32x4 av, uv;
#pragma unroll
                for (int e = 0; e < 4; ++e) {
                    const float r = sigm(Gt[ct][e] + ba[e]), ig = sigm(Gt[ct + 4][e] + bi[e]);
                    const float la = -r * sp[e];
                    const float a = __expf(la);
                    av[e] = a;
                    uv[e] = sqrtf(fmaxf((1.0f - a) * (1.0f + a), 0.f)) * ig * xv[e];
                }
                *(LAS f32x4*)(AA + t * 64 + c0) = av; *(LAS f32x4*)(UU + t * 64 + c0) = uv;
            }
        }
        __syncthreads();
        {
            const int ch = tid & 63, seg = tid >> 6;
            float Pp = 1.f, h = 0.f;
#pragma unroll
            for (int k = 0; k < 16; ++k) { const int o = seg * 16 + k, tt = dir ? 127 - o : o; const float a = AA[tt * 64 + ch], u = UU[tt * 64 + ch]; h = a * h + u; Pp *= a; }
            AGG[(seg * 64 + ch) * 2] = Pp; AGG[(seg * 64 + ch) * 2 + 1] = h;
            __syncthreads();
            float cin = CARRY[(c & 1) * 64 + ch];
            for (int s = 0; s < seg; ++s) cin = AGG[(s * 64 + ch) * 2] * cin + AGG[(s * 64 + ch) * 2 + 1];
            h = cin;
            bf16* yo = yout + (size_t)lrow0 * YLD + 64 * nb + ch;
#pragma unroll
            for (int k = 0; k < 16; ++k) { const int o = seg * 16 + k, tt = dir ? 127 - o : o; const float a = AA[tt * 64 + ch], u = UU[tt * 64 + ch]; h = a * h + u; yo[(size_t)tt * YLD] = f2bf(h); }
            if (seg == 7) CARRY[((c + 1) & 1) * 64 + ch] = next_reset ? 0.f : h;
        }
    }
#undef LRU_LOAD
    __syncthreads();
}

__device__ __forceinline__ void conv_prepass(const bf16* proj, bf16* cxb, const float* cw, const float* cb, int sub, int bx, int G) {
    const int tid = launder_tid();
    for (int id = bx * 512 + tid; id < 96 * (THALF / 32); id += G * 512) {
        const int cgp = id % 96, seg = id / 96, xc = 8 * cgp;
        const int row0 = seg * 32, gv = sub * 5 + (row0 >> 13), seqlen = gv < 8 ? 8192 : 4096, posb = row0 % seqlen;
#pragma unroll 1
        for (int blk = 0; blk < 4; ++blk) {
            const int r0 = row0 + 8 * blk, p0 = posb + 8 * blk;
            u32x4 raw[11];
#pragma unroll
            for (int r = 0; r < 11; ++r) { const int s_ = p0 - 2 + r; raw[r] = (u32x4){0u, 0u, 0u, 0u}; if (s_ >= 0 && s_ < seqlen) raw[r] = *(const u32x4*)(proj + (size_t)(r0 - 2 + r) * PLD + PC_XBC + xc); }
#pragma unroll
            for (int hc = 0; hc < 2; ++hc) {
                const int cl = xc + 4 * hc;
                const f32x4 w0 = *(const f32x4*)(cw + 0 * 768 + cl), w1 = *(const f32x4*)(cw + 1 * 768 + cl), w2 = *(const f32x4*)(cw + 2 * 768 + cl), w3 = *(const f32x4*)(cw + 3 * 768 + cl), bb = *(const f32x4*)(cb + cl);
                f32x4 ring[4] = {bb, bb, bb, bb};
#pragma unroll
                for (int r = 0; r < 11; ++r) {
                    const unsigned xa = raw[r][2 * hc], xb = raw[r][2 * hc + 1];
                    const f32x4 x = (f32x4){bflo(xa), bfhi(xa), bflo(xb), bfhi(xb)};
                    if (r <= 7) ring[r & 3] += w0 * x;
                    if (r >= 1 && r <= 8) ring[(r - 1) & 3] += w1 * x;
                    if (r >= 2 && r <= 9) ring[(r - 2) & 3] += w2 * x;
                    if (r >= 3) {
                        const int od = r - 3;
                        f32x4 t = ring[od & 3] + w3 * x;
                        ring[od & 3] = bb;
#pragma unroll
                        for (int e = 0; e < 4; ++e) t[e] = siluf(t[e]);
                        u32x2 pk; pk.x = pk2(t[0], t[1]); pk.y = pk2(t[2], t[3]);
                        *(u32x2*)(cxb + (size_t)(r0 + od) * 768 + cl) = pk;
                    }
                }
            }
        }
    }
}

__global__ void __launch_bounds__(512, 2) mega_fwd(Args args) {
    extern __shared__ __attribute__((aligned(16))) unsigned char lds_raw[];
    LAS unsigned char* lds = (LAS unsigned char*)lds_raw;
    cg::grid_group grid = cg::this_grid();
#define GRID_SYNC() do { asm volatile("s_waitcnt vmcnt(0) lgkmcnt(0)" ::: "memory"); __syncthreads(); grid.sync(); } while (0)
    const int wid = __builtin_amdgcn_readfirstlane(launder_tid() >> 6), G = gridDim.x, bx = blockIdx.x;
    unsigned char* ws; float* X;
    { KArgsPtr KA0 = kargs(); ws = KA0->ws; X = KA0->out; }
    bf16* XB = (bf16*)(ws + WS_XB); float* SSQ = (float*)(ws + WS_SSQ);
    float* RCOS = (float*)(ws + WS_ROPE); float* RSIN = RCOS + 8192 * 64;
    bf16* PROJ = (bf16*)(ws + WS_PROJ); bf16* YF = (bf16*)(ws + WS_Y); bf16* YBK = (bf16*)(ws + WS_YB); bf16* HB = (bf16*)(ws + WS_H);
    const int gw = bx * 8 + wid, NGW = G * 8;

    {
        KArgsPtr KA = kargs();
        const int tid = launder_tid(), lane = tid & 63;
        LAS float* scr = (LAS float*)(lds + wid * 16384);
        constexpr int I_GU = (DM / 64) * (NGU / 32), I_D = (DFF / 64) * (DM / 32), I_IN = (DM / 64) * (NIN / 32), I_OUT = (NMIX / 64) * (DM / 32);
        constexpr int I_LAYER = 2 * I_GU + 2 * I_D + I_IN + I_OUT;
        for (int it = gw; it < NLAYER * I_LAYER; it += NGW) {
            const int l = it / I_LAYER; int r = it % I_LAYER;
            if (r < I_GU) { transpose_item(KA->in[3] + (size_t)l * DM * NGU, DM, NGU, NGU, KA->in[2] + l * DM, (bf16*)(ws + WS_WGU1 + l * SZ_WGU), 1, r, lane, scr); continue; } r -= I_GU;
            if (r < I_GU) { transpose_item(KA->in[23] + (size_t)l * DM * NGU, DM, NGU, NGU, KA->in[22] + l * DM, (bf16*)(ws + WS_WGU2 + l * SZ_WGU), 1, r, lane, scr); continue; } r -= I_GU;
            if (r < I_D) { transpose_item(KA->in[4] + (size_t)l * DFF * DM, DFF, DM, DM, nullptr, (bf16*)(ws + WS_WD1 + l * SZ_WD), 0, r, lane, scr); continue; } r -= I_D;
            if (r < I_D) { transpose_item(KA->in[24] + (size_t)l * DFF * DM, DFF, DM, DM, nullptr, (bf16*)(ws + WS_WD2 + l * SZ_WD), 0, r, lane, scr); continue; } r -= I_D;
            if (r < I_IN) { transpose_item(KA->in[6] + (size_t)l * DM * W_IN_SRC, DM, W_IN_SRC, NIN, KA->in[5] + l * DM, (bf16*)(ws + WS_WIN + l * SZ_WIN), 2, r, lane, scr); continue; } r -= I_IN;
            transpose_item(KA->in[21] + (size_t)l * NMIX * DM, NMIX, DM, DM, nullptr, (bf16*)(ws + WS_WOUT + l * SZ_WOUT), 0, r, lane, scr);
        }
        for (int m = gw; m < TT; m += NGW) {
            const float* src = m < 65536 ? KA->in[0] + (size_t)m * DM : KA->in[1] + (size_t)(m - 65536) * DM;
            float s = 0.f;
#pragma unroll
            for (int j = 0; j < 4; ++j) {
                const f32x4 v = *(const f32x4*)(src + 256 * j + 4 * lane);
                *(f32x4*)(X + (size_t)m * DM + 256 * j + 4 * lane) = v;
                u32x2 w; w.x = pk2(v[0], v[1]); w.y = pk2(v[2], v[3]);
                *(u32x2*)(XB + (size_t)m * DM + 256 * j + 4 * lane) = w;
                s += (v[0] * v[0] + v[1] * v[1]) + (v[2] * v[2] + v[3] * v[3]);
            }
            s = wave_sum(s);
            if (lane < 16) SSQ[(size_t)m * 16 + lane] = lane == 0 ? s : 0.f;
        }
        for (int i = bx * 512 + tid; i < 8192 * 64; i += G * 512) {
            const int pos = i >> 6, f = i & 63;
            const float inv = 1.0f / powf(10000.0f, (float)(2 * f) / 128.0f);
            const float ang = (float)pos * inv;
            RCOS[i] = cosf(ang); RSIN[i] = sinf(ang);
        }
    }
    GRID_SYNC();

    for (int l = 0; l < NLAYER; ++l) {
        for (int st = 0; st < 3; ++st) {
            const int nsub = st == 1 ? 2 : 1;
            for (int sub = 0; sub < nsub; ++sub) {
                if (st != 1) {
                    const bf16* Wgu = (const bf16*)(ws + (st == 0 ? WS_WGU1 : WS_WGU2) + l * SZ_WGU);
                    pg8::Gemm g{XB, Wgu, TT, NGU, DM}; pg8::StaticOrder S; S.init(TT, NGU, G, bx);
                    EpiGU E{HB, SSQ};
#ifndef NO_GU
                    pg8::gemm_phase<EpiGU, pg8::StaticOrder, PG8_ALIGN, PG8_SP2>(lds, g, S, E);
#endif
                } else {
                    const bf16* Win = (const bf16*)(ws + WS_WIN + l * SZ_WIN);
                    pg8::Gemm g{XB + (size_t)sub * THALF * DM, Win, THALF, NIN, DM}; pg8::StaticOrder S; S.init(THALF, NIN, G, bx);
                    EpiProj E{PROJ, SSQ, sub * THALF, RCOS, RSIN};
#ifndef NO_PROJ
                    pg8::gemm_phase<EpiProj, pg8::StaticOrder, PG8_ALIGN, PG8_SP2>(lds, g, S, E);
#endif
                }
                GRID_SYNC();
                if (st == 1) {
                    bf16* CXB = (bf16*)(ws + WS_CXB);
                    { KArgsPtr KA = kargs(); conv_prepass(PROJ, CXB, KA->in[14] + (size_t)l * 4 * 768, KA->in[15] + l * 768, sub, bx, G); }
                    GRID_SYNC();
                    for (int item = bx; item < 200; item += G) {
                        KArgsPtr KA = kargs();
                        if (item < 40) {
                            const int vloc = item >> 3, hd = (item & 7) >> 1, dir = item & 1;
#ifndef NO_RET
                            ret_item(lds, PROJ, dir ? YBK : YF, sub * 5 + vloc, vloc, hd, dir);
#endif
                        } else if (item < 120) {
                            const int q = item - 40, vloc = q >> 4, hh = (q & 15) >> 1, dir = q & 1;
#ifndef NO_SSD
                            ssd_item(lds, PROJ, CXB, dir ? YBK : YF, KA->in[16] + l * 16, KA->in[17] + l * 16, KA->in[18] + l * 8,
                                     sub * 5 + vloc, vloc, hh, dir);
#endif
                        } else {
                            const int q = item - 120, vloc = q >> 4, nb = (q & 15) >> 1, dir = q & 1;
#ifndef NO_LRU
                            lru_item(lds, PROJ, dir ? YBK : YF, KA->in[7] + (size_t)l * 4 * 512, KA->in[8] + l * 512, KA->in[9] + (size_t)l * 2 * 8 * 64 * 64, KA->in[10] + l * 1024,
                                     KA->in[11] + (size_t)l * 2 * 8 * 64 * 64, KA->in[12] + l * 1024, KA->in[13] + l * 1024, sub * 5 + vloc, vloc, nb, dir);
#endif
                        }
                    }
                    GRID_SYNC();
                    {
                        KArgsPtr KA = kargs();
                        const int tid = launder_tid(), lane = tid & 63;
                        const float* ssd_norm = KA->in[19] + l * 512; const float* ret_norm = KA->in[20] + l * 512;
                        const f32x8 nw_s = ld8f(ssd_norm + 8 * lane), nw_r = ld8f(ret_norm + 8 * lane);
                        for (int row = gw; row < THALF; row += NGW) {
                            bf16* yr = YF + (size_t)row * YLD; const bf16* yb = YBK + (size_t)row * YLD; const bf16* pr = PROJ + (size_t)row * PLD;
                            {
                                const f32x8 a = unpack8(*(const u32x4*)(yr + 8 * lane)), b = unpack8(*(const u32x4*)(yb + 8 * lane)), gt = unpack8(*(const u32x4*)(pr + PC_GATE + 8 * lane));
                                f32x8 o;
#pragma unroll
                                for (int e = 0; e < 8; ++e) o[e] = (a[e] + b[e]) * gelu_tanh(gt[e]);
                                *(u32x4*)(yr + 8 * lane) = pack8(o);
                            }
                            {
                                const f32x8 a = unpack8(*(const u32x4*)(yr + 512 + 8 * lane)), b = unpack8(*(const u32x4*)(yb + 512 + 8 * lane)), z = unpack8(*(const u32x4*)(pr + PC_Z + 8 * lane));
                                f32x8 v; float ss = 0.f;
#pragma unroll
                                for (int e = 0; e < 8; ++e) { v[e] = (a[e] + b[e]) * siluf(z[e]); ss += v[e] * v[e]; }
                                ss = wave_sum(ss);
                                const float rs = rsqrtf(ss * (1.0f / 512.0f) + EPSN);
                                *(u32x4*)(yr + 512 + 8 * lane) = pack8(v * rs * nw_s);
                            }
                            {
                                const f32x8 a = unpack8(*(const u32x4*)(yr + 1024 + 8 * lane)), b = unpack8(*(const u32x4*)(yb + 1024 + 8 * lane)), gg = unpack8(*(const u32x4*)(pr + PC_G + 8 * lane));
                                f32x8 v = a + b; float s1 = 0.f;
#pragma unroll
                                for (int e = 0; e < 8; ++e) s1 += v[e];
                                s1 += __shfl_xor(s1, 1); s1 += __shfl_xor(s1, 2); s1 += __shfl_xor(s1, 4); s1 += __shfl_xor(s1, 8);
                                const float mu = s1 * (1.0f / 128.0f); float s2 = 0.f;
#pragma unroll
                                for (int e = 0; e < 8; ++e) { v[e] -= mu; s2 += v[e] * v[e]; }
                                s2 += __shfl_xor(s2, 1); s2 += __shfl_xor(s2, 2); s2 += __shfl_xor(s2, 4); s2 += __shfl_xor(s2, 8);
                                const float rs = rsqrtf(s2 * (1.0f / 128.0f) + EPSN);
                                f32x8 o;
#pragma unroll
                                for (int e = 0; e < 8; ++e) o[e] = v[e] * rs * nw_r[e] * siluf(gg[e]);
                                *(u32x4*)(yr + 1024 + 8 * lane) = pack8(o);
                            }
                        }
                    }
                    GRID_SYNC();
                }
                {
                    pg8::Gemm g; float coef; int roff;
                    if (st != 1) { g = pg8::Gemm{HB, (const bf16*)(ws + (st == 0 ? WS_WD1 : WS_WD2) + l * SZ_WD), TT, DM, DFF}; coef = 0.5f; roff = 0; }
                    else { g = pg8::Gemm{YF, (const bf16*)(ws + WS_WOUT + l * SZ_WOUT), THALF, DM, NMIX}; coef = 1.0f; roff = sub * THALF; }
                    pg8::StaticOrder S; S.init(g.M, g.N, G, bx);
                    EpiRes E{X, XB, SSQ, coef, roff};
#ifndef NO_RES
                    pg8::gemm_phase<EpiRes, pg8::StaticOrder, PG8_ALIGN, PG8_SP2>(lds, g, S, E);
#endif
                }
                GRID_SYNC();
            }
        }
    }
    {
        KArgsPtr KA = kargs();
        const int tid = launder_tid(), lane = tid & 63;
        const float* fw = KA->in[25];
        for (int m = gw; m < TT; m += NGW) {
            const float rs = row_rs(SSQ, (size_t)m);
#pragma unroll
            for (int j = 0; j < 4; ++j) {
                float* p = X + (size_t)m * DM + 256 * j + 4 * lane;
                const f32x4 v = *(const f32x4*)p, w = *(const f32x4*)(fw + 256 * j + 4 * lane);
                *(f32x4*)p = v * rs * w;
            }
        }
    }
}

extern "C" void kernel_launch(void* const* d_in, const int* in_sizes, int n_in, void* d_out, int out_size, void* d_ws, size_t ws_size, hipStream_t stream) {
    static int grid = 0;
    if (grid == 0) {
        if (n_in != 26 || out_size != TT * DM || ws_size < WS_NEED) { fprintf(stderr, "kernel_launch: unexpected problem (n_in %d, out %d, ws %zu, need %zu)\n", n_in, out_size, ws_size, (size_t)WS_NEED); grid = -1; return; }
        int dev = 0, cus = 0, per_cu = 0;
        if (hipGetDevice(&dev) != hipSuccess || hipDeviceGetAttribute(&cus, hipDeviceAttributeMultiprocessorCount, dev) != hipSuccess) { grid = -1; return; }
        if (hipFuncSetAttribute((const void*)mega_fwd, hipFuncAttributeMaxDynamicSharedMemorySize, LDS_BYTES) != hipSuccess) { fprintf(stderr, "kernel_launch: hipFuncSetAttribute failed\n"); grid = -1; return; }
        if (hipOccupancyMaxActiveBlocksPerMultiprocessor(&per_cu, (const void*)mega_fwd, 512, LDS_BYTES) != hipSuccess || per_cu < 1) { fprintf(stderr, "kernel_launch: occupancy query says %d\n", per_cu); per_cu = 1; }
        (void)hipGetLastError();
        grid = cus;
    }
    if (grid < 0) return;
    Args a{};
    for (int i = 0; i < 26; ++i) a.in[i] = (const float*)d_in[i];
    a.out = (float*)d_out; a.ws = (unsigned char*)d_ws;
    void* kargs[] = {&a};
    hipError_t e = hipLaunchCooperativeKernel((const void*)mega_fwd, dim3(grid), dim3(512), kargs, LDS_BYTES, stream);
    if (e != hipSuccess) fprintf(stderr, "kernel_launch: cooperative launch failed: %s (grid %d)\n", hipGetErrorString(e), grid);
}
```

```cpp
#include <hip/hip_runtime.h>
#include <hip/hip_cooperative_groups.h>
#include <cstdio>
#include <cstdint>
namespace cg = cooperative_groups;
namespace pg8 {
#define PG8_LAS __attribute__((address_space(3)))
typedef unsigned short bf16_t;
typedef short bf16x8 __attribute__((ext_vector_type(8)));
typedef float f32x4 __attribute__((ext_vector_type(4)));
typedef unsigned u32x4 __attribute__((ext_vector_type(4)));
constexpr int BM = 256, BK = 64, HALF = 128, HTB = HALF * BK * 2  , STAGE_BYTES = 8 * HTB, NXCD = 8, WGM = 8;

__host__ __device__ __forceinline__ int lds_byte(int r, int c) { const int st = (r >> 4) * 2 + (c >> 5), rr = r & 15, cc = c & 31, ob = rr * 64 + cc * 2; return st * 1024 + (ob ^ (((ob >> 9) & 1) << 5)); }
__host__ __device__ __forceinline__ void stage_rc(int b, int& R, int& C) { const int st = b / 1024, sb = b % 1024, swz = sb ^ (((sb >> 9) & 1) << 5); R = (st >> 1) * 16 + swz / 64; C = (st & 1) * 32 + (swz % 64) / 2; }
__host__ __device__ __forceinline__ int perm32(int rho) { const int n = rho >> 4, i = rho & 15; return 8 * (i >> 2) + 4 * n + (i & 3); }

struct Unit { int pm, pn; };
struct Gemm { const bf16_t* A; const bf16_t* Bt; int M, N, K; };

struct StaticOrder {
    int nM, nN, nwg, G, c;
    __host__ __device__ void init(int M, int N, int G_, int c_) { nM = M / BM; nN = N / BM; nwg = nM * nN; G = G_; c = c_; }
    __host__ __device__ bool next(int i, Unit& u) const {
        const long L = (long)i * G + c; if (L >= nwg) return false;
        int wgid = (int)L; { const int q = nwg / NXCD, r = nwg % NXCD, xcd = wgid % NXCD, off = wgid / NXCD; wgid = (xcd < r ? xcd * (q + 1) : r * (q + 1) + (xcd - r) * q) + off; }
        const int nig = WGM * nN, gid = wgid / nig, fm = gid * WGM, gsz = (nM - fm) < WGM ? (nM - fm) : WGM;
        u.pm = fm + ((wgid % nig) % gsz); u.pn = (wgid % nig) / gsz; return true;
    }
    __device__ __forceinline__ void a_ready(const Unit&) const {}
    __device__ __forceinline__ void done(const Unit&) const {}
};

__device__ __forceinline__ unsigned cvt_pk_bf16(float lo, float hi) { unsigned r; asm volatile("v_cvt_pk_bf16_f32 %0, %1, %2" : "=v"(r) : "v"(lo), "v"(hi)); return r; }
typedef float f32x2 __attribute__((ext_vector_type(2)));
template <class Epi, class Sched, bool ALIGN_EPI = false, bool SP2 = false>
__device__ __forceinline__ void gemm_phase(PG8_LAS unsigned char* lds, const Gemm g, const Sched& S, const Epi& E) {
    int tid_l = threadIdx.x; asm volatile("" : "+v"(tid_l));
    const int tid = tid_l, wid = __builtin_amdgcn_readfirstlane(tid >> 6), lane = tid & 63, wr = wid >> 2, wc = wid & 3, fr = lane & 15, fq = lane >> 4;
    const int K = g.K, nt = K / BK;
    unsigned voffA[2], voffB[2];
#pragma unroll
    for (int i = 0; i < 2; ++i) { int R, C; stage_rc(tid * 16 + i * 8192, R, C); const int Rb = Epi::PERM ? ((R & ~31) + perm32(R & 31)) : R;
        voffA[i] = (unsigned)(R * K + C) * 2u; voffB[i] = (unsigned)(Rb * K + C) * 2u; }
    const size_t kstep = (size_t)(BK * 2);
    const size_t hstep = (size_t)HALF * K * 2;
    const size_t tstep = 2 * hstep;
    const unsigned ldsw = (unsigned)wid * 1024u;
    const int aoff = lds_byte(wr * 64 + fr, fq * 8), boff = lds_byte(wc * 32 + fr, fq * 8);
#define PG8_SA(b, h) (((b) * 2 + (h)) * HTB)
#define PG8_SB(b, h) ((4 + (b) * 2 + (h)) * HTB)
#define PG8_STAGE(bufoff, gbase, voff) do { _Pragma("unroll") for (int _i = 0; _i < 2; ++_i) \
        __builtin_amdgcn_global_load_lds((const unsigned*)((const char*)(gbase) + (voff)[_i]), (PG8_LAS unsigned*)(lds + (bufoff) + ldsw + _i * 8192), 16, 0, 0); } while (0)
#define PG8_LDA(dst, b, h) do { _Pragma("unroll") for (int m = 0; m < 4; ++m) _Pragma("unroll") for (int k = 0; k < 2; ++k) dst[m][k] = *(const PG8_LAS bf16x8*)(lds + PG8_SA(b, h) + aoff + m * 2048 + k * 1024); } while (0)
#define PG8_LDB(dst, b, h) do { _Pragma("unroll") for (int n = 0; n < 2; ++n) _Pragma("unroll") for (int k = 0; k < 2; ++k) dst[n][k] = *(const PG8_LAS bf16x8*)(lds + PG8_SB(b, h) + boff + n * 2048 + k * 1024); } while (0)
#define PG8_MMA(ai, bj, At, Bt) do { __builtin_amdgcn_s_setprio(1); _Pragma("unroll") for (int m = 0; m < 4; ++m) _Pragma("unroll") for (int n = 0; n < 2; ++n) _Pragma("unroll") for (int k = 0; k < 2; ++k) \
        acc[ai][bj][m][n] = __builtin_amdgcn_mfma_f32_16x16x32_bf16(Bt[n][k], At[m][k], acc[ai][bj][m][n], 0, 0, 0); __builtin_amdgcn_s_setprio(0); } while (0)
#define PG8_WAIT_V(n) asm volatile("s_waitcnt vmcnt(" #n ")" ::: "memory")
#define PG8_WAIT_L(n) asm volatile("s_waitcnt lgkmcnt(" #n ")" ::: "memory")
#define PG8_BAR __builtin_amdgcn_s_barrier()
#define PG8_SCHED __builtin_amdgcn_sched_barrier(0)
    Unit cur, nxt; int ui = 0;
    if (!S.next(0, cur)) return;
    f32x4 acc[2][2][4][2];
#pragma unroll
    for (int a = 0; a < 2; ++a)
#pragma unroll
        for (int b = 0; b < 2; ++b)
#pragma unroll
            for (int m = 0; m < 4; ++m)
#pragma unroll
                for (int n = 0; n < 2; ++n) acc[a][b][m][n] = (f32x4){0.f, 0.f, 0.f, 0.f};
    bf16x8 At[4][2], B0[2][2], B1[2][2];
    const char* cA = (const char*)g.A + (size_t)cur.pm * tstep; const char* cB = (const char*)g.Bt + (size_t)cur.pn * tstep;
    S.a_ready(cur);
    if constexpr (SP2) {
        PG8_STAGE(PG8_SB(0, 0), cB, voffB); PG8_STAGE(PG8_SB(0, 1), cB + hstep, voffB); PG8_STAGE(PG8_SA(0, 0), cA, voffA); PG8_STAGE(PG8_SA(0, 1), cA + hstep, voffA);
        if (wr == 1) PG8_BAR;
        PG8_WAIT_V(2); PG8_BAR;
        PG8_STAGE(PG8_SB(1, 0), cB + kstep, voffB); PG8_STAGE(PG8_SA(1, 0), cA + kstep, voffA); PG8_STAGE(PG8_SB(1, 1), cB + hstep + kstep, voffB);
        PG8_WAIT_V(6); PG8_BAR;
    } else {
        PG8_STAGE(PG8_SB(0, 0), cB, voffB); PG8_STAGE(PG8_SA(0, 0), cA, voffA); PG8_STAGE(PG8_SB(0, 1), cB + hstep, voffB); PG8_STAGE(PG8_SA(0, 1), cA + hstep, voffA);
        if (wr == 1) PG8_BAR;
        PG8_WAIT_V(4); PG8_BAR;
        PG8_STAGE(PG8_SB(1, 0), cB + kstep, voffB); PG8_STAGE(PG8_SA(1, 0), cA + kstep, voffA); PG8_STAGE(PG8_SB(1, 1), cB + hstep + kstep, voffB);
        PG8_WAIT_V(6); PG8_BAR;
    }
    for (;;) {
        const bool has_next = S.next(ui + 1, nxt);
        const char* nA = has_next ? (const char*)g.A + (size_t)nxt.pm * tstep : cA; const char* nB = has_next ? (const char*)g.Bt + (size_t)nxt.pn * tstep : cB;
        for (int t = 0; t < nt; t += 2) {
            const bool last = (t == nt - 2);
            const char* a1 = cA + (size_t)(t + 1) * kstep;
            const char* a2 = last ? nA : cA + (size_t)(t + 2) * kstep; const char* b2 = last ? nB : cB + (size_t)(t + 2) * kstep;
            const char* a3 = a2 + kstep; const char* b3 = b2 + kstep;
            if (last && has_next) S.a_ready(nxt);
            if constexpr (SP2) {
            PG8_LDB(B0, 0, 0); PG8_LDB(B1, 0, 1); PG8_SCHED; PG8_LDA(At, 0, 0); PG8_STAGE(PG8_SA(1, 1), a1 + hstep, voffA);
            PG8_WAIT_V(8); PG8_WAIT_L(0); PG8_BAR; PG8_MMA(0, 0, At, B0); PG8_MMA(0, 1, At, B1); PG8_BAR; PG8_SCHED;
            PG8_LDA(At, 0, 1); PG8_STAGE(PG8_SB(0, 0), b2, voffB); PG8_STAGE(PG8_SB(0, 1), b2 + hstep, voffB); PG8_STAGE(PG8_SA(0, 0), a2, voffA);
            PG8_WAIT_V(8); PG8_WAIT_L(0); PG8_BAR; PG8_MMA(1, 0, At, B0); PG8_MMA(1, 1, At, B1); PG8_BAR; PG8_SCHED;
            PG8_LDB(B0, 1, 0); PG8_LDB(B1, 1, 1); PG8_SCHED; PG8_LDA(At, 1, 0); PG8_STAGE(PG8_SA(0, 1), a2 + hstep, voffA);
            PG8_WAIT_V(8); PG8_WAIT_L(0); PG8_BAR; PG8_MMA(0, 0, At, B0); PG8_MMA(0, 1, At, B1); PG8_BAR; PG8_SCHED;
            PG8_LDA(At, 1, 1); PG8_STAGE(PG8_SB(1, 0), b3, voffB); PG8_STAGE(PG8_SB(1, 1), b3 + hstep, voffB); PG8_STAGE(PG8_SA(1, 0), a3, voffA);
            PG8_WAIT_V(8); PG8_WAIT_L(0); PG8_BAR; PG8_MMA(1, 0, At, B0); PG8_MMA(1, 1, At, B1); PG8_BAR; PG8_SCHED;
            } else {
            PG8_LDB(B0, 0, 0); PG8_SCHED; PG8_LDA(At, 0, 0); PG8_STAGE(PG8_SA(1, 1), a1 + hstep, voffA);
            PG8_WAIT_L(8); PG8_BAR; PG8_WAIT_L(0); PG8_MMA(0, 0, At, B0); PG8_BAR; PG8_SCHED;
            PG8_LDB(B1, 0, 1); PG8_STAGE(PG8_SB(0, 0), b2, voffB);
            PG8_BAR; PG8_WAIT_L(0); PG8_MMA(0, 1, At, B1); PG8_BAR;
            PG8_LDA(At, 0, 1); PG8_STAGE(PG8_SA(0, 0), a2, voffA);
            PG8_BAR; PG8_WAIT_L(0); PG8_MMA(1, 0, At, B0); PG8_BAR; PG8_SCHED;
            PG8_STAGE(PG8_SB(0, 1), b2 + hstep, voffB);
            PG8_WAIT_V(6); PG8_BAR; PG8_MMA(1, 1, At, B1); PG8_BAR;
            PG8_LDB(B0, 1, 0); PG8_SCHED; PG8_LDA(At, 1, 0); PG8_STAGE(PG8_SA(0, 1), a2 + hstep, voffA);
            PG8_WAIT_L(8); PG8_BAR; PG8_WAIT_L(0); PG8_MMA(0, 0, At, B0); PG8_BAR; PG8_SCHED;
            PG8_LDB(B1, 1, 1); PG8_STAGE(PG8_SB(1, 0), b3, voffB);
            PG8_BAR; PG8_WAIT_L(0); PG8_MMA(0, 1, At, B1); PG8_BAR;
            PG8_LDA(At, 1, 1); PG8_STAGE(PG8_SA(1, 0), a3, voffA);
            PG8_BAR; PG8_WAIT_L(0); PG8_MMA(1, 0, At, B0); PG8_BAR; PG8_SCHED;
            PG8_STAGE(PG8_SB(1, 1), b3 + hstep, voffB);
            PG8_WAIT_V(6); PG8_BAR; PG8_MMA(1, 1, At, B1); PG8_BAR;
            }
        }
        if constexpr (ALIGN_EPI) { if (wr == 0) PG8_BAR; }
        if constexpr (!Epi::AFTER_DRAIN) { E(acc, cur, wr, wc, fr, fq); S.done(cur); }
        if (!has_next) break;
#pragma unroll
        for (int a = 0; a < 2; ++a)
#pragma unroll
            for (int b = 0; b < 2; ++b)
#pragma unroll
                for (int m = 0; m < 4; ++m)
#pragma unroll
                    for (int n = 0; n < 2; ++n) acc[a][b][m][n] = (f32x4){0.f, 0.f, 0.f, 0.f};
        cur = nxt; cA = nA; cB = nB; ++ui;
        if constexpr (ALIGN_EPI) { if (wr == 1) PG8_BAR; }
    }
    PG8_WAIT_V(0);
    if constexpr (!ALIGN_EPI) { if (wr == 0) PG8_BAR; }
    PG8_BAR;
    if constexpr (Epi::AFTER_DRAIN) { E.fused(acc, cur, wr, wc, fr, fq, lds, wid, lane); S.done(cur); }
#undef PG8_SA
#undef PG8_SB
#undef PG8_STAGE
#undef PG8_LDA
#undef PG8_LDB
#undef PG8_MMA
#undef PG8_WAIT_V
#undef PG8_WAIT_L
#undef PG8_BAR
#undef PG8_SCHED
}
}
#ifndef PG8_SP2
#define PG8_SP2 true
#endif
#ifndef PG8_ALIGN
#define PG8_ALIGN true
#endif

#define LAS __attribute__((address_space(3)))
typedef unsigned short bf16;
typedef float f32x4 __attribute__((ext_vector_type(4)));
typedef float f32x8 __attribute__((ext_vector_type(8)));
typedef short bf16x8 __attribute__((ext_vector_type(8)));
typedef unsigned u32x4 __attribute__((ext_vector_type(4)));
typedef unsigned u32x2 __attribute__((ext_vector_type(2)));

constexpr int DM = 1024, DFF = 2816, NGU = 5632, NIN = 4608, NMIX = 1536, NLAYER = 4;
constexpr int TT = 81920, THALF = 40960, PLD = NIN  , YLD = NMIX;
constexpr int W_IN_SRC = 4368;
constexpr float EPSN = 1e-6f;
constexpr int PC_LRUX = 0, PC_GATE = 512, PC_Z = 1024, PC_XBC = 1536, PC_Q = 2304, PC_K = 2816, PC_V = 3328, PC_G = 3840, PC_DT = 4352;

constexpr size_t al256(size_t x) { return (x + 255) & ~(size_t)255; }
constexpr size_t SZ_WGU = (size_t)NGU * DM * 2, SZ_WD = (size_t)DM * DFF * 2, SZ_WIN = (size_t)NIN * DM * 2, SZ_WOUT = (size_t)DM * NMIX * 2;
constexpr size_t WS_WGU1 = 0;
constexpr size_t WS_WD1 = WS_WGU1 + NLAYER * SZ_WGU;
constexpr size_t WS_WIN = WS_WD1 + NLAYER * SZ_WD;
constexpr size_t WS_WOUT = WS_WIN + NLAYER * SZ_WIN;
constexpr size_t WS_WGU2 = WS_WOUT + NLAYER * SZ_WOUT;
constexpr size_t WS_WD2 = WS_WGU2 + NLAYER * SZ_WGU;
constexpr size_t WS_XB = al256(WS_WD2 + NLAYER * SZ_WD);
constexpr size_t WS_SSQ = al256(WS_XB + (size_t)TT * DM * 2);
constexpr size_t WS_ROPE = al256(WS_SSQ + (size_t)TT * 16 * 4);
constexpr size_t WS_BIG = al256(WS_ROPE + (size_t)8192 * 64 * 4 * 2);
constexpr size_t WS_PROJ = WS_BIG;
constexpr size_t WS_Y = al256(WS_PROJ + (size_t)THALF * PLD * 2);
constexpr size_t WS_YB = al256(WS_Y + (size_t)THALF * YLD * 2);
constexpr size_t WS_CXB = al256(WS_YB + (size_t)THALF * YLD * 2);
constexpr size_t WS_END1 = al256(WS_CXB + (size_t)THALF * 768 * 2);
constexpr size_t WS_H = WS_BIG;
constexpr size_t WS_END2 = al256(WS_H + (size_t)TT * DFF * 2);
constexpr size_t WS_NEED = WS_END1 > WS_END2 ? WS_END1 : WS_END2;

constexpr int LDS_BYTES = 147456;

__device__ __forceinline__ float bflo(unsigned w) { return __builtin_bit_cast(float, w << 16); }
__device__ __forceinline__ float bfhi(unsigned w) { return __builtin_bit_cast(float, w & 0xffff0000u); }
__device__ __forceinline__ float bf2f(bf16 b) { return __builtin_bit_cast(float, (unsigned)b << 16); }
__device__ __forceinline__ bf16 f2bf(float f) { unsigned u = __builtin_bit_cast(unsigned, f); return (bf16)((u + 0x7fffu + ((u >> 16) & 1u)) >> 16); }
__device__ __forceinline__ unsigned pk2(float lo, float hi) { return pg8::cvt_pk_bf16(lo, hi); }
__device__ __forceinline__ f32x8 unpack8(u32x4 w) { f32x8 o; o[0] = bflo(w.x); o[1] = bfhi(w.x); o[2] = bflo(w.y); o[3] = bfhi(w.y); o[4] = bflo(w.z); o[5] = bfhi(w.z); o[6] = bflo(w.w); o[7] = bfhi(w.w); return o; }
__device__ __forceinline__ u32x4 pack8(f32x8 v) { u32x4 w; w.x = pk2(v[0], v[1]); w.y = pk2(v[2], v[3]); w.z = pk2(v[4], v[5]); w.w = pk2(v[6], v[7]); return w; }
__device__ __forceinline__ f32x8 ld8f(const float* p) { const f32x4 a = *(const f32x4*)p, b = *(const f32x4*)(p + 4); f32x8 o; o[0] = a[0]; o[1] = a[1]; o[2] = a[2]; o[3] = a[3]; o[4] = b[0]; o[5] = b[1]; o[6] = b[2]; o[7] = b[3]; return o; }
__device__ __forceinline__ float sigm(float x) { return __builtin_amdgcn_rcpf(1.0f + __expf(-x)); }
__device__ __forceinline__ float siluf(float x) { return x * sigm(x); }
__device__ __forceinline__ float softplusf(float x) { return fmaxf(x, 0.f) + log1pf(__expf(-fabsf(x))); }
__device__ __forceinline__ float gelu_tanh(float x) { const float y = 0.7978845608028654f * (x + 0.044715f * x * x * x); const float t = 1.0f - 2.0f * __builtin_amdgcn_rcpf(1.0f + __expf(2.0f * y)); return 0.5f * x * (1.0f + t); }
__device__ __forceinline__ float wave_sum(float v) {
#pragma unroll
    for (int o = 1; o < 64; o <<= 1) v += __shfl_xor(v, o);
    return v;
}
__device__ __forceinline__ float row_rs(const float* ssq, size_t row) {
    const f32x4 a = *(const f32x4*)(ssq + row * 16), b = *(const f32x4*)(ssq + row * 16 + 4), c = *(const f32x4*)(ssq + row * 16 + 8), d = *(const f32x4*)(ssq + row * 16 + 12);
    const float s = ((a[0] + a[1]) + (a[2] + a[3])) + ((b[0] + b[1]) + (b[2] + b[3])) + ((c[0] + c[1]) + (c[2] + c[3])) + ((d[0] + d[1]) + (d[2] + d[3]));
    return rsqrtf(s * (1.0f / DM) + EPSN);
}
__device__ __forceinline__ int launder_tid() { int t = threadIdx.x; asm volatile("" : "+v"(t)); return t; }
#define MFMA16(a, b, c) __builtin_amdgcn_mfma_f32_16x16x32_bf16((a), (b), (c), 0, 0, 0)
__device__ __forceinline__ bf16x8 ldfrag(const LAS bf16* p) { return *(const LAS bf16x8*)p; }

struct EpiGU {
    static constexpr bool PERM = true, AFTER_DRAIN = false;
    bf16* H; const float* ssq;
    __device__ __forceinline__ void operator()(const pg8::f32x4 (&acc)[2][2][4][2], const pg8::Unit& u, int wr, int wc, int fr, int fq) const {
        const int row0 = u.pm * 256 + wr * 64 + fr, col0 = u.pn * 128 + wc * 32 + 8 * fq;
#pragma unroll
        for (int ai = 0; ai < 2; ++ai)
#pragma unroll
            for (int m = 0; m < 4; ++m) {
                const size_t row = (size_t)(row0 + ai * 128 + m * 16);
                const float rs = row_rs(ssq, row);
                const pg8::f32x4 g0 = acc[ai][0][m][0] * rs, g1 = acc[ai][0][m][1] * rs, u0 = acc[ai][1][m][0] * rs, u1 = acc[ai][1][m][1] * rs;
                u32x4 w;
                w.x = pk2(siluf(g0[0]) * u0[0], siluf(g0[1]) * u0[1]); w.y = pk2(siluf(g0[2]) * u0[2], siluf(g0[3]) * u0[3]);
                w.z = pk2(siluf(g1[0]) * u1[0], siluf(g1[1]) * u1[1]); w.w = pk2(siluf(g1[2]) * u1[2], siluf(g1[3]) * u1[3]);
                *(u32x4*)(H + row * DFF + col0) = w;
                asm volatile("" ::: "memory");
            }
    }
};
struct EpiProj {
    static constexpr bool PERM = true, AFTER_DRAIN = false;
    bf16* P; const float* ssq; int row_off; const float* rcos; const float* rsin;
    __device__ __forceinline__ void operator()(const pg8::f32x4 (&acc)[2][2][4][2], const pg8::Unit& u, int wr, int wc, int fr, int fq) const {
        const int row0 = u.pm * 256 + wr * 64 + fr, col0 = u.pn * 256 + wc * 32 + 8 * fq;
        if (u.pn >= 9 && u.pn <= 12) {
            const float ksc = u.pn >= 11 ? 0.08838834764831845f : 1.0f;
            const int d0 = 32 * (wc & 1) + 8 * fq, colr = u.pn * 256 + 128 * (wc >> 1) + d0;
#pragma unroll
            for (int ai = 0; ai < 2; ++ai)
#pragma unroll
                for (int m = 0; m < 4; ++m) {
                    const size_t row = (size_t)(row0 + ai * 128 + m * 16);
                    const int gr = (int)row + row_off, pos = gr < 65536 ? (gr & 8191) : (gr & 4095);
                    const float rs = row_rs(ssq, (size_t)gr) * ksc;
                    u32x4 w1, w2;
#pragma unroll
                    for (int n = 0; n < 2; ++n) {
                        const pg8::f32x4 cs = *(const pg8::f32x4*)(rcos + (size_t)pos * 64 + d0 + 4 * n), sn = *(const pg8::f32x4*)(rsin + (size_t)pos * 64 + d0 + 4 * n);
                        const pg8::f32x4 t1 = acc[ai][0][m][n] * rs, t2 = acc[ai][1][m][n] * rs;
                        const pg8::f32x4 o1 = t1 * cs - t2 * sn, o2 = t1 * sn + t2 * cs;
                        if (n == 0) { w1.x = pk2(o1[0], o1[1]); w1.y = pk2(o1[2], o1[3]); w2.x = pk2(o2[0], o2[1]); w2.y = pk2(o2[2], o2[3]); }
                        else { w1.z = pk2(o1[0], o1[1]); w1.w = pk2(o1[2], o1[3]); w2.z = pk2(o2[0], o2[1]); w2.w = pk2(o2[2], o2[3]); }
                    }
                    *(u32x4*)(P + row * PLD + colr) = w1; *(u32x4*)(P + row * PLD + colr + 64) = w2;
                    asm volatile("" ::: "memory");
                }
            return;
        }
#pragma unroll
        for (int ai = 0; ai < 2; ++ai)
#pragma unroll
            for (int m = 0; m < 4; ++m) {
                const size_t row = (size_t)(row0 + ai * 128 + m * 16);
                const float rs = row_rs(ssq, row + row_off);
#pragma unroll
                for (int bj = 0; bj < 2; ++bj) {
                    const pg8::f32x4 v0 = acc[ai][bj][m][0] * rs, v1 = acc[ai][bj][m][1] * rs;
                    u32x4 w; w.x = pk2(v0[0], v0[1]); w.y = pk2(v0[2], v0[3]); w.z = pk2(v1[0], v1[1]); w.w = pk2(v1[2], v1[3]);
                    *(u32x4*)(P + row * PLD + col0 + bj * 128) = w;
                }
                asm volatile("" ::: "memory");
            }
    }
};
struct EpiRes {
    static constexpr bool PERM = true, AFTER_DRAIN = false;
    float* X; bf16* XB; float* ssq; float coef; int row_off;
    __device__ __forceinline__ void operator()(const pg8::f32x4 (&acc)[2][2][4][2], const pg8::Unit& u, int wr, int wc, int fr, int fq) const {
        const int row0 = row_off + u.pm * 256 + wr * 64 + fr, col0 = u.pn * 256 + wc * 32 + 8 * fq;
#pragma unroll
        for (int ai = 0; ai < 2; ++ai)
#pragma unroll
            for (int m = 0; m < 4; ++m) {
                const size_t row = (size_t)(row0 + ai * 128 + m * 16);
                float s = 0.f;
#pragma unroll
                for (int bj = 0; bj < 2; ++bj) {
                    float* xp = X + row * DM + col0 + bj * 128;
                    pg8::f32x4 x0 = *(const pg8::f32x4*)xp, x1 = *(const pg8::f32x4*)(xp + 4);
                    x0 += acc[ai][bj][m][0] * coef; x1 += acc[ai][bj][m][1] * coef;
                    *(pg8::f32x4*)xp = x0; *(pg8::f32x4*)(xp + 4) = x1;
                    s += (x0[0] * x0[0] + x0[1] * x0[1]) + (x0[2] * x0[2] + x0[3] * x0[3]) + (x1[0] * x1[0] + x1[1] * x1[1]) + (x1[2] * x1[2] + x1[3] * x1[3]);
                    u32x4 w; w.x = pk2(x0[0], x0[1]); w.y = pk2(x0[2], x0[3]); w.z = pk2(x1[0], x1[1]); w.w = pk2(x1[2], x1[3]);
                    *(u32x4*)(XB + row * DM + col0 + bj * 128) = w;
                }
                s += __shfl_xor(s, 16); s += __shfl_xor(s, 32);
                if (fq == 0) ssq[row * 16 + u.pn * 4 + wc] = s;
                asm volatile("" ::: "memory");
            }
    }
};

__device__ __forceinline__ int colmap(int kind, int n) {
    if (kind == 0) return n;
    if (kind == 1) { const int t = n >> 8, w = n & 255; return w < 128 ? 128 * t + w : DFF + 128 * t + (w - 128); }
    if (n < 2304) return n;
    if (n < 3328) { const int t = n >> 8, w = n & 255, bj = w >> 7, o = w & 127; return 256 * t + 128 * (o >> 6) + (o & 63) + 64 * bj + 16; }
    return n < 4352 ? n + 16 : (n < 4368 ? n - 4352 + 2304 : -1);
}
__device__ __forceinline__ void transpose_item(const float* W, int K, int Nsrc, int Ndst, const float* kscale, bf16* WT, int kind, int item, int lane, LAS float* scr) {
    const int nblk = Ndst / 32, kb = item / nblk, nb = item % nblk, k0 = 64 * kb, n0 = 32 * nb;
    const int sc = colmap(kind, n0 + (lane & 31));
#pragma unroll 8
    for (int i = 0; i < 32; ++i) { const int kk = 2 * i + (lane >> 5); float v = 0.f; if (sc >= 0) { v = W[(size_t)(k0 + kk) * Nsrc + sc]; if (kscale) v *= kscale[k0 + kk]; } scr[kk * 33 + (lane & 31)] = v; }
    asm volatile("s_waitcnt lgkmcnt(0)" ::: "memory");
    const int c = lane & 7;
#pragma unroll
    for (int j = 0; j < 4; ++j) { const int n = (lane >> 3) + 8 * j; const LAS float* s = scr + (8 * c) * 33 + n;
        u32x4 o; o.x = pk2(s[0 * 33], s[1 * 33]); o.y = pk2(s[2 * 33], s[3 * 33]); o.z = pk2(s[4 * 33], s[5 * 33]); o.w = pk2(s[6 * 33], s[7 * 33]);
        *(u32x4*)(WT + (size_t)(n0 + n) * K + k0 + 8 * c) = o; }
    asm volatile("s_waitcnt lgkmcnt(0)" ::: "memory");
}

struct Args { const float* in[26]; float* out; unsigned char* ws; };
typedef const __attribute__((address_space(4))) Args* KArgsPtr;
__device__ __forceinline__ KArgsPtr kargs() { KArgsPtr p = (KArgsPtr)__builtin_amdgcn_kernarg_segment_ptr(); asm volatile("" : "+s"(p)); return p; }

__device__ __forceinline__ f32x8 conv8(const bf16* proj, int lrow, int pcol, int pos, int seqlen, const float* cw, int cw_ld, const float* cb, int ccol) {
    f32x8 acc = ld8f(cb + ccol);
#pragma unroll
    for (int k = 0; k < 4; ++k) {
        const int s = pos + k - 2;
        if (s >= 0 && s < seqlen) {
            const u32x4 raw = *(const u32x4*)(proj + (size_t)(lrow + k - 2) * PLD + pcol);
            acc += ld8f(cw + k * cw_ld + ccol) * unpack8(raw);
        }
    }
    return acc;
}

__device__ __forceinline__ void ret_item(LAS unsigned char* lds, const bf16* proj, bf16* yout, int gv, int vloc, int hd, int dir) {
    const int tid = launder_tid(), wid = __builtin_amdgcn_readfirstlane(tid >> 6), lane = tid & 63, fr = lane & 15, fq = lane >> 4;
    constexpr int LD = 136;
    LAS bf16* KN = (LAS bf16*)lds; LAS bf16* KTW = KN + 128 * LD; LAS bf16* VT = KTW + 128 * LD; LAS bf16* RT = VT + 128 * LD;
    const int seqlen = gv < 8 ? 8192 : 4096;
    const float l2g = log2f(1.0f - exp2f(-5.0f - (float)hd));
    const float cdec = exp2f(l2g * 128.0f);
    const int i0 = 4 * ((tid >> 2) & 31), c8 = 8 * ((tid & 3) + 4 * (tid >> 7)), qi = 16 * wid + fr;
    float wl[4];
#pragma unroll
    for (int r = 0; r < 4; ++r) wl[r] = exp2f(l2g * (float)(dir ? i0 + r : 127 - (i0 + r)));
    const float rsc = exp2f(l2g * (float)(dir ? 128 - qi : qi + 1));
    f32x4 R[8];
#pragma unroll
    for (int i = 0; i < 8; ++i) R[i] = (f32x4){0.f, 0.f, 0.f, 0.f};
    for (int i = tid; i < 128 * LD / 2; i += 512) ((LAS unsigned*)RT)[i] = 0u;
    u32x4 kraw[4], vraw[4], qraw[4];
#define RET_LOAD(CC) do { const int lr0_ = vloc * 8192 + (CC) * 128; \
        _Pragma("unroll") for (int r = 0; r < 4; ++r) { const bf16* rp_ = proj + (size_t)(lr0_ + i0 + r) * PLD + 128 * hd + c8; kraw[r] = *(const u32x4*)(rp_ + PC_K); vraw[r] = *(const u32x4*)(rp_ + PC_V); } \
        _Pragma("unroll") for (int ks = 0; ks < 4; ++ks) qraw[ks] = *(const u32x4*)(proj + (size_t)(lr0_ + qi) * PLD + PC_Q + 128 * hd + 32 * ks + 8 * fq); } while (0)
    RET_LOAD(dir ? 63 : 0);
    __syncthreads();
    for (int c = 0; c < 64; ++c) {
        const int cc = dir ? 63 - c : c;
        const int lrow0 = vloc * 8192 + cc * 128;
        const bool do_intra = ((cc & 1) == dir);
        bool next_reset = false;
        if (c < 63) { const int ncc = dir ? cc - 1 : cc + 1; const int np = (ncc * 128) % seqlen; next_reset = dir ? (np + 128 == seqlen) : (np == 0); }
        {
            if (do_intra) {
#pragma unroll
                for (int r = 0; r < 4; ++r) *(LAS u32x4*)(KN + (i0 + r) * LD + c8) = kraw[r];
            }
            LAS bf16* kt = KTW + c8 * LD + i0; LAS bf16* vt = VT + c8 * LD + i0;
#pragma unroll
            for (int m = 0; m < 4; ++m) {
                u32x2 we, wo;
                we.x = pk2(bflo(kraw[0][m]) * wl[0], bflo(kraw[1][m]) * wl[1]); we.y = pk2(bflo(kraw[2][m]) * wl[2], bflo(kraw[3][m]) * wl[3]);
                wo.x = pk2(bfhi(kraw[0][m]) * wl[0], bfhi(kraw[1][m]) * wl[1]); wo.y = pk2(bfhi(kraw[2][m]) * wl[2], bfhi(kraw[3][m]) * wl[3]);
                *(LAS u32x2*)(kt + (2 * m) * LD) = we; *(LAS u32x2*)(kt + (2 * m + 1) * LD) = wo;
                u32x2 ve, vo;
                ve.x = (vraw[0][m] & 0xffffu) | (vraw[1][m] << 16); ve.y = (vraw[2][m] & 0xffffu) | (vraw[3][m] << 16);
                vo.x = (vraw[0][m] >> 16) | (vraw[1][m] & 0xffff0000u); vo.y = (vraw[2][m] >> 16) | (vraw[3][m] & 0xffff0000u);
                *(LAS u32x2*)(vt + (2 * m) * LD) = ve; *(LAS u32x2*)(vt + (2 * m + 1) * LD) = vo;
            }
        }
        bf16x8 qf[4];
#pragma unroll
        for (int ks = 0; ks < 4; ++ks) qf[ks] = __builtin_bit_cast(bf16x8, qraw[ks]);
        if (c < 63) { const int ncc = dir ? cc - 1 : cc + 1; RET_LOAD(ncc); }
        __syncthreads();
        unsigned sp[8][2];
        if (do_intra) {
#pragma unroll
            for (int ct = 0; ct < 8; ++ct) {
                f32x4 a = (f32x4){0.f, 0.f, 0.f, 0.f};
#pragma unroll
                for (int ks = 0; ks < 4; ++ks) a = MFMA16(ldfrag(KN + (16 * ct + fr) * LD + 32 * ks + 8 * fq), qf[ks], a);
                const int j0 = 16 * ct + 4 * fq;
                float dv[4];
#pragma unroll
                for (int e = 0; e < 4; ++e) { const int dd = qi - (j0 + e); dv[e] = a[e] * exp2f(l2g * (float)(dd < 0 ? -dd : dd)); }
                sp[ct][0] = pk2(dv[0], dv[1]); sp[ct][1] = pk2(dv[2], dv[3]);
            }
            __syncthreads();
#pragma unroll
            for (int ct = 0; ct < 8; ++ct) { u32x2 w; w.x = sp[ct][0]; w.y = sp[ct][1]; *(LAS u32x2*)(KN + qi * LD + 16 * ct + 4 * fq) = w; }
        }
        {
            f32x4 Y[8];
#pragma unroll
            for (int ct = 0; ct < 8; ++ct) {
                f32x4 a = (f32x4){0.f, 0.f, 0.f, 0.f};
#pragma unroll
                for (int ks = 0; ks < 4; ++ks) a = MFMA16(ldfrag(RT + (16 * ct + fr) * LD + 32 * ks + 8 * fq), qf[ks], a);
                Y[ct] = a * rsc;
            }
            if (do_intra) {
#pragma unroll
                for (int ks = 0; ks < 4; ++ks) {
                    const bf16x8 pf = ldfrag(KN + qi * LD + 32 * ks + 8 * fq);
#pragma unroll
                    for (int ct = 0; ct < 8; ++ct) Y[ct] = MFMA16(ldfrag(VT + (16 * ct + fr) * LD + 32 * ks + 8 * fq), pf, Y[ct]);
                }
            }
            bf16* yo = yout + (size_t)(lrow0 + qi) * YLD + 1024 + 128 * hd + 4 * fq;
#pragma unroll
            for (int ct = 0; ct < 8; ++ct) { u32x2 w; w.x = pk2(Y[ct][0], Y[ct][1]); w.y = pk2(Y[ct][2], Y[ct][3]); *(u32x2*)(yo + 16 * ct) = w; }
        }
#pragma unroll
        for (int ct = 0; ct < 8; ++ct) R[ct] *= cdec;
#pragma unroll
        for (int ks = 0; ks < 4; ++ks) {
            const bf16x8 kf = ldfrag(KTW + (16 * wid + fr) * LD + 32 * ks + 8 * fq);
#pragma unroll
            for (int ct = 0; ct < 8; ++ct) R[ct] = MFMA16(kf, ldfrag(VT + (16 * ct + fr) * LD + 32 * ks + 8 * fq), R[ct]);
        }
        if (next_reset) {
#pragma unroll
            for (int ct = 0; ct < 8; ++ct) R[ct] = (f32x4){0.f, 0.f, 0.f, 0.f};
        }
        __syncthreads();
#pragma unroll
        for (int ct = 0; ct < 8; ++ct) { u32x2 w; w.x = pk2(R[ct][0], R[ct][1]); w.y = pk2(R[ct][2], R[ct][3]); *(LAS u32x2*)(RT + (16 * ct + fr) * LD + 16 * wid + 4 * fq) = w; }
    }
#undef RET_LOAD
    __syncthreads();
}

__device__ __forceinline__ void ssd_item(LAS unsigned char* lds, const bf16* proj, const bf16* cxb, bf16* yout, const float* dt_bias, const float* a_log, const float* dskip,
                                         int gv, int vloc, int hh, int dir) {
    const int tid = launder_tid(), wid = __builtin_amdgcn_readfirstlane(tid >> 6), lane = tid & 63, fr = lane & 15, fq = lane >> 4;
    constexpr int LDL = 136, LDS_ = 72;
    LAS bf16* XST = (LAS bf16*)lds;
    LAS bf16* CN = XST + 64 * LDL;
    LAS bf16* BN = CN + 128 * LDS_;
    LAS bf16* BTW = BN + 128 * LDS_;
    LAS bf16* PP = BTW + 64 * LDL;
    LAS bf16* HL = PP + 128 * LDL;
    LAS float* DT = (LAS float*)(HL + 64 * LDS_);
    LAS float* ACUM = DT + 128;
    LAS float* CWL = ACUM + 128;
    const int seqlen = gv < 8 ? 8192 : 4096, grp = hh >> 2;
    const float aneg = -__expf(a_log[dir * 8 + hh]), dtb = dt_bias[dir * 8 + hh], dsk = dskip[hh];
    const int cg8 = tid % 24, rb = tid / 24, sec = cg8 >> 3, c8 = (cg8 & 7) * 8, i0 = 8 * rb;
    const int xc = sec == 0 ? 64 * hh + c8 : (sec == 1 ? 512 + 64 * grp + c8 : 640 + 64 * grp + c8);
    const bool stager = tid < 384;
    f32x4 Hc[2];
    Hc[0] = (f32x4){0.f, 0.f, 0.f, 0.f}; Hc[1] = (f32x4){0.f, 0.f, 0.f, 0.f};
    for (int i = tid; i < 64 * LDS_ / 2; i += 512) ((LAS unsigned*)HL)[i] = 0u;
    u32x4 raw[8]; float dtraw = 0.f;
#define SSD_LOAD(CC) do { const int lr0_ = vloc * 8192 + (CC) * 128; \
        if (stager) { _Pragma("unroll") for (int r = 0; r < 8; ++r) raw[r] = *(const u32x4*)(cxb + (size_t)(lr0_ + i0 + r) * 768 + xc); } \
        if (tid < 128) dtraw = bf2f(proj[(size_t)(lr0_ + tid) * PLD + PC_DT + dir * 8 + hh]); } while (0)
    SSD_LOAD(dir ? 63 : 0);
    __syncthreads();
    for (int c = 0; c < 64; ++c) {
        const int cc = dir ? 63 - c : c;
        const int lrow0 = vloc * 8192 + cc * 128;
        bool next_reset = false;
        if (c < 63) { const int ncc = dir ? cc - 1 : cc + 1; const int np = (ncc * 128) % seqlen; next_reset = dir ? (np + 128 == seqlen) : (np == 0); }
        if (tid < 128) DT[tid] = softplusf(dtraw + dtb);
        __syncthreads();
        float tot;
        {
            const float x0 = DT[2 * lane] * aneg, x1 = DT[2 * lane + 1] * aneg;
            float s = x0 + x1;
#pragma unroll
            for (int o = 1; o < 64; o <<= 1) { const float t = __shfl_up(s, o); if (lane >= o) s += t; }
            tot = __shfl(s, 63);
            const float p1 = s, p0 = s - x1;
            if (dir == 0) { ACUM[2 * lane] = p0; ACUM[2 * lane + 1] = p1; }
            else { ACUM[2 * lane] = tot - p0 + x0; ACUM[2 * lane + 1] = tot - p1 + x1; }
        }
        if (stager) {
#pragma unroll
            for (int hc = 0; hc < 2; ++hc) {
                u32x2 pv[4];
#pragma unroll
                for (int od = 0; od < 8; ++od) {
                    u32x2 pk; pk.x = raw[od][2 * hc]; pk.y = raw[od][2 * hc + 1];
                    if (sec == 0) pv[od & 3] = pk;
                    else if (sec == 1) { *(LAS u32x2*)(BN + (i0 + od) * LDS_ + c8 + 4 * hc) = pk; const float wr = __expf(tot - ACUM[i0 + od]) * DT[i0 + od];
                        u32x2 pw; pw.x = pk2(bflo(pk.x) * wr, bfhi(pk.x) * wr); pw.y = pk2(bflo(pk.y) * wr, bfhi(pk.y) * wr); pv[od & 3] = pw; }
                    else *(LAS u32x2*)(CN + (i0 + od) * LDS_ + c8 + 4 * hc) = pk;
                    if ((od & 3) == 3 && sec != 2) {
                        LAS bf16* dstT = (sec == 0 ? XST : BTW) + (c8 + 4 * hc) * LDL + i0 + (od - 3);
#pragma unroll
                        for (int m = 0; m < 2; ++m) {
                            u32x2 we, wo;
                            we.x = (pv[0][m] & 0xffffu) | (pv[1][m] << 16); we.y = (pv[2][m] & 0xffffu) | (pv[3][m] << 16);
                            wo.x = (pv[0][m] >> 16) | (pv[1][m] & 0xffff0000u); wo.y = (pv[2][m] >> 16) | (pv[3][m] & 0xffff0000u);
                            *(LAS u32x2*)(dstT + (2 * m) * LDL) = we; *(LAS u32x2*)(dstT + (2 * m + 1) * LDL) = wo;
                        }
                    }
                }
            }
        }
        if (c < 63) { const int ncc = dir ? cc - 1 : cc + 1; SSD_LOAD(ncc); }
        __syncthreads();
        const int qi = 16 * wid + fr;
        bf16x8 cf[2];
        cf[0] = ldfrag(CN + qi * LDS_ + 8 * fq); cf[1] = ldfrag(CN + qi * LDS_ + 32 + 8 * fq);
        const float aci = ACUM[qi];
#pragma unroll
        for (int ct = 0; ct < 8; ++ct) {
            f32x4 a = (f32x4){0.f, 0.f, 0.f, 0.f};
#pragma unroll
            for (int ks = 0; ks < 2; ++ks) a = MFMA16(ldfrag(BN + (16 * ct + fr) * LDS_ + 32 * ks + 8 * fq), cf[ks], a);
            const int j0 = 16 * ct + 4 * fq;
            const f32x4 acj = *(const LAS f32x4*)(ACUM + j0), dtj = *(const LAS f32x4*)(DT + j0);
            float wv[4];
#pragma unroll
            for (int e = 0; e < 4; ++e) { const int j = j0 + e; const bool ok = dir ? (j >= qi) : (j <= qi); wv[e] = ok ? a[e] * __expf(aci - acj[e]) * dtj[e] : 0.f; }
            u32x2 w; w.x = pk2(wv[0], wv[1]); w.y = pk2(wv[2], wv[3]);
            *(LAS u32x2*)(PP + qi * LDL + j0) = w;
        }
        {
            const float ea = __expf(aci);
            f32x4 Y[4];
#pragma unroll
            for (int pt = 0; pt < 4; ++pt) {
                f32x4 a = (f32x4){0.f, 0.f, 0.f, 0.f};
#pragma unroll
                for (int ks = 0; ks < 2; ++ks) a = MFMA16(ldfrag(HL + (16 * pt + fr) * LDS_ + 32 * ks + 8 * fq), cf[ks], a);
                Y[pt] = a * ea;
            }
#pragma unroll
            for (int ks = 0; ks < 4; ++ks) {
                const bf16x8 pf = ldfrag(PP + qi * LDL + 32 * ks + 8 * fq);
#pragma unroll
                for (int pt = 0; pt < 4; ++pt) Y[pt] = MFMA16(ldfrag(XST + (16 * pt + fr) * LDL + 32 * ks + 8 * fq), pf, Y[pt]);
            }
            bf16* yo = yout + (size_t)(lrow0 + qi) * YLD + 512 + 64 * hh + 4 * fq;
#pragma unroll
            for (int pt = 0; pt < 4; ++pt) {
                if (dir == 0) {
#pragma unroll
                    for (int e = 0; e < 4; ++e) Y[pt][e] += dsk * bf2f(XST[(16 * pt + 4 * fq + e) * LDL + qi]);
                }
                u32x2 w; w.x = pk2(Y[pt][0], Y[pt][1]); w.y = pk2(Y[pt][2], Y[pt][3]); *(u32x2*)(yo + 16 * pt) = w;
            }
        }
        {
            const float et = __expf(tot);
            Hc[0] *= et; Hc[1] *= et;
#pragma unroll
            for (int ks = 0; ks < 4; ++ks) {
                const bf16x8 xf = ldfrag(XST + (16 * (wid & 3) + fr) * LDL + 32 * ks + 8 * fq);
#pragma unroll
                for (int j2 = 0; j2 < 2; ++j2) Hc[j2] = MFMA16(ldfrag(BTW + (16 * (2 * (wid >> 2) + j2) + fr) * LDL + 32 * ks + 8 * fq), xf, Hc[j2]);
            }
            if (next_reset) { Hc[0] = (f32x4){0.f, 0.f, 0.f, 0.f}; Hc[1] = (f32x4){0.f, 0.f, 0.f, 0.f}; }
        }
        __syncthreads();
#pragma unroll
        for (int j2 = 0; j2 < 2; ++j2) { u32x2 w; w.x = pk2(Hc[j2][0], Hc[j2][1]); w.y = pk2(Hc[j2][2], Hc[j2][3]);
            *(LAS u32x2*)(HL + (16 * (wid & 3) + fr) * LDS_ + 16 * (2 * (wid >> 2) + j2) + 4 * fq) = w; }
    }
#undef SSD_LOAD
    __syncthreads();
}

__device__ __forceinline__ void lru_item(LAS unsigned char* lds, const bf16* proj, bf16* yout, const float* cw, const float* cb, const float* w_a, const float* b_a, const float* w_i, const float* b_i,
                                         const float* lam, int gv, int vloc, int nb, int dir) {
    const int tid = launder_tid(), wid = __builtin_amdgcn_readfirstlane(tid >> 6), lane = tid & 63, fr = lane & 15, fq = lane >> 4;
    constexpr int LDX = 72;
    LAS bf16* XCB = (LAS bf16*)lds;
    LAS bf16* WT = XCB + 128 * LDX;
    LAS float* AA = (LAS float*)(WT + 128 * LDX);
    LAS float* UU = AA + 128 * 64;
    LAS float* AGG = UU + 128 * 64;
    LAS float* CARRY = AGG + 8 * 64 * 2;
    LAS float* BA = CARRY + 128;
    LAS float* BI = BA + 64;
    LAS float* SP = BI + 64;
    const int seqlen = gv < 8 ? 8192 : 4096;
    for (int idx = tid; idx < 8192; idx += 512) {
        const int mat = idx >> 12, rem = idx & 4095, i = rem >> 6, j = rem & 63;
        const float* w = (mat ? w_i : w_a) + (size_t)((dir * 8 + nb) * 64 + i) * 64 + j;
        WT[(64 * mat + j) * LDX + i] = f2bf(*w);
    }
    if (tid < 64) { CARRY[tid] = 0.f; CARRY[64 + tid] = 0.f; BA[tid] = b_a[dir * 512 + 64 * nb + tid]; BI[tid] = b_i[dir * 512 + 64 * nb + tid]; SP[tid] = 8.0f * softplusf(-lam[dir * 512 + 64 * nb + tid]); }
    const int c8 = (tid & 7) * 8, i0 = 2 * (tid >> 3), ccol = 64 * nb + c8;
    const f32x8 w0 = ld8f(cw + 0 * 512 + ccol), w1 = ld8f(cw + 1 * 512 + ccol), w2 = ld8f(cw + 2 * 512 + ccol), w3 = ld8f(cw + 3 * 512 + ccol), bb = ld8f(cb + ccol);
    u32x4 raw[5];
#define LRU_LOAD(CC) do { const int lr0_ = vloc * 8192 + (CC) * 128, p0_ = ((CC) * 128) % seqlen; \
        _Pragma("unroll") for (int r = 0; r < 5; ++r) { const int s_ = p0_ + i0 - 2 + r; raw[r] = (u32x4){0u, 0u, 0u, 0u}; \
            if (s_ >= 0 && s_ < seqlen) raw[r] = *(const u32x4*)(proj + (size_t)(lr0_ + i0 - 2 + r) * PLD + PC_LRUX + ccol); } } while (0)
    LRU_LOAD(dir ? 63 : 0);
    __syncthreads();
    for (int c = 0; c < 64; ++c) {
        const int cc = dir ? 63 - c : c;
        const int lrow0 = vloc * 8192 + cc * 128;
        bool next_reset = false;
        if (c < 63) { const int ncc = dir ? cc - 1 : cc + 1; const int np = (ncc * 128) % seqlen; next_reset = dir ? (np + 128 == seqlen) : (np == 0); }
#pragma unroll
        for (int r = 0; r < 2; ++r) {
            const f32x8 v = bb + w0 * unpack8(raw[r]) + w1 * unpack8(raw[r + 1]) + w2 * unpack8(raw[r + 2]) + w3 * unpack8(raw[r + 3]);
            *(LAS u32x4*)(XCB + (i0 + r) * LDX + c8) = pack8(v);
        }
        if (c < 63) { const int ncc = dir ? cc - 1 : cc + 1; LRU_LOAD(ncc); }
        __syncthreads();
        const int t = 16 * wid + fr;
        {
            bf16x8 xf[2];
            xf[0] = ldfrag(XCB + t * LDX + 8 * fq); xf[1] = ldfrag(XCB + t * LDX + 32 + 8 * fq);
            f32x4 Gt[8];
#pragma unroll
            for (int ct = 0; ct < 8; ++ct) {
                f32x4 a = (f32x4){0.f, 0.f, 0.f, 0.f};
#pragma unroll
                for (int ks = 0; ks < 2; ++ks) a = MFMA16(ldfrag(WT + (16 * ct + fr) * LDX + 32 * ks + 8 * fq), xf[ks], a);
                Gt[ct] = a;
            }
#pragma unroll
            for (int ct = 0; ct < 4; ++ct) {
                const int c0 = 16 * ct + 4 * fq;
                const f32x4 ba = *(const LAS f32x4*)(BA + c0), bi = *(const LAS f32x4*)(BI + c0), sp = *(const LAS f32x4*)(SP + c0);
                const u32x2 xw = *(const LAS u32x2*)(XCB + t * LDX + c0);
                const float xv[4] = {bflo(xw.x), bfhi(xw.x), bflo(xw.y), bfhi(xw.y)};
                f32x4 av, uv;
#pragma unroll
                for (int e = 0; e < 4; ++e) {
                    const float r = sigm(Gt[ct][e] + ba[e]), ig = sigm(Gt[ct + 4][e] + bi[e]);
                    const float la = -r * sp[e];
                    const float a = __expf(la);
                    av[e] = a;
                    uv[e] = sqrtf(fmaxf((1.0f - a) * (1.0f + a), 0.f)) * ig * xv[e];
                }
                *(LAS f32x4*)(AA + t * 64 + c0) = av; *(LAS f32x4*)(UU + t * 64 + c0) = uv;
            }
        }
        __syncthreads();
        {
            const int ch = tid & 63, seg = tid >> 6;
            float Pp = 1.f, h = 0.f;
#pragma unroll
            for (int k = 0; k < 16; ++k) { const int o = seg * 16 + k, tt = dir ? 127 - o : o; const float a = AA[tt * 64 + ch], u = UU[tt * 64 + ch]; h = a * h + u; Pp *= a; }
            AGG[(seg * 64 + ch) * 2] = Pp; AGG[(seg * 64 + ch) * 2 + 1] = h;
            __syncthreads();
            float cin = CARRY[(c & 1) * 64 + ch];
            for (int s = 0; s < seg; ++s) cin = AGG[(s * 64 + ch) * 2] * cin + AGG[(s * 64 + ch) * 2 + 1];
            h = cin;
            bf16* yo = yout + (size_t)lrow0 * YLD + 64 * nb + ch;
#pragma unroll
            for (int k = 0; k < 16; ++k) { const int o = seg * 16 + k, tt = dir ? 127 - o : o; const float a = AA[tt * 64 + ch], u = UU[tt * 64 + ch]; h = a * h + u; yo[(size_t)tt * YLD] = f2bf(h); }
            if (seg == 7) CARRY[((c + 1) & 1) * 64 + ch] = next_reset ? 0.f : h;
        }
    }
#undef LRU_LOAD
    __syncthreads();
}

__device__ __forceinline__ void conv_prepass(const bf16* proj, bf16* cxb, const float* cw, const float* cb, int sub, int bx, int G) {
    const int tid = launder_tid();
    for (int id = bx * 512 + tid; id < 96 * (THALF / 32); id += G * 512) {
        const int cgp = id % 96, seg = id / 96, xc = 8 * cgp;
        const int row0 = seg * 32, gv = sub * 5 + (row0 >> 13), seqlen = gv < 8 ? 8192 : 4096, posb = row0 % seqlen;
#pragma unroll 1
        for (int blk = 0; blk < 4; ++blk) {
            const int r0 = row0 + 8 * blk, p0 = posb + 8 * blk;
            u32x4 raw[11];
#pragma unroll
            for (int r = 0; r < 11; ++r) { const int s_ = p0 - 2 + r; raw[r] = (u32x4){0u, 0u, 0u, 0u}; if (s_ >= 0 && s_ < seqlen) raw[r] = *(const u32x4*)(proj + (size_t)(r0 - 2 + r) * PLD + PC_XBC + xc); }
#pragma unroll
            for (int hc = 0; hc < 2; ++hc) {
                const int cl = xc + 4 * hc;
                const f32x4 w0 = *(const f32x4*)(cw + 0 * 768 + cl), w1 = *(const f32x4*)(cw + 1 * 768 + cl), w2 = *(const f32x4*)(cw + 2 * 768 + cl), w3 = *(const f32x4*)(cw + 3 * 768 + cl), bb = *(const f32x4*)(cb + cl);
                f32x4 ring[4] = {bb, bb, bb, bb};
#pragma unroll
                for (int r = 0; r < 11; ++r) {
                    const unsigned xa = raw[r][2 * hc], xb = raw[r][2 * hc + 1];
                    const f32x4 x = (f32x4){bflo(xa), bfhi(xa), bflo(xb), bfhi(xb)};
                    if (r <= 7) ring[r & 3] += w0 * x;
                    if (r >= 1 && r <= 8) ring[(r - 1) & 3] += w1 * x;
                    if (r >= 2 && r <= 9) ring[(r - 2) & 3] += w2 * x;
                    if (r >= 3) {
                        const int od = r - 3;
                        f32x4 t = ring[od & 3] + w3 * x;
                        ring[od & 3] = bb;
#pragma unroll
                        for (int e = 0; e < 4; ++e) t[e] = siluf(t[e]);
                        u32x2 pk; pk.x = pk2(t[0], t[1]); pk.y = pk2(t[2], t[3]);
                        *(u32x2*)(cxb + (size_t)(r0 + od) * 768 + cl) = pk;
                    }
                }
            }
        }
    }
}

__global__ void __launch_bounds__(512, 2) mega_fwd(Args args) {
    extern __shared__ __attribute__((aligned(16))) unsigned char lds_raw[];
    LAS unsigned char* lds = (LAS unsigned char*)lds_raw;
    cg::grid_group grid = cg::this_grid();
#define GRID_SYNC() do { asm volatile("s_waitcnt vmcnt(0) lgkmcnt(0)" ::: "memory"); __syncthreads(); grid.sync(); } while (0)
    const int wid = __builtin_amdgcn_readfirstlane(launder_tid() >> 6), G = gridDim.x, bx = blockIdx.x;
    unsigned char* ws; float* X;
    { KArgsPtr KA0 = kargs(); ws = KA0->ws; X = KA0->out; }
    bf16* XB = (bf16*)(ws + WS_XB); float* SSQ = (float*)(ws + WS_SSQ);
    float* RCOS = (float*)(ws + WS_ROPE); float* RSIN = RCOS + 8192 * 64;
    bf16* PROJ = (bf16*)(ws + WS_PROJ); bf16* YF = (bf16*)(ws + WS_Y); bf16* YBK = (bf16*)(ws + WS_YB); bf16* HB = (bf16*)(ws + WS_H);
    const int gw = bx * 8 + wid, NGW = G * 8;

    {
        KArgsPtr KA = kargs();
        const int tid = launder_tid(), lane = tid & 63;
        LAS float* scr = (LAS float*)(lds + wid * 16384);
        constexpr int I_GU = (DM / 64) * (NGU / 32), I_D = (DFF / 64) * (DM / 32), I_IN = (DM / 64) * (NIN / 32), I_OUT = (NMIX / 64) * (DM / 32);
        constexpr int I_LAYER = 2 * I_GU + 2 * I_D + I_IN + I_OUT;
        for (int it = gw; it < NLAYER * I_LAYER; it += NGW) {
            const int l = it / I_LAYER; int r = it % I_LAYER;
            if (r < I_GU) { transpose_item(KA->in[3] + (size_t)l * DM * NGU, DM, NGU, NGU, KA->in[2] + l * DM, (bf16*)(ws + WS_WGU1 + l * SZ_WGU), 1, r, lane, scr); continue; } r -= I_GU;
            if (r < I_GU) { transpose_item(KA->in[23] + (size_t)l * DM * NGU, DM, NGU, NGU, KA->in[22] + l * DM, (bf16*)(ws + WS_WGU2 + l * SZ_WGU), 1, r, lane, scr); continue; } r -= I_GU;
            if (r < I_D) { transpose_item(KA->in[4] + (size_t)l * DFF * DM, DFF, DM, DM, nullptr, (bf16*)(ws + WS_WD1 + l * SZ_WD), 0, r, lane, scr); continue; } r -= I_D;
            if (r < I_D) { transpose_item(KA->in[24] + (size_t)l * DFF * DM, DFF, DM, DM, nullptr, (bf16*)(ws + WS_WD2 + l * SZ_WD), 0, r, lane, scr); continue; } r -= I_D;
            if (r < I_IN) { transpose_item(KA->in[6] + (size_t)l * DM * W_IN_SRC, DM, W_IN_SRC, NIN, KA->in[5] + l * DM, (bf16*)(ws + WS_WIN + l * SZ_WIN), 2, r, lane, scr); continue; } r -= I_IN;
            transpose_item(KA->in[21] + (size_t)l * NMIX * DM, NMIX, DM, DM, nullptr, (bf16*)(ws + WS_WOUT + l * SZ_WOUT), 0, r, lane, scr);
        }
        for (int m = gw; m < TT; m += NGW) {
            const float* src = m < 65536 ? KA->in[0] + (size_t)m * DM : KA->in[1] + (size_t)(m - 65536) * DM;
            float s = 0.f;
#pragma unroll
            for (int j = 0; j < 4; ++j) {
                const f32x4 v = *(const f32x4*)(src + 256 * j + 4 * lane);
                *(f32x4*)(X + (size_t)m * DM + 256 * j + 4 * lane) = v;
                u32x2 w; w.x = pk2(v[0], v[1]); w.y = pk2(v[2], v[3]);
                *(u32x2*)(XB + (size_t)m * DM + 256 * j + 4 * lane) = w;
                s += (v[0] * v[0] + v[1] * v[1]) + (v[2] * v[2] + v[3] * v[3]);
            }
            s = wave_sum(s);
            if (lane < 16) SSQ[(size_t)m * 16 + lane] = lane == 0 ? s : 0.f;
        }
        for (int i = bx * 512 + tid; i < 8192 * 64; i += G * 512) {
            const int pos = i >> 6, f = i & 63;
            const float inv = 1.0f / powf(10000.0f, (float)(2 * f) / 128.0f);
            const float ang = (float)pos * inv;
            RCOS[i] = cosf(ang); RSIN[i] = sinf(ang);
        }
    }
    GRID_SYNC();

    for (int l = 0; l < NLAYER; ++l) {
        for (int st = 0; st < 3; ++st) {
            const int nsub = st == 1 ? 2 : 1;
            for (int sub = 0; sub < nsub; ++sub) {
                if (st != 1) {
                    const bf16* Wgu = (const bf16*)(ws + (st == 0 ? WS_WGU1 : WS_WGU2) + l * SZ_WGU);
                    pg8::Gemm g{XB, Wgu, TT, NGU, DM}; pg8::StaticOrder S; S.init(TT, NGU, G, bx);
                    EpiGU E{HB, SSQ};
#ifndef NO_GU
                    pg8::gemm_phase<EpiGU, pg8::StaticOrder, PG8_ALIGN, PG8_SP2>(lds, g, S, E);
#endif
                } else {
                    const bf16* Win = (const bf16*)(ws + WS_WIN + l * SZ_WIN);
                    pg8::Gemm g{XB + (size_t)sub * THALF * DM, Win, THALF, NIN, DM}; pg8::StaticOrder S; S.init(THALF, NIN, G, bx);
                    EpiProj E{PROJ, SSQ, sub * THALF, RCOS, RSIN};
#ifndef NO_PROJ
                    pg8::gemm_phase<EpiProj, pg8::StaticOrder, PG8_ALIGN, PG8_SP2>(lds, g, S, E);
#endif
                }
                GRID_SYNC();
                if (st == 1) {
                    bf16* CXB = (bf16*)(ws + WS_CXB);
                    { KArgsPtr KA = kargs(); conv_prepass(PROJ, CXB, KA->in[14] + (size_t)l * 4 * 768, KA->in[15] + l * 768, sub, bx, G); }
                    GRID_SYNC();
                    for (int item = bx; item < 200; item += G) {
                        KArgsPtr KA = kargs();
                        if (item < 40) {
                            const int vloc = item >> 3, hd = (item & 7) >> 1, dir = item & 1;
#ifndef NO_RET
                            ret_item(lds, PROJ, dir ? YBK : YF, sub * 5 + vloc, vloc, hd, dir);
#endif
                        } else if (item < 120) {
                            const int q = item - 40, vloc = q >> 4, hh = (q & 15) >> 1, dir = q & 1;
#ifndef NO_SSD
                            ssd_item(lds, PROJ, CXB, dir ? YBK : YF, KA->in[16] + l * 16, KA->in[17] + l * 16, KA->in[18] + l * 8,
                                     sub * 5 + vloc, vloc, hh, dir);
#endif
                        } else {
                            const int q = item - 120, vloc = q >> 4, nb = (q & 15) >> 1, dir = q & 1;
#ifndef NO_LRU
                            lru_item(lds, PROJ, dir ? YBK : YF, KA->in[7] + (size_t)l * 4 * 512, KA->in[8] + l * 512, KA->in[9] + (size_t)l * 2 * 8 * 64 * 64, KA->in[10] + l * 1024,
                                     KA->in[11] + (size_t)l * 2 * 8 * 64 * 64, KA->in[12] + l * 1024, KA->in[13] + l * 1024, sub * 5 + vloc, vloc, nb, dir);
#endif
                        }
                    }
                    GRID_SYNC();
                    {
                        KArgsPtr KA = kargs();
                        const int tid = launder_tid(), lane = tid & 63;
                        const float* ssd_norm = KA->in[19] + l * 512; const float* ret_norm = KA->in[20] + l * 512;
                        const f32x8 nw_s = ld8f(ssd_norm + 8 * lane), nw_r = ld8f(ret_norm + 8 * lane);
                        for (int row = gw; row < THALF; row += NGW) {
                            bf16* yr = YF + (size_t)row * YLD; const bf16* yb = YBK + (size_t)row * YLD; const bf16* pr = PROJ + (size_t)row * PLD;
                            {
                                const f32x8 a = unpack8(*(const u32x4*)(yr + 8 * lane)), b = unpack8(*(const u32x4*)(yb + 8 * lane)), gt = unpack8(*(const u32x4*)(pr + PC_GATE + 8 * lane));
                                f32x8 o;
#pragma unroll
                                for (int e = 0; e < 8; ++e) o[e] = (a[e] + b[e]) * gelu_tanh(gt[e]);
                                *(u32x4*)(yr + 8 * lane) = pack8(o);
                            }
                            {
                                const f32x8 a = unpack8(*(const u32x4*)(yr + 512 + 8 * lane)), b = unpack8(*(const u32x4*)(yb + 512 + 8 * lane)), z = unpack8(*(const u32x4*)(pr + PC_Z + 8 * lane));
                                f32x8 v; float ss = 0.f;
#pragma unroll
                                for (int e = 0; e < 8; ++e) { v[e] = (a[e] + b[e]) * siluf(z[e]); ss += v[e] * v[e]; }
                                ss = wave_sum(ss);
                                const float rs = rsqrtf(ss * (1.0f / 512.0f) + EPSN);
                                *(u32x4*)(yr + 512 + 8 * lane) = pack8(v * rs * nw_s);
                            }
                            {
                                const f32x8 a = unpack8(*(const u32x4*)(yr + 1024 + 8 * lane)), b = unpack8(*(const u32x4*)(yb + 1024 + 8 * lane)), gg = unpack8(*(const u32x4*)(pr + PC_G + 8 * lane));
                                f32x8 v = a + b; float s1 = 0.f;
#pragma unroll
                                for (int e = 0; e < 8; ++e) s1 += v[e];
                                s1 += __shfl_xor(s1, 1); s1 += __shfl_xor(s1, 2); s1 += __shfl_xor(s1, 4); s1 += __shfl_xor(s1, 8);
                                const float mu = s1 * (1.0f / 128.0f); float s2 = 0.f;
#pragma unroll
                                for (int e = 0; e < 8; ++e) { v[e] -= mu; s2 += v[e] * v[e]; }
                                s2 += __shfl_xor(s2, 1); s2 += __shfl_xor(s2, 2); s2 += __shfl_xor(s2, 4); s2 += __shfl_xor(s2, 8);
                                const float rs = rsqrtf(s2 * (1.0f / 128.0f) + EPSN);
                                f32x8 o;
#pragma unroll
                                for (int e = 0; e < 8; ++e) o[e] = v[e] * rs * nw_r[e] * siluf(gg[e]);
                                *(u32x4*)(yr + 1024 + 8 * lane) = pack8(o);
                            }
                        }
                    }
                    GRID_SYNC();
                }
                {
                    pg8::Gemm g; float coef; int roff;
                    if (st != 1) { g = pg8::Gemm{HB, (const bf16*)(ws + (st == 0 ? WS_WD1 : WS_WD2) + l * SZ_WD), TT, DM, DFF}; coef = 0.5f; roff = 0; }
                    else { g = pg8::Gemm{YF, (const bf16*)(ws + WS_WOUT + l * SZ_WOUT), THALF, DM, NMIX}; coef = 1.0f; roff = sub * THALF; }
                    pg8::StaticOrder S; S.init(g.M, g.N, G, bx);
                    EpiRes E{X, XB, SSQ, coef, roff};
#ifndef NO_RES
                    pg8::gemm_phase<EpiRes, pg8::StaticOrder, PG8_ALIGN, PG8_SP2>(lds, g, S, E);
#endif
                }
                GRID_SYNC();
            }
        }
    }
    {
        KArgsPtr KA = kargs();
        const int tid = launder_tid(), lane = tid & 63;
        const float* fw = KA->in[25];
        for (int m = gw; m < TT; m += NGW) {
            const float rs = row_rs(SSQ, (size_t)m);
#pragma unroll
            for (int j = 0; j < 4; ++j) {
                float* p = X + (size_t)m * DM + 256 * j + 4 * lane;
                const f32x4 v = *(const f32x4*)p, w = *(const f32x4*)(fw + 256 * j + 4 * lane);
                *(f32x4*)p = v * rs * w;
            }
        }
    }
}

extern "C" void kernel_launch(void* const* d_in, const int* in_sizes, int n_in, void* d_out, int out_size, void* d_ws, size_t ws_size, hipStream_t stream) {
    static int grid = 0;
    if (grid == 0) {
        if (n_in != 26 || out_size != TT * DM || ws_size < WS_NEED) { fprintf(stderr, "kernel_launch: unexpected problem (n_in %d, out %d, ws %zu, need %zu)\n", n_in, out_size, ws_size, (size_t)WS_NEED); grid = -1; return; }
        int dev = 0, cus = 0, per_cu = 0;
        if (hipGetDevice(&dev) != hipSuccess || hipDeviceGetAttribute(&cus, hipDeviceAttributeMultiprocessorCount, dev) != hipSuccess) { grid = -1; return; }
        if (hipFuncSetAttribute((const void*)mega_fwd, hipFuncAttributeMaxDynamicSharedMemorySize, LDS_BYTES) != hipSuccess) { fprintf(stderr, "kernel_launch: hipFuncSetAttribute failed\n"); grid = -1; return; }
        if (hipOccupancyMaxActiveBlocksPerMultiprocessor(&per_cu, (const void*)mega_fwd, 512, LDS_BYTES) != hipSuccess || per_cu < 1) { fprintf(stderr, "kernel_launch: occupancy query says %d\n", per_cu); per_cu = 1; }
        (void)hipGetLastError();
        grid = cus;
    }
    if (grid < 0) return;
    Args a{};
    for (int i = 0; i < 26; ++i) a.in[i] = (const float*)d_in[i];
    a.out = (float*)d_out; a.ws = (unsigned char*)d_ws;
    void* kargs[] = {&a};
    hipError_t e = hipLaunchCooperativeKernel((const void*)mega_fwd, dim3(grid), dim3(512), kargs, LDS_BYTES, stream);
    if (e != hipSuccess) fprintf(stderr, "kernel_launch: cooperative launch failed: %s (grid %d)\n", hipGetErrorString(e), grid);
}
```

```cpp
#include <hip/hip_runtime.h>
#include <hip/hip_cooperative_groups.h>
#include <cstdio>
#include <cstdint>
namespace cg = cooperative_groups;
namespace pg8 {
#define PG8_LAS __attribute__((address_space(3)))
typedef unsigned short bf16_t;
typedef short bf16x8 __attribute__((ext_vector_type(8)));
typedef float f32x4 __attribute__((ext_vector_type(4)));
typedef unsigned u32x4 __attribute__((ext_vector_type(4)));
constexpr int BM = 256, BK = 64, HALF = 128, HTB = HALF * BK * 2  , STAGE_BYTES = 8 * HTB, NXCD = 8, WGM = 8;

__host__ __device__ __forceinline__ int lds_byte(int r, int c) { const int st = (r >> 4) * 2 + (c >> 5), rr = r & 15, cc = c & 31, ob = rr * 64 + cc * 2; return st * 1024 + (ob ^ (((ob >> 9) & 1) << 5)); }
__host__ __device__ __forceinline__ void stage_rc(int b, int& R, int& C) { const int st = b / 1024, sb = b % 1024, swz = sb ^ (((sb >> 9) & 1) << 5); R = (st >> 1) * 16 + swz / 64; C = (st & 1) * 32 + (swz % 64) / 2; }
__host__ __device__ __forceinline__ int perm32(int rho) { const int n = rho >> 4, i = rho & 15; return 8 * (i >> 2) + 4 * n + (i & 3); }

struct Unit { int pm, pn; };
struct Gemm { const bf16_t* A; const bf16_t* Bt; int M, N, K; };

struct StaticOrder {
    int nM, nN, nwg, G, c;
    __host__ __device__ void init(int M, int N, int G_, int c_) { nM = M / BM; nN = N / BM; nwg = nM * nN; G = G_; c = c_; }
    __host__ __device__ bool next(int i, Unit& u) const {
        const long L = (long)i * G + c; if (L >= nwg) return false;
        int wgid = (int)L; { const int q = nwg / NXCD, r = nwg % NXCD, xcd = wgid % NXCD, off = wgid / NXCD; wgid = (xcd < r ? xcd * (q + 1) : r * (q + 1) + (xcd - r) * q) + off; }
        const int nig = WGM * nN, gid = wgid / nig, fm = gid * WGM, gsz = (nM - fm) < WGM ? (nM - fm) : WGM;
        u.pm = fm + ((wgid % nig) % gsz); u.pn = (wgid % nig) / gsz; return true;
    }
    __device__ __forceinline__ void a_ready(const Unit&) const {}
    __device__ __forceinline__ void done(const Unit&) const {}
};

__device__ __forceinline__ unsigned cvt_pk_bf16(float lo, float hi) { unsigned r; asm volatile("v_cvt_pk_bf16_f32 %0, %1, %2" : "=v"(r) : "v"(lo), "v"(hi)); return r; }
typedef float f32x2 __attribute__((ext_vector_type(2)));
template <class Epi, class Sched, bool ALIGN_EPI = false, bool SP2 = false>
__device__ __forceinline__ void gemm_phase(PG8_LAS unsigned char* lds, const Gemm g, const Sched& S, const Epi& E) {
    int tid_l = threadIdx.x; asm volatile("" : "+v"(tid_l));
    const int tid = tid_l, wid = __builtin_amdgcn_readfirstlane(tid >> 6), lane = tid & 63, wr = wid >> 2, wc = wid & 3, fr = lane & 15, fq = lane >> 4;
    const int K = g.K, nt = K / BK;
    unsigned voffA[2], voffB[2];
#pragma unroll
    for (int i = 0; i < 2; ++i) { int R, C; stage_rc(tid * 16 + i * 8192, R, C); const int Rb = Epi::PERM ? ((R & ~31) + perm32(R & 31)) : R;
        voffA[i] = (unsigned)(R * K + C) * 2u; voffB[i] = (unsigned)(Rb * K + C) * 2u; }
    const size_t kstep = (size_t)(BK * 2);
    const size_t hstep = (size_t)HALF * K * 2;
    const size_t tstep = 2 * hstep;
    const unsigned ldsw = (unsigned)wid * 1024u;
    const int aoff = lds_byte(wr * 64 + fr, fq * 8), boff = lds_byte(wc * 32 + fr, fq * 8);
#define PG8_SA(b, h) (((b) * 2 + (h)) * HTB)
#define PG8_SB(b, h) ((4 + (b) * 2 + (h)) * HTB)
#define PG8_STAGE(bufoff, gbase, voff) do { _Pragma("unroll") for (int _i = 0; _i < 2; ++_i) \
        __builtin_amdgcn_global_load_lds((const unsigned*)((const char*)(gbase) + (voff)[_i]), (PG8_LAS unsigned*)(lds + (bufoff) + ldsw + _i * 8192), 16, 0, 0); } while (0)
#define PG8_LDA(dst, b, h) do { _Pragma("unroll") for (int m = 0; m < 4; ++m) _Pragma("unroll") for (int k = 0; k < 2; ++k) dst[m][k] = *(const PG8_LAS bf16x8*)(lds + PG8_SA(b, h) + aoff + m * 2048 + k * 1024); } while (0)
#define PG8_LDB(dst, b, h) do { _Pragma("unroll") for (int n = 0; n < 2; ++n) _Pragma("unroll") for (int k = 0; k < 2; ++k) dst[n][k] = *(const PG8_LAS bf16x8*)(lds + PG8_SB(b, h) + boff + n * 2048 + k * 1024); } while (0)
#define PG8_MMA(ai, bj, At, Bt) do { __builtin_amdgcn_s_setprio(1); _Pragma("unroll") for (int m = 0; m < 4; ++m) _Pragma("unroll") for (int n = 0; n < 2; ++n) _Pragma("unroll") for (int k = 0; k < 2; ++k) \
        acc[ai][bj][m][n] = __builtin_amdgcn_mfma_f32_16x16x32_bf16(Bt[n][k], At[m][k], acc[ai][bj][m][n], 0, 0, 0); __builtin_amdgcn_s_setprio(0); } while (0)
#define PG8_WAIT_V(n) asm volatile("s_waitcnt vmcnt(" #n ")" ::: "memory")
#define PG8_WAIT_L(n) asm volatile("s_waitcnt lgkmcnt(" #n ")" ::: "memory")
#define PG8_BAR __builtin_amdgcn_s_barrier()
#define PG8_SCHED __builtin_amdgcn_sched_barrier(0)
    Unit cur, nxt; int ui = 0;
    if (!S.next(0, cur)) return;
    f32x4 acc[2][2][4][2];
#pragma unroll
    for (int a = 0; a < 2; ++a)
#pragma unroll
        for (int b = 0; b < 2; ++b)
#pragma unroll
            for (int m = 0; m < 4; ++m)
#pragma unroll
                for (int n = 0; n < 2; ++n) acc[a][b][m][n] = (f32x4){0.f, 0.f, 0.f, 0.f};
    bf16x8 At[4][2], B0[2][2], B1[2][2];
    const char* cA = (const char*)g.A + (size_t)cur.pm * tstep; const char* cB = (const char*)g.Bt + (size_t)cur.pn * tstep;
    S.a_ready(cur);
    if constexpr (SP2) {
        PG8_STAGE(PG8_SB(0, 0), cB, voffB); PG8_STAGE(PG8_SB(0, 1), cB + hstep, voffB); PG8_STAGE(PG8_SA(0, 0), cA, voffA); PG8_STAGE(PG8_SA(0, 1), cA + hstep, voffA);
        if (wr == 1) PG8_BAR;
        PG8_WAIT_V(2); PG8_BAR;
        PG8_STAGE(PG8_SB(1, 0), cB + kstep, voffB); PG8_STAGE(PG8_SA(1, 0), cA + kstep, voffA); PG8_STAGE(PG8_SB(1, 1), cB + hstep + kstep, voffB);
        PG8_WAIT_V(6); PG8_BAR;
    } else {
        PG8_STAGE(PG8_SB(0, 0), cB, voffB); PG8_STAGE(PG8_SA(0, 0), cA, voffA); PG8_STAGE(PG8_SB(0, 1), cB + hstep, voffB); PG8_STAGE(PG8_SA(0, 1), cA + hstep, voffA);
        if (wr == 1) PG8_BAR;
        PG8_WAIT_V(4); PG8_BAR;
        PG8_STAGE(PG8_SB(1, 0), cB + kstep, voffB); PG8_STAGE(PG8_SA(1, 0), cA + kstep, voffA); PG8_STAGE(PG8_SB(1, 1), cB + hstep + kstep, voffB);
        PG8_WAIT_V(6); PG8_BAR;
    }
    for (;;) {
        const bool has_next = S.next(ui + 1, nxt);
        const char* nA = has_next ? (const char*)g.A + (size_t)nxt.pm * tstep : cA; const char* nB = has_next ? (const char*)g.Bt + (size_t)nxt.pn * tstep : cB;
        for (int t = 0; t < nt; t += 2) {
            const bool last = (t == nt - 2);
            const char* a1 = cA + (size_t)(t + 1) * kstep;
            const char* a2 = last ? nA : cA + (size_t)(t + 2) * kstep; const char* b2 = last ? nB : cB + (size_t)(t + 2) * kstep;
            const char* a3 = a2 + kstep; const char* b3 = b2 + kstep;
            if (last && has_next) S.a_ready(nxt);
            if constexpr (SP2) {
            PG8_LDB(B0, 0, 0); PG8_LDB(B1, 0, 1); PG8_SCHED; PG8_LDA(At, 0, 0); PG8_STAGE(PG8_SA(1, 1), a1 + hstep, voffA);
            PG8_WAIT_V(8); PG8_WAIT_L(0); PG8_BAR; PG8_MMA(0, 0, At, B0); PG8_MMA(0, 1, At, B1); PG8_BAR; PG8_SCHED;
            PG8_LDA(At, 0, 1); PG8_STAGE(PG8_SB(0, 0), b2, voffB); PG8_STAGE(PG8_SB(0, 1), b2 + hstep, voffB); PG8_STAGE(PG8_SA(0, 0), a2, voffA);
            PG8_WAIT_V(8); PG8_WAIT_L(0); PG8_BAR; PG8_MMA(1, 0, At, B0); PG8_MMA(1, 1, At, B1); PG8_BAR; PG8_SCHED;
            PG8_LDB(B0, 1, 0); PG8_LDB(B1, 1, 1); PG8_SCHED; PG8_LDA(At, 1, 0); PG8_STAGE(PG8_SA(0, 1), a2 + hstep, voffA);
            PG8_WAIT_V(8); PG8_WAIT_L(0); PG8_BAR; PG8_MMA(0, 0, At, B0); PG8_MMA(0, 1, At, B1); PG8_BAR; PG8_SCHED;
            PG8_LDA(At, 1, 1); PG8_STAGE(PG8_SB(1, 0), b3, voffB); PG8_STAGE(PG8_SB(1, 1), b3 + hstep, voffB); PG8_STAGE(PG8_SA(1, 0), a3, voffA);
            PG8_WAIT_V(8); PG8_WAIT_L(0); PG8_BAR; PG8_MMA(1, 0, At, B0); PG8_MMA(1, 1, At, B1); PG8_BAR; PG8_SCHED;
            } else {
            PG8_LDB(B0, 0, 0); PG8_SCHED; PG8_LDA(At, 0, 0); PG8_STAGE(PG8_SA(1, 1), a1 + hstep, voffA);
            PG8_WAIT_L(8); PG8_BAR; PG8_WAIT_L(0); PG8_MMA(0, 0, At, B0); PG8_BAR; PG8_SCHED;
            PG8_LDB(B1, 0, 1); PG8_STAGE(PG8_SB(0, 0), b2, voffB);
            PG8_BAR; PG8_WAIT_L(0); PG8_MMA(0, 1, At, B1); PG8_BAR;
            PG8_LDA(At, 0, 1); PG8_STAGE(PG8_SA(0, 0), a2, voffA);
            PG8_BAR; PG8_WAIT_L(0); PG8_MMA(1, 0, At, B0); PG8_BAR; PG8_SCHED;
            PG8_STAGE(PG8_SB(0, 1), b2 + hstep, voffB);
            PG8_WAIT_V(6); PG8_BAR; PG8_MMA(1, 1, At, B1); PG8_BAR;
            PG8_LDB(B0, 1, 0); PG8_SCHED; PG8_LDA(At, 1, 0); PG8_STAGE(PG8_SA(0, 1), a2 + hstep, voffA);
            PG8_WAIT_L(8); PG8_BAR; PG8_WAIT_L(0); PG8_MMA(0, 0, At, B0); PG8_BAR; PG8_SCHED;
            PG8_LDB(B1, 1, 1); PG8_STAGE(PG8_SB(1, 0), b3, voffB);
            PG8_BAR; PG8_WAIT_L(0); PG8_MMA(0, 1, At, B1); PG8_BAR;
            PG8_LDA(At, 1, 1); PG8_STAGE(PG8_SA(1, 0), a3, voffA);
            PG8_BAR; PG8_WAIT_L(0); PG8_MMA(1, 0, At, B0); PG8_BAR; PG8_SCHED;
            PG8_STAGE(PG8_SB(1, 1), b3 + hstep, voffB);
            PG8_WAIT_V(6); PG8_BAR; PG8_MMA(1, 1, At, B1); PG8_BAR;
            }
        }
        if constexpr (ALIGN_EPI) { if (wr == 0) PG8_BAR; }
        if constexpr (!Epi::AFTER_DRAIN) { E(acc, cur, wr, wc, fr, fq); S.done(cur); }
        if (!has_next) break;
#pragma unroll
        for (int a = 0; a < 2; ++a)
#pragma unroll
            for (int b = 0; b < 2; ++b)
#pragma unroll
                for (int m = 0; m < 4; ++m)
#pragma unroll
                    for (int n = 0; n < 2; ++n) acc[a][b][m][n] = (f32x4){0.f, 0.f, 0.f, 0.f};
        cur = nxt; cA = nA; cB = nB; ++ui;
        if constexpr (ALIGN_EPI) { if (wr == 1) PG8_BAR; }
    }
    PG8_WAIT_V(0);
    if constexpr (!ALIGN_EPI) { if (wr == 0) PG8_BAR; }
    PG8_BAR;
    if constexpr (Epi::AFTER_DRAIN) { E.fused(acc, cur, wr, wc, fr, fq, lds, wid, lane); S.done(cur); }
#undef PG8_SA
#undef PG8_SB
#undef PG8_STAGE
#undef PG8_LDA
#undef PG8_LDB
#undef PG8_MMA
#undef PG8_WAIT_V
#undef PG8_WAIT_L
#undef PG8_BAR
#undef PG8_SCHED
}
}
#ifndef PG8_SP2
#define PG8_SP2 true
#endif
#ifndef PG8_ALIGN
#define PG8_ALIGN true
#endif

#define LAS __attribute__((address_space(3)))
typedef unsigned short bf16;
typedef float f32x4 __attribute__((ext_vector_type(4)));
typedef float f32x8 __attribute__((ext_vector_type(8)));
typedef short bf16x8 __attribute__((ext_vector_type(8)));
typedef unsigned u32x4 __attribute__((ext_vector_type(4)));
typedef unsigned u32x2 __attribute__((ext_vector_type(2)));

constexpr int DM = 1024, DFF = 2816, NGU = 5632, NIN = 4608, NMIX = 1536, NLAYER = 4;
constexpr int TT = 81920, THALF = 40960, PLD = NIN  , YLD = NMIX;
constexpr int W_IN_SRC = 4368;
constexpr float EPSN = 1e-6f;
constexpr int PC_LRUX = 0, PC_GATE = 512, PC_Z = 1024, PC_XBC = 1536, PC_Q = 2304, PC_K = 2816, PC_V = 3328, PC_G = 3840, PC_DT = 4352;

constexpr size_t al256(size_t x) { return (x + 255) & ~(size_t)255; }
constexpr size_t SZ_WGU = (size_t)NGU * DM * 2, SZ_WD = (size_t)DM * DFF * 2, SZ_WIN = (size_t)NIN * DM * 2, SZ_WOUT = (size_t)DM * NMIX * 2;
constexpr size_t WS_WGU1 = 0;
constexpr size_t WS_WD1 = WS_WGU1 + NLAYER * SZ_WGU;
constexpr size_t WS_WIN = WS_WD1 + NLAYER * SZ_WD;
constexpr size_t WS_WOUT = WS_WIN + NLAYER * SZ_WIN;
constexpr size_t WS_WGU2 = WS_WOUT + NLAYER * SZ_WOUT;
constexpr size_t WS_WD2 = WS_WGU2 + NLAYER * SZ_WGU;
constexpr size_t WS_XB = al256(WS_WD2 + NLAYER * SZ_WD);
constexpr size_t WS_SSQ = al256(WS_XB + (size_t)TT * DM * 2);
constexpr size_t WS_ROPE = al256(WS_SSQ + (size_t)TT * 16 * 4);
constexpr size_t WS_BIG = al256(WS_ROPE + (size_t)8192 * 64 * 4 * 2);
constexpr size_t WS_PROJ = WS_BIG;
constexpr size_t WS_Y = al256(WS_PROJ + (size_t)THALF * PLD * 2);
constexpr size_t WS_YB = al256(WS_Y + (size_t)THALF * YLD * 2);
constexpr size_t WS_CXB = al256(WS_YB + (size_t)THALF * YLD * 2);
constexpr size_t WS_BAR = al256(WS_CXB + (size_t)THALF * 768 * 2);
constexpr size_t WS_END1 = al256(WS_BAR + 16384);
constexpr size_t WS_H = WS_BIG;
constexpr size_t WS_END2 = al256(WS_H + (size_t)TT * DFF * 2);
constexpr size_t WS_NEED = WS_END1 > WS_END2 ? WS_END1 : WS_END2;

constexpr int LDS_BYTES = 147456;

__device__ __forceinline__ float bflo(unsigned w) { return __builtin_bit_cast(float, w << 16); }
__device__ __forceinline__ float bfhi(unsigned w) { return __builtin_bit_cast(float, w & 0xffff0000u); }
__device__ __forceinline__ float bf2f(bf16 b) { return __builtin_bit_cast(float, (unsigned)b << 16); }
__device__ __forceinline__ bf16 f2bf(float f) { unsigned u = __builtin_bit_cast(unsigned, f); return (bf16)((u + 0x7fffu + ((u >> 16) & 1u)) >> 16); }
__device__ __forceinline__ unsigned pk2(float lo, float hi) { return pg8::cvt_pk_bf16(lo, hi); }
__device__ __forceinline__ f32x8 unpack8(u32x4 w) { f32x8 o; o[0] = bflo(w.x); o[1] = bfhi(w.x); o[2] = bflo(w.y); o[3] = bfhi(w.y); o[4] = bflo(w.z); o[5] = bfhi(w.z); o[6] = bflo(w.w); o[7] = bfhi(w.w); return o; }
__device__ __forceinline__ u32x4 pack8(f32x8 v) { u32x4 w; w.x = pk2(v[0], v[1]); w.y = pk2(v[2], v[3]); w.z = pk2(v[4], v[5]); w.w = pk2(v[6], v[7]); return w; }
__device__ __forceinline__ f32x8 ld8f(const float* p) { const f32x4 a = *(const f32x4*)p, b = *(const f32x4*)(p + 4); f32x8 o; o[0] = a[0]; o[1] = a[1]; o[2] = a[2]; o[3] = a[3]; o[4] = b[0]; o[5] = b[1]; o[6] = b[2]; o[7] = b[3]; return o; }
__device__ __forceinline__ float sigm(float x) { return __builtin_amdgcn_rcpf(1.0f + __expf(-x)); }
__device__ __forceinline__ float siluf(float x) { return x * sigm(x); }
__device__ __forceinline__ float softplusf(float x) { return fmaxf(x, 0.f) + log1pf(__expf(-fabsf(x))); }
__device__ __forceinline__ float gelu_tanh(float x) { const float y = 0.7978845608028654f * (x + 0.044715f * x * x * x); const float t = 1.0f - 2.0f * __builtin_amdgcn_rcpf(1.0f + __expf(2.0f * y)); return 0.5f * x * (1.0f + t); }
__device__ __forceinline__ float wave_sum(float v) {
#pragma unroll
    for (int o = 1; o < 64; o <<= 1) v += __shfl_xor(v, o);
    return v;
}
__device__ __forceinline__ float row_rs(const float* ssq, size_t row) {
    const f32x4 a = *(const f32x4*)(ssq + row * 16), b = *(const f32x4*)(ssq + row * 16 + 4), c = *(const f32x4*)(ssq + row * 16 + 8), d = *(const f32x4*)(ssq + row * 16 + 12);
    const float s = ((a[0] + a[1]) + (a[2] + a[3])) + ((b[0] + b[1]) + (b[2] + b[3])) + ((c[0] + c[1]) + (c[2] + c[3])) + ((d[0] + d[1]) + (d[2] + d[3]));
    return rsqrtf(s * (1.0f / DM) + EPSN);
}
__device__ __forceinline__ int launder_tid() { int t = threadIdx.x; asm volatile("" : "+v"(t)); return t; }
#define MFMA16(a, b, c) __builtin_amdgcn_mfma_f32_16x16x32_bf16((a), (b), (c), 0, 0, 0)
__device__ __forceinline__ bf16x8 ldfrag(const LAS bf16* p) { return *(const LAS bf16x8*)p; }

struct EpiGU {
    static constexpr bool PERM = true, AFTER_DRAIN = false;
    bf16* H; const float* ssq;
    __device__ __forceinline__ void operator()(const pg8::f32x4 (&acc)[2][2][4][2], const pg8::Unit& u, int wr, int wc, int fr, int fq) const {
        const int row0 = u.pm * 256 + wr * 64 + fr, col0 = u.pn * 128 + wc * 32 + 8 * fq;
#pragma unroll
        for (int ai = 0; ai < 2; ++ai)
#pragma unroll
            for (int m = 0; m < 4; ++m) {
                const size_t row = (size_t)(row0 + ai * 128 + m * 16);
                const float rs = row_rs(ssq, row);
                const pg8::f32x4 g0 = acc[ai][0][m][0] * rs, g1 = acc[ai][0][m][1] * rs, u0 = acc[ai][1][m][0] * rs, u1 = acc[ai][1][m][1] * rs;
                u32x4 w;
                w.x = pk2(siluf(g0[0]) * u0[0], siluf(g0[1]) * u0[1]); w.y = pk2(siluf(g0[2]) * u0[2], siluf(g0[3]) * u0[3]);
                w.z = pk2(siluf(g1[0]) * u1[0], siluf(g1[1]) * u1[1]); w.w = pk2(siluf(g1[2]) * u1[2], siluf(g1[3]) * u1[3]);
                *(u32x4*)(H + row * DFF + col0) = w;
                asm volatile("" ::: "memory");
            }
    }
};
struct EpiProj {
    static constexpr bool PERM = true, AFTER_DRAIN = false;
    bf16* P; const float* ssq; int row_off; const float* rcos; const float* rsin;
    __device__ __forceinline__ void operator()(const pg8::f32x4 (&acc)[2][2][4][2], const pg8::Unit& u, int wr, int wc, int fr, int fq) const {
        const int row0 = u.pm * 256 + wr * 64 + fr, col0 = u.pn * 256 + wc * 32 + 8 * fq;
        if (u.pn >= 9 && u.pn <= 12) {
            const float ksc = u.pn >= 11 ? 0.08838834764831845f : 1.0f;
            const int d0 = 32 * (wc & 1) + 8 * fq, colr = u.pn * 256 + 128 * (wc >> 1) + d0;
#pragma unroll
            for (int ai = 0; ai < 2; ++ai)
#pragma unroll
                for (int m = 0; m < 4; ++m) {
                    const size_t row = (size_t)(row0 + ai * 128 + m * 16);
                    const int gr = (int)row + row_off, pos = gr < 65536 ? (gr & 8191) : (gr & 4095);
                    const float rs = row_rs(ssq, (size_t)gr) * ksc;
                    u32x4 w1, w2;
#pragma unroll
                    for (int n = 0; n < 2; ++n) {
                        const pg8::f32x4 cs = *(const pg8::f32x4*)(rcos + (size_t)pos * 64 + d0 + 4 * n), sn = *(const pg8::f32x4*)(rsin + (size_t)pos * 64 + d0 + 4 * n);
                        const pg8::f32x4 t1 = acc[ai][0][m][n] * rs, t2 = acc[ai][1][m][n] * rs;
                        const pg8::f32x4 o1 = t1 * cs - t2 * sn, o2 = t1 * sn + t2 * cs;
                        if (n == 0) { w1.x = pk2(o1[0], o1[1]); w1.y = pk2(o1[2], o1[3]); w2.x = pk2(o2[0], o2[1]); w2.y = pk2(o2[2], o2[3]); }
                        else { w1.z = pk2(o1[0], o1[1]); w1.w = pk2(o1[2], o1[3]); w2.z = pk2(o2[0], o2[1]); w2.w = pk2(o2[2], o2[3]); }
                    }
                    *(u32x4*)(P + row * PLD + colr) = w1; *(u32x4*)(P + row * PLD + colr + 64) = w2;
                    asm volatile("" ::: "memory");
                }
            return;
        }
#pragma unroll
        for (int ai = 0; ai < 2; ++ai)
#pragma unroll
            for (int m = 0; m < 4; ++m) {
                const size_t row = (size_t)(row0 + ai * 128 + m * 16);
                const float rs = row_rs(ssq, row + row_off);
#pragma unroll
                for (int bj = 0; bj < 2; ++bj) {
                    const pg8::f32x4 v0 = acc[ai][bj][m][0] * rs, v1 = acc[ai][bj][m][1] * rs;
                    u32x4 w; w.x = pk2(v0[0], v0[1]); w.y = pk2(v0[2], v0[3]); w.z = pk2(v1[0], v1[1]); w.w = pk2(v1[2], v1[3]);
                    *(u32x4*)(P + row * PLD + col0 + bj * 128) = w;
                }
                asm volatile("" ::: "memory");
            }
    }
};
struct EpiRes {
    static constexpr bool PERM = true, AFTER_DRAIN = false;
    float* X; bf16* XB; float* ssq; float coef; int row_off;
    __device__ __forceinline__ void operator()(const pg8::f32x4 (&acc)[2][2][4][2], const pg8::Unit& u, int wr, int wc, int fr, int fq) const {
        const int row0 = row_off + u.pm * 256 + wr * 64 + fr, col0 = u.pn * 256 + wc * 32 + 8 * fq;
#pragma unroll
        for (int ai = 0; ai < 2; ++ai)
#pragma unroll
            for (int m = 0; m < 4; ++m) {
                const size_t row = (size_t)(row0 + ai * 128 + m * 16);
                float s = 0.f;
#pragma unroll
                for (int bj = 0; bj < 2; ++bj) {
                    float* xp = X + row * DM + col0 + bj * 128;
                    pg8::f32x4 x0 = *(const pg8::f32x4*)xp, x1 = *(const pg8::f32x4*)(xp + 4);
                    x0 += acc[ai][bj][m][0] * coef; x1 += acc[ai][bj][m][1] * coef;
                    *(pg8::f32x4*)xp = x0; *(pg8::f32x4*)(xp + 4) = x1;
                    s += (x0[0] * x0[0] + x0[1] * x0[1]) + (x0[2] * x0[2] + x0[3] * x0[3]) + (x1[0] * x1[0] + x1[1] * x1[1]) + (x1[2] * x1[2] + x1[3] * x1[3]);
                    u32x4 w; w.x = pk2(x0[0], x0[1]); w.y = pk2(x0[2], x0[3]); w.z = pk2(x1[0], x1[1]); w.w = pk2(x1[2], x1[3]);
                    *(u32x4*)(XB + row * DM + col0 + bj * 128) = w;
                }
                s += __shfl_xor(s, 16); s += __shfl_xor(s, 32);
                if (fq == 0) ssq[row * 16 + u.pn * 4 + wc] = s;
                asm volatile("" ::: "memory");
            }
    }
};

__device__ __forceinline__ int colmap(int kind, int n) {
    if (kind == 0) return n;
    if (kind == 1) { const int t = n >> 8, w = n & 255; return w < 128 ? 128 * t + w : DFF + 128 * t + (w - 128); }
    if (n < 2304) return n;
    if (n < 3328) { const int t = n >> 8, w = n & 255, bj = w >> 7, o = w & 127; return 256 * t + 128 * (o >> 6) + (o & 63) + 64 * bj + 16; }
    return n < 4352 ? n + 16 : (n < 4368 ? n - 4352 + 2304 : -1);
}
__device__ __forceinline__ void transpose_item(const float* W, int K, int Nsrc, int Ndst, const float* kscale, bf16* WT, int kind, int item, int lane, LAS float* scr) {
    const int nblk = Ndst / 32, kb = item / nblk, nb = item % nblk, k0 = 64 * kb, n0 = 32 * nb;
    const int sc = colmap(kind, n0 + (lane & 31));
#pragma unroll 8
    for (int i = 0; i < 32; ++i) { const int kk = 2 * i + (lane >> 5); float v = 0.f; if (sc >= 0) { v = W[(size_t)(k0 + kk) * Nsrc + sc]; if (kscale) v *= kscale[k0 + kk]; } scr[kk * 33 + (lane & 31)] = v; }
    asm volatile("s_waitcnt lgkmcnt(0)" ::: "memory");
    const int c = lane & 7;
#pragma unroll
    for (int j = 0; j < 4; ++j) { const int n = (lane >> 3) + 8 * j; const LAS float* s = scr + (8 * c) * 33 + n;
        u32x4 o; o.x = pk2(s[0 * 33], s[1 * 33]); o.y = pk2(s[2 * 33], s[3 * 33]); o.z = pk2(s[4 * 33], s[5 * 33]); o.w = pk2(s[6 * 33], s[7 * 33]);
        *(u32x4*)(WT + (size_t)(n0 + n) * K + k0 + 8 * c) = o; }
    asm volatile("s_waitcnt lgkmcnt(0)" ::: "memory");
}

struct Args { const float* in[26]; float* out; unsigned char* ws; };
typedef const __attribute__((address_space(4))) Args* KArgsPtr;
__device__ __forceinline__ KArgsPtr kargs() { KArgsPtr p = (KArgsPtr)__builtin_amdgcn_kernarg_segment_ptr(); asm volatile("" : "+s"(p)); return p; }

__device__ __forceinline__ f32x8 conv8(const bf16* proj, int lrow, int pcol, int pos, int seqlen, const float* cw, int cw_ld, const float* cb, int ccol) {
    f32x8 acc = ld8f(cb + ccol);
#pragma unroll
    for (int k = 0; k < 4; ++k) {
        const int s = pos + k - 2;
        if (s >= 0 && s < seqlen) {
            const u32x4 raw = *(const u32x4*)(proj + (size_t)(lrow + k - 2) * PLD + pcol);
            acc += ld8f(cw + k * cw_ld + ccol) * unpack8(raw);
        }
    }
    return acc;
}

__device__ __forceinline__ void ret_item(LAS unsigned char* lds, const bf16* proj, bf16* yout, int gv, int vloc, int hd, int dir) {
    const int tid = launder_tid(), wid = __builtin_amdgcn_readfirstlane(tid >> 6), lane = tid & 63, fr = lane & 15, fq = lane >> 4;
    constexpr int LD = 136;
    LAS bf16* KN = (LAS bf16*)lds; LAS bf16* KTW = KN + 128 * LD; LAS bf16* VT = KTW + 128 * LD; LAS bf16* RT = VT + 128 * LD;
    const int seqlen = gv < 8 ? 8192 : 4096;
    const float l2g = log2f(1.0f - exp2f(-5.0f - (float)hd));
    const float cdec = exp2f(l2g * 128.0f);
    const int i0 = 4 * ((tid >> 2) & 31), c8 = 8 * ((tid & 3) + 4 * (tid >> 7)), qi = 16 * wid + fr;
    float wl[4];
#pragma unroll
    for (int r = 0; r < 4; ++r) wl[r] = exp2f(l2g * (float)(dir ? i0 + r : 127 - (i0 + r)));
    const float rsc = exp2f(l2g * (float)(dir ? 128 - qi : qi + 1));
    f32x4 R[8];
#pragma unroll
    for (int i = 0; i < 8; ++i) R[i] = (f32x4){0.f, 0.f, 0.f, 0.f};
    for (int i = tid; i < 128 * LD / 2; i += 512) ((LAS unsigned*)RT)[i] = 0u;
    u32x4 kraw[4], vraw[4], qraw[4];
#define RET_LOAD(CC) do { const int lr0_ = vloc * 8192 + (CC) * 128; \
        _Pragma("unroll") for (int r = 0; r < 4; ++r) { const bf16* rp_ = proj + (size_t)(lr0_ + i0 + r) * PLD + 128 * hd + c8; kraw[r] = *(const u32x4*)(rp_ + PC_K); vraw[r] = *(const u32x4*)(rp_ + PC_V); } \
        _Pragma("unroll") for (int ks = 0; ks < 4; ++ks) qraw[ks] = *(const u32x4*)(proj + (size_t)(lr0_ + qi) * PLD + PC_Q + 128 * hd + 32 * ks + 8 * fq); } while (0)
    RET_LOAD(dir ? 63 : 0);
    __syncthreads();
    for (int c = 0; c < 64; ++c) {
        const int cc = dir ? 63 - c : c;
        const int lrow0 = vloc * 8192 + cc * 128;
        const bool do_intra = ((cc & 1) == dir);
        bool next_reset = false;
        if (c < 63) { const int ncc = dir ? cc - 1 : cc + 1; const int np = (ncc * 128) % seqlen; next_reset = dir ? (np + 128 == seqlen) : (np == 0); }
        {
            if (do_intra) {
#pragma unroll
                for (int r = 0; r < 4; ++r) *(LAS u32x4*)(KN + (i0 + r) * LD + c8) = kraw[r];
            }
            LAS bf16* kt = KTW + c8 * LD + i0; LAS bf16* vt = VT + c8 * LD + i0;
#pragma unroll
            for (int m = 0; m < 4; ++m) {
                u32x2 we, wo;
                we.x = pk2(bflo(kraw[0][m]) * wl[0], bflo(kraw[1][m]) * wl[1]); we.y = pk2(bflo(kraw[2][m]) * wl[2], bflo(kraw[3][m]) * wl[3]);
                wo.x = pk2(bfhi(kraw[0][m]) * wl[0], bfhi(kraw[1][m]) * wl[1]); wo.y = pk2(bfhi(kraw[2][m]) * wl[2], bfhi(kraw[3][m]) * wl[3]);
                *(LAS u32x2*)(kt + (2 * m) * LD) = we; *(LAS u32x2*)(kt + (2 * m + 1) * LD) = wo;
                u32x2 ve, vo;
                ve.x = (vraw[0][m] & 0xffffu) | (vraw[1][m] << 16); ve.y = (vraw[2][m] & 0xffffu) | (vraw[3][m] << 16);
                vo.x = (vraw[0][m] >> 16) | (vraw[1][m] & 0xffff0000u); vo.y = (vraw[2][m] >> 16) | (vraw[3][m] & 0xffff0000u);
                *(LAS u32x2*)(vt + (2 * m) * LD) = ve; *(LAS u32x2*)(vt + (2 * m + 1) * LD) = vo;
            }
        }
        bf16x8 qf[4];
#pragma unroll
        for (int ks = 0; ks < 4; ++ks) qf[ks] = __builtin_bit_cast(bf16x8, qraw[ks]);
        if (c < 63) { const int ncc = dir ? cc - 1 : cc + 1; RET_LOAD(ncc); }
        __syncthreads();
        unsigned sp[8][2];
        if (do_intra) {
#pragma unroll
            for (int ct = 0; ct < 8; ++ct) {
                f32x4 a = (f32x4){0.f, 0.f, 0.f, 0.f};
#pragma unroll
                for (int ks = 0; ks < 4; ++ks) a = MFMA16(ldfrag(KN + (16 * ct + fr) * LD + 32 * ks + 8 * fq), qf[ks], a);
                const int j0 = 16 * ct + 4 * fq;
                float dv[4];
#pragma unroll
                for (int e = 0; e < 4; ++e) { const int dd = qi - (j0 + e); dv[e] = a[e] * exp2f(l2g * (float)(dd < 0 ? -dd : dd)); }
                sp[ct][0] = pk2(dv[0], dv[1]); sp[ct][1] = pk2(dv[2], dv[3]);
            }
            __syncthreads();
#pragma unroll
            for (int ct = 0; ct < 8; ++ct) { u32x2 w; w.x = sp[ct][0]; w.y = sp[ct][1]; *(LAS u32x2*)(KN + qi * LD + 16 * ct + 4 * fq) = w; }
        }
        {
            f32x4 Y[8];
#pragma unroll
            for (int ct = 0; ct < 8; ++ct) {
                f32x4 a = (f32x4){0.f, 0.f, 0.f, 0.f};
#pragma unroll
                for (int ks = 0; ks < 4; ++ks) a = MFMA16(ldfrag(RT + (16 * ct + fr) * LD + 32 * ks + 8 * fq), qf[ks], a);
                Y[ct] = a * rsc;
            }
            if (do_intra) {
#pragma unroll
                for (int ks = 0; ks < 4; ++ks) {
                    const bf16x8 pf = ldfrag(KN + qi * LD + 32 * ks + 8 * fq);
#pragma unroll
                    for (int ct = 0; ct < 8; ++ct) Y[ct] = MFMA16(ldfrag(VT + (16 * ct + fr) * LD + 32 * ks + 8 * fq), pf, Y[ct]);
                }
            }
            bf16* yo = yout + (size_t)(lrow0 + qi) * YLD + 1024 + 128 * hd + 4 * fq;
#pragma unroll
            for (int ct = 0; ct < 8; ++ct) { u32x2 w; w.x = pk2(Y[ct][0], Y[ct][1]); w.y = pk2(Y[ct][2], Y[ct][3]); *(u32x2*)(yo + 16 * ct) = w; }
        }
#pragma unroll
        for (int ct = 0; ct < 8; ++ct) R[ct] *= cdec;
#pragma unroll
        for (int ks = 0; ks < 4; ++ks) {
            const bf16x8 kf = ldfrag(KTW + (16 * wid + fr) * LD + 32 * ks + 8 * fq);
#pragma unroll
            for (int ct = 0; ct < 8; ++ct) R[ct] = MFMA16(kf, ldfrag(VT + (16 * ct + fr) * LD + 32 * ks + 8 * fq), R[ct]);
        }
        if (next_reset) {
#pragma unroll
            for (int ct = 0; ct < 8; ++ct) R[ct] = (f32x4){0.f, 0.f, 0.f, 0.f};
        }
        __syncthreads();
#pragma unroll
        for (int ct = 0; ct < 8; ++ct) { u32x2 w; w.x = pk2(R[ct][0], R[ct][1]); w.y = pk2(R[ct][2], R[ct][3]); *(LAS u32x2*)(RT + (16 * ct + fr) * LD + 16 * wid + 4 * fq) = w; }
    }
#undef RET_LOAD
    __syncthreads();
}

__device__ __forceinline__ void ssd_item(LAS unsigned char* lds, const bf16* proj, const bf16* cxb, bf16* yout, const float* dt_bias, const float* a_log, const float* dskip,
                                         int gv, int vloc, int hh, int dir) {
    const int tid = launder_tid(), wid = __builtin_amdgcn_readfirstlane(tid >> 6), lane = tid & 63, fr = lane & 15, fq = lane >> 4;
    constexpr int LDL = 136, LDS_ = 72;
    LAS bf16* XST = (LAS bf16*)lds;
    LAS bf16* CN = XST + 64 * LDL;
    LAS bf16* BN = CN + 128 * LDS_;
    LAS bf16* BTW = BN + 128 * LDS_;
    LAS bf16* PP = BTW + 64 * LDL;
    LAS bf16* HL = PP + 128 * LDL;
    LAS float* DT = (LAS float*)(HL + 64 * LDS_);
    LAS float* ACUM = DT + 128;
    LAS float* CWL = ACUM + 128;
    const int seqlen = gv < 8 ? 8192 : 4096, grp = hh >> 2;
    const float aneg = -__expf(a_log[dir * 8 + hh]), dtb = dt_bias[dir * 8 + hh], dsk = dskip[hh];
    const int cg8 = tid % 24, rb = tid / 24, sec = cg8 >> 3, c8 = (cg8 & 7) * 8, i0 = 8 * rb;
    const int xc = sec == 0 ? 64 * hh + c8 : (sec == 1 ? 512 + 64 * grp + c8 : 640 + 64 * grp + c8);
    const bool stager = tid < 384;
    f32x4 Hc[2];
    Hc[0] = (f32x4){0.f, 0.f, 0.f, 0.f}; Hc[1] = (f32x4){0.f, 0.f, 0.f, 0.f};
    for (int i = tid; i < 64 * LDS_ / 2; i += 512) ((LAS unsigned*)HL)[i] = 0u;
    u32x4 raw[8]; float dtraw = 0.f;
#define SSD_LOAD(CC) do { const int lr0_ = vloc * 8192 + (CC) * 128; \
        if (stager) { _Pragma("unroll") for (int r = 0; r < 8; ++r) raw[r] = *(const u32x4*)(cxb + (size_t)(lr0_ + i0 + r) * 768 + xc); } \
        if (tid < 128) dtraw = bf2f(proj[(size_t)(lr0_ + tid) * PLD + PC_DT + dir * 8 + hh]); } while (0)
    SSD_LOAD(dir ? 63 : 0);
    __syncthreads();
    for (int c = 0; c < 64; ++c) {
        const int cc = dir ? 63 - c : c;
        const int lrow0 = vloc * 8192 + cc * 128;
        bool next_reset = false;
        if (c < 63) { const int ncc = dir ? cc - 1 : cc + 1; const int np = (ncc * 128) % seqlen; next_reset = dir ? (np + 128 == seqlen) : (np == 0); }
        if (tid < 128) DT[tid] = softplusf(dtraw + dtb);
        __syncthreads();
        float tot;
        {
            const float x0 = DT[2 * lane] * aneg, x1 = DT[2 * lane + 1] * aneg;
            float s = x0 + x1;
#pragma unroll
            for (int o = 1; o < 64; o <<= 1) { const float t = __shfl_up(s, o); if (lane >= o) s += t; }
            tot = __shfl(s, 63);
            const float p1 = s, p0 = s - x1;
            if (dir == 0) { ACUM[2 * lane] = p0; ACUM[2 * lane + 1] = p1; }
            else { ACUM[2 * lane] = tot - p0 + x0; ACUM[2 * lane + 1] = tot - p1 + x1; }
        }
        if (stager) {
#pragma unroll
            for (int hc = 0; hc < 2; ++hc) {
                u32x2 pv[4];
#pragma unroll
                for (int od = 0; od < 8; ++od) {
                    u32x2 pk; pk.x = raw[od][2 * hc]; pk.y = raw[od][2 * hc + 1];
                    if (sec == 0) pv[od & 3] = pk;
                    else if (sec == 1) { *(LAS u32x2*)(BN + (i0 + od) * LDS_ + c8 + 4 * hc) = pk; const float wr = __expf(tot - ACUM[i0 + od]) * DT[i0 + od];
                        u32x2 pw; pw.x = pk2(bflo(pk.x) * wr, bfhi(pk.x) * wr); pw.y = pk2(bflo(pk.y) * wr, bfhi(pk.y) * wr); pv[od & 3] = pw; }
                    else *(LAS u32x2*)(CN + (i0 + od) * LDS_ + c8 + 4 * hc) = pk;
                    if ((od & 3) == 3 && sec != 2) {
                        LAS bf16* dstT = (sec == 0 ? XST : BTW) + (c8 + 4 * hc) * LDL + i0 + (od - 3);
#pragma unroll
                        for (int m = 0; m < 2; ++m) {
                            u32x2 we, wo;
                            we.x = (pv[0][m] & 0xffffu) | (pv[1][m] << 16); we.y = (pv[2][m] & 0xffffu) | (pv[3][m] << 16);
                            wo.x = (pv[0][m] >> 16) | (pv[1][m] & 0xffff0000u); wo.y = (pv[2][m] >> 16) | (pv[3][m] & 0xffff0000u);
                            *(LAS u32x2*)(dstT + (2 * m) * LDL) = we; *(LAS u32x2*)(dstT + (2 * m + 1) * LDL) = wo;
                        }
                    }
                }
            }
        }
        if (c < 63) { const int ncc = dir ? cc - 1 : cc + 1; SSD_LOAD(ncc); }
        __syncthreads();
        const int qi = 16 * wid + fr;
        bf16x8 cf[2];
        cf[0] = ldfrag(CN + qi * LDS_ + 8 * fq); cf[1] = ldfrag(CN + qi * LDS_ + 32 + 8 * fq);
        const float aci = ACUM[qi];
#pragma unroll
        for (int ct = 0; ct < 8; ++ct) {
            f32x4 a = (f32x4){0.f, 0.f, 0.f, 0.f};
#pragma unroll
            for (int ks = 0; ks < 2; ++ks) a = MFMA16(ldfrag(BN + (16 * ct + fr) * LDS_ + 32 * ks + 8 * fq), cf[ks], a);
            const int j0 = 16 * ct + 4 * fq;
            const f32x4 acj = *(const LAS f32x4*)(ACUM + j0), dtj = *(const LAS f32x4*)(DT + j0);
            float wv[4];
#pragma unroll
            for (int e = 0; e < 4; ++e) { const int j = j0 + e; const bool ok = dir ? (j >= qi) : (j <= qi); wv[e] = ok ? a[e] * __expf(aci - acj[e]) * dtj[e] : 0.f; }
            u32x2 w; w.x = pk2(wv[0], wv[1]); w.y = pk2(wv[2], wv[3]);
            *(LAS u32x2*)(PP + qi * LDL + j0) = w;
        }
        {
            const float ea = __expf(aci);
            f32x4 Y[4];
#pragma unroll
            for (int pt = 0; pt < 4; ++pt) {
                f32x4 a = (f32x4){0.f, 0.f, 0.f, 0.f};
#pragma unroll
                for (int ks = 0; ks < 2; ++ks) a = MFMA16(ldfrag(HL + (16 * pt + fr) * LDS_ + 32 * ks + 8 * fq), cf[ks], a);
                Y[pt] = a * ea;
            }
#pragma unroll
            for (int ks = 0; ks < 4; ++ks) {
                const bf16x8 pf = ldfrag(PP + qi * LDL + 32 * ks + 8 * fq);
#pragma unroll
                for (int pt = 0; pt < 4; ++pt) Y[pt] = MFMA16(ldfrag(XST + (16 * pt + fr) * LDL + 32 * ks + 8 * fq), pf, Y[pt]);
            }
            bf16* yo = yout + (size_t)(lrow0 + qi) * YLD + 512 + 64 * hh + 4 * fq;
#pragma unroll
            for (int pt = 0; pt < 4; ++pt) {
                if (dir == 0) {
#pragma unroll
                    for (int e = 0; e < 4; ++e) Y[pt][e] += dsk * bf2f(XST[(16 * pt + 4 * fq + e) * LDL + qi]);
                }
                u32x2 w; w.x = pk2(Y[pt][0], Y[pt][1]); w.y = pk2(Y[pt][2], Y[pt][3]); *(u32x2*)(yo + 16 * pt) = w;
            }
        }
        {
            const float et = __expf(tot);
            Hc[0] *= et; Hc[1] *= et;
#pragma unroll
            for (int ks = 0; ks < 4; ++ks) {
                const bf16x8 xf = ldfrag(XST + (16 * (wid & 3) + fr) * LDL + 32 * ks + 8 * fq);
#pragma unroll
                for (int j2 = 0; j2 < 2; ++j2) Hc[j2] = MFMA16(ldfrag(BTW + (16 * (2 * (wid >> 2) + j2) + fr) * LDL + 32 * ks + 8 * fq), xf, Hc[j2]);
            }
            if (next_reset) { Hc[0] = (f32x4){0.f, 0.f, 0.f, 0.f}; Hc[1] = (f32x4){0.f, 0.f, 0.f, 0.f}; }
        }
        __syncthreads();
#pragma unroll
        for (int j2 = 0; j2 < 2; ++j2) { u32x2 w; w.x = pk2(Hc[j2][0], Hc[j2][1]); w.y = pk2(Hc[j2][2], Hc[j2][3]);
            *(LAS u32x2*)(HL + (16 * (wid & 3) + fr) * LDS_ + 16 * (2 * (wid >> 2) + j2) + 4 * fq) = w; }
    }
#undef SSD_LOAD
    __syncthreads();
}

__device__ __forceinline__ void lru_item(LAS unsigned char* lds, const bf16* proj, bf16* yout, const float* cw, const float* cb, const float* w_a, const float* b_a, const float* w_i, const float* b_i,
                                         const float* lam, int gv, int vloc, int nb, int dir) {
    const int tid = launder_tid(), wid = __builtin_amdgcn_readfirstlane(tid >> 6), lane = tid & 63, fr = lane & 15, fq = lane >> 4;
    constexpr int LDX = 72;
    LAS bf16* XCB = (LAS bf16*)lds;
    LAS bf16* WT = XCB + 128 * LDX;
    LAS float* AA = (LAS float*)(WT + 128 * LDX);
    LAS float* UU = AA + 128 * 64;
    LAS float* AGG = UU + 128 * 64;
    LAS float* CARRY = AGG + 8 * 64 * 2;
    LAS float* BA = CARRY + 128;
    LAS float* BI = BA + 64;
    LAS float* SP = BI + 64;
    const int seqlen = gv < 8 ? 8192 : 4096;
    for (int idx = tid; idx < 8192; idx += 512) {
        const int mat = idx >> 12, rem = idx & 4095, i = rem >> 6, j = rem & 63;
        const float* w = (mat ? w_i : w_a) + (size_t)((dir * 8 + nb) * 64 + i) * 64 + j;
        WT[(64 * mat + j) * LDX + i] = f2bf(*w);
    }
    if (tid < 64) { CARRY[tid] = 0.f; CARRY[64 + tid] = 0.f; BA[tid] = b_a[dir * 512 + 64 * nb + tid]; BI[tid] = b_i[dir * 512 + 64 * nb + tid]; SP[tid] = 8.0f * softplusf(-lam[dir * 512 + 64 * nb + tid]); }
    const int c8 = (tid & 7) * 8, i0 = 2 * (tid >> 3), ccol = 64 * nb + c8;
    const f32x8 w0 = ld8f(cw + 0 * 512 + ccol), w1 = ld8f(cw + 1 * 512 + ccol), w2 = ld8f(cw + 2 * 512 + ccol), w3 = ld8f(cw + 3 * 512 + ccol), bb = ld8f(cb + ccol);
    u32x4 raw[5];
#define LRU_LOAD(CC) do { const int lr0_ = vloc * 8192 + (CC) * 128, p0_ = ((CC) * 128) % seqlen; \
        _Pragma("unroll") for (int r = 0; r < 5; ++r) { const int s_ = p0_ + i0 - 2 + r; raw[r] = (u32x4){0u, 0u, 0u, 0u}; \
            if (s_ >= 0 && s_ < seqlen) raw[r] = *(const u32x4*)(proj + (size_t)(lr0_ + i0 - 2 + r) * PLD + PC_LRUX + ccol); } } while (0)
    LRU_LOAD(dir ? 63 : 0);
    __syncthreads();
    for (int c = 0; c < 64; ++c) {
        const int cc = dir ? 63 - c : c;
        const int lrow0 = vloc * 8192 + cc * 128;
        bool next_reset = false;
        if (c < 63) { const int ncc = dir ? cc - 1 : cc + 1; const int np = (ncc * 128) % seqlen; next_reset = dir ? (np + 128 == seqlen) : (np == 0); }
#pragma unroll
        for (int r = 0; r < 2; ++r) {
            const f32x8 v = bb + w0 * unpack8(raw[r]) + w1 * unpack8(raw[r + 1]) + w2 * unpack8(raw[r + 2]) + w3 * unpack8(raw[r + 3]);
            *(LAS u32x4*)(XCB + (i0 + r) * LDX + c8) = pack8(v);
        }
        if (c < 63) { const int ncc = dir ? cc - 1 : cc + 1; LRU_LOAD(ncc); }
        __syncthreads();
        const int t = 16 * wid + fr;
        {
            bf16x8 xf[2];
            xf[0] = ldfrag(XCB + t * LDX + 8 * fq); xf[1] = ldfrag(XCB + t * LDX + 32 + 8 * fq);
            f32x4 Gt[8];
#pragma unroll
            for (int ct = 0; ct < 8; ++ct) {
                f32x4 a = (f32x4){0.f, 0.f, 0.f, 0.f};
#pragma unroll
                for (int ks = 0; ks < 2; ++ks) a = MFMA16(ldfrag(WT + (16 * ct + fr) * LDX + 32 * ks + 8 * fq), xf[ks], a);
                Gt[ct] = a;
            }
#pragma unroll
            for (int ct = 0; ct < 4; ++ct) {
                const int c0 = 16 * ct + 4 * fq;
                const f32x4 ba = *(const LAS f32x4*)(BA + c0), bi = *(const LAS f32x4*)(BI + c0), sp = *(const LAS f32x4*)(SP + c0);
                const u32x2 xw = *(const LAS u32x2*)(XCB + t * LDX + c0);
                const float xv[4] = {bflo(xw.x), bfhi(xw.x), bflo(xw.y), bfhi(xw.y)};
                f32x4 av, uv;
#pragma unroll
                for (int e = 0; e < 4; ++e) {
                    const float r = sigm(Gt[ct][e] + ba[e]), ig = sigm(Gt[ct + 4][e] + bi[e]);
                    const float la = -r * sp[e];
                    const float a = __expf(la);
                    av[e] = a;
                    uv[e] = sqrtf(fmaxf((1.0f - a) * (1.0f + a), 0.f)) * ig * xv[e];
                }
                *(LAS f32x4*)(AA + t * 64 + c0) = av; *(LAS f32x4*)(UU + t * 64 + c0) = uv;
            }
        }
        __syncthreads();
        {
            const int ch = tid & 63, seg = tid >> 6;
            float Pp = 1.f, h = 0.f;
#pragma unroll
            for (int k = 0; k < 16; ++k) { const int o = seg * 16 + k, tt = dir ? 127 - o : o; const float a = AA[tt * 64 + ch], u = UU[tt * 64 + ch]; h = a * h + u; Pp *= a; }
            AGG[(seg * 64 + ch) * 2] = Pp; AGG[(seg * 64 + ch) * 2 + 1] = h;
            __syncthreads();
            float cin = CARRY[(c & 1) * 64 + ch];
            for (int s = 0; s < seg; ++s) cin = AGG[(s * 64 + ch) * 2] * cin + AGG[(s * 64 + ch) * 2 + 1];
            h = cin;
            bf16* yo = yout + (size_t)lrow0 * YLD + 64 * nb + ch;
#pragma unroll
            for (int k = 0; k < 16; ++k) { const int o = seg * 16 + k, tt = dir ? 127 - o : o; const float a = AA[tt * 64 + ch], u = UU[tt * 64 + ch]; h = a * h + u; yo[(size_t)tt * YLD] = f2bf(h); }
            if (seg == 7) CARRY[((c + 1) & 1) * 64 + ch] = next_reset ? 0.f : h;
        }
    }
#undef LRU_LOAD
    __syncthreads();
}

__device__ __forceinline__ void conv_prepass(const bf16* proj, bf16* cxb, const float* cw, const float* cb, int sub, int bx, int G) {
    const int tid = launder_tid();
    for (int id = bx * 512 + tid; id < 96 * (THALF / 32); id += G * 512) {
        const int cgp = id % 96, seg = id / 96, xc = 8 * cgp;
        const int row0 = seg * 32, gv = sub * 5 + (row0 >> 13), seqlen = gv < 8 ? 8192 : 4096, posb = row0 % seqlen;
#pragma unroll 1
        for (int blk = 0; blk < 4; ++blk) {
            const int r0 = row0 + 8 * blk, p0 = posb + 8 * blk;
            u32x4 raw[11];
#pragma unroll
            for (int r = 0; r < 11; ++r) { const int s_ = p0 - 2 + r; raw[r] = (u32x4){0u, 0u, 0u, 0u}; if (s_ >= 0 && s_ < seqlen) raw[r] = *(const u32x4*)(proj + (size_t)(r0 - 2 + r) * PLD + PC_XBC + xc); }
#pragma unroll
            for (int hc = 0; hc < 2; ++hc) {
                const int cl = xc + 4 * hc;
                const f32x4 w0 = *(const f32x4*)(cw + 0 * 768 + cl), w1 = *(const f32x4*)(cw + 1 * 768 + cl), w2 = *(const f32x4*)(cw + 2 * 768 + cl), w3 = *(const f32x4*)(cw + 3 * 768 + cl), bb = *(const f32x4*)(cb + cl);
                f32x4 ring[4] = {bb, bb, bb, bb};
#pragma unroll
                for (int r = 0; r < 11; ++r) {
                    const unsigned xa = raw[r][2 * hc], xb = raw[r][2 * hc + 1];
                    const f32x4 x = (f32x4){bflo(xa), bfhi(xa), bflo(xb), bfhi(xb)};
                    if (r <= 7) ring[r & 3] += w0 * x;
                    if (r >= 1 && r <= 8) ring[(r - 1) & 3] += w1 * x;
                    if (r >= 2 && r <= 9) ring[(r - 2) & 3] += w2 * x;
                    if (r >= 3) {
                        const int od = r - 3;
                        f32x4 t = ring[od & 3] + w3 * x;
                        ring[od & 3] = bb;
#pragma unroll
                        for (int e = 0; e < 4; ++e) t[e] = siluf(t[e]);
                        u32x2 pk; pk.x = pk2(t[0], t[1]); pk.y = pk2(t[2], t[3]);
                        *(u32x2*)(cxb + (size_t)(r0 + od) * 768 + cl) = pk;
                    }
                }
            }
        }
    }
}

#define XB_TMO      128
#define XB_XCNT(j)  (256  + 64 * (j))
#define XB_XSUB(j)  (1280 + 64 * (j))
#define XB_XGEN(j)  (2304 + 64 * (j))
#define XB_TOP      3328
#define XB_TOPGEN   3392
#define XCD_BAR_WORDS 3456
#define XB_SPIN_CAP (1u << 18)

__device__ __forceinline__ unsigned xb_ld(unsigned* p)              { return __hip_atomic_load(p, __ATOMIC_RELAXED, __HIP_MEMORY_SCOPE_AGENT); }
__device__ __forceinline__ unsigned xb_add(unsigned* p, unsigned v) { return __hip_atomic_fetch_add(p, v, __ATOMIC_RELAXED, __HIP_MEMORY_SCOPE_AGENT); }
__device__ __forceinline__ unsigned xb_xcc_id() { return (unsigned)__builtin_amdgcn_s_getreg((3 << 11) | 20) & 0xFu; }
#define XB_SPIN(cond, bar) do { unsigned _sp = 0; while (cond) { __builtin_amdgcn_s_sleep(1); \
    if ((++_sp & 255u) == 0u) { if (xb_ld(&(bar)[XB_TMO])) break; if (_sp > XB_SPIN_CAP) { atomicAdd(&(bar)[XB_TMO], 1u); break; } } } } while (0)

struct XcdBarrier {
    unsigned* bar; unsigned x;
    volatile LAS unsigned* st;
};

__device__ __forceinline__ XcdBarrier xcd_barrier_post(unsigned* bar, volatile LAS unsigned* st) {
    XcdBarrier b; b.bar = bar; b.x = xb_xcc_id(); b.st = st;
    if (threadIdx.x == 0) (void)xb_add(&bar[XB_XCNT(b.x)], 1u);
    return b;
}
__device__ __forceinline__ void xcd_barrier_complete(unsigned* bar, unsigned x, unsigned& nloc, unsigned& nx) {
    const unsigned G = gridDim.x * gridDim.y * gridDim.z;
    unsigned sum, cnt, mine, sp = 0u;
    for (;;) {
        sum = 0u; cnt = 0u; mine = 0u;
#pragma unroll
        for (unsigned j = 0; j < 16; ++j) { const unsigned c = xb_ld(&bar[XB_XCNT(j)]); sum += c; cnt += (c > 0u) ? 1u : 0u; mine = (j == x) ? c : mine; }
        if (sum == G) break;
        __builtin_amdgcn_s_sleep(1);
        if ((++sp & 255u) == 0u) { if (xb_ld(&bar[XB_TMO])) break; if (sp > XB_SPIN_CAP) { atomicAdd(&bar[XB_TMO], 1u); break; } }
    }
    nloc = mine > 0u ? mine : 1u; nx = cnt > 0u ? cnt : 1u;
}

__device__ __forceinline__ void xcd_barrier(const XcdBarrier& b) {
    asm volatile("s_waitcnt vmcnt(0)" ::: "memory");
    __syncthreads();
    if (threadIdx.x == 0) {
        unsigned* bar = b.bar;
        __builtin_amdgcn_s_waitcnt(0);
        unsigned nloc = b.st[0], nx = b.st[1];
        if (nloc == 0u) { xcd_barrier_complete(bar, b.x, nloc, nx); b.st[0] = nloc; b.st[1] = nx; }
        const unsigned old = xb_add(&bar[XB_XSUB(b.x)], 1u);
        const unsigned gen = old / nloc;
        if (old + 1u == (gen + 1u) * nloc) {
            __builtin_amdgcn_fence(__ATOMIC_RELEASE, "agent");
            asm volatile("s_waitcnt vmcnt(0)" ::: "memory");
            const unsigned og = xb_add(&bar[XB_TOP], 1u);
            const unsigned tg = og / nx;
            if (og + 1u == (tg + 1u) * nx) xb_add(&bar[XB_TOPGEN], 1u);
            else XB_SPIN(xb_ld(&bar[XB_TOPGEN]) == tg, bar);
            __builtin_amdgcn_fence(__ATOMIC_ACQUIRE, "agent");
            xb_add(&bar[XB_XGEN(b.x)], 1u);
            asm volatile("s_waitcnt vmcnt(0)" ::: "memory");
        } else {
            XB_SPIN(xb_ld(&bar[XB_XGEN(b.x)]) == gen, bar);
            __builtin_amdgcn_fence(__ATOMIC_ACQUIRE, "agent");
            asm volatile("s_waitcnt vmcnt(0)" ::: "memory");
        }
    }
    __syncthreads();
}


__global__ void __launch_bounds__(512, 2) mega_fwd(Args args) {
    extern __shared__ __attribute__((aligned(16))) unsigned char lds_raw[];
    LAS unsigned char* lds = (LAS unsigned char*)lds_raw;
    cg::grid_group grid = cg::this_grid();
#define CG_SYNC() do { asm volatile("s_waitcnt vmcnt(0) lgkmcnt(0)" ::: "memory"); __syncthreads(); grid.sync(); } while (0)
    volatile LAS unsigned* xb_st = (volatile LAS unsigned*)((LAS unsigned char*)lds_raw + LDS_BYTES - 64);
    if (threadIdx.x == 0) { xb_st[0] = 0u; xb_st[1] = 0u; }
    __syncthreads();
    const XcdBarrier xbar = xcd_barrier_post((unsigned*)(kargs()->ws + WS_BAR), xb_st);
#define GRID_SYNC() xcd_barrier(xbar)
    const int wid = __builtin_amdgcn_readfirstlane(launder_tid() >> 6), G = gridDim.x, bx = blockIdx.x;
    unsigned char* ws; float* X;
    { KArgsPtr KA0 = kargs(); ws = KA0->ws; X = KA0->out; }
    bf16* XB = (bf16*)(ws + WS_XB); float* SSQ = (float*)(ws + WS_SSQ);
    float* RCOS = (float*)(ws + WS_ROPE); float* RSIN = RCOS + 8192 * 64;
    bf16* PROJ = (bf16*)(ws + WS_PROJ); bf16* YF = (bf16*)(ws + WS_Y); bf16* YBK = (bf16*)(ws + WS_YB); bf16* HB = (bf16*)(ws + WS_H);
    const int gw = bx * 8 + wid, NGW = G * 8;

    {
        KArgsPtr KA = kargs();
        const int tid = launder_tid(), lane = tid & 63;
        LAS float* scr = (LAS float*)(lds + wid * 16384);
        constexpr int I_GU = (DM / 64) * (NGU / 32), I_D = (DFF / 64) * (DM / 32), I_IN = (DM / 64) * (NIN / 32), I_OUT = (NMIX / 64) * (DM / 32);
        constexpr int I_LAYER = 2 * I_GU + 2 * I_D + I_IN + I_OUT;
        for (int it = gw; it < NLAYER * I_LAYER; it += NGW) {
            const int l = it / I_LAYER; int r = it % I_LAYER;
            if (r < I_GU) { transpose_item(KA->in[3] + (size_t)l * DM * NGU, DM, NGU, NGU, KA->in[2] + l * DM, (bf16*)(ws + WS_WGU1 + l * SZ_WGU), 1, r, lane, scr); continue; } r -= I_GU;
            if (r < I_GU) { transpose_item(KA->in[23] + (size_t)l * DM * NGU, DM, NGU, NGU, KA->in[22] + l * DM, (bf16*)(ws + WS_WGU2 + l * SZ_WGU), 1, r, lane, scr); continue; } r -= I_GU;
            if (r < I_D) { transpose_item(KA->in[4] + (size_t)l * DFF * DM, DFF, DM, DM, nullptr, (bf16*)(ws + WS_WD1 + l * SZ_WD), 0, r, lane, scr); continue; } r -= I_D;
            if (r < I_D) { transpose_item(KA->in[24] + (size_t)l * DFF * DM, DFF, DM, DM, nullptr, (bf16*)(ws + WS_WD2 + l * SZ_WD), 0, r, lane, scr); continue; } r -= I_D;
            if (r < I_IN) { transpose_item(KA->in[6] + (size_t)l * DM * W_IN_SRC, DM, W_IN_SRC, NIN, KA->in[5] + l * DM, (bf16*)(ws + WS_WIN + l * SZ_WIN), 2, r, lane, scr); continue; } r -= I_IN;
            transpose_item(KA->in[21] + (size_t)l * NMIX * DM, NMIX, DM, DM, nullptr, (bf16*)(ws + WS_WOUT + l * SZ_WOUT), 0, r, lane, scr);
        }
        for (int m = gw; m < TT; m += NGW) {
            const float* src = m < 65536 ? KA->in[0] + (size_t)m * DM : KA->in[1] + (size_t)(m - 65536) * DM;
            float s = 0.f;
#pragma unroll
            for (int j = 0; j < 4; ++j) {
                const f32x4 v = *(const f32x4*)(src + 256 * j + 4 * lane);
                *(f32x4*)(X + (size_t)m * DM + 256 * j + 4 * lane) = v;
                u32x2 w; w.x = pk2(v[0], v[1]); w.y = pk2(v[2], v[3]);
                *(u32x2*)(XB + (size_t)m * DM + 256 * j + 4 * lane) = w;
                s += (v[0] * v[0] + v[1] * v[1]) + (v[2] * v[2] + v[3] * v[3]);
            }
            s = wave_sum(s);
            if (lane < 16) SSQ[(size_t)m * 16 + lane] = lane == 0 ? s : 0.f;
        }
        for (int i = bx * 512 + tid; i < 8192 * 64; i += G * 512) {
            const int pos = i >> 6, f = i & 63;
            const float inv = 1.0f / powf(10000.0f, (float)(2 * f) / 128.0f);
            const float ang = (float)pos * inv;
            RCOS[i] = cosf(ang); RSIN[i] = sinf(ang);
        }
    }
    CG_SYNC();

    for (int l = 0; l < NLAYER; ++l) {
        for (int st = 0; st < 3; ++st) {
            const int nsub = st == 1 ? 2 : 1;
            for (int sub = 0; sub < nsub; ++sub) {
                if (st != 1) {
                    const bf16* Wgu = (const bf16*)(ws + (st == 0 ? WS_WGU1 : WS_WGU2) + l * SZ_WGU);
                    pg8::Gemm g{XB, Wgu, TT, NGU, DM}; pg8::StaticOrder S; S.init(TT, NGU, G, bx);
                    EpiGU E{HB, SSQ};
#ifndef NO_GU
                    pg8::gemm_phase<EpiGU, pg8::StaticOrder, PG8_ALIGN, PG8_SP2>(lds, g, S, E);
#endif
                } else {
                    const bf16* Win = (const bf16*)(ws + WS_WIN + l * SZ_WIN);
                    pg8::Gemm g{XB + (size_t)sub * THALF * DM, Win, THALF, NIN, DM}; pg8::StaticOrder S; S.init(THALF, NIN, G, bx);
                    EpiProj E{PROJ, SSQ, sub * THALF, RCOS, RSIN};
#ifndef NO_PROJ
                    pg8::gemm_phase<EpiProj, pg8::StaticOrder, PG8_ALIGN, PG8_SP2>(lds, g, S, E);
#endif
                }
                GRID_SYNC();
                if (st == 1) {
                    bf16* CXB = (bf16*)(ws + WS_CXB);
                    { KArgsPtr KA = kargs(); conv_prepass(PROJ, CXB, KA->in[14] + (size_t)l * 4 * 768, KA->in[15] + l * 768, sub, bx, G); }
                    GRID_SYNC();
                    for (int item = bx; item < 200; item += G) {
                        KArgsPtr KA = kargs();
                        if (item < 40) {
                            const int vloc = item >> 3, hd = (item & 7) >> 1, dir = item & 1;
#ifndef NO_RET
                            ret_item(lds, PROJ, dir ? YBK : YF, sub * 5 + vloc, vloc, hd, dir);
#endif
                        } else if (item < 120) {
                            const int q = item - 40, vloc = q >> 4, hh = (q & 15) >> 1, dir = q & 1;
#ifndef NO_SSD
                            ssd_item(lds, PROJ, CXB, dir ? YBK : YF, KA->in[16] + l * 16, KA->in[17] + l * 16, KA->in[18] + l * 8,
                                     sub * 5 + vloc, vloc, hh, dir);
#endif
                        } else {
                            const int q = item - 120, vloc = q >> 4, nb = (q & 15) >> 1, dir = q & 1;
#ifndef NO_LRU
                            lru_item(lds, PROJ, dir ? YBK : YF, KA->in[7] + (size_t)l * 4 * 512, KA->in[8] + l * 512, KA->in[9] + (size_t)l * 2 * 8 * 64 * 64, KA->in[10] + l * 1024,
                                     KA->in[11] + (size_t)l * 2 * 8 * 64 * 64, KA->in[12] + l * 1024, KA->in[13] + l * 1024, sub * 5 + vloc, vloc, nb, dir);
#endif
                        }
                    }
                    GRID_SYNC();
                    {
                        KArgsPtr KA = kargs();
                        const int tid = launder_tid(), lane = tid & 63;
                        const float* ssd_norm = KA->in[19] + l * 512; const float* ret_norm = KA->in[20] + l * 512;
                        const f32x8 nw_s = ld8f(ssd_norm + 8 * lane), nw_r = ld8f(ret_norm + 8 * lane);
                        for (int row = gw; row < THALF; row += NGW) {
                            bf16* yr = YF + (size_t)row * YLD; const bf16* yb = YBK + (size_t)row * YLD; const bf16* pr = PROJ + (size_t)row * PLD;
                            {
                                const f32x8 a = unpack8(*(const u32x4*)(yr + 8 * lane)), b = unpack8(*(const u32x4*)(yb + 8 * lane)), gt = unpack8(*(const u32x4*)(pr + PC_GATE + 8 * lane));
                                f32x8 o;
#pragma unroll
                                for (int e = 0; e < 8; ++e) o[e] = (a[e] + b[e]) * gelu_tanh(gt[e]);
                                *(u32x4*)(yr + 8 * lane) = pack8(o);
                            }
                            {
                                const f32x8 a = unpack8(*(const u32x4*)(yr + 512 + 8 * lane)), b = unpack8(*(const u32x4*)(yb + 512 + 8 * lane)), z = unpack8(*(const u32x4*)(pr + PC_Z + 8 * lane));
                                f32x8 v; float ss = 0.f;
#pragma unroll
                                for (int e = 0; e < 8; ++e) { v[e] = (a[e] + b[e]) * siluf(z[e]); ss += v[e] * v[e]; }
                                ss = wave_sum(ss);
                                const float rs = rsqrtf(ss * (1.0f / 512.0f) + EPSN);
                                *(u32x4*)(yr + 512 + 8 * lane) = pack8(v * rs * nw_s);
                            }
                            {
                                const f32x8 a = unpack8(*(const u32x4*)(yr + 1024 + 8 * lane)), b = unpack8(*(const u32x4*)(yb + 1024 + 8 * lane)), gg = unpack8(*(const u32x4*)(pr + PC_G + 8 * lane));
                                f32x8 v = a + b; float s1 = 0.f;
#pragma unroll
                                for (int e = 0; e < 8; ++e) s1 += v[e];
                                s1 += __shfl_xor(s1, 1); s1 += __shfl_xor(s1, 2); s1 += __shfl_xor(s1, 4); s1 += __shfl_xor(s1, 8);
                                const float mu = s1 * (1.0f / 128.0f); float s2 = 0.f;
#pragma unroll
                                for (int e = 0; e < 8; ++e) { v[e] -= mu; s2 += v[e] * v[e]; }
                                s2 += __shfl_xor(s2, 1); s2 += __shfl_xor(s2, 2); s2 += __shfl_xor(s2, 4); s2 += __shfl_xor(s2, 8);
                                const float rs = rsqrtf(s2 * (1.0f / 128.0f) + EPSN);
                                f32x8 o;
#pragma unroll
                                for (int e = 0; e < 8; ++e) o[e] = v[e] * rs * nw_r[e] * siluf(gg[e]);
                                *(u32x4*)(yr + 1024 + 8 * lane) = pack8(o);
                            }
                        }
                    }
                    GRID_SYNC();
                }
                {
                    pg8::Gemm g; float coef; int roff;
                    if (st != 1) { g = pg8::Gemm{HB, (const bf16*)(ws + (st == 0 ? WS_WD1 : WS_WD2) + l * SZ_WD), TT, DM, DFF}; coef = 0.5f; roff = 0; }
                    else { g = pg8::Gemm{YF, (const bf16*)(ws + WS_WOUT + l * SZ_WOUT), THALF, DM, NMIX}; coef = 1.0f; roff = sub * THALF; }
                    pg8::StaticOrder S; S.init(g.M, g.N, G, bx);
                    EpiRes E{X, XB, SSQ, coef, roff};
#ifndef NO_RES
                    pg8::gemm_phase<EpiRes, pg8::StaticOrder, PG8_ALIGN, PG8_SP2>(lds, g, S, E);
#endif
                }
                GRID_SYNC();
            }
        }
    }
    {
        KArgsPtr KA = kargs();
        const int tid = launder_tid(), lane = tid & 63;
        const float* fw = KA->in[25];
        for (int m = gw; m < TT; m += NGW) {
            const float rs = row_rs(SSQ, (size_t)m);
#pragma unroll
            for (int j = 0; j < 4; ++j) {
                float* p = X + (size_t)m * DM + 256 * j + 4 * lane;
                const f32x4 v = *(const f32x4*)p, w = *(const f32x4*)(fw + 256 * j + 4 * lane);
                *(f32x4*)p = v * rs * w;
            }
        }
    }
}

extern "C" void kernel_launch(void* const* d_in, const int* in_sizes, int n_in, void* d_out, int out_size, void* d_ws, size_t ws_size, hipStream_t stream) {
    static int grid = 0;
    if (grid == 0) {
        if (n_in != 26 || out_size != TT * DM || ws_size < WS_NEED) { fprintf(stderr, "kernel_launch: unexpected problem (n_in %d, out %d, ws %zu, need %zu)\n", n_in, out_size, ws_size, (size_t)WS_NEED); grid = -1; return; }
        int dev = 0, cus = 0, per_cu = 0;
        if (hipGetDevice(&dev) != hipSuccess || hipDeviceGetAttribute(&cus, hipDeviceAttributeMultiprocessorCount, dev) != hipSuccess) { grid = -1; return; }
        if (hipFuncSetAttribute((const void*)mega_fwd, hipFuncAttributeMaxDynamicSharedMemorySize, LDS_BYTES) != hipSuccess) { fprintf(stderr, "kernel_launch: hipFuncSetAttribute failed\n"); grid = -1; return; }
        if (hipOccupancyMaxActiveBlocksPerMultiprocessor(&per_cu, (const void*)mega_fwd, 512, LDS_BYTES) != hipSuccess || per_cu < 1) { fprintf(stderr, "kernel_launch: occupancy query says %d\n", per_cu); per_cu = 1; }
        (void)hipGetLastError();
        grid = cus;
    }
    if (grid < 0) return;
    Args a{};
    for (int i = 0; i < 26; ++i) a.in[i] = (const float*)d_in[i];
    a.out = (float*)d_out; a.ws = (unsigned char*)d_ws;
    if (hipMemsetAsync((unsigned char*)d_ws + WS_BAR, 0, 16384, stream) != hipSuccess) { fprintf(stderr, "kernel_launch: hipMemsetAsync of the barrier words failed\n"); return; }
    void* kargs[] = {&a};
    hipError_t e = hipLaunchCooperativeKernel((const void*)mega_fwd, dim3(grid), dim3(512), kargs, LDS_BYTES, stream);
    if (e != hipSuccess) fprintf(stderr, "kernel_launch: cooperative launch failed: %s (grid %d)\n", hipGetErrorString(e), grid);
}
```

```cpp
#include <hip/hip_runtime.h>
#include <hip/hip_cooperative_groups.h>
#include <cstdio>
#include <cstdint>
namespace cg = cooperative_groups;
namespace pg8 {
#define PG8_LAS __attribute__((address_space(3)))
typedef unsigned short bf16_t;
typedef short bf16x8 __attribute__((ext_vector_type(8)));
typedef float f32x4 __attribute__((ext_vector_type(4)));
typedef unsigned u32x4 __attribute__((ext_vector_type(4)));
constexpr int BM = 256, BK = 64, HALF = 128, HTB = HALF * BK * 2  , STAGE_BYTES = 8 * HTB, NXCD = 8, WGM = 8;

__host__ __device__ __forceinline__ int lds_byte(int r, int c) { const int st = (r >> 4) * 2 + (c >> 5), rr = r & 15, cc = c & 31, ob = rr * 64 + cc * 2; return st * 1024 + (ob ^ (((ob >> 9) & 1) << 5)); }
__host__ __device__ __forceinline__ void stage_rc(int b, int& R, int& C) { const int st = b / 1024, sb = b % 1024, swz = sb ^ (((sb >> 9) & 1) << 5); R = (st >> 1) * 16 + swz / 64; C = (st & 1) * 32 + (swz % 64) / 2; }
__host__ __device__ __forceinline__ int perm32(int rho) { const int n = rho >> 4, i = rho & 15; return 8 * (i >> 2) + 4 * n + (i & 3); }

struct Unit { int pm, pn; };
struct Gemm { const bf16_t* A; const bf16_t* Bt; int M, N, K; };

struct StaticOrder {
    int nM, nN, nwg, G, c;
    __host__ __device__ void init(int M, int N, int G_, int c_) { nM = M / BM; nN = N / BM; nwg = nM * nN; G = G_; c = c_; }
    __host__ __device__ bool next(int i, Unit& u) const {
        const long L = (long)i * G + c; if (L >= nwg) return false;
        int wgid = (int)L; { const int q = nwg / NXCD, r = nwg % NXCD, xcd = wgid % NXCD, off = wgid / NXCD; wgid = (xcd < r ? xcd * (q + 1) : r * (q + 1) + (xcd - r) * q) + off; }
        const int nig = WGM * nN, gid = wgid / nig, fm = gid * WGM, gsz = (nM - fm) < WGM ? (nM - fm) : WGM;
        u.pm = fm + ((wgid % nig) % gsz); u.pn = (wgid % nig) / gsz; return true;
    }
    __device__ __forceinline__ void a_ready(const Unit&) const {}
    __device__ __forceinline__ void done(const Unit&) const {}
};

__device__ __forceinline__ unsigned cvt_pk_bf16(float lo, float hi) { unsigned r; asm volatile("v_cvt_pk_bf16_f32 %0, %1, %2" : "=v"(r) : "v"(lo), "v"(hi)); return r; }
typedef float f32x2 __attribute__((ext_vector_type(2)));
template <class Epi, class Sched, bool ALIGN_EPI = false, bool SP2 = false>
__device__ __forceinline__ void gemm_phase(PG8_LAS unsigned char* lds, const Gemm g, const Sched& S, const Epi& E) {
    int tid_l = threadIdx.x; asm volatile("" : "+v"(tid_l));
    const int tid = tid_l, wid = __builtin_amdgcn_readfirstlane(tid >> 6), lane = tid & 63, wr = wid >> 2, wc = wid & 3, fr = lane & 15, fq = lane >> 4;
    const int K = g.K, nt = K / BK;
    unsigned voffA[2], voffB[2];
#pragma unroll
    for (int i = 0; i < 2; ++i) { int R, C; stage_rc(tid * 16 + i * 8192, R, C); const int Rb = Epi::PERM ? ((R & ~31) + perm32(R & 31)) : R;
        voffA[i] = (unsigned)(R * K + C) * 2u; voffB[i] = (unsigned)(Rb * K + C) * 2u; }
    const size_t kstep = (size_t)(BK * 2);
    const size_t hstep = (size_t)HALF * K * 2;
    const size_t tstep = 2 * hstep;
    const unsigned ldsw = (unsigned)wid * 1024u;
    const int aoff = lds_byte(wr * 64 + fr, fq * 8), boff = lds_byte(wc * 32 + fr, fq * 8);
#define PG8_SA(b, h) (((b) * 2 + (h)) * HTB)
#define PG8_SB(b, h) ((4 + (b) * 2 + (h)) * HTB)
#define PG8_STAGE(bufoff, gbase, voff) do { _Pragma("unroll") for (int _i = 0; _i < 2; ++_i) \
        __builtin_amdgcn_global_load_lds((const unsigned*)((const char*)(gbase) + (voff)[_i]), (PG8_LAS unsigned*)(lds + (bufoff) + ldsw + _i * 8192), 16, 0, 0); } while (0)
#define PG8_LDA(dst, b, h) do { _Pragma("unroll") for (int m = 0; m < 4; ++m) _Pragma("unroll") for (int k = 0; k < 2; ++k) dst[m][k] = *(const PG8_LAS bf16x8*)(lds + PG8_SA(b, h) + aoff + m * 2048 + k * 1024); } while (0)
#define PG8_LDB(dst, b, h) do { _Pragma("unroll") for (int n = 0; n < 2; ++n) _Pragma("unroll") for (int k = 0; k < 2; ++k) dst[n][k] = *(const PG8_LAS bf16x8*)(lds + PG8_SB(b, h) + boff + n * 2048 + k * 1024); } while (0)
#define PG8_MMA(ai, bj, At, Bt) do { __builtin_amdgcn_s_setprio(1); _Pragma("unroll") for (int m = 0; m < 4; ++m) _Pragma("unroll") for (int n = 0; n < 2; ++n) _Pragma("unroll") for (int k = 0; k < 2; ++k) \
        acc[ai][bj][m][n] = __builtin_amdgcn_mfma_f32_16x16x32_bf16(Bt[n][k], At[m][k], acc[ai][bj][m][n], 0, 0, 0); __builtin_amdgcn_s_setprio(0); } while (0)
#define PG8_WAIT_V(n) asm volatile("s_waitcnt vmcnt(" #n ")" ::: "memory")
#define PG8_WAIT_L(n) asm volatile("s_waitcnt lgkmcnt(" #n ")" ::: "memory")
#define PG8_BAR __builtin_amdgcn_s_barrier()
#define PG8_SCHED __builtin_amdgcn_sched_barrier(0)
    Unit cur, nxt; int ui = 0;
    if (!S.next(0, cur)) return;
    f32x4 acc[2][2][4][2];
#pragma unroll
    for (int a = 0; a < 2; ++a)
#pragma unroll
        for (int b = 0; b < 2; ++b)
#pragma unroll
            for (int m = 0; m < 4; ++m)
#pragma unroll
                for (int n = 0; n < 2; ++n) acc[a][b][m][n] = (f32x4){0.f, 0.f, 0.f, 0.f};
    bf16x8 At[4][2], B0[2][2], B1[2][2];
    const char* cA = (const char*)g.A + (size_t)cur.pm * tstep; const char* cB = (const char*)g.Bt + (size_t)cur.pn * tstep;
    S.a_ready(cur);
    if constexpr (SP2) {
        PG8_STAGE(PG8_SB(0, 0), cB, voffB); PG8_STAGE(PG8_SB(0, 1), cB + hstep, voffB); PG8_STAGE(PG8_SA(0, 0), cA, voffA); PG8_STAGE(PG8_SA(0, 1), cA + hstep, voffA);
        if (wr == 1) PG8_BAR;
        PG8_WAIT_V(2); PG8_BAR;
        PG8_STAGE(PG8_SB(1, 0), cB + kstep, voffB); PG8_STAGE(PG8_SA(1, 0), cA + kstep, voffA); PG8_STAGE(PG8_SB(1, 1), cB + hstep + kstep, voffB);
        PG8_WAIT_V(6); PG8_BAR;
    } else {
        PG8_STAGE(PG8_SB(0, 0), cB, voffB); PG8_STAGE(PG8_SA(0, 0), cA, voffA); PG8_STAGE(PG8_SB(0, 1), cB + hstep, voffB); PG8_STAGE(PG8_SA(0, 1), cA + hstep, voffA);
        if (wr == 1) PG8_BAR;
        PG8_WAIT_V(4); PG8_BAR;
        PG8_STAGE(PG8_SB(1, 0), cB + kstep, voffB); PG8_STAGE(PG8_SA(1, 0), cA + kstep, voffA); PG8_STAGE(PG8_SB(1, 1), cB + hstep + kstep, voffB);
        PG8_WAIT_V(6); PG8_BAR;
    }
    for (;;) {
        const bool has_next = S.next(ui + 1, nxt);
        const char* nA = has_next ? (const char*)g.A + (size_t)nxt.pm * tstep : cA; const char* nB = has_next ? (const char*)g.Bt + (size_t)nxt.pn * tstep : cB;
        for (int t = 0; t < nt; t += 2) {
            const bool last = (t == nt - 2);
            const char* a1 = cA + (size_t)(t + 1) * kstep;
            const char* a2 = last ? nA : cA + (size_t)(t + 2) * kstep; const char* b2 = last ? nB : cB + (size_t)(t + 2) * kstep;
            const char* a3 = a2 + kstep; const char* b3 = b2 + kstep;
            if (last && has_next) S.a_ready(nxt);
            if constexpr (SP2) {
            PG8_LDB(B0, 0, 0); PG8_LDB(B1, 0, 1); PG8_SCHED; PG8_LDA(At, 0, 0); PG8_STAGE(PG8_SA(1, 1), a1 + hstep, voffA);
            PG8_WAIT_V(8); PG8_WAIT_L(0); PG8_BAR; PG8_MMA(0, 0, At, B0); PG8_MMA(0, 1, At, B1); PG8_BAR; PG8_SCHED;
            PG8_LDA(At, 0, 1); PG8_STAGE(PG8_SB(0, 0), b2, voffB); PG8_STAGE(PG8_SB(0, 1), b2 + hstep, voffB); PG8_STAGE(PG8_SA(0, 0), a2, voffA);
            PG8_WAIT_V(8); PG8_WAIT_L(0); PG8_BAR; PG8_MMA(1, 0, At, B0); PG8_MMA(1, 1, At, B1); PG8_BAR; PG8_SCHED;
            PG8_LDB(B0, 1, 0); PG8_LDB(B1, 1, 1); PG8_SCHED; PG8_LDA(At, 1, 0); PG8_STAGE(PG8_SA(0, 1), a2 + hstep, voffA);
            PG8_WAIT_V(8); PG8_WAIT_L(0); PG8_BAR; PG8_MMA(0, 0, At, B0); PG8_MMA(0, 1, At, B1); PG8_BAR; PG8_SCHED;
            PG8_LDA(At, 1, 1); PG8_STAGE(PG8_SB(1, 0), b3, voffB); PG8_STAGE(PG8_SB(1, 1), b3 + hstep, voffB); PG8_STAGE(PG8_SA(1, 0), a3, voffA);
            PG8_WAIT_V(8); PG8_WAIT_L(0); PG8_BAR; PG8_MMA(1, 0, At, B0); PG8_MMA(1, 1, At, B1); PG8_BAR; PG8_SCHED;
            } else {
            PG8_LDB(B0, 0, 0); PG8_SCHED; PG8_LDA(At, 0, 0); PG8_STAGE(PG8_SA(1, 1), a1 + hstep, voffA);
            PG8_WAIT_L(8); PG8_BAR; PG8_WAIT_L(0); PG8_MMA(0, 0, At, B0); PG8_BAR; PG8_SCHED;
            PG8_LDB(B1, 0, 1); PG8_STAGE(PG8_SB(0, 0), b2, voffB);
            PG8_BAR; PG8_WAIT_L(0); PG8_MMA(0, 1, At, B1); PG8_BAR;
            PG8_LDA(At, 0, 1); PG8_STAGE(PG8_SA(0, 0), a2, voffA);
            PG8_BAR; PG8_WAIT_L(0); PG8_MMA(1, 0, At, B0); PG8_BAR; PG8_SCHED;
            PG8_STAGE(PG8_SB(0, 1), b2 + hstep, voffB);
            PG8_WAIT_V(6); PG8_BAR; PG8_MMA(1, 1, At, B1); PG8_BAR;
            PG8_LDB(B0, 1, 0); PG8_SCHED; PG8_LDA(At, 1, 0); PG8_STAGE(PG8_SA(0, 1), a2 + hstep, voffA);
            PG8_WAIT_L(8); PG8_BAR; PG8_WAIT_L(0); PG8_MMA(0, 0, At, B0); PG8_BAR; PG8_SCHED;
            PG8_LDB(B1, 1, 1); PG8_STAGE(PG8_SB(1, 0), b3, voffB);
            PG8_BAR; PG8_WAIT_L(0); PG8_MMA(0, 1, At, B1); PG8_BAR;
            PG8_LDA(At, 1, 1); PG8_STAGE(PG8_SA(1, 0), a3, voffA);
            PG8_BAR; PG8_WAIT_L(0); PG8_MMA(1, 0, At, B0); PG8_BAR; PG8_SCHED;
            PG8_STAGE(PG8_SB(1, 1), b3 + hstep, voffB);
            PG8_WAIT_V(6); PG8_BAR; PG8_MMA(1, 1, At, B1); PG8_BAR;
            }
        }
        if constexpr (ALIGN_EPI) { if (wr == 0) PG8_BAR; }
        if constexpr (!Epi::AFTER_DRAIN) { E(acc, cur, wr, wc, fr, fq); S.done(cur); }
        if (!has_next) break;
#pragma unroll
        for (int a = 0; a < 2; ++a)
#pragma unroll
            for (int b = 0; b < 2; ++b)
#pragma unroll
                for (int m = 0; m < 4; ++m)
#pragma unroll
                    for (int n = 0; n < 2; ++n) acc[a][b][m][n] = (f32x4){0.f, 0.f, 0.f, 0.f};
        cur = nxt; cA = nA; cB = nB; ++ui;
        if constexpr (ALIGN_EPI) { if (wr == 1) PG8_BAR; }
    }
    PG8_WAIT_V(0);
    if constexpr (!ALIGN_EPI) { if (wr == 0) PG8_BAR; }
    PG8_BAR;
    if constexpr (Epi::AFTER_DRAIN) { E.fused(acc, cur, wr, wc, fr, fq, lds, wid, lane); S.done(cur); }
#undef PG8_SA
#undef PG8_SB
#undef PG8_STAGE
#undef PG8_LDA
#undef PG8_LDB
#undef PG8_MMA
#undef PG8_WAIT_V
#undef PG8_WAIT_L
#undef PG8_BAR
#undef PG8_SCHED
}
}
#ifndef PG8_SP2
#define PG8_SP2 true
#endif
#ifndef PG8_ALIGN
#define PG8_ALIGN true
#endif

#define LAS __attribute__((address_space(3)))
typedef unsigned short bf16;
typedef float f32x4 __attribute__((ext_vector_type(4)));
typedef float f32x8 __attribute__((ext_vector_type(8)));
typedef short bf16x8 __attribute__((ext_vector_type(8)));
typedef unsigned u32x4 __attribute__((ext_vector_type(4)));
typedef unsigned u32x2 __attribute__((ext_vector_type(2)));

constexpr int DM = 1024, DFF = 2816, NGU = 5632, NIN = 4608, NMIX = 1536, NLAYER = 4;
constexpr int TT = 81920, THALF = 40960, PLD = NIN  , YLD = NMIX;
constexpr int W_IN_SRC = 4368;
constexpr float EPSN = 1e-6f;
constexpr int PC_LRUX = 0, PC_GATE = 512, PC_Z = 1024, PC_XBC = 1536, PC_Q = 2304, PC_K = 2816, PC_V = 3328, PC_G = 3840, PC_DT = 4352;

constexpr size_t al256(size_t x) { return (x + 255) & ~(size_t)255; }
constexpr size_t SZ_WGU = (size_t)NGU * DM * 2, SZ_WD = (size_t)DM * DFF * 2, SZ_WIN = (size_t)NIN * DM * 2, SZ_WOUT = (size_t)DM * NMIX * 2;
constexpr size_t WS_WGU1 = 0;
constexpr size_t WS_WD1 = WS_WGU1 + NLAYER * SZ_WGU;
constexpr size_t WS_WIN = WS_WD1 + NLAYER * SZ_WD;
constexpr size_t WS_WOUT = WS_WIN + NLAYER * SZ_WIN;
constexpr size_t WS_WGU2 = WS_WOUT + NLAYER * SZ_WOUT;
constexpr size_t WS_WD2 = WS_WGU2 + NLAYER * SZ_WGU;
constexpr size_t WS_XB = al256(WS_WD2 + NLAYER * SZ_WD);
constexpr size_t WS_SSQ = al256(WS_XB + (size_t)TT * DM * 2);
constexpr size_t WS_ROPE = al256(WS_SSQ + (size_t)TT * 16 * 4);
constexpr size_t WS_BIG = al256(WS_ROPE + (size_t)8192 * 64 * 4 * 2);
constexpr size_t WS_PROJ = WS_BIG;
constexpr size_t WS_Y = al256(WS_PROJ + (size_t)THALF * PLD * 2);
constexpr size_t WS_YB = al256(WS_Y + (size_t)THALF * YLD * 2);
constexpr size_t WS_CXB = al256(WS_YB + (size_t)THALF * YLD * 2);
constexpr size_t WS_BAR = al256(WS_CXB + (size_t)THALF * 768 * 2);
constexpr size_t WS_END1 = al256(WS_BAR + 16384);
constexpr size_t WS_H = WS_BIG;
constexpr size_t WS_END2 = al256(WS_H + (size_t)TT * DFF * 2);
constexpr size_t WS_NEED = WS_END1 > WS_END2 ? WS_END1 : WS_END2;

constexpr int LDS_BYTES = 147456;

__device__ __forceinline__ float bflo(unsigned w) { return __builtin_bit_cast(float, w << 16); }
__device__ __forceinline__ float bfhi(unsigned w) { return __builtin_bit_cast(float, w & 0xffff0000u); }
__device__ __forceinline__ float bf2f(bf16 b) { return __builtin_bit_cast(float, (unsigned)b << 16); }
__device__ __forceinline__ bf16 f2bf(float f) { unsigned u = __builtin_bit_cast(unsigned, f); return (bf16)((u + 0x7fffu + ((u >> 16) & 1u)) >> 16); }
__device__ __forceinline__ unsigned pk2(float lo, float hi) { return pg8::cvt_pk_bf16(lo, hi); }
__device__ __forceinline__ f32x8 unpack8(u32x4 w) { f32x8 o; o[0] = bflo(w.x); o[1] = bfhi(w.x); o[2] = bflo(w.y); o[3] = bfhi(w.y); o[4] = bflo(w.z); o[5] = bfhi(w.z); o[6] = bflo(w.w); o[7] = bfhi(w.w); return o; }
__device__ __forceinline__ u32x4 pack8(f32x8 v) { u32x4 w; w.x = pk2(v[0], v[1]); w.y = pk2(v[2], v[3]); w.z = pk2(v[4], v[5]); w.w = pk2(v[6], v[7]); return w; }
__device__ __forceinline__ f32x8 ld8f(const float* p) { const f32x4 a = *(const f32x4*)p, b = *(const f32x4*)(p + 4); f32x8 o; o[0] = a[0]; o[1] = a[1]; o[2] = a[2]; o[3] = a[3]; o[4] = b[0]; o[5] = b[1]; o[6] = b[2]; o[7] = b[3]; return o; }
__device__ __forceinline__ float sigm(float x) { return __builtin_amdgcn_rcpf(1.0f + __expf(-x)); }
__device__ __forceinline__ float siluf(float x) { return x * sigm(x); }
__device__ __forceinline__ float softplusf(float x) { return fmaxf(x, 0.f) + log1pf(__expf(-fabsf(x))); }
__device__ __forceinline__ float gelu_tanh(float x) { const float y = 0.7978845608028654f * (x + 0.044715f * x * x * x); const float t = 1.0f - 2.0f * __builtin_amdgcn_rcpf(1.0f + __expf(2.0f * y)); return 0.5f * x * (1.0f + t); }
__device__ __forceinline__ float wave_sum(float v) {
#pragma unroll
    for (int o = 1; o < 64; o <<= 1) v += __shfl_xor(v, o);
    return v;
}
__device__ __forceinline__ float row_rs(const float* ssq, size_t row) {
    const f32x4 a = *(const f32x4*)(ssq + row * 16), b = *(const f32x4*)(ssq + row * 16 + 4), c = *(const f32x4*)(ssq + row * 16 + 8), d = *(const f32x4*)(ssq + row * 16 + 12);
    const float s = ((a[0] + a[1]) + (a[2] + a[3])) + ((b[0] + b[1]) + (b[2] + b[3])) + ((c[0] + c[1]) + (c[2] + c[3])) + ((d[0] + d[1]) + (d[2] + d[3]));
    return rsqrtf(s * (1.0f / DM) + EPSN);
}
__device__ __forceinline__ int launder_tid() { int t = threadIdx.x; asm volatile("" : "+v"(t)); return t; }
#define MFMA16(a, b, c) __builtin_amdgcn_mfma_f32_16x16x32_bf16((a), (b), (c), 0, 0, 0)
__device__ __forceinline__ bf16x8 ldfrag(const LAS bf16* p) { return *(const LAS bf16x8*)p; }

struct EpiGU {
    static constexpr bool PERM = true, AFTER_DRAIN = false;
    bf16* H; const float* ssq;
    __device__ __forceinline__ void operator()(const pg8::f32x4 (&acc)[2][2][4][2], const pg8::Unit& u, int wr, int wc, int fr, int fq) const {
        const int row0 = u.pm * 256 + wr * 64 + fr, col0 = u.pn * 128 + wc * 32 + 8 * fq;
#pragma unroll
        for (int ai = 0; ai < 2; ++ai)
#pragma unroll
            for (int m = 0; m < 4; ++m) {
                const size_t row = (size_t)(row0 + ai * 128 + m * 16);
                const float rs = row_rs(ssq, row);
                const pg8::f32x4 g0 = acc[ai][0][m][0] * rs, g1 = acc[ai][0][m][1] * rs, u0 = acc[ai][1][m][0] * rs, u1 = acc[ai][1][m][1] * rs;
                u32x4 w;
                w.x = pk2(siluf(g0[0]) * u0[0], siluf(g0[1]) * u0[1]); w.y = pk2(siluf(g0[2]) * u0[2], siluf(g0[3]) * u0[3]);
                w.z = pk2(siluf(g1[0]) * u1[0], siluf(g1[1]) * u1[1]); w.w = pk2(siluf(g1[2]) * u1[2], siluf(g1[3]) * u1[3]);
                *(u32x4*)(H + row * DFF + col0) = w;
                asm volatile("" ::: "memory");
            }
    }
};
struct EpiProj {
    static constexpr bool PERM = true, AFTER_DRAIN = false;
    bf16* P; const float* ssq; int row_off; const float* rcos; const float* rsin;
    __device__ __forceinline__ void operator()(const pg8::f32x4 (&acc)[2][2][4][2], const pg8::Unit& u, int wr, int wc, int fr, int fq) const {
        const int row0 = u.pm * 256 + wr * 64 + fr, col0 = u.pn * 256 + wc * 32 + 8 * fq;
        if (u.pn >= 9 && u.pn <= 12) {
            const float ksc = u.pn >= 11 ? 0.08838834764831845f : 1.0f;
            const int d0 = 32 * (wc & 1) + 8 * fq, colr = u.pn * 256 + 128 * (wc >> 1) + d0;
#pragma unroll
            for (int ai = 0; ai < 2; ++ai)
#pragma unroll
                for (int m = 0; m < 4; ++m) {
                    const size_t row = (size_t)(row0 + ai * 128 + m * 16);
                    const int gr = (int)row + row_off, pos = gr < 65536 ? (gr & 8191) : (gr & 4095);
                    const float rs = row_rs(ssq, (size_t)gr) * ksc;
                    u32x4 w1, w2;
#pragma unroll
                    for (int n = 0; n < 2; ++n) {
                        const pg8::f32x4 cs = *(const pg8::f32x4*)(rcos + (size_t)pos * 64 + d0 + 4 * n), sn = *(const pg8::f32x4*)(rsin + (size_t)pos * 64 + d0 + 4 * n);
                        const pg8::f32x4 t1 = acc[ai][0][m][n] * rs, t2 = acc[ai][1][m][n] * rs;
                        const pg8::f32x4 o1 = t1 * cs - t2 * sn, o2 = t1 * sn + t2 * cs;
                        if (n == 0) { w1.x = pk2(o1[0], o1[1]); w1.y = pk2(o1[2], o1[3]); w2.x = pk2(o2[0], o2[1]); w2.y = pk2(o2[2], o2[3]); }
                        else { w1.z = pk2(o1[0], o1[1]); w1.w = pk2(o1[2], o1[3]); w2.z = pk2(o2[0], o2[1]); w2.w = pk2(o2[2], o2[3]); }
                    }
                    *(u32x4*)(P + row * PLD + colr) = w1; *(u32x4*)(P + row * PLD + colr + 64) = w2;
                    asm volatile("" ::: "memory");
                }
            return;
        }
#pragma unroll
        for (int ai = 0; ai < 2; ++ai)
#pragma unroll
            for (int m = 0; m < 4; ++m) {
                const size_t row = (size_t)(row0 + ai * 128 + m * 16);
                const float rs = row_rs(ssq, row + row_off);
#pragma unroll
                for (int bj = 0; bj < 2; ++bj) {
                    const pg8::f32x4 v0 = acc[ai][bj][m][0] * rs, v1 = acc[ai][bj][m][1] * rs;
                    u32x4 w; w.x = pk2(v0[0], v0[1]); w.y = pk2(v0[2], v0[3]); w.z = pk2(v1[0], v1[1]); w.w = pk2(v1[2], v1[3]);
                    *(u32x4*)(P + row * PLD + col0 + bj * 128) = w;
                }
                asm volatile("" ::: "memory");
            }
    }
};
struct EpiRes {
    static constexpr bool PERM = true, AFTER_DRAIN = false;
    float* X; bf16* XB; float* ssq; float coef; int row_off;
    __device__ __forceinline__ void operator()(const pg8::f32x4 (&acc)[2][2][4][2], const pg8::Unit& u, int wr, int wc, int fr, int fq) const {
        const int row0 = row_off + u.pm * 256 + wr * 64 + fr, col0 = u.pn * 256 + wc * 32 + 8 * fq;
#pragma unroll
        for (int ai = 0; ai < 2; ++ai)
#pragma unroll
            for (int m = 0; m < 4; ++m) {
                const size_t row = (size_t)(row0 + ai * 128 + m * 16);
                float s = 0.f;
#pragma unroll
                for (int bj = 0; bj < 2; ++bj) {
                    float* xp = X + row * DM + col0 + bj * 128;
                    pg8::f32x4 x0 = *(const pg8::f32x4*)xp, x1 = *(const pg8::f32x4*)(xp + 4);
                    x0 += acc[ai][bj][m][0] * coef; x1 += acc[ai][bj][m][1] * coef;
                    *(pg8::f32x4*)xp = x0; *(pg8::f32x4*)(xp + 4) = x1;
                    s += (x0[0] * x0[0] + x0[1] * x0[1]) + (x0[2] * x0[2] + x0[3] * x0[3]) + (x1[0] * x1[0] + x1[1] * x1[1]) + (x1[2] * x1[2] + x1[3] * x1[3]);
                    u32x4 w; w.x = pk2(x0[0], x0[1]); w.y = pk2(x0[2], x0[3]); w.z = pk2(x1[0], x1[1]); w.w = pk2(x1[2], x1[3]);
                    *(u32x4*)(XB + row * DM + col0 + bj * 128) = w;
                }
                s += __shfl_xor(s, 16); s += __shfl_xor(s, 32);
                if (fq == 0) ssq[row * 16 + u.pn * 4 + wc] = s;
                asm volatile("" ::: "memory");
            }
    }
};

__device__ __forceinline__ int colmap(int kind, int n) {
    if (kind == 0) return n;
    if (kind == 1) { const int t = n >> 8, w = n & 255; return w < 128 ? 128 * t + w : DFF + 128 * t + (w - 128); }
    if (n < 2304) return n;
    if (n < 3328) { const int t = n >> 8, w = n & 255, bj = w >> 7, o = w & 127; return 256 * t + 128 * (o >> 6) + (o & 63) + 64 * bj + 16; }
    return n < 4352 ? n + 16 : (n < 4368 ? n - 4352 + 2304 : -1);
}
__device__ __forceinline__ void transpose_item(const float* W, int K, int Nsrc, int Ndst, const float* kscale, bf16* WT, int kind, int item, int lane, LAS float* scr) {
    const int nblk = Ndst / 32, kb = item / nblk, nb = item % nblk, k0 = 64 * kb, n0 = 32 * nb;
    const int sc = colmap(kind, n0 + (lane & 31));
#pragma unroll 8
    for (int i = 0; i < 32; ++i) { const int kk = 2 * i + (lane >> 5); float v = 0.f; if (sc >= 0) { v = W[(size_t)(k0 + kk) * Nsrc + sc]; if (kscale) v *= kscale[k0 + kk]; } scr[kk * 33 + (lane & 31)] = v; }
    asm volatile("s_waitcnt lgkmcnt(0)" ::: "memory");
    const int c = lane & 7;
#pragma unroll
    for (int j = 0; j < 4; ++j) { const int n = (lane >> 3) + 8 * j; const LAS float* s = scr + (8 * c) * 33 + n;
        u32x4 o; o.x = pk2(s[0 * 33], s[1 * 33]); o.y = pk2(s[2 * 33], s[3 * 33]); o.z = pk2(s[4 * 33], s[5 * 33]); o.w = pk2(s[6 * 33], s[7 * 33]);
        *(u32x4*)(WT + (size_t)(n0 + n) * K + k0 + 8 * c) = o; }
    asm volatile("s_waitcnt lgkmcnt(0)" ::: "memory");
}

struct Args { const float* in[26]; float* out; unsigned char* ws; };
typedef const __attribute__((address_space(4))) Args* KArgsPtr;
__device__ __forceinline__ KArgsPtr kargs() { KArgsPtr p = (KArgsPtr)__builtin_amdgcn_kernarg_segment_ptr(); asm volatile("" : "+s"(p)); return p; }

__device__ __forceinline__ f32x8 conv8(const bf16* proj, int lrow, int pcol, int pos, int seqlen, const float* cw, int cw_ld, const float* cb, int ccol) {
    f32x8 acc = ld8f(cb + ccol);
#pragma unroll
    for (int k = 0; k < 4; ++k) {
        const int s = pos + k - 2;
        if (s >= 0 && s < seqlen) {
            const u32x4 raw = *(const u32x4*)(proj + (size_t)(lrow + k - 2) * PLD + pcol);
            acc += ld8f(cw + k * cw_ld + ccol) * unpack8(raw);
        }
    }
    return acc;
}

__device__ __forceinline__ void ret_item(LAS unsigned char* lds, const bf16* proj, bf16* yout, int gv, int vloc, int hd, int dir) {
    const int tid = launder_tid(), wid = __builtin_amdgcn_readfirstlane(tid >> 6), lane = tid & 63, fr = lane & 15, fq = lane >> 4;
    constexpr int LD = 136;
    LAS bf16* KN = (LAS bf16*)lds; LAS bf16* KTW = KN + 128 * LD; LAS bf16* VT = KTW + 128 * LD; LAS bf16* RT = VT + 128 * LD;
    const int seqlen = gv < 8 ? 8192 : 4096;
    const float l2g = log2f(1.0f - exp2f(-5.0f - (float)hd));
    const float cdec = exp2f(l2g * 128.0f);
    const int i0 = 4 * ((tid >> 2) & 31), c8 = 8 * ((tid & 3) + 4 * (tid >> 7)), qi = 16 * wid + fr;
    float wl[4];
#pragma unroll
    for (int r = 0; r < 4; ++r) wl[r] = exp2f(l2g * (float)(dir ? i0 + r : 127 - (i0 + r)));
    const float rsc = exp2f(l2g * (float)(dir ? 128 - qi : qi + 1));
    f32x4 R[8];
#pragma unroll
    for (int i = 0; i < 8; ++i) R[i] = (f32x4){0.f, 0.f, 0.f, 0.f};
    for (int i = tid; i < 128 * LD / 2; i += 512) ((LAS unsigned*)RT)[i] = 0u;
    u32x4 kraw[4], vraw[4], qraw[4];
#define RET_LOAD(CC) do { const int lr0_ = vloc * 8192 + (CC) * 128; \
        _Pragma("unroll") for (int r = 0; r < 4; ++r) { const bf16* rp_ = proj + (size_t)(lr0_ + i0 + r) * PLD + 128 * hd + c8; kraw[r] = *(const u32x4*)(rp_ + PC_K); vraw[r] = *(const u32x4*)(rp_ + PC_V); } \
        _Pragma("unroll") for (int ks = 0; ks < 4; ++ks) qraw[ks] = *(const u32x4*)(proj + (size_t)(lr0_ + qi) * PLD + PC_Q + 128 * hd + 32 * ks + 8 * fq); } while (0)
    RET_LOAD(dir ? 63 : 0);
    __syncthreads();
    for (int c = 0; c < 64; ++c) {
        const int cc = dir ? 63 - c : c;
        const int lrow0 = vloc * 8192 + cc * 128;
        const bool do_intra = ((cc & 1) == dir);
        bool next_reset = false;
        if (c < 63) { const int ncc = dir ? cc - 1 : cc + 1; const int np = (ncc * 128) % seqlen; next_reset = dir ? (np + 128 == seqlen) : (np == 0); }
        {
            if (do_intra) {
#pragma unroll
                for (int r = 0; r < 4; ++r) *(LAS u32x4*)(KN + (i0 + r) * LD + c8) = kraw[r];
            }
            LAS bf16* kt = KTW + c8 * LD + i0; LAS bf16* vt = VT + c8 * LD + i0;
#pragma unroll
            for (int m = 0; m < 4; ++m) {
                u32x2 we, wo;
                we.x = pk2(bflo(kraw[0][m]) * wl[0], bflo(kraw[1][m]) * wl[1]); we.y = pk2(bflo(kraw[2][m]) * wl[2], bflo(kraw[3][m]) * wl[3]);
                wo.x = pk2(bfhi(kraw[0][m]) * wl[0], bfhi(kraw[1][m]) * wl[1]); wo.y = pk2(bfhi(kraw[2][m]) * wl[2], bfhi(kraw[3][m]) * wl[3]);
                *(LAS u32x2*)(kt + (2 * m) * LD) = we; *(LAS u32x2*)(kt + (2 * m + 1) * LD) = wo;
                u32x2 ve, vo;
                ve.x = (vraw[0][m] & 0xffffu) | (vraw[1][m] << 16); ve.y = (vraw[2][m] & 0xffffu) | (vraw[3][m] << 16);
                vo.x = (vraw[0][m] >> 16) | (vraw[1][m] & 0xffff0000u); vo.y = (vraw[2][m] >> 16) | (vraw[3][m] & 0xffff0000u);
                *(LAS u32x2*)(vt + (2 * m) * LD) = ve; *(LAS u32x2*)(vt + (2 * m + 1) * LD) = vo;
            }
        }
        bf16x8 qf[4];
#pragma unroll
        for (int ks = 0; ks < 4; ++ks) qf[ks] = __builtin_bit_cast(bf16x8, qraw[ks]);
        if (c < 63) { const int ncc = dir ? cc - 1 : cc + 1; RET_LOAD(ncc); }
        __syncthreads();
        unsigned sp[8][2];
        if (do_intra) {
#pragma unroll
            for (int ct = 0; ct < 8; ++ct) {
                f32x4 a = (f32x4){0.f, 0.f, 0.f, 0.f};
#pragma unroll
                for (int ks = 0; ks < 4; ++ks) a = MFMA16(ldfrag(KN + (16 * ct + fr) * LD + 32 * ks + 8 * fq), qf[ks], a);
                const int j0 = 16 * ct + 4 * fq;
                float dv[4];
#pragma unroll
                for (int e = 0; e < 4; ++e) { const int dd = qi - (j0 + e); dv[e] = a[e] * exp2f(l2g * (float)(dd < 0 ? -dd : dd)); }
                sp[ct][0] = pk2(dv[0], dv[1]); sp[ct][1] = pk2(dv[2], dv[3]);
            }
            __syncthreads();
#pragma unroll
            for (int ct = 0; ct < 8; ++ct) { u32x2 w; w.x = sp[ct][0]; w.y = sp[ct][1]; *(LAS u32x2*)(KN + qi * LD + 16 * ct + 4 * fq) = w; }
        }
        {
            f32x4 Y[8];
#pragma unroll
            for (int ct = 0; ct < 8; ++ct) {
                f32x4 a = (f32x4){0.f, 0.f, 0.f, 0.f};
#pragma unroll
                for (int ks = 0; ks < 4; ++ks) a = MFMA16(ldfrag(RT + (16 * ct + fr) * LD + 32 * ks + 8 * fq), qf[ks], a);
                Y[ct] = a * rsc;
            }
            if (do_intra) {
#pragma unroll
                for (int ks = 0; ks < 4; ++ks) {
                    const bf16x8 pf = ldfrag(KN + qi * LD + 32 * ks + 8 * fq);
#pragma unroll
                    for (int ct = 0; ct < 8; ++ct) Y[ct] = MFMA16(ldfrag(VT + (16 * ct + fr) * LD + 32 * ks + 8 * fq), pf, Y[ct]);
                }
            }
            bf16* yo = yout + (size_t)(lrow0 + qi) * YLD + 1024 + 128 * hd + 4 * fq;
#pragma unroll
            for (int ct = 0; ct < 8; ++ct) { u32x2 w; w.x = pk2(Y[ct][0], Y[ct][1]); w.y = pk2(Y[ct][2], Y[ct][3]); *(u32x2*)(yo + 16 * ct) = w; }
        }
#pragma unroll
        for (int ct = 0; ct < 8; ++ct) R[ct] *= cdec;
#pragma unroll
        for (int ks = 0; ks < 4; ++ks) {
            const bf16x8 kf = ldfrag(KTW + (16 * wid + fr) * LD + 32 * ks + 8 * fq);
#pragma unroll
            for (int ct = 0; ct < 8; ++ct) R[ct] = MFMA16(kf, ldfrag(VT + (16 * ct + fr) * LD + 32 * ks + 8 * fq), R[ct]);
        }
        if (next_reset) {
#pragma unroll
            for (int ct = 0; ct < 8; ++ct) R[ct] = (f32x4){0.f, 0.f, 0.f, 0.f};
        }
        __syncthreads();
#pragma unroll
        for (int ct = 0; ct < 8; ++ct) { u32x2 w; w.x = pk2(R[ct][0], R[ct][1]); w.y = pk2(R[ct][2], R[ct][3]); *(LAS u32x2*)(RT + (16 * ct + fr) * LD + 16 * wid + 4 * fq) = w; }
    }
#undef RET_LOAD
    __syncthreads();
}

__device__ __forceinline__ void ssd_item(LAS unsigned char* lds, const bf16* proj, const bf16* cxb, bf16* yout, const float* dt_bias, const float* a_log, const float* dskip,
                                         int gv, int vloc, int hh, int dir) {
    const int tid = launder_tid(), wid = __builtin_amdgcn_readfirstlane(tid >> 6), lane = tid & 63, fr = lane & 15, fq = lane >> 4;
    constexpr int LDL = 136, LDS_ = 72;
    LAS bf16* XST = (LAS bf16*)lds;
    LAS bf16* CN = XST + 64 * LDL;
    LAS bf16* BN = CN + 128 * LDS_;
    LAS bf16* BTW = BN + 128 * LDS_;
    LAS bf16* PP = BTW + 64 * LDL;
    LAS bf16* HL = PP + 128 * LDL;
    LAS float* DT = (LAS float*)(HL + 64 * LDS_);
    LAS float* ACUM = DT + 128;
    LAS float* CWL = ACUM + 128;
    const int seqlen = gv < 8 ? 8192 : 4096, grp = hh >> 2;
    const float aneg = -__expf(a_log[dir * 8 + hh]), dtb = dt_bias[dir * 8 + hh], dsk = dskip[hh];
    const int cg8 = tid % 24, rb = tid / 24, sec = cg8 >> 3, c8 = (cg8 & 7) * 8, i0 = 8 * rb;
    const int xc = sec == 0 ? 64 * hh + c8 : (sec == 1 ? 512 + 64 * grp + c8 : 640 + 64 * grp + c8);
    const bool stager = tid < 384;
    f32x4 Hc[2];
    Hc[0] = (f32x4){0.f, 0.f, 0.f, 0.f}; Hc[1] = (f32x4){0.f, 0.f, 0.f, 0.f};
    for (int i = tid; i < 64 * LDS_ / 2; i += 512) ((LAS unsigned*)HL)[i] = 0u;
    u32x4 raw[8]; float dtraw = 0.f;
#define SSD_LOAD(CC) do { const int lr0_ = vloc * 8192 + (CC) * 128; \
        if (stager) { _Pragma("unroll") for (int r = 0; r < 8; ++r) raw[r] = *(const u32x4*)(cxb + (size_t)(lr0_ + i0 + r) * 768 + xc); } \
        if (tid < 128) dtraw = bf2f(proj[(size_t)(lr0_ + tid) * PLD + PC_DT + dir * 8 + hh]); } while (0)
    SSD_LOAD(dir ? 63 : 0);
    __syncthreads();
    for (int c = 0; c < 64; ++c) {
        const int cc = dir ? 63 - c : c;
        const int lrow0 = vloc * 8192 + cc * 128;
        bool next_reset = false;
        if (c < 63) { const int ncc = dir ? cc - 1 : cc + 1; const int np = (ncc * 128) % seqlen; next_reset = dir ? (np + 128 == seqlen) : (np == 0); }
        if (tid < 128) DT[tid] = softplusf(dtraw + dtb);
        __syncthreads();
        float tot;
        {
            const float x0 = DT[2 * lane] * aneg, x1 = DT[2 * lane + 1] * aneg;
            float s = x0 + x1;
#pragma unroll
            for (int o = 1; o < 64; o <<= 1) { const float t = __shfl_up(s, o); if (lane >= o) s += t; }
            tot = __shfl(s, 63);
            const float p1 = s, p0 = s - x1;
            if (dir == 0) { ACUM[2 * lane] = p0; ACUM[2 * lane + 1] = p1; }
            else { ACUM[2 * lane] = tot - p0 + x0; ACUM[2 * lane + 1] = tot - p1 + x1; }
        }
        if (stager) {
#pragma unroll
            for (int hc = 0; hc < 2; ++hc) {
                u32x2 pv[4];
#pragma unroll
                for (int od = 0; od < 8; ++od) {
                    u32x2 pk; pk.x = raw[od][2 * hc]; pk.y = raw[od][2 * hc + 1];
                    if (sec == 0) pv[od & 3] = pk;
                    else if (sec == 1) { *(LAS u32x2*)(BN + (i0 + od) * LDS_ + c8 + 4 * hc) = pk; const float wr = __expf(tot - ACUM[i0 + od]) * DT[i0 + od];
                        u32x2 pw; pw.x = pk2(bflo(pk.x) * wr, bfhi(pk.x) * wr); pw.y = pk2(bflo(pk.y) * wr, bfhi(pk.y) * wr); pv[od & 3] = pw; }
                    else *(LAS u32x2*)(CN + (i0 + od) * LDS_ + c8 + 4 * hc) = pk;
                    if ((od & 3) == 3 && sec != 2) {
                        LAS bf16* dstT = (sec == 0 ? XST : BTW) + (c8 + 4 * hc) * LDL + i0 + (od - 3);
#pragma unroll
                        for (int m = 0; m < 2; ++m) {
                            u32x2 we, wo;
                            we.x = (pv[0][m] & 0xffffu) | (pv[1][m] << 16); we.y = (pv[2][m] & 0xffffu) | (pv[3][m] << 16);
                            wo.x = (pv[0][m] >> 16) | (pv[1][m] & 0xffff0000u); wo.y = (pv[2][m] >> 16) | (pv[3][m] & 0xffff0000u);
                            *(LAS u32x2*)(dstT + (2 * m) * LDL) = we; *(LAS u32x2*)(dstT + (2 * m + 1) * LDL) = wo;
                        }
                    }
                }
            }
        }
        if (c < 63) { const int ncc = dir ? cc - 1 : cc + 1; SSD_LOAD(ncc); }
        __syncthreads();
        const int qi = 16 * wid + fr;
        bf16x8 cf[2];
        cf[0] = ldfrag(CN + qi * LDS_ + 8 * fq); cf[1] = ldfrag(CN + qi * LDS_ + 32 + 8 * fq);
        const float aci = ACUM[qi];
#pragma unroll
        for (int ct = 0; ct < 8; ++ct) {
            f32x4 a = (f32x4){0.f, 0.f, 0.f, 0.f};
#pragma unroll
            for (int ks = 0; ks < 2; ++ks) a = MFMA16(ldfrag(BN + (16 * ct + fr) * LDS_ + 32 * ks + 8 * fq), cf[ks], a);
            const int j0 = 16 * ct + 4 * fq;
            const f32x4 acj = *(const LAS f32x4*)(ACUM + j0), dtj = *(const LAS f32x4*)(DT + j0);
            float wv[4];
#pragma unroll
            for (int e = 0; e < 4; ++e) { const int j = j0 + e; const bool ok = dir ? (j >= qi) : (j <= qi); wv[e] = ok ? a[e] * __expf(aci - acj[e]) * dtj[e] : 0.f; }
            u32x2 w; w.x = pk2(wv[0], wv[1]); w.y = pk2(wv[2], wv[3]);
            *(LAS u32x2*)(PP + qi * LDL + j0) = w;
        }
        {
            const float ea = __expf(aci);
            f32x4 Y[4];
#pragma unroll
            for (int pt = 0; pt < 4; ++pt) {
                f32x4 a = (f32x4){0.f, 0.f, 0.f, 0.f};
#pragma unroll
                for (int ks = 0; ks < 2; ++ks) a = MFMA16(ldfrag(HL + (16 * pt + fr) * LDS_ + 32 * ks + 8 * fq), cf[ks], a);
                Y[pt] = a * ea;
            }
#pragma unroll
            for (int ks = 0; ks < 4; ++ks) {
                const bf16x8 pf = ldfrag(PP + qi * LDL + 32 * ks + 8 * fq);
#pragma unroll
                for (int pt = 0; pt < 4; ++pt) Y[pt] = MFMA16(ldfrag(XST + (16 * pt + fr) * LDL + 32 * ks + 8 * fq), pf, Y[pt]);
            }
            bf16* yo = yout + (size_t)(lrow0 + qi) * YLD + 512 + 64 * hh + 4 * fq;
#pragma unroll
            for (int pt = 0; pt < 4; ++pt) {
                if (dir == 0) {
#pragma unroll
                    for (int e = 0; e < 4; ++e) Y[pt][e] += dsk * bf2f(XST[(16 * pt + 4 * fq + e) * LDL + qi]);
                }
                u32x2 w; w.x = pk2(Y[pt][0], Y[pt][1]); w.y = pk2(Y[pt][2], Y[pt][3]); *(u32x2*)(yo + 16 * pt) = w;
            }
        }
        {
            const float et = __expf(tot);
            Hc[0] *= et; Hc[1] *= et;
#pragma unroll
            for (int ks = 0; ks < 4; ++ks) {
                const bf16x8 xf = ldfrag(XST + (16 * (wid & 3) + fr) * LDL + 32 * ks + 8 * fq);
#pragma unroll
                for (int j2 = 0; j2 < 2; ++j2) Hc[j2] = MFMA16(ldfrag(BTW + (16 * (2 * (wid >> 2) + j2) + fr) * LDL + 32 * ks + 8 * fq), xf, Hc[j2]);
            }
            if (next_reset) { Hc[0] = (f32x4){0.f, 0.f, 0.f, 0.f}; Hc[1] = (f32x4){0.f, 0.f, 0.f, 0.f}; }
        }
        __syncthreads();
#pragma unroll
        for (int j2 = 0; j2 < 2; ++j2) { u32x2 w; w.x = pk2(Hc[j2][0], Hc[j2][1]); w.y = pk2(Hc[j2][2], Hc[j2][3]);
            *(LAS u32x2*)(HL + (16 * (wid & 3) + fr) * LDS_ + 16 * (2 * (wid >> 2) + j2) + 4 * fq) = w; }
    }
#undef SSD_LOAD
    __syncthreads();
}

__device__ __forceinline__ void lru_item(LAS unsigned char* lds, const bf16* proj, bf16* yout, const float* cw, const float* cb, const float* w_a, const float* b_a, const float* w_i, const float* b_i,
                                         const float* lam, int gv, int vloc, int nb, int dir) {
    const int tid = launder_tid(), wid = __builtin_amdgcn_readfirstlane(tid >> 6), lane = tid & 63, fr = lane & 15, fq = lane >> 4;
    constexpr int LDX = 72;
    LAS bf16* XCB = (LAS bf16*)lds;
    LAS bf16* WT = XCB + 128 * LDX;
    LAS float* AA = (LAS float*)(WT + 128 * LDX);
    LAS float* UU = AA + 128 * 64;
    LAS float* AGG = UU + 128 * 64;
    LAS float* CARRY = AGG + 8 * 64 * 2;
    LAS float* BA = CARRY + 128;
    LAS float* BI = BA + 64;
    LAS float* SP = BI + 64;
    const int seqlen = gv < 8 ? 8192 : 4096;
    for (int idx = tid; idx < 8192; idx += 512) {
        const int mat = idx >> 12, rem = idx & 4095, i = rem >> 6, j = rem & 63;
        const float* w = (mat ? w_i : w_a) + (size_t)((dir * 8 + nb) * 64 + i) * 64 + j;
        WT[(64 * mat + j) * LDX + i] = f2bf(*w);
    }
    if (tid < 64) { CARRY[tid] = 0.f; CARRY[64 + tid] = 0.f; BA[tid] = b_a[dir * 512 + 64 * nb + tid]; BI[tid] = b_i[dir * 512 + 64 * nb + tid]; SP[tid] = 8.0f * softplusf(-lam[dir * 512 + 64 * nb + tid]); }
    const int c8 = (tid & 7) * 8, i0 = 2 * (tid >> 3), ccol = 64 * nb + c8;
    const f32x8 w0 = ld8f(cw + 0 * 512 + ccol), w1 = ld8f(cw + 1 * 512 + ccol), w2 = ld8f(cw + 2 * 512 + ccol), w3 = ld8f(cw + 3 * 512 + ccol), bb = ld8f(cb + ccol);
    u32x4 raw[5];
#define LRU_LOAD(CC) do { const int lr0_ = vloc * 8192 + (CC) * 128, p0_ = ((CC) * 128) % seqlen; \
        _Pragma("unroll") for (int r = 0; r < 5; ++r) { const int s_ = p0_ + i0 - 2 + r; raw[r] = (u32x4){0u, 0u, 0u, 0u}; \
            if (s_ >= 0 && s_ < seqlen) raw[r] = *(const u32x4*)(proj + (size_t)(lr0_ + i0 - 2 + r) * PLD + PC_LRUX + ccol); } } while (0)
    LRU_LOAD(dir ? 63 : 0);
    __syncthreads();
    for (int c = 0; c < 64; ++c) {
        const int cc = dir ? 63 - c : c;
        const int lrow0 = vloc * 8192 + cc * 128;
        bool next_reset = false;
        if (c < 63) { const int ncc = dir ? cc - 1 : cc + 1; const int np = (ncc * 128) % seqlen; next_reset = dir ? (np + 128 == seqlen) : (np == 0); }
#pragma unroll
        for (int r = 0; r < 2; ++r) {
            const f32x8 v = bb + w0 * unpack8(raw[r]) + w1 * unpack8(raw[r + 1]) + w2 * unpack8(raw[r + 2]) + w3 * unpack8(raw[r + 3]);
            *(LAS u32x4*)(XCB + (i0 + r) * LDX + c8) = pack8(v);
        }
        if (c < 63) { const int ncc = dir ? cc - 1 : cc + 1; LRU_LOAD(ncc); }
        __syncthreads();
        const int t = 16 * wid + fr;
        {
            bf16x8 xf[2];
            xf[0] = ldfrag(XCB + t * LDX + 8 * fq); xf[1] = ldfrag(XCB + t * LDX + 32 + 8 * fq);
            f32x4 Gt[8];
#pragma unroll
            for (int ct = 0; ct < 8; ++ct) {
                f32x4 a = (f32x4){0.f, 0.f, 0.f, 0.f};
#pragma unroll
                for (int ks = 0; ks < 2; ++ks) a = MFMA16(ldfrag(WT + (16 * ct + fr) * LDX + 32 * ks + 8 * fq), xf[ks], a);
                Gt[ct] = a;
            }
#pragma unroll
            for (int ct = 0; ct < 4; ++ct) {
                const int c0 = 16 * ct + 4 * fq;
                const f32x4 ba = *(const LAS f32x4*)(BA + c0), bi = *(const LAS f32x4*)(BI + c0), sp = *(const LAS f32x4*)(SP + c0);
                const u32x2 xw = *(const LAS u32x2*)(XCB + t * LDX + c0);
                const float xv[4] = {bflo(xw.x), bfhi(xw.x), bflo(xw.y), bfhi(xw.y)};
                f32x4 av, uv;
#pragma unroll
                for (int e = 0; e < 4; ++e) {
                    const float r = sigm(Gt[ct][e] + ba[e]), ig = sigm(Gt[ct + 4][e] + bi[e]);
                    const float la = -r * sp[e];
                    const float a = __expf(la);
                    av[e] = a;
                    uv[e] = sqrtf(fmaxf((1.0f - a) * (1.0f + a), 0.f)) * ig * xv[e];
                }
                *(LAS f32x4*)(AA + t * 64 + c0) = av; *(LAS f32x4*)(UU + t * 64 + c0) = uv;
            }
        }
        __syncthreads();
        {
            const int ch = tid & 63, seg = tid >> 6;
            float Pp = 1.f, h = 0.f;
#pragma unroll
            for (int k = 0; k < 16; ++k) { const int o = seg * 16 + k, tt = dir ? 127 - o : o; const float a = AA[tt * 64 + ch], u = UU[tt * 64 + ch]; h = a * h + u; Pp *= a; }
            AGG[(seg * 64 + ch) * 2] = Pp; AGG[(seg * 64 + ch) * 2 + 1] = h;
            __syncthreads();
            float cin = CARRY[(c & 1) * 64 + ch];
            for (int s = 0; s < seg; ++s) cin = AGG[(s * 64 + ch) * 2] * cin + AGG[(s * 64 + ch) * 2 + 1];
            h = cin;
            bf16* yo = yout + (size_t)lrow0 * YLD + 64 * nb + ch;
#pragma unroll
            for (int k = 0; k < 16; ++k) { const int o = seg * 16 + k, tt = dir ? 127 - o : o; const float a = AA[tt * 64 + ch], u = UU[tt * 64 + ch]; h = a * h + u; yo[(size_t)tt * YLD] = f2bf(h); }
            if (seg == 7) CARRY[((c + 1) & 1) * 64 + ch] = next_reset ? 0.f : h;
        }
    }
#undef LRU_LOAD
    __syncthreads();
}

__device__ __forceinline__ void conv_prepass(const bf16* proj, bf16* cxb, const float* cw, const float* cb, int sub, int bx, int G) {
    const int tid = launder_tid();
    for (int id = bx * 512 + tid; id < 96 * (THALF / 32); id += G * 512) {
        const int cgp = id % 96, seg = id / 96, xc = 8 * cgp;
        const int row0 = seg * 32, gv = sub * 5 + (row0 >> 13), seqlen = gv < 8 ? 8192 : 4096, posb = row0 % seqlen;
#pragma unroll 1
        for (int blk = 0; blk < 4; ++blk) {
            const int r0 = row0 + 8 * blk, p0 = posb + 8 * blk;
            u32x4 raw[11];
#pragma unroll
            for (int r = 0; r < 11; ++r) { const int s_ = p0 - 2 + r; raw[r] = (u32x4){0u, 0u, 0u, 0u}; if (s_ >= 0 && s_ < seqlen) raw[r] = *(const u32x4*)(proj + (size_t)(r0 - 2 + r) * PLD + PC_XBC + xc); }
#pragma unroll
            for (int hc = 0; hc < 2; ++hc) {
                const int cl = xc + 4 * hc;
                const f32x4 w0 = *(const f32x4*)(cw + 0 * 768 + cl), w1 = *(const f32x4*)(cw + 1 * 768 + cl), w2 = *(const f32x4*)(cw + 2 * 768 + cl), w3 = *(const f32x4*)(cw + 3 * 768 + cl), bb = *(const f32x4*)(cb + cl);
                f32x4 ring[4] = {bb, bb, bb, bb};
#pragma unroll
                for (int r = 0; r < 11; ++r) {
                    const unsigned xa = raw[r][2 * hc], xb = raw[r][2 * hc + 1];
                    const f32x4 x = (f32x4){bflo(xa), bfhi(xa), bflo(xb), bfhi(xb)};
                    if (r <= 7) ring[r & 3] += w0 * x;
                    if (r >= 1 && r <= 8) ring[(r - 1) & 3] += w1 * x;
                    if (r >= 2 && r <= 9) ring[(r - 2) & 3] += w2 * x;
                    if (r >= 3) {
                        const int od = r - 3;
                        f32x4 t = ring[od & 3] + w3 * x;
                        ring[od & 3] = bb;
#pragma unroll
                        for (int e = 0; e < 4; ++e) t[e] = siluf(t[e]);
                        u32x2 pk; pk.x = pk2(t[0], t[1]); pk.y = pk2(t[2], t[3]);
                        *(u32x2*)(cxb + (size_t)(r0 + od) * 768 + cl) = pk;
                    }
                }
            }
        }
    }
}

constexpr int I_GU = (DM / 64) * (NGU / 32), I_D = (DFF / 64) * (DM / 32), I_IN = (DM / 64) * (NIN / 32), I_OUT = (NMIX / 64) * (DM / 32);
constexpr int I_LAYER = 2 * I_GU + 2 * I_D + I_IN + I_OUT;
__device__ __forceinline__ void convert_item(KArgsPtr KA, unsigned char* ws, int l, int r, int lane, LAS float* scr) {
    if (r < I_GU) { transpose_item(KA->in[3] + (size_t)l * DM * NGU, DM, NGU, NGU, KA->in[2] + l * DM, (bf16*)(ws + WS_WGU1 + l * SZ_WGU), 1, r, lane, scr); return; } r -= I_GU;
    if (r < I_GU) { transpose_item(KA->in[23] + (size_t)l * DM * NGU, DM, NGU, NGU, KA->in[22] + l * DM, (bf16*)(ws + WS_WGU2 + l * SZ_WGU), 1, r, lane, scr); return; } r -= I_GU;
    if (r < I_D) { transpose_item(KA->in[4] + (size_t)l * DFF * DM, DFF, DM, DM, nullptr, (bf16*)(ws + WS_WD1 + l * SZ_WD), 0, r, lane, scr); return; } r -= I_D;
    if (r < I_D) { transpose_item(KA->in[24] + (size_t)l * DFF * DM, DFF, DM, DM, nullptr, (bf16*)(ws + WS_WD2 + l * SZ_WD), 0, r, lane, scr); return; } r -= I_D;
    if (r < I_IN) { transpose_item(KA->in[6] + (size_t)l * DM * W_IN_SRC, DM, W_IN_SRC, NIN, KA->in[5] + l * DM, (bf16*)(ws + WS_WIN + l * SZ_WIN), 2, r, lane, scr); return; } r -= I_IN;
    transpose_item(KA->in[21] + (size_t)l * NMIX * DM, NMIX, DM, DM, nullptr, (bf16*)(ws + WS_WOUT + l * SZ_WOUT), 0, r, lane, scr);
}

#define XB_TMO      128
#define XB_XCNT(j)  (256  + 64 * (j))
#define XB_XSUB(j)  (1280 + 64 * (j))
#define XB_XGEN(j)  (2304 + 64 * (j))
#define XB_TOP      3328
#define XB_TOPGEN   3392
#define XCD_BAR_WORDS 3456
#define XB_SPIN_CAP (1u << 18)

__device__ __forceinline__ unsigned xb_ld(unsigned* p)              { return __hip_atomic_load(p, __ATOMIC_RELAXED, __HIP_MEMORY_SCOPE_AGENT); }
__device__ __forceinline__ unsigned xb_add(unsigned* p, unsigned v) { return __hip_atomic_fetch_add(p, v, __ATOMIC_RELAXED, __HIP_MEMORY_SCOPE_AGENT); }
__device__ __forceinline__ unsigned xb_xcc_id() { return (unsigned)__builtin_amdgcn_s_getreg((3 << 11) | 20) & 0xFu; }
#define XB_SPIN(cond, bar) do { unsigned _sp = 0; while (cond) { __builtin_amdgcn_s_sleep(1); \
    if ((++_sp & 255u) == 0u) { if (xb_ld(&(bar)[XB_TMO])) break; if (_sp > XB_SPIN_CAP) { atomicAdd(&(bar)[XB_TMO], 1u); break; } } } } while (0)

struct XcdBarrier {
    unsigned* bar; unsigned x;
    volatile LAS unsigned* st;
};

__device__ __forceinline__ XcdBarrier xcd_barrier_post(unsigned* bar, volatile LAS unsigned* st) {
    XcdBarrier b; b.bar = bar; b.x = xb_xcc_id(); b.st = st;
    if (threadIdx.x == 0) (void)xb_add(&bar[XB_XCNT(b.x)], 1u);
    return b;
}
__device__ __forceinline__ void xcd_barrier_complete(unsigned* bar, unsigned x, unsigned& nloc, unsigned& nx) {
    const unsigned G = gridDim.x * gridDim.y * gridDim.z;
    unsigned sum, cnt, mine, sp = 0u;
    for (;;) {
        sum = 0u; cnt = 0u; mine = 0u;
#pragma unroll
        for (unsigned j = 0; j < 16; ++j) { const unsigned c = xb_ld(&bar[XB_XCNT(j)]); sum += c; cnt += (c > 0u) ? 1u : 0u; mine = (j == x) ? c : mine; }
        if (sum == G) break;
        __builtin_amdgcn_s_sleep(1);
        if ((++sp & 255u) == 0u) { if (xb_ld(&bar[XB_TMO])) break; if (sp > XB_SPIN_CAP) { atomicAdd(&bar[XB_TMO], 1u); break; } }
    }
    nloc = mine > 0u ? mine : 1u; nx = cnt > 0u ? cnt : 1u;
}

__device__ __forceinline__ void xcd_barrier(const XcdBarrier& b) {
    asm volatile("s_waitcnt vmcnt(0)" ::: "memory");
    __syncthreads();
    if (threadIdx.x == 0) {
        unsigned* bar = b.bar;
        __builtin_amdgcn_s_waitcnt(0);
        unsigned nloc = b.st[0], nx = b.st[1];
        if (nloc == 0u) { xcd_barrier_complete(bar, b.x, nloc, nx); b.st[0] = nloc; b.st[1] = nx; }
        const unsigned old = xb_add(&bar[XB_XSUB(b.x)], 1u);
        const unsigned gen = old / nloc;
        if (old + 1u == (gen + 1u) * nloc) {
            __builtin_amdgcn_fence(__ATOMIC_RELEASE, "agent");
            asm volatile("s_waitcnt vmcnt(0)" ::: "memory");
            const unsigned og = xb_add(&bar[XB_TOP], 1u);
            const unsigned tg = og / nx;
            if (og + 1u == (tg + 1u) * nx) xb_add(&bar[XB_TOPGEN], 1u);
            else XB_SPIN(xb_ld(&bar[XB_TOPGEN]) == tg, bar);
            __builtin_amdgcn_fence(__ATOMIC_ACQUIRE, "agent");
            xb_add(&bar[XB_XGEN(b.x)], 1u);
            asm volatile("s_waitcnt vmcnt(0)" ::: "memory");
        } else {
            XB_SPIN(xb_ld(&bar[XB_XGEN(b.x)]) == gen, bar);
            __builtin_amdgcn_fence(__ATOMIC_ACQUIRE, "agent");
            asm volatile("s_waitcnt vmcnt(0)" ::: "memory");
        }
    }
    __syncthreads();
}


__global__ void __launch_bounds__(512, 2) mega_fwd(Args args) {
    extern __shared__ __attribute__((aligned(16))) unsigned char lds_raw[];
    LAS unsigned char* lds = (LAS unsigned char*)lds_raw;
    cg::grid_group grid = cg::this_grid();
#define CG_SYNC() do { asm volatile("s_waitcnt vmcnt(0) lgkmcnt(0)" ::: "memory"); __syncthreads(); grid.sync(); } while (0)
    volatile LAS unsigned* xb_st = (volatile LAS unsigned*)((LAS unsigned char*)lds_raw + LDS_BYTES - 64);
    if (threadIdx.x == 0) { xb_st[0] = 0u; xb_st[1] = 0u; }
    __syncthreads();
    const XcdBarrier xbar = xcd_barrier_post((unsigned*)(kargs()->ws + WS_BAR), xb_st);
#define GRID_SYNC() xcd_barrier(xbar)
    const int wid = __builtin_amdgcn_readfirstlane(launder_tid() >> 6), G = gridDim.x, bx = blockIdx.x;
    unsigned char* ws; float* X;
    { KArgsPtr KA0 = kargs(); ws = KA0->ws; X = KA0->out; }
    bf16* XB = (bf16*)(ws + WS_XB); float* SSQ = (float*)(ws + WS_SSQ);
    float* RCOS = (float*)(ws + WS_ROPE); float* RSIN = RCOS + 8192 * 64;
    bf16* PROJ = (bf16*)(ws + WS_PROJ); bf16* YF = (bf16*)(ws + WS_Y); bf16* YBK = (bf16*)(ws + WS_YB); bf16* HB = (bf16*)(ws + WS_H);
    const int gw = bx * 8 + wid, NGW = G * 8;

    {
        KArgsPtr KA = kargs();
        const int tid = launder_tid(), lane = tid & 63;
        LAS float* scr = (LAS float*)(lds + wid * 16384);
        for (int it = gw; it < I_LAYER; it += NGW) convert_item(KA, ws, 0, it, lane, scr);
        for (int m = gw; m < TT; m += NGW) {
            const float* src = m < 65536 ? KA->in[0] + (size_t)m * DM : KA->in[1] + (size_t)(m - 65536) * DM;
            float s = 0.f;
#pragma unroll
            for (int j = 0; j < 4; ++j) {
                const f32x4 v = *(const f32x4*)(src + 256 * j + 4 * lane);
                *(f32x4*)(X + (size_t)m * DM + 256 * j + 4 * lane) = v;
                u32x2 w; w.x = pk2(v[0], v[1]); w.y = pk2(v[2], v[3]);
                *(u32x2*)(XB + (size_t)m * DM + 256 * j + 4 * lane) = w;
                s += (v[0] * v[0] + v[1] * v[1]) + (v[2] * v[2] + v[3] * v[3]);
            }
            s = wave_sum(s);
            if (lane < 16) SSQ[(size_t)m * 16 + lane] = lane == 0 ? s : 0.f;
        }
        for (int i = bx * 512 + tid; i < 8192 * 64; i += G * 512) {
            const int pos = i >> 6, f = i & 63;
            const float inv = 1.0f / powf(10000.0f, (float)(2 * f) / 128.0f);
            const float ang = (float)pos * inv;
            RCOS[i] = cosf(ang); RSIN[i] = sinf(ang);
        }
    }
    CG_SYNC();

    for (int l = 0; l < NLAYER; ++l) {
        for (int st = 0; st < 3; ++st) {
            const int nsub = st == 1 ? 2 : 1;
            for (int sub = 0; sub < nsub; ++sub) {
                if (st != 1) {
                    const bf16* Wgu = (const bf16*)(ws + (st == 0 ? WS_WGU1 : WS_WGU2) + l * SZ_WGU);
                    pg8::Gemm g{XB, Wgu, TT, NGU, DM}; pg8::StaticOrder S; S.init(TT, NGU, G, bx);
                    EpiGU E{HB, SSQ};
#ifndef NO_GU
                    pg8::gemm_phase<EpiGU, pg8::StaticOrder, PG8_ALIGN, PG8_SP2>(lds, g, S, E);
#endif
                } else {
                    const bf16* Win = (const bf16*)(ws + WS_WIN + l * SZ_WIN);
                    pg8::Gemm g{XB + (size_t)sub * THALF * DM, Win, THALF, NIN, DM}; pg8::StaticOrder S; S.init(THALF, NIN, G, bx);
                    EpiProj E{PROJ, SSQ, sub * THALF, RCOS, RSIN};
#ifndef NO_PROJ
                    pg8::gemm_phase<EpiProj, pg8::StaticOrder, PG8_ALIGN, PG8_SP2>(lds, g, S, E);
#endif
                }
                GRID_SYNC();
                if (st == 1) {
                    bf16* CXB = (bf16*)(ws + WS_CXB);
                    { KArgsPtr KA = kargs(); conv_prepass(PROJ, CXB, KA->in[14] + (size_t)l * 4 * 768, KA->in[15] + l * 768, sub, bx, G); }
                    GRID_SYNC();
                    if (bx >= 200 && l + 1 < NLAYER) {
                        KArgsPtr KA = kargs();
                        const int tid = launder_tid(), lane = tid & 63, wv = __builtin_amdgcn_readfirstlane(tid >> 6);
                        LAS float* scr = (LAS float*)(lds + wv * 16384);
                        const int lo = sub * (I_LAYER / 2), hi = lo + I_LAYER / 2, nwv = (G - 200) * 8;
                        for (int it = lo + (bx - 200) * 8 + wv; it < hi; it += nwv) convert_item(KA, ws, l + 1, it, lane, scr);
                    }
                    for (int item = bx; item < 200; item += G) {
                        KArgsPtr KA = kargs();
                        if (item < 40) {
                            const int vloc = item >> 3, hd = (item & 7) >> 1, dir = item & 1;
#ifndef NO_RET
                            ret_item(lds, PROJ, dir ? YBK : YF, sub * 5 + vloc, vloc, hd, dir);
#endif
                        } else if (item < 120) {
                            const int q = item - 40, vloc = q >> 4, hh = (q & 15) >> 1, dir = q & 1;
#ifndef NO_SSD
                            ssd_item(lds, PROJ, CXB, dir ? YBK : YF, KA->in[16] + l * 16, KA->in[17] + l * 16, KA->in[18] + l * 8,
                                     sub * 5 + vloc, vloc, hh, dir);
#endif
                        } else {
                            const int q = item - 120, vloc = q >> 4, nb = (q & 15) >> 1, dir = q & 1;
#ifndef NO_LRU
                            lru_item(lds, PROJ, dir ? YBK : YF, KA->in[7] + (size_t)l * 4 * 512, KA->in[8] + l * 512, KA->in[9] + (size_t)l * 2 * 8 * 64 * 64, KA->in[10] + l * 1024,
                                     KA->in[11] + (size_t)l * 2 * 8 * 64 * 64, KA->in[12] + l * 1024, KA->in[13] + l * 1024, sub * 5 + vloc, vloc, nb, dir);
#endif
                        }
                    }
                    GRID_SYNC();
                    {
                        KArgsPtr KA = kargs();
                        const int tid = launder_tid(), lane = tid & 63;
                        const float* ssd_norm = KA->in[19] + l * 512; const float* ret_norm = KA->in[20] + l * 512;
                        const f32x8 nw_s = ld8f(ssd_norm + 8 * lane), nw_r = ld8f(ret_norm + 8 * lane);
                        for (int row = gw; row < THALF; row += NGW) {
                            bf16* yr = YF + (size_t)row * YLD; const bf16* yb = YBK + (size_t)row * YLD; const bf16* pr = PROJ + (size_t)row * PLD;
                            {
                                const f32x8 a = unpack8(*(const u32x4*)(yr + 8 * lane)), b = unpack8(*(const u32x4*)(yb + 8 * lane)), gt = unpack8(*(const u32x4*)(pr + PC_GATE + 8 * lane));
                                f32x8 o;
#pragma unroll
                                for (int e = 0; e < 8; ++e) o[e] = (a[e] + b[e]) * gelu_tanh(gt[e]);
                                *(u32x4*)(yr + 8 * lane) = pack8(o);
                            }
                            {
                                const f32x8 a = unpack8(*(const u32x4*)(yr + 512 + 8 * lane)), b = unpack8(*(const u32x4*)(yb + 512 + 8 * lane)), z = unpack8(*(const u32x4*)(pr + PC_Z + 8 * lane));
                                f32x8 v; float ss = 0.f;
#pragma unroll
                                for (int e = 0; e < 8; ++e) { v[e] = (a[e] + b[e]) * siluf(z[e]); ss += v[e] * v[e]; }
                                ss = wave_sum(ss);
                                const float rs = rsqrtf(ss * (1.0f / 512.0f) + EPSN);
                                *(u32x4*)(yr + 512 + 8 * lane) = pack8(v * rs * nw_s);
                            }
                            {
                                const f32x8 a = unpack8(*(const u32x4*)(yr + 1024 + 8 * lane)), b = unpack8(*(const u32x4*)(yb + 1024 + 8 * lane)), gg = unpack8(*(const u32x4*)(pr + PC_G + 8 * lane));
                                f32x8 v = a + b; float s1 = 0.f;
#pragma unroll
                                for (int e = 0; e < 8; ++e) s1 += v[e];
                                s1 += __shfl_xor(s1, 1); s1 += __shfl_xor(s1, 2); s1 += __shfl_xor(s1, 4); s1 += __shfl_xor(s1, 8);
                                const float mu = s1 * (1.0f / 128.0f); float s2 = 0.f;
#pragma unroll
                                for (int e = 0; e < 8; ++e) { v[e] -= mu; s2 += v[e] * v[e]; }
                                s2 += __shfl_xor(s2, 1); s2 += __shfl_xor(s2, 2); s2 += __shfl_xor(s2, 4); s2 += __shfl_xor(s2, 8);
                                const float rs = rsqrtf(s2 * (1.0f / 128.0f) + EPSN);
                                f32x8 o;
#pragma unroll
                                for (int e = 0; e < 8; ++e) o[e] = v[e] * rs * nw_r[e] * siluf(gg[e]);
                                *(u32x4*)(yr + 1024 + 8 * lane) = pack8(o);
                            }
                        }
                    }
                    GRID_SYNC();
                }
                {
                    pg8::Gemm g; float coef; int roff;
                    if (st != 1) { g = pg8::Gemm{HB, (const bf16*)(ws + (st == 0 ? WS_WD1 : WS_WD2) + l * SZ_WD), TT, DM, DFF}; coef = 0.5f; roff = 0; }
                    else { g = pg8::Gemm{YF, (const bf16*)(ws + WS_WOUT + l * SZ_WOUT), THALF, DM, NMIX}; coef = 1.0f; roff = sub * THALF; }
                    pg8::StaticOrder S; S.init(g.M, g.N, G, bx);
                    EpiRes E{X, XB, SSQ, coef, roff};
#ifndef NO_RES
                    pg8::gemm_phase<EpiRes, pg8::StaticOrder, PG8_ALIGN, PG8_SP2>(lds, g, S, E);
#endif
                }
                GRID_SYNC();
            }
        }
    }
    {
        KArgsPtr KA = kargs();
        const int tid = launder_tid(), lane = tid & 63;
        const float* fw = KA->in[25];
        for (int m = gw; m < TT; m += NGW) {
            const float rs = row_rs(SSQ, (size_t)m);
#pragma unroll
            for (int j = 0; j < 4; ++j) {
                float* p = X + (size_t)m * DM + 256 * j + 4 * lane;
                const f32x4 v = *(const f32x4*)p, w = *(const f32x4*)(fw + 256 * j + 4 * lane);
                *(f32x4*)p = v * rs * w;
            }
        }
    }
}

extern "C" void kernel_launch(void* const* d_in, const int* in_sizes, int n_in, void* d_out, int out_size, void* d_ws, size_t ws_size, hipStream_t stream) {
    static int grid = 0;
    if (grid == 0) {
        if (n_in != 26 || out_size != TT * DM || ws_size < WS_NEED) { fprintf(stderr, "kernel_launch: unexpected problem (n_in %d, out %d, ws %zu, need %zu)\n", n_in, out_size, ws_size, (size_t)WS_NEED); grid = -1; return; }
        int dev = 0, cus = 0, per_cu = 0;
        if (hipGetDevice(&dev) != hipSuccess || hipDeviceGetAttribute(&cus, hipDeviceAttributeMultiprocessorCount, dev) != hipSuccess) { grid = -1; return; }
        if (hipFuncSetAttribute((const void*)mega_fwd, hipFuncAttributeMaxDynamicSharedMemorySize, LDS_BYTES) != hipSuccess) { fprintf(stderr, "kernel_launch: hipFuncSetAttribute failed\n"); grid = -1; return; }
        if (hipOccupancyMaxActiveBlocksPerMultiprocessor(&per_cu, (const void*)mega_fwd, 512, LDS_BYTES) != hipSuccess || per_cu < 1) { fprintf(stderr, "kernel_launch: occupancy query says %d\n", per_cu); per_cu = 1; }
        (void)hipGetLastError();
        grid = cus;
    }
    if (grid < 0) return;
    Args a{};
    for (int i = 0; i < 26; ++i) a.in[i] = (const float*)d_in[i];
    a.out = (float*)d_out; a.ws = (unsigned char*)d_ws;
    if (hipMemsetAsync((unsigned char*)d_ws + WS_BAR, 0, 16384, stream) != hipSuccess) { fprintf(stderr, "kernel_launch: hipMemsetAsync of the barrier words failed\n"); return; }
    void* kargs[] = {&a};
    hipError_t e = hipLaunchCooperativeKernel((const void*)mega_fwd, dim3(grid), dim3(512), kargs, LDS_BYTES, stream);
    if (e != hipSuccess) fprintf(stderr, "kernel_launch: cooperative launch failed: %s (grid %d)\n", hipGetErrorString(e), grid);
}
```

```cpp
#include <hip/hip_runtime.h>
#include <hip/hip_cooperative_groups.h>
#include <cstdio>
#include <cstdint>
namespace cg = cooperative_groups;
namespace pg8 {
#define PG8_LAS __attribute__((address_space(3)))
typedef unsigned short bf16_t;
typedef short bf16x8 __attribute__((ext_vector_type(8)));
typedef float f32x4 __attribute__((ext_vector_type(4)));
typedef unsigned u32x4 __attribute__((ext_vector_type(4)));
constexpr int BM = 256, BK = 64, HALF = 128, HTB = HALF * BK * 2  , STAGE_BYTES = 8 * HTB, NXCD = 8, WGM = 8;

__host__ __device__ __forceinline__ int lds_byte(int r, int c) { const int st = (r >> 4) * 2 + (c >> 5), rr = r & 15, cc = c & 31, ob = rr * 64 + cc * 2; return st * 1024 + (ob ^ (((ob >> 9) & 1) << 5)); }
__host__ __device__ __forceinline__ void stage_rc(int b, int& R, int& C) { const int st = b / 1024, sb = b % 1024, swz = sb ^ (((sb >> 9) & 1) << 5); R = (st >> 1) * 16 + swz / 64; C = (st & 1) * 32 + (swz % 64) / 2; }
__host__ __device__ __forceinline__ int perm32(int rho) { const int n = rho >> 4, i = rho & 15; return 8 * (i >> 2) + 4 * n + (i & 3); }

struct Unit { int pm, pn; };
struct Gemm { const bf16_t* A; const bf16_t* Bt; int M, N, K; };

struct StaticOrder {
    int nM, nN, nwg, G, c;
    __host__ __device__ void init(int M, int N, int G_, int c_) { nM = M / BM; nN = N / BM; nwg = nM * nN; G = G_; c = c_; }
    __host__ __device__ bool next(int i, Unit& u) const {
        const long L = (long)i * G + c; if (L >= nwg) return false;
        int wgid = (int)L; { const int q = nwg / NXCD, r = nwg % NXCD, xcd = wgid % NXCD, off = wgid / NXCD; wgid = (xcd < r ? xcd * (q + 1) : r * (q + 1) + (xcd - r) * q) + off; }
        const int nig = WGM * nN, gid = wgid / nig, fm = gid * WGM, gsz = (nM - fm) < WGM ? (nM - fm) : WGM;
        u.pm = fm + ((wgid % nig) % gsz); u.pn = (wgid % nig) / gsz; return true;
    }
    __device__ __forceinline__ void a_ready(const Unit&) const {}
    __device__ __forceinline__ void done(const Unit&) const {}
};

__device__ __forceinline__ unsigned cvt_pk_bf16(float lo, float hi) { unsigned r; asm volatile("v_cvt_pk_bf16_f32 %0, %1, %2" : "=v"(r) : "v"(lo), "v"(hi)); return r; }
typedef float f32x2 __attribute__((ext_vector_type(2)));
template <class Epi, class Sched, bool ALIGN_EPI = false, bool SP2 = false>
__device__ __forceinline__ void gemm_phase(PG8_LAS unsigned char* lds, const Gemm g, const Sched& S, const Epi& E) {
    int tid_l = threadIdx.x; asm volatile("" : "+v"(tid_l));
    const int tid = tid_l, wid = __builtin_amdgcn_readfirstlane(tid >> 6), lane = tid & 63, wr = wid >> 2, wc = wid & 3, fr = lane & 15, fq = lane >> 4;
    const int K = g.K, nt = K / BK;
    unsigned voffA[2], voffB[2];
#pragma unroll
    for (int i = 0; i < 2; ++i) { int R, C; stage_rc(tid * 16 + i * 8192, R, C); const int Rb = Epi::PERM ? ((R & ~31) + perm32(R & 31)) : R;
        voffA[i] = (unsigned)(R * K + C) * 2u; voffB[i] = (unsigned)(Rb * K + C) * 2u; }
    const size_t kstep = (size_t)(BK * 2);
    const size_t hstep = (size_t)HALF * K * 2;
    const size_t tstep = 2 * hstep;
    const unsigned ldsw = (unsigned)wid * 1024u;
    const int aoff = lds_byte(wr * 64 + fr, fq * 8), boff = lds_byte(wc * 32 + fr, fq * 8);
#define PG8_SA(b, h) (((b) * 2 + (h)) * HTB)
#define PG8_SB(b, h) ((4 + (b) * 2 + (h)) * HTB)
#define PG8_STAGE(bufoff, gbase, voff) do { _Pragma("unroll") for (int _i = 0; _i < 2; ++_i) \
        __builtin_amdgcn_global_load_lds((const unsigned*)((const char*)(gbase) + (voff)[_i]), (PG8_LAS unsigned*)(lds + (bufoff) + ldsw + _i * 8192), 16, 0, 0); } while (0)
#define PG8_LDA(dst, b, h) do { _Pragma("unroll") for (int m = 0; m < 4; ++m) _Pragma("unroll") for (int k = 0; k < 2; ++k) dst[m][k] = *(const PG8_LAS bf16x8*)(lds + PG8_SA(b, h) + aoff + m * 2048 + k * 1024); } while (0)
#define PG8_LDB(dst, b, h) do { _Pragma("unroll") for (int n = 0; n < 2; ++n) _Pragma("unroll") for (int k = 0; k < 2; ++k) dst[n][k] = *(const PG8_LAS bf16x8*)(lds + PG8_SB(b, h) + boff + n * 2048 + k * 1024); } while (0)
#define PG8_MMA(ai, bj, At, Bt) do { __builtin_amdgcn_s_setprio(1); _Pragma("unroll") for (int m = 0; m < 4; ++m) _Pragma("unroll") for (int n = 0; n < 2; ++n) _Pragma("unroll") for (int k = 0; k < 2; ++k) \
        acc[ai][bj][m][n] = __builtin_amdgcn_mfma_f32_16x16x32_bf16(Bt[n][k], At[m][k], acc[ai][bj][m][n], 0, 0, 0); __builtin_amdgcn_s_setprio(0); } while (0)
#define PG8_WAIT_V(n) asm volatile("s_waitcnt vmcnt(" #n ")" ::: "memory")
#define PG8_WAIT_L(n) asm volatile("s_waitcnt lgkmcnt(" #n ")" ::: "memory")
#define PG8_BAR __builtin_amdgcn_s_barrier()
#define PG8_SCHED __builtin_amdgcn_sched_barrier(0)
    Unit cur, nxt; int ui = 0;
    if (!S.next(0, cur)) return;
    f32x4 acc[2][2][4][2];
#pragma unroll
    for (int a = 0; a < 2; ++a)
#pragma unroll
        for (int b = 0; b < 2; ++b)
#pragma unroll
            for (int m = 0; m < 4; ++m)
#pragma unroll
                for (int n = 0; n < 2; ++n) acc[a][b][m][n] = (f32x4){0.f, 0.f, 0.f, 0.f};
    bf16x8 At[4][2], B0[2][2], B1[2][2];
    const char* cA = (const char*)g.A + (size_t)cur.pm * tstep; const char* cB = (const char*)g.Bt + (size_t)cur.pn * tstep;
    S.a_ready(cur);
    if constexpr (SP2) {
        PG8_STAGE(PG8_SB(0, 0), cB, voffB); PG8_STAGE(PG8_SB(0, 1), cB + hstep, voffB); PG8_STAGE(PG8_SA(0, 0), cA, voffA); PG8_STAGE(PG8_SA(0, 1), cA + hstep, voffA);
        if (wr == 1) PG8_BAR;
        PG8_WAIT_V(2); PG8_BAR;
        PG8_STAGE(PG8_SB(1, 0), cB + kstep, voffB); PG8_STAGE(PG8_SA(1, 0), cA + kstep, voffA); PG8_STAGE(PG8_SB(1, 1), cB + hstep + kstep, voffB);
        PG8_WAIT_V(6); PG8_BAR;
    } else {
        PG8_STAGE(PG8_SB(0, 0), cB, voffB); PG8_STAGE(PG8_SA(0, 0), cA, voffA); PG8_STAGE(PG8_SB(0, 1), cB + hstep, voffB); PG8_STAGE(PG8_SA(0, 1), cA + hstep, voffA);
        if (wr == 1) PG8_BAR;
        PG8_WAIT_V(4); PG8_BAR;
        PG8_STAGE(PG8_SB(1, 0), cB + kstep, voffB); PG8_STAGE(PG8_SA(1, 0), cA + kstep, voffA); PG8_STAGE(PG8_SB(1, 1), cB + hstep + kstep, voffB);
        PG8_WAIT_V(6); PG8_BAR;
    }
    for (;;) {
        const bool has_next = S.next(ui + 1, nxt);
        const char* nA = has_next ? (const char*)g.A + (size_t)nxt.pm * tstep : cA; const char* nB = has_next ? (const char*)g.Bt + (size_t)nxt.pn * tstep : cB;
        for (int t = 0; t < nt; t += 2) {
            const bool last = (t == nt - 2);
            const char* a1 = cA + (size_t)(t + 1) * kstep;
            const char* a2 = last ? nA : cA + (size_t)(t + 2) * kstep; const char* b2 = last ? nB : cB + (size_t)(t + 2) * kstep;
            const char* a3 = a2 + kstep; const char* b3 = b2 + kstep;
            if (last && has_next) S.a_ready(nxt);
            if constexpr (SP2) {
            PG8_LDB(B0, 0, 0); PG8_LDB(B1, 0, 1); PG8_SCHED; PG8_LDA(At, 0, 0); PG8_STAGE(PG8_SA(1, 1), a1 + hstep, voffA);
            PG8_WAIT_V(8); PG8_WAIT_L(0); PG8_BAR; PG8_MMA(0, 0, At, B0); PG8_MMA(0, 1, At, B1); PG8_BAR; PG8_SCHED;
            PG8_LDA(At, 0, 1); PG8_STAGE(PG8_SB(0, 0), b2, voffB); PG8_STAGE(PG8_SB(0, 1), b2 + hstep, voffB); PG8_STAGE(PG8_SA(0, 0), a2, voffA);
            PG8_WAIT_V(8); PG8_WAIT_L(0); PG8_BAR; PG8_MMA(1, 0, At, B0); PG8_MMA(1, 1, At, B1); PG8_BAR; PG8_SCHED;
            PG8_LDB(B0, 1, 0); PG8_LDB(B1, 1, 1); PG8_SCHED; PG8_LDA(At, 1, 0); PG8_STAGE(PG8_SA(0, 1), a2 + hstep, voffA);
            PG8_WAIT_V(8); PG8_WAIT_L(0); PG8_BAR; PG8_MMA(0, 0, At, B0); PG8_MMA(0, 1, At, B1); PG8_BAR; PG8_SCHED;
            PG8_LDA(At, 1, 1); PG8_STAGE(PG8_SB(1, 0), b3, voffB); PG8_STAGE(PG8_SB(1, 1), b3 + hstep, voffB); PG8_STAGE(PG8_SA(1, 0), a3, voffA);
            PG8_WAIT_V(8); PG8_WAIT_L(0); PG8_BAR; PG8_MMA(1, 0, At, B0); PG8_MMA(1, 1, At, B1); PG8_BAR; PG8_SCHED;
            } else {
            PG8_LDB(B0, 0, 0); PG8_SCHED; PG8_LDA(At, 0, 0); PG8_STAGE(PG8_SA(1, 1), a1 + hstep, voffA);
            PG8_WAIT_L(8); PG8_BAR; PG8_WAIT_L(0); PG8_MMA(0, 0, At, B0); PG8_BAR; PG8_SCHED;
            PG8_LDB(B1, 0, 1); PG8_STAGE(PG8_SB(0, 0), b2, voffB);
            PG8_BAR; PG8_WAIT_L(0); PG8_MMA(0, 1, At, B1); PG8_BAR;
            PG8_LDA(At, 0, 1); PG8_STAGE(PG8_SA(0, 0), a2, voffA);
            PG8_BAR; PG8_WAIT_L(0); PG8_MMA(1, 0, At, B0); PG8_BAR; PG8_SCHED;
            PG8_STAGE(PG8_SB(0, 1), b2 + hstep, voffB);
            PG8_WAIT_V(6); PG8_BAR; PG8_MMA(1, 1, At, B1); PG8_BAR;
            PG8_LDB(B0, 1, 0); PG8_SCHED; PG8_LDA(At, 1, 0); PG8_STAGE(PG8_SA(0, 1), a2 + hstep, voffA);
            PG8_WAIT_L(8); PG8_BAR; PG8_WAIT_L(0); PG8_MMA(0, 0, At, B0); PG8_BAR; PG8_SCHED;
            PG8_LDB(B1, 1, 1); PG8_STAGE(PG8_SB(1, 0), b3, voffB);
            PG8_BAR; PG8_WAIT_L(0); PG8_MMA(0, 1, At, B1); PG8_BAR;
            PG8_LDA(At, 1, 1); PG8_STAGE(PG8_SA(1, 0), a3, voffA);
            PG8_BAR; PG8_WAIT_L(0); PG8_MMA(1, 0, At, B0); PG8_BAR; PG8_SCHED;
            PG8_STAGE(PG8_SB(1, 1), b3 + hstep, voffB);
            PG8_WAIT_V(6); PG8_BAR; PG8_MMA(1, 1, At, B1); PG8_BAR;
            }
        }
        if constexpr (ALIGN_EPI) { if (wr == 0) PG8_BAR; }
        if constexpr (!Epi::AFTER_DRAIN) { E(acc, cur, wr, wc, fr, fq); S.done(cur); }
        if (!has_next) break;
#pragma unroll
        for (int a = 0; a < 2; ++a)
#pragma unroll
            for (int b = 0; b < 2; ++b)
#pragma unroll
                for (int m = 0; m < 4; ++m)
#pragma unroll
                    for (int n = 0; n < 2; ++n) acc[a][b][m][n] = (f32x4){0.f, 0.f, 0.f, 0.f};
        cur = nxt; cA = nA; cB = nB; ++ui;
        if constexpr (ALIGN_EPI) { if (wr == 1) PG8_BAR; }
    }
    PG8_WAIT_V(0);
    if constexpr (!ALIGN_EPI) { if (wr == 0) PG8_BAR; }
    PG8_BAR;
    if constexpr (Epi::AFTER_DRAIN) { E.fused(acc, cur, wr, wc, fr, fq, lds, wid, lane); S.done(cur); }
#undef PG8_SA
#undef PG8_SB
#undef PG8_STAGE
#undef PG8_LDA
#undef PG8_LDB
#undef PG8_MMA
#undef PG8_WAIT_V
#undef PG8_WAIT_L
#undef PG8_BAR
#undef PG8_SCHED
}
}
#ifndef PG8_SP2
#define PG8_SP2 true
#endif
#ifndef PG8_ALIGN
#define PG8_ALIGN true
#endif

#define LAS __attribute__((address_space(3)))
typedef unsigned short bf16;
typedef float f32x4 __attribute__((ext_vector_type(4)));
typedef float f32x8 __attribute__((ext_vector_type(8)));
typedef short bf16x8 __attribute__((ext_vector_type(8)));
typedef unsigned u32x4 __attribute__((ext_vector_type(4)));
typedef unsigned u32x2 __attribute__((ext_vector_type(2)));

constexpr int DM = 1024, DFF = 2816, NGU = 5632, NIN = 4608, NMIX = 1536, NLAYER = 4;
constexpr int TT = 81920, THALF = 40960, PLD = NIN  , YLD = NMIX;
constexpr int W_IN_SRC = 4368;
constexpr float EPSN = 1e-6f;
constexpr int PC_LRUX = 0, PC_GATE = 512, PC_Z = 1024, PC_XBC = 1536, PC_Q = 2304, PC_K = 2816, PC_V = 3328, PC_G = 3840, PC_DT = 4352;

constexpr size_t al256(size_t x) { return (x + 255) & ~(size_t)255; }
constexpr size_t SZ_WGU = (size_t)NGU * DM * 2, SZ_WD = (size_t)DM * DFF * 2, SZ_WIN = (size_t)NIN * DM * 2, SZ_WOUT = (size_t)DM * NMIX * 2;
constexpr size_t WS_WGU1 = 0;
constexpr size_t WS_WD1 = WS_WGU1 + NLAYER * SZ_WGU;
constexpr size_t WS_WIN = WS_WD1 + NLAYER * SZ_WD;
constexpr size_t WS_WOUT = WS_WIN + NLAYER * SZ_WIN;
constexpr size_t WS_WGU2 = WS_WOUT + NLAYER * SZ_WOUT;
constexpr size_t WS_WD2 = WS_WGU2 + NLAYER * SZ_WGU;
constexpr size_t WS_XB = al256(WS_WD2 + NLAYER * SZ_WD);
constexpr size_t WS_SSQ = al256(WS_XB + (size_t)TT * DM * 2);
constexpr size_t WS_ROPE = al256(WS_SSQ + (size_t)TT * 16 * 4);
constexpr size_t WS_BIG = al256(WS_ROPE + (size_t)8192 * 64 * 4 * 2);
constexpr size_t WS_PROJ = WS_BIG;
constexpr size_t WS_Y = al256(WS_PROJ + (size_t)THALF * PLD * 2);
constexpr size_t WS_YB = al256(WS_Y + (size_t)THALF * YLD * 2);
constexpr size_t WS_CXB = al256(WS_YB + (size_t)THALF * YLD * 2);
constexpr size_t WS_BAR = al256(WS_CXB + (size_t)THALF * 768 * 2);
constexpr size_t WS_END1 = al256(WS_BAR + 16384);
constexpr size_t WS_H = WS_BIG;
constexpr size_t WS_END2 = al256(WS_H + (size_t)TT * DFF * 2);
constexpr size_t WS_NEED = WS_END1 > WS_END2 ? WS_END1 : WS_END2;

constexpr int LDS_BYTES = 147456;

__device__ __forceinline__ float bflo(unsigned w) { return __builtin_bit_cast(float, w << 16); }
__device__ __forceinline__ float bfhi(unsigned w) { return __builtin_bit_cast(float, w & 0xffff0000u); }
__device__ __forceinline__ float bf2f(bf16 b) { return __builtin_bit_cast(float, (unsigned)b << 16); }
__device__ __forceinline__ bf16 f2bf(float f) { unsigned u = __builtin_bit_cast(unsigned, f); return (bf16)((u + 0x7fffu + ((u >> 16) & 1u)) >> 16); }
__device__ __forceinline__ unsigned pk2(float lo, float hi) { return pg8::cvt_pk_bf16(lo, hi); }
__device__ __forceinline__ f32x8 unpack8(u32x4 w) { f32x8 o; o[0] = bflo(w.x); o[1] = bfhi(w.x); o[2] = bflo(w.y); o[3] = bfhi(w.y); o[4] = bflo(w.z); o[5] = bfhi(w.z); o[6] = bflo(w.w); o[7] = bfhi(w.w); return o; }
__device__ __forceinline__ u32x4 pack8(f32x8 v) { u32x4 w; w.x = pk2(v[0], v[1]); w.y = pk2(v[2], v[3]); w.z = pk2(v[4], v[5]); w.w = pk2(v[6], v[7]); return w; }
__device__ __forceinline__ f32x8 ld8f(const float* p) { const f32x4 a = *(const f32x4*)p, b = *(const f32x4*)(p + 4); f32x8 o; o[0] = a[0]; o[1] = a[1]; o[2] = a[2]; o[3] = a[3]; o[4] = b[0]; o[5] = b[1]; o[6] = b[2]; o[7] = b[3]; return o; }
__device__ __forceinline__ float sigm(float x) { return __builtin_amdgcn_rcpf(1.0f + __expf(-x)); }
__device__ __forceinline__ float siluf(float x) { return x * sigm(x); }
__device__ __forceinline__ float softplusf(float x) { return fmaxf(x, 0.f) + log1pf(__expf(-fabsf(x))); }
__device__ __forceinline__ float gelu_tanh(float x) { const float y = 0.7978845608028654f * (x + 0.044715f * x * x * x); const float t = 1.0f - 2.0f * __builtin_amdgcn_rcpf(1.0f + __expf(2.0f * y)); return 0.5f * x * (1.0f + t); }
__device__ __forceinline__ float wave_sum(float v) {
#pragma unroll
    for (int o = 1; o < 64; o <<= 1) v += __shfl_xor(v, o);
    return v;
}
__device__ __forceinline__ float row_rs(const float* ssq, size_t row) {
    const f32x4 a = *(const f32x4*)(ssq + row * 16), b = *(const f32x4*)(ssq + row * 16 + 4), c = *(const f32x4*)(ssq + row * 16 + 8), d = *(const f32x4*)(ssq + row * 16 + 12);
    const float s = ((a[0] + a[1]) + (a[2] + a[3])) + ((b[0] + b[1]) + (b[2] + b[3])) + ((c[0] + c[1]) + (c[2] + c[3])) + ((d[0] + d[1]) + (d[2] + d[3]));
    return rsqrtf(s * (1.0f / DM) + EPSN);
}
__device__ __forceinline__ int launder_tid() { int t = threadIdx.x; asm volatile("" : "+v"(t)); return t; }
__device__ __forceinline__ float row_rs4(const float* ssq, size_t row, int fq) {
    const f32x4 a = *(const f32x4*)(ssq + row * 16 + 4 * fq);
    float s = (a[0] + a[1]) + (a[2] + a[3]);
    s += __shfl_xor(s, 16); s += __shfl_xor(s, 32);
    return rsqrtf(s * (1.0f / DM) + EPSN);
}
#define MFMA16(a, b, c) __builtin_amdgcn_mfma_f32_16x16x32_bf16((a), (b), (c), 0, 0, 0)
__device__ __forceinline__ bf16x8 ldfrag(const LAS bf16* p) { return *(const LAS bf16x8*)p; }

struct EpiGU {
    static constexpr bool PERM = true, AFTER_DRAIN = false;
    bf16* H; const float* ssq;
    __device__ __forceinline__ void operator()(const pg8::f32x4 (&acc)[2][2][4][2], const pg8::Unit& u, int wr, int wc, int fr, int fq) const {
        const int row0 = u.pm * 256 + wr * 64 + fr, col0 = u.pn * 128 + wc * 32 + 8 * fq;
#pragma unroll
        for (int ai = 0; ai < 2; ++ai)
#pragma unroll
            for (int m = 0; m < 4; ++m) {
                const size_t row = (size_t)(row0 + ai * 128 + m * 16);
                const float rs = row_rs4(ssq, row, fq);
                const pg8::f32x4 g0 = acc[ai][0][m][0] * rs, g1 = acc[ai][0][m][1] * rs, u0 = acc[ai][1][m][0] * rs, u1 = acc[ai][1][m][1] * rs;
                u32x4 w;
                w.x = pk2(siluf(g0[0]) * u0[0], siluf(g0[1]) * u0[1]); w.y = pk2(siluf(g0[2]) * u0[2], siluf(g0[3]) * u0[3]);
                w.z = pk2(siluf(g1[0]) * u1[0], siluf(g1[1]) * u1[1]); w.w = pk2(siluf(g1[2]) * u1[2], siluf(g1[3]) * u1[3]);
                *(u32x4*)(H + row * DFF + col0) = w;
                asm volatile("" ::: "memory");
            }
    }
};
struct EpiProj {
    static constexpr bool PERM = true, AFTER_DRAIN = false;
    bf16* P; const float* ssq; int row_off; const float* rcos; const float* rsin;
    __device__ __forceinline__ void operator()(const pg8::f32x4 (&acc)[2][2][4][2], const pg8::Unit& u, int wr, int wc, int fr, int fq) const {
        const int row0 = u.pm * 256 + wr * 64 + fr, col0 = u.pn * 256 + wc * 32 + 8 * fq;
        if (u.pn >= 9 && u.pn <= 12) {
            const float ksc = u.pn >= 11 ? 0.08838834764831845f : 1.0f;
            const int d0 = 32 * (wc & 1) + 8 * fq, colr = u.pn * 256 + 128 * (wc >> 1) + d0;
#pragma unroll
            for (int ai = 0; ai < 2; ++ai)
#pragma unroll
                for (int m = 0; m < 4; ++m) {
                    const size_t row = (size_t)(row0 + ai * 128 + m * 16);
                    const int gr = (int)row + row_off, pos = gr < 65536 ? (gr & 8191) : (gr & 4095);
                    const float rs = row_rs4(ssq, (size_t)gr, fq) * ksc;
                    u32x4 w1, w2;
#pragma unroll
                    for (int n = 0; n < 2; ++n) {
                        const pg8::f32x4 cs = *(const pg8::f32x4*)(rcos + (size_t)pos * 64 + d0 + 4 * n), sn = *(const pg8::f32x4*)(rsin + (size_t)pos * 64 + d0 + 4 * n);
                        const pg8::f32x4 t1 = acc[ai][0][m][n] * rs, t2 = acc[ai][1][m][n] * rs;
                        const pg8::f32x4 o1 = t1 * cs - t2 * sn, o2 = t1 * sn + t2 * cs;
                        if (n == 0) { w1.x = pk2(o1[0], o1[1]); w1.y = pk2(o1[2], o1[3]); w2.x = pk2(o2[0], o2[1]); w2.y = pk2(o2[2], o2[3]); }
                        else { w1.z = pk2(o1[0], o1[1]); w1.w = pk2(o1[2], o1[3]); w2.z = pk2(o2[0], o2[1]); w2.w = pk2(o2[2], o2[3]); }
                    }
                    *(u32x4*)(P + row * PLD + colr) = w1; *(u32x4*)(P + row * PLD + colr + 64) = w2;
                    asm volatile("" ::: "memory");
                }
            return;
        }
#pragma unroll
        for (int ai = 0; ai < 2; ++ai)
#pragma unroll
            for (int m = 0; m < 4; ++m) {
                const size_t row = (size_t)(row0 + ai * 128 + m * 16);
                const float rs = row_rs4(ssq, row + row_off, fq);
#pragma unroll
                for (int bj = 0; bj < 2; ++bj) {
                    const pg8::f32x4 v0 = acc[ai][bj][m][0] * rs, v1 = acc[ai][bj][m][1] * rs;
                    u32x4 w; w.x = pk2(v0[0], v0[1]); w.y = pk2(v0[2], v0[3]); w.z = pk2(v1[0], v1[1]); w.w = pk2(v1[2], v1[3]);
                    *(u32x4*)(P + row * PLD + col0 + bj * 128) = w;
                }
                asm volatile("" ::: "memory");
            }
    }
};
struct EpiRes {
    static constexpr bool PERM = true, AFTER_DRAIN = false;
    float* X; bf16* XB; float* ssq; float coef; int row_off;
    __device__ __forceinline__ void operator()(const pg8::f32x4 (&acc)[2][2][4][2], const pg8::Unit& u, int wr, int wc, int fr, int fq) const {
        const int row0 = row_off + u.pm * 256 + wr * 64 + fr, col0 = u.pn * 256 + wc * 32 + 8 * fq;
#pragma unroll
        for (int ai = 0; ai < 2; ++ai)
#pragma unroll
            for (int m = 0; m < 4; ++m) {
                const size_t row = (size_t)(row0 + ai * 128 + m * 16);
                float s = 0.f;
#pragma unroll
                for (int bj = 0; bj < 2; ++bj) {
                    float* xp = X + row * DM + col0 + bj * 128;
                    pg8::f32x4 x0 = *(const pg8::f32x4*)xp, x1 = *(const pg8::f32x4*)(xp + 4);
                    x0 += acc[ai][bj][m][0] * coef; x1 += acc[ai][bj][m][1] * coef;
                    *(pg8::f32x4*)xp = x0; *(pg8::f32x4*)(xp + 4) = x1;
                    s += (x0[0] * x0[0] + x0[1] * x0[1]) + (x0[2] * x0[2] + x0[3] * x0[3]) + (x1[0] * x1[0] + x1[1] * x1[1]) + (x1[2] * x1[2] + x1[3] * x1[3]);
                    u32x4 w; w.x = pk2(x0[0], x0[1]); w.y = pk2(x0[2], x0[3]); w.z = pk2(x1[0], x1[1]); w.w = pk2(x1[2], x1[3]);
                    *(u32x4*)(XB + row * DM + col0 + bj * 128) = w;
                }
                s += __shfl_xor(s, 16); s += __shfl_xor(s, 32);
                if (fq == 0) ssq[row * 16 + u.pn * 4 + wc] = s;
                asm volatile("" ::: "memory");
            }
    }
};

__device__ __forceinline__ int colmap(int kind, int n) {
    if (kind == 0) return n;
    if (kind == 1) { const int t = n >> 8, w = n & 255; return w < 128 ? 128 * t + w : DFF + 128 * t + (w - 128); }
    if (n < 2304) return n;
    if (n < 3328) { const int t = n >> 8, w = n & 255, bj = w >> 7, o = w & 127; return 256 * t + 128 * (o >> 6) + (o & 63) + 64 * bj + 16; }
    return n < 4352 ? n + 16 : (n < 4368 ? n - 4352 + 2304 : -1);
}
__device__ __forceinline__ void transpose_item(const float* W, int K, int Nsrc, int Ndst, const float* kscale, bf16* WT, int kind, int item, int lane, LAS float* scr) {
    const int nblk = Ndst / 32, kb = item / nblk, nb = item % nblk, k0 = 64 * kb, n0 = 32 * nb;
    const int sc = colmap(kind, n0 + (lane & 31));
#pragma unroll 8
    for (int i = 0; i < 32; ++i) { const int kk = 2 * i + (lane >> 5); float v = 0.f; if (sc >= 0) { v = W[(size_t)(k0 + kk) * Nsrc + sc]; if (kscale) v *= kscale[k0 + kk]; } scr[kk * 33 + (lane & 31)] = v; }
    asm volatile("s_waitcnt lgkmcnt(0)" ::: "memory");
    const int c = lane & 7;
#pragma unroll
    for (int j = 0; j < 4; ++j) { const int n = (lane >> 3) + 8 * j; const LAS float* s = scr + (8 * c) * 33 + n;
        u32x4 o; o.x = pk2(s[0 * 33], s[1 * 33]); o.y = pk2(s[2 * 33], s[3 * 33]); o.z = pk2(s[4 * 33], s[5 * 33]); o.w = pk2(s[6 * 33], s[7 * 33]);
        *(u32x4*)(WT + (size_t)(n0 + n) * K + k0 + 8 * c) = o; }
    asm volatile("s_waitcnt lgkmcnt(0)" ::: "memory");
}

struct Args { const float* in[26]; float* out; unsigned char* ws; };
typedef const __attribute__((address_space(4))) Args* KArgsPtr;
__device__ __forceinline__ KArgsPtr kargs() { KArgsPtr p = (KArgsPtr)__builtin_amdgcn_kernarg_segment_ptr(); asm volatile("" : "+s"(p)); return p; }

__device__ __forceinline__ f32x8 conv8(const bf16* proj, int lrow, int pcol, int pos, int seqlen, const float* cw, int cw_ld, const float* cb, int ccol) {
    f32x8 acc = ld8f(cb + ccol);
#pragma unroll
    for (int k = 0; k < 4; ++k) {
        const int s = pos + k - 2;
        if (s >= 0 && s < seqlen) {
            const u32x4 raw = *(const u32x4*)(proj + (size_t)(lrow + k - 2) * PLD + pcol);
            acc += ld8f(cw + k * cw_ld + ccol) * unpack8(raw);
        }
    }
    return acc;
}

__device__ __forceinline__ void ret_item(LAS unsigned char* lds, const bf16* proj, bf16* yout, int gv, int vloc, int hd, int dir) {
    const int tid = launder_tid(), wid = __builtin_amdgcn_readfirstlane(tid >> 6), lane = tid & 63, fr = lane & 15, fq = lane >> 4;
    constexpr int LD = 136;
    LAS bf16* KN = (LAS bf16*)lds; LAS bf16* KTW = KN + 128 * LD; LAS bf16* VT = KTW + 128 * LD; LAS bf16* RT = VT + 128 * LD;
    const int seqlen = gv < 8 ? 8192 : 4096;
    const float l2g = log2f(1.0f - exp2f(-5.0f - (float)hd));
    const float cdec = exp2f(l2g * 128.0f);
    const int i0 = 4 * ((tid >> 2) & 31), c8 = 8 * ((tid & 3) + 4 * (tid >> 7)), qi = 16 * wid + fr;
    float wl[4];
#pragma unroll
    for (int r = 0; r < 4; ++r) wl[r] = exp2f(l2g * (float)(dir ? i0 + r : 127 - (i0 + r)));
    const float rsc = exp2f(l2g * (float)(dir ? 128 - qi : qi + 1));
    f32x4 R[8];
#pragma unroll
    for (int i = 0; i < 8; ++i) R[i] = (f32x4){0.f, 0.f, 0.f, 0.f};
    for (int i = tid; i < 128 * LD / 2; i += 512) ((LAS unsigned*)RT)[i] = 0u;
    u32x4 kraw[4], vraw[4], qraw[4];
#define RET_LOAD(CC) do { const int lr0_ = vloc * 8192 + (CC) * 128; \
        _Pragma("unroll") for (int r = 0; r < 4; ++r) { const bf16* rp_ = proj + (size_t)(lr0_ + i0 + r) * PLD + 128 * hd + c8; kraw[r] = *(const u32x4*)(rp_ + PC_K); vraw[r] = *(const u32x4*)(rp_ + PC_V); } \
        _Pragma("unroll") for (int ks = 0; ks < 4; ++ks) qraw[ks] = *(const u32x4*)(proj + (size_t)(lr0_ + qi) * PLD + PC_Q + 128 * hd + 32 * ks + 8 * fq); } while (0)
    RET_LOAD(dir ? 63 : 0);
    __syncthreads();
    for (int c = 0; c < 64; ++c) {
        const int cc = dir ? 63 - c : c;
        const int lrow0 = vloc * 8192 + cc * 128;
        const bool do_intra = ((cc & 1) == dir);
        bool next_reset = false;
        if (c < 63) { const int ncc = dir ? cc - 1 : cc + 1; const int np = (ncc * 128) % seqlen; next_reset = dir ? (np + 128 == seqlen) : (np == 0); }
        {
            if (do_intra) {
#pragma unroll
                for (int r = 0; r < 4; ++r) *(LAS u32x4*)(KN + (i0 + r) * LD + c8) = kraw[r];
            }
            LAS bf16* kt = KTW + c8 * LD + i0; LAS bf16* vt = VT + c8 * LD + i0;
#pragma unroll
            for (int m = 0; m < 4; ++m) {
                u32x2 we, wo;
                we.x = pk2(bflo(kraw[0][m]) * wl[0], bflo(kraw[1][m]) * wl[1]); we.y = pk2(bflo(kraw[2][m]) * wl[2], bflo(kraw[3][m]) * wl[3]);
                wo.x = pk2(bfhi(kraw[0][m]) * wl[0], bfhi(kraw[1][m]) * wl[1]); wo.y = pk2(bfhi(kraw[2][m]) * wl[2], bfhi(kraw[3][m]) * wl[3]);
                *(LAS u32x2*)(kt + (2 * m) * LD) = we; *(LAS u32x2*)(kt + (2 * m + 1) * LD) = wo;
                u32x2 ve, vo;
                ve.x = (vraw[0][m] & 0xffffu) | (vraw[1][m] << 16); ve.y = (vraw[2][m] & 0xffffu) | (vraw[3][m] << 16);
                vo.x = (vraw[0][m] >> 16) | (vraw[1][m] & 0xffff0000u); vo.y = (vraw[2][m] >> 16) | (vraw[3][m] & 0xffff0000u);
                *(LAS u32x2*)(vt + (2 * m) * LD) = ve; *(LAS u32x2*)(vt + (2 * m + 1) * LD) = vo;
            }
        }
        bf16x8 qf[4];
#pragma unroll
        for (int ks = 0; ks < 4; ++ks) qf[ks] = __builtin_bit_cast(bf16x8, qraw[ks]);
        if (c < 63) { const int ncc = dir ? cc - 1 : cc + 1; RET_LOAD(ncc); }
        __syncthreads();
        unsigned sp[8][2];
        if (do_intra) {
#pragma unroll
            for (int ct = 0; ct < 8; ++ct) {
                f32x4 a = (f32x4){0.f, 0.f, 0.f, 0.f};
#pragma unroll
                for (int ks = 0; ks < 4; ++ks) a = MFMA16(ldfrag(KN + (16 * ct + fr) * LD + 32 * ks + 8 * fq), qf[ks], a);
                const int j0 = 16 * ct + 4 * fq;
                float dv[4];
#pragma unroll
                for (int e = 0; e < 4; ++e) { const int dd = qi - (j0 + e); dv[e] = a[e] * exp2f(l2g * (float)(dd < 0 ? -dd : dd)); }
                sp[ct][0] = pk2(dv[0], dv[1]); sp[ct][1] = pk2(dv[2], dv[3]);
            }
            __syncthreads();
#pragma unroll
            for (int ct = 0; ct < 8; ++ct) { u32x2 w; w.x = sp[ct][0]; w.y = sp[ct][1]; *(LAS u32x2*)(KN + qi * LD + 16 * ct + 4 * fq) = w; }
        }
        {
            f32x4 Y[8];
#pragma unroll
            for (int ct = 0; ct < 8; ++ct) {
                f32x4 a = (f32x4){0.f, 0.f, 0.f, 0.f};
#pragma unroll
                for (int ks = 0; ks < 4; ++ks) a = MFMA16(ldfrag(RT + (16 * ct + fr) * LD + 32 * ks + 8 * fq), qf[ks], a);
                Y[ct] = a * rsc;
            }
            if (do_intra) {
#pragma unroll
                for (int ks = 0; ks < 4; ++ks) {
                    const bf16x8 pf = ldfrag(KN + qi * LD + 32 * ks + 8 * fq);
#pragma unroll
                    for (int ct = 0; ct < 8; ++ct) Y[ct] = MFMA16(ldfrag(VT + (16 * ct + fr) * LD + 32 * ks + 8 * fq), pf, Y[ct]);
                }
            }
            bf16* yo = yout + (size_t)(lrow0 + qi) * YLD + 1024 + 128 * hd + 4 * fq;
#pragma unroll
            for (int ct = 0; ct < 8; ++ct) { u32x2 w; w.x = pk2(Y[ct][0], Y[ct][1]); w.y = pk2(Y[ct][2], Y[ct][3]); *(u32x2*)(yo + 16 * ct) = w; }
        }
#pragma unroll
        for (int ct = 0; ct < 8; ++ct) R[ct] *= cdec;
#pragma unroll
        for (int ks = 0; ks < 4; ++ks) {
            const bf16x8 kf = ldfrag(KTW + (16 * wid + fr) * LD + 32 * ks + 8 * fq);
#pragma unroll
            for (int ct = 0; ct < 8; ++ct) R[ct] = MFMA16(kf, ldfrag(VT + (16 * ct + fr) * LD + 32 * ks + 8 * fq), R[ct]);
        }
        if (next_reset) {
#pragma unroll
            for (int ct = 0; ct < 8; ++ct) R[ct] = (f32x4){0.f, 0.f, 0.f, 0.f};
        }
        __syncthreads();
#pragma unroll
        for (int ct = 0; ct < 8; ++ct) { u32x2 w; w.x = pk2(R[ct][0], R[ct][1]); w.y = pk2(R[ct][2], R[ct][3]); *(LAS u32x2*)(RT + (16 * ct + fr) * LD + 16 * wid + 4 * fq) = w; }
    }
#undef RET_LOAD
    __syncthreads();
}

__device__ __forceinline__ void ssd_item(LAS unsigned char* lds, const bf16* proj, const bf16* cxb, bf16* yout, const float* dt_bias, const float* a_log, const float* dskip,
                                         int gv, int vloc, int hh, int dir) {
    const int tid = launder_tid(), wid = __builtin_amdgcn_readfirstlane(tid >> 6), lane = tid & 63, fr = lane & 15, fq = lane >> 4;
    constexpr int LDL = 136, LDS_ = 72;
    LAS bf16* XST = (LAS bf16*)lds;
    LAS bf16* CN = XST + 64 * LDL;
    LAS bf16* BN = CN + 128 * LDS_;
    LAS bf16* BTW = BN + 128 * LDS_;
    LAS bf16* PP = BTW + 64 * LDL;
    LAS bf16* HL = PP + 128 * LDL;
    LAS float* DT = (LAS float*)(HL + 64 * LDS_);
    LAS float* ACUM = DT + 128;
    LAS float* CWL = ACUM + 128;
    const int seqlen = gv < 8 ? 8192 : 4096, grp = hh >> 2;
    const float aneg = -__expf(a_log[dir * 8 + hh]), dtb = dt_bias[dir * 8 + hh], dsk = dskip[hh];
    const int cg8 = tid % 24, rb = tid / 24, sec = cg8 >> 3, c8 = (cg8 & 7) * 8, i0 = 8 * rb;
    const int xc = sec == 0 ? 64 * hh + c8 : (sec == 1 ? 512 + 64 * grp + c8 : 640 + 64 * grp + c8);
    const bool stager = tid < 384;
    f32x4 Hc[2];
    Hc[0] = (f32x4){0.f, 0.f, 0.f, 0.f}; Hc[1] = (f32x4){0.f, 0.f, 0.f, 0.f};
    for (int i = tid; i < 64 * LDS_ / 2; i += 512) ((LAS unsigned*)HL)[i] = 0u;
    u32x4 raw[8]; float dtraw = 0.f;
#define SSD_LOAD(CC) do { const int lr0_ = vloc * 8192 + (CC) * 128; \
        if (stager) { _Pragma("unroll") for (int r = 0; r < 8; ++r) raw[r] = *(const u32x4*)(cxb + (size_t)(lr0_ + i0 + r) * 768 + xc); } \
        if (tid < 128) dtraw = bf2f(proj[(size_t)(lr0_ + tid) * PLD + PC_DT + dir * 8 + hh]); } while (0)
    SSD_LOAD(dir ? 63 : 0);
    __syncthreads();
    for (int c = 0; c < 64; ++c) {
        const int cc = dir ? 63 - c : c;
        const int lrow0 = vloc * 8192 + cc * 128;
        bool next_reset = false;
        if (c < 63) { const int ncc = dir ? cc - 1 : cc + 1; const int np = (ncc * 128) % seqlen; next_reset = dir ? (np + 128 == seqlen) : (np == 0); }
        if (tid < 128) DT[tid] = softplusf(dtraw + dtb);
        __syncthreads();
        float tot;
        {
            const float x0 = DT[2 * lane] * aneg, x1 = DT[2 * lane + 1] * aneg;
            float s = x0 + x1;
#pragma unroll
            for (int o = 1; o < 64; o <<= 1) { const float t = __shfl_up(s, o); if (lane >= o) s += t; }
            tot = __shfl(s, 63);
            const float p1 = s, p0 = s - x1;
            if (dir == 0) { ACUM[2 * lane] = p0; ACUM[2 * lane + 1] = p1; }
            else { ACUM[2 * lane] = tot - p0 + x0; ACUM[2 * lane + 1] = tot - p1 + x1; }
        }
        if (stager) {
#pragma unroll
            for (int hc = 0; hc < 2; ++hc) {
                u32x2 pv[4];
#pragma unroll
                for (int od = 0; od < 8; ++od) {
                    u32x2 pk; pk.x = raw[od][2 * hc]; pk.y = raw[od][2 * hc + 1];
                    if (sec == 0) pv[od & 3] = pk;
                    else if (sec == 1) { *(LAS u32x2*)(BN + (i0 + od) * LDS_ + c8 + 4 * hc) = pk; const float wr = __expf(tot - ACUM[i0 + od]) * DT[i0 + od];
                        u32x2 pw; pw.x = pk2(bflo(pk.x) * wr, bfhi(pk.x) * wr); pw.y = pk2(bflo(pk.y) * wr, bfhi(pk.y) * wr); pv[od & 3] = pw; }
                    else *(LAS u32x2*)(CN + (i0 + od) * LDS_ + c8 + 4 * hc) = pk;
                    if ((od & 3) == 3 && sec != 2) {
                        LAS bf16* dstT = (sec == 0 ? XST : BTW) + (c8 + 4 * hc) * LDL + i0 + (od - 3);
#pragma unroll
                        for (int m = 0; m < 2; ++m) {
                            u32x2 we, wo;
                            we.x = (pv[0][m] & 0xffffu) | (pv[1][m] << 16); we.y = (pv[2][m] & 0xffffu) | (pv[3][m] << 16);
                            wo.x = (pv[0][m] >> 16) | (pv[1][m] & 0xffff0000u); wo.y = (pv[2][m] >> 16) | (pv[3][m] & 0xffff0000u);
                            *(LAS u32x2*)(dstT + (2 * m) * LDL) = we; *(LAS u32x2*)(dstT + (2 * m + 1) * LDL) = wo;
                        }
                    }
                }
            }
        }
        if (c < 63) { const int ncc = dir ? cc - 1 : cc + 1; SSD_LOAD(ncc); }
        __syncthreads();
        const int qi = 16 * wid + fr;
        bf16x8 cf[2];
        cf[0] = ldfrag(CN + qi * LDS_ + 8 * fq); cf[1] = ldfrag(CN + qi * LDS_ + 32 + 8 * fq);
        const float aci = ACUM[qi];
#pragma unroll
        for (int ct = 0; ct < 8; ++ct) {
            f32x4 a = (f32x4){0.f, 0.f, 0.f, 0.f};
#pragma unroll
            for (int ks = 0; ks < 2; ++ks) a = MFMA16(ldfrag(BN + (16 * ct + fr) * LDS_ + 32 * ks + 8 * fq), cf[ks], a);
            const int j0 = 16 * ct + 4 * fq;
            const f32x4 acj = *(const LAS f32x4*)(ACUM + j0), dtj = *(const LAS f32x4*)(DT + j0);
            float wv[4];
#pragma unroll
            for (int e = 0; e < 4; ++e) { const int j = j0 + e; const bool ok = dir ? (j >= qi) : (j <= qi); wv[e] = ok ? a[e] * __expf(aci - acj[e]) * dtj[e] : 0.f; }
            u32x2 w; w.x = pk2(wv[0], wv[1]); w.y = pk2(wv[2], wv[3]);
            *(LAS u32x2*)(PP + qi * LDL + j0) = w;
        }
        {
            const float ea = __expf(aci);
            f32x4 Y[4];
#pragma unroll
            for (int pt = 0; pt < 4; ++pt) {
                f32x4 a = (f32x4){0.f, 0.f, 0.f, 0.f};
#pragma unroll
                for (int ks = 0; ks < 2; ++ks) a = MFMA16(ldfrag(HL + (16 * pt + fr) * LDS_ + 32 * ks + 8 * fq), cf[ks], a);
                Y[pt] = a * ea;
            }
#pragma unroll
            for (int ks = 0; ks < 4; ++ks) {
                const bf16x8 pf = ldfrag(PP + qi * LDL + 32 * ks + 8 * fq);
#pragma unroll
                for (int pt = 0; pt < 4; ++pt) Y[pt] = MFMA16(ldfrag(XST + (16 * pt + fr) * LDL + 32 * ks + 8 * fq), pf, Y[pt]);
            }
            bf16* yo = yout + (size_t)(lrow0 + qi) * YLD + 512 + 64 * hh + 4 * fq;
#pragma unroll
            for (int pt = 0; pt < 4; ++pt) {
                if (dir == 0) {
#pragma unroll
                    for (int e = 0; e < 4; ++e) Y[pt][e] += dsk * bf2f(XST[(16 * pt + 4 * fq + e) * LDL + qi]);
                }
                u32x2 w; w.x = pk2(Y[pt][0], Y[pt][1]); w.y = pk2(Y[pt][2], Y[pt][3]); *(u32x2*)(yo + 16 * pt) = w;
            }
        }
        {
            const float et = __expf(tot);
            Hc[0] *= et; Hc[1] *= et;
#pragma unroll
            for (int ks = 0; ks < 4; ++ks) {
                const bf16x8 xf = ldfrag(XST + (16 * (wid & 3) + fr) * LDL + 32 * ks + 8 * fq);
#pragma unroll
                for (int j2 = 0; j2 < 2; ++j2) Hc[j2] = MFMA16(ldfrag(BTW + (16 * (2 * (wid >> 2) + j2) + fr) * LDL + 32 * ks + 8 * fq), xf, Hc[j2]);
            }
            if (next_reset) { Hc[0] = (f32x4){0.f, 0.f, 0.f, 0.f}; Hc[1] = (f32x4){0.f, 0.f, 0.f, 0.f}; }
        }
        __syncthreads();
#pragma unroll
        for (int j2 = 0; j2 < 2; ++j2) { u32x2 w; w.x = pk2(Hc[j2][0], Hc[j2][1]); w.y = pk2(Hc[j2][2], Hc[j2][3]);
            *(LAS u32x2*)(HL + (16 * (wid & 3) + fr) * LDS_ + 16 * (2 * (wid >> 2) + j2) + 4 * fq) = w; }
    }
#undef SSD_LOAD
    __syncthreads();
}

__device__ __forceinline__ void lru_item(LAS unsigned char* lds, const bf16* proj, bf16* yout, const float* cw, const float* cb, const float* w_a, const float* b_a, const float* w_i, const float* b_i,
                                         const float* lam, int gv, int vloc, int nb, int dir) {
    const int tid = launder_tid(), wid = __builtin_amdgcn_readfirstlane(tid >> 6), lane = tid & 63, fr = lane & 15, fq = lane >> 4;
    constexpr int LDX = 72;
    LAS bf16* XCB = (LAS bf16*)lds;
    LAS bf16* WT = XCB + 128 * LDX;
    LAS float* AA = (LAS float*)(WT + 128 * LDX);
    LAS float* UU = AA + 128 * 64;
    LAS float* AGG = UU + 128 * 64;
    LAS float* CARRY = AGG + 8 * 64 * 2;
    LAS float* BA = CARRY + 128;
    LAS float* BI = BA + 64;
    LAS float* SP = BI + 64;
    const int seqlen = gv < 8 ? 8192 : 4096;
    for (int idx = tid; idx < 8192; idx += 512) {
        const int mat = idx >> 12, rem = idx & 4095, i = rem >> 6, j = rem & 63;
        const float* w = (mat ? w_i : w_a) + (size_t)((dir * 8 + nb) * 64 + i) * 64 + j;
        WT[(64 * mat + j) * LDX + i] = f2bf(*w);
    }
    if (tid < 64) { CARRY[tid] = 0.f; CARRY[64 + tid] = 0.f; BA[tid] = b_a[dir * 512 + 64 * nb + tid]; BI[tid] = b_i[dir * 512 + 64 * nb + tid]; SP[tid] = 8.0f * softplusf(-lam[dir * 512 + 64 * nb + tid]); }
    const int c8 = (tid & 7) * 8, i0 = 2 * (tid >> 3), ccol = 64 * nb + c8;
    const f32x8 w0 = ld8f(cw + 0 * 512 + ccol), w1 = ld8f(cw + 1 * 512 + ccol), w2 = ld8f(cw + 2 * 512 + ccol), w3 = ld8f(cw + 3 * 512 + ccol), bb = ld8f(cb + ccol);
    u32x4 raw[5];
#define LRU_LOAD(CC) do { const int lr0_ = vloc * 8192 + (CC) * 128, p0_ = ((CC) * 128) % seqlen; \
        _Pragma("unroll") for (int r = 0; r < 5; ++r) { const int s_ = p0_ + i0 - 2 + r; raw[r] = (u32x4){0u, 0u, 0u, 0u}; \
            if (s_ >= 0 && s_ < seqlen) raw[r] = *(const u32x4*)(proj + (size_t)(lr0_ + i0 - 2 + r) * PLD + PC_LRUX + ccol); } } while (0)
    LRU_LOAD(dir ? 63 : 0);
    __syncthreads();
    for (int c = 0; c < 64; ++c) {
        const int cc = dir ? 63 - c : c;
        const int lrow0 = vloc * 8192 + cc * 128;
        bool next_reset = false;
        if (c < 63) { const int ncc = dir ? cc - 1 : cc + 1; const int np = (ncc * 128) % seqlen; next_reset = dir ? (np + 128 == seqlen) : (np == 0); }
#pragma unroll
        for (int r = 0; r < 2; ++r) {
            const f32x8 v = bb + w0 * unpack8(raw[r]) + w1 * unpack8(raw[r + 1]) + w2 * unpack8(raw[r + 2]) + w3 * unpack8(raw[r + 3]);
            *(LAS u32x4*)(XCB + (i0 + r) * LDX + c8) = pack8(v);
        }
        if (c < 63) { const int ncc = dir ? cc - 1 : cc + 1; LRU_LOAD(ncc); }
        __syncthreads();
        const int t = 16 * wid + fr;
        {
            bf16x8 xf[2];
            xf[0] = ldfrag(XCB + t * LDX + 8 * fq); xf[1] = ldfrag(XCB + t * LDX + 32 + 8 * fq);
            f32x4 Gt[8];
#pragma unroll
            for (int ct = 0; ct < 8; ++ct) {
                f32x4 a = (f32x4){0.f, 0.f, 0.f, 0.f};
#pragma unroll
                for (int ks = 0; ks < 2; ++ks) a = MFMA16(ldfrag(WT + (16 * ct + fr) * LDX + 32 * ks + 8 * fq), xf[ks], a);
                Gt[ct] = a;
            }
#pragma unroll
            for (int ct = 0; ct < 4; ++ct) {
                const int c0 = 16 * ct + 4 * fq;
                const f32x4 ba = *(const LAS f32x4*)(BA + c0), bi = *(const LAS f32x4*)(BI + c0), sp = *(const LAS f32x4*)(SP + c0);
                const u32x2 xw = *(const LAS u32x2*)(XCB + t * LDX + c0);
                const float xv[4] = {bflo(xw.x), bfhi(xw.x), bflo(xw.y), bfhi(xw.y)};
                f32x4 av, uv;
#pragma unroll
                for (int e = 0; e < 4; ++e) {
                    const float r = sigm(Gt[ct][e] + ba[e]), ig = sigm(Gt[ct + 4][e] + bi[e]);
                    const float la = -r * sp[e];
                    const float a = __expf(la);
                    av[e] = a;
                    uv[e] = sqrtf(fmaxf((1.0f - a) * (1.0f + a), 0.f)) * ig * xv[e];
                }
                *(LAS f32x4*)(AA + t * 64 + c0) = av; *(LAS f32x4*)(UU + t * 64 + c0) = uv;
            }
        }
        __syncthreads();
        {
            const int ch = tid & 63, seg = tid >> 6;
            float Pp = 1.f, h = 0.f;
#pragma unroll
            for (int k = 0; k < 16; ++k) { const int o = seg * 16 + k, tt = dir ? 127 - o : o; const float a = AA[tt * 64 + ch], u = UU[tt * 64 + ch]; h = a * h + u; Pp *= a; }
            AGG[(seg * 64 + ch) * 2] = Pp; AGG[(seg * 64 + ch) * 2 + 1] = h;
            __syncthreads();
            float cin = CARRY[(c & 1) * 64 + ch];
            for (int s = 0; s < seg; ++s) cin = AGG[(s * 64 + ch) * 2] * cin + AGG[(s * 64 + ch) * 2 + 1];
            h = cin;
            bf16* yo = yout + (size_t)lrow0 * YLD + 64 * nb + ch;
#pragma unroll
            for (int k = 0; k < 16; ++k) { const int o = seg * 16 + k, tt = dir ? 127 - o : o; const float a = AA[tt * 64 + ch], u = UU[tt * 64 + ch]; h = a * h + u; yo[(size_t)tt * YLD] = f2bf(h); }
            if (seg == 7) CARRY[((c + 1) & 1) * 64 + ch] = next_reset ? 0.f : h;
        }
    }
#undef LRU_LOAD
    __syncthreads();
}

__device__ __forceinline__ void conv_prepass(const bf16* proj, bf16* cxb, const float* cw, const float* cb, int sub, int bx, int G) {
    const int tid = launder_tid();
    for (int id = bx * 512 + tid; id < 96 * (THALF / 32); id += G * 512) {
        const int cgp = id % 96, seg = id / 96, xc = 8 * cgp;
        const int row0 = seg * 32, gv = sub * 5 + (row0 >> 13), seqlen = gv < 8 ? 8192 : 4096, posb = row0 % seqlen;
#pragma unroll 1
        for (int blk = 0; blk < 4; ++blk) {
            const int r0 = row0 + 8 * blk, p0 = posb + 8 * blk;
            u32x4 raw[11];
#pragma unroll
            for (int r = 0; r < 11; ++r) { const int s_ = p0 - 2 + r; raw[r] = (u32x4){0u, 0u, 0u, 0u}; if (s_ >= 0 && s_ < seqlen) raw[r] = *(const u32x4*)(proj + (size_t)(r0 - 2 + r) * PLD + PC_XBC + xc); }
#pragma unroll
            for (int hc = 0; hc < 2; ++hc) {
                const int cl = xc + 4 * hc;
                const f32x4 w0 = *(const f32x4*)(cw + 0 * 768 + cl), w1 = *(const f32x4*)(cw + 1 * 768 + cl), w2 = *(const f32x4*)(cw + 2 * 768 + cl), w3 = *(const f32x4*)(cw + 3 * 768 + cl), bb = *(const f32x4*)(cb + cl);
                f32x4 ring[4] = {bb, bb, bb, bb};
#pragma unroll
                for (int r = 0; r < 11; ++r) {
                    const unsigned xa = raw[r][2 * hc], xb = raw[r][2 * hc + 1];
                    const f32x4 x = (f32x4){bflo(xa), bfhi(xa), bflo(xb), bfhi(xb)};
                    if (r <= 7) ring[r & 3] += w0 * x;
                    if (r >= 1 && r <= 8) ring[(r - 1) & 3] += w1 * x;
                    if (r >= 2 && r <= 9) ring[(r - 2) & 3] += w2 * x;
                    if (r >= 3) {
                        const int od = r - 3;
                        f32x4 t = ring[od & 3] + w3 * x;
                        ring[od & 3] = bb;
#pragma unroll
                        for (int e = 0; e < 4; ++e) t[e] = siluf(t[e]);
                        u32x2 pk; pk.x = pk2(t[0], t[1]); pk.y = pk2(t[2], t[3]);
                        *(u32x2*)(cxb + (size_t)(r0 + od) * 768 + cl) = pk;
                    }
                }
            }
        }
    }
}

constexpr int I_GU = (DM / 64) * (NGU / 32), I_D = (DFF / 64) * (DM / 32), I_IN = (DM / 64) * (NIN / 32), I_OUT = (NMIX / 64) * (DM / 32);
constexpr int I_LAYER = 2 * I_GU + 2 * I_D + I_IN + I_OUT;
__device__ __forceinline__ void convert_item(KArgsPtr KA, unsigned char* ws, int l, int r, int lane, LAS float* scr) {
    if (r < I_GU) { transpose_item(KA->in[3] + (size_t)l * DM * NGU, DM, NGU, NGU, KA->in[2] + l * DM, (bf16*)(ws + WS_WGU1 + l * SZ_WGU), 1, r, lane, scr); return; } r -= I_GU;
    if (r < I_GU) { transpose_item(KA->in[23] + (size_t)l * DM * NGU, DM, NGU, NGU, KA->in[22] + l * DM, (bf16*)(ws + WS_WGU2 + l * SZ_WGU), 1, r, lane, scr); return; } r -= I_GU;
    if (r < I_D) { transpose_item(KA->in[4] + (size_t)l * DFF * DM, DFF, DM, DM, nullptr, (bf16*)(ws + WS_WD1 + l * SZ_WD), 0, r, lane, scr); return; } r -= I_D;
    if (r < I_D) { transpose_item(KA->in[24] + (size_t)l * DFF * DM, DFF, DM, DM, nullptr, (bf16*)(ws + WS_WD2 + l * SZ_WD), 0, r, lane, scr); return; } r -= I_D;
    if (r < I_IN) { transpose_item(KA->in[6] + (size_t)l * DM * W_IN_SRC, DM, W_IN_SRC, NIN, KA->in[5] + l * DM, (bf16*)(ws + WS_WIN + l * SZ_WIN), 2, r, lane, scr); return; } r -= I_IN;
    transpose_item(KA->in[21] + (size_t)l * NMIX * DM, NMIX, DM, DM, nullptr, (bf16*)(ws + WS_WOUT + l * SZ_WOUT), 0, r, lane, scr);
}

#define XB_TMO      128
#define XB_XCNT(j)  (256  + 64 * (j))
#define XB_XSUB(j)  (1280 + 64 * (j))
#define XB_XGEN(j)  (2304 + 64 * (j))
#define XB_TOP      3328
#define XB_TOPGEN   3392
#define XCD_BAR_WORDS 3456
#define XB_SPIN_CAP (1u << 18)

__device__ __forceinline__ unsigned xb_ld(unsigned* p)              { return __hip_atomic_load(p, __ATOMIC_RELAXED, __HIP_MEMORY_SCOPE_AGENT); }
__device__ __forceinline__ unsigned xb_add(unsigned* p, unsigned v) { return __hip_atomic_fetch_add(p, v, __ATOMIC_RELAXED, __HIP_MEMORY_SCOPE_AGENT); }
__device__ __forceinline__ unsigned xb_xcc_id() { return (unsigned)__builtin_amdgcn_s_getreg((3 << 11) | 20) & 0xFu; }
#define XB_SPIN(cond, bar) do { unsigned _sp = 0; while (cond) { __builtin_amdgcn_s_sleep(1); \
    if ((++_sp & 255u) == 0u) { if (xb_ld(&(bar)[XB_TMO])) break; if (_sp > XB_SPIN_CAP) { atomicAdd(&(bar)[XB_TMO], 1u); break; } } } } while (0)

struct XcdBarrier {
    unsigned* bar; unsigned x;
    volatile LAS unsigned* st;
};

__device__ __forceinline__ XcdBarrier xcd_barrier_post(unsigned* bar, volatile LAS unsigned* st) {
    XcdBarrier b; b.bar = bar; b.x = xb_xcc_id(); b.st = st;
    if (threadIdx.x == 0) (void)xb_add(&bar[XB_XCNT(b.x)], 1u);
    return b;
}
__device__ __forceinline__ void xcd_barrier_complete(unsigned* bar, unsigned x, unsigned& nloc, unsigned& nx) {
    const unsigned G = gridDim.x * gridDim.y * gridDim.z;
    unsigned sum, cnt, mine, sp = 0u;
    for (;;) {
        sum = 0u; cnt = 0u; mine = 0u;
#pragma unroll
        for (unsigned j = 0; j < 16; ++j) { const unsigned c = xb_ld(&bar[XB_XCNT(j)]); sum += c; cnt += (c > 0u) ? 1u : 0u; mine = (j == x) ? c : mine; }
        if (sum == G) break;
        __builtin_amdgcn_s_sleep(1);
        if ((++sp & 255u) == 0u) { if (xb_ld(&bar[XB_TMO])) break; if (sp > XB_SPIN_CAP) { atomicAdd(&bar[XB_TMO], 1u); break; } }
    }
    nloc = mine > 0u ? mine : 1u; nx = cnt > 0u ? cnt : 1u;
}

__device__ __forceinline__ void xcd_barrier(const XcdBarrier& b) {
    asm volatile("s_waitcnt vmcnt(0)" ::: "memory");
    __syncthreads();
    if (threadIdx.x == 0) {
        unsigned* bar = b.bar;
        __builtin_amdgcn_s_waitcnt(0);
        unsigned nloc = b.st[0], nx = b.st[1];
        if (nloc == 0u) { xcd_barrier_complete(bar, b.x, nloc, nx); b.st[0] = nloc; b.st[1] = nx; }
        const unsigned old = xb_add(&bar[XB_XSUB(b.x)], 1u);
        const unsigned gen = old / nloc;
        if (old + 1u == (gen + 1u) * nloc) {
            __builtin_amdgcn_fence(__ATOMIC_RELEASE, "agent");
            asm volatile("s_waitcnt vmcnt(0)" ::: "memory");
            const unsigned og = xb_add(&bar[XB_TOP], 1u);
            const unsigned tg = og / nx;
            if (og + 1u == (tg + 1u) * nx) xb_add(&bar[XB_TOPGEN], 1u);
            else XB_SPIN(xb_ld(&bar[XB_TOPGEN]) == tg, bar);
            __builtin_amdgcn_fence(__ATOMIC_ACQUIRE, "agent");
            xb_add(&bar[XB_XGEN(b.x)], 1u);
            asm volatile("s_waitcnt vmcnt(0)" ::: "memory");
        } else {
            XB_SPIN(xb_ld(&bar[XB_XGEN(b.x)]) == gen, bar);
            __builtin_amdgcn_fence(__ATOMIC_ACQUIRE, "agent");
            asm volatile("s_waitcnt vmcnt(0)" ::: "memory");
        }
    }
    __syncthreads();
}


__global__ void __launch_bounds__(512, 2) mega_fwd(Args args) {
    extern __shared__ __attribute__((aligned(16))) unsigned char lds_raw[];
    LAS unsigned char* lds = (LAS unsigned char*)lds_raw;
    cg::grid_group grid = cg::this_grid();
#define CG_SYNC() do { asm volatile("s_waitcnt vmcnt(0) lgkmcnt(0)" ::: "memory"); __syncthreads(); grid.sync(); } while (0)
    volatile LAS unsigned* xb_st = (volatile LAS unsigned*)((LAS unsigned char*)lds_raw + LDS_BYTES - 64);
    if (threadIdx.x == 0) { xb_st[0] = 0u; xb_st[1] = 0u; }
    __syncthreads();
    const XcdBarrier xbar = xcd_barrier_post((unsigned*)(kargs()->ws + WS_BAR), xb_st);
#define GRID_SYNC() xcd_barrier(xbar)
    const int wid = __builtin_amdgcn_readfirstlane(launder_tid() >> 6), G = gridDim.x, bx = blockIdx.x;
    unsigned char* ws; float* X;
    { KArgsPtr KA0 = kargs(); ws = KA0->ws; X = KA0->out; }
    bf16* XB = (bf16*)(ws + WS_XB); float* SSQ = (float*)(ws + WS_SSQ);
    float* RCOS = (float*)(ws + WS_ROPE); float* RSIN = RCOS + 8192 * 64;
    bf16* PROJ = (bf16*)(ws + WS_PROJ); bf16* YF = (bf16*)(ws + WS_Y); bf16* YBK = (bf16*)(ws + WS_YB); bf16* HB = (bf16*)(ws + WS_H);
    const int gw = bx * 8 + wid, NGW = G * 8;

    {
        KArgsPtr KA = kargs();
        const int tid = launder_tid(), lane = tid & 63;
        LAS float* scr = (LAS float*)(lds + wid * 16384);
        for (int it = gw; it < I_LAYER; it += NGW) convert_item(KA, ws, 0, it, lane, scr);
        for (int m = gw; m < TT; m += NGW) {
            const float* src = m < 65536 ? KA->in[0] + (size_t)m * DM : KA->in[1] + (size_t)(m - 65536) * DM;
            float s = 0.f;
#pragma unroll
            for (int j = 0; j < 4; ++j) {
                const f32x4 v = *(const f32x4*)(src + 256 * j + 4 * lane);
                *(f32x4*)(X + (size_t)m * DM + 256 * j + 4 * lane) = v;
                u32x2 w; w.x = pk2(v[0], v[1]); w.y = pk2(v[2], v[3]);
                *(u32x2*)(XB + (size_t)m * DM + 256 * j + 4 * lane) = w;
                s += (v[0] * v[0] + v[1] * v[1]) + (v[2] * v[2] + v[3] * v[3]);
            }
            s = wave_sum(s);
            if (lane < 16) SSQ[(size_t)m * 16 + lane] = lane == 0 ? s : 0.f;
        }
        for (int i = bx * 512 + tid; i < 8192 * 64; i += G * 512) {
            const int pos = i >> 6, f = i & 63;
            const float inv = 1.0f / powf(10000.0f, (float)(2 * f) / 128.0f);
            const float ang = (float)pos * inv;
            RCOS[i] = cosf(ang); RSIN[i] = sinf(ang);
        }
    }
    CG_SYNC();

    for (int l = 0; l < NLAYER; ++l) {
        for (int st = 0; st < 3; ++st) {
            const int nsub = st == 1 ? 2 : 1;
            for (int sub = 0; sub < nsub; ++sub) {
                if (st != 1) {
                    const bf16* Wgu = (const bf16*)(ws + (st == 0 ? WS_WGU1 : WS_WGU2) + l * SZ_WGU);
                    pg8::Gemm g{XB, Wgu, TT, NGU, DM}; pg8::StaticOrder S; S.init(TT, NGU, G, bx);
                    EpiGU E{HB, SSQ};
#ifndef NO_GU
                    pg8::gemm_phase<EpiGU, pg8::StaticOrder, PG8_ALIGN, PG8_SP2>(lds, g, S, E);
#endif
                } else {
                    const bf16* Win = (const bf16*)(ws + WS_WIN + l * SZ_WIN);
                    pg8::Gemm g{XB + (size_t)sub * THALF * DM, Win, THALF, NIN, DM}; pg8::StaticOrder S; S.init(THALF, NIN, G, bx);
                    EpiProj E{PROJ, SSQ, sub * THALF, RCOS, RSIN};
#ifndef NO_PROJ
                    pg8::gemm_phase<EpiProj, pg8::StaticOrder, PG8_ALIGN, PG8_SP2>(lds, g, S, E);
#endif
                }
                GRID_SYNC();
                if (st == 1) {
                    bf16* CXB = (bf16*)(ws + WS_CXB);
                    { KArgsPtr KA = kargs(); conv_prepass(PROJ, CXB, KA->in[14] + (size_t)l * 4 * 768, KA->in[15] + l * 768, sub, bx, G); }
                    GRID_SYNC();
                    if (bx >= 200 && l + 1 < NLAYER) {
                        KArgsPtr KA = kargs();
                        const int tid = launder_tid(), lane = tid & 63, wv = __builtin_amdgcn_readfirstlane(tid >> 6);
                        LAS float* scr = (LAS float*)(lds + wv * 16384);
                        const int lo = sub * (I_LAYER / 2), hi = lo + I_LAYER / 2, nwv = (G - 200) * 8;
                        for (int it = lo + (bx - 200) * 8 + wv; it < hi; it += nwv) convert_item(KA, ws, l + 1, it, lane, scr);
                    }
                    for (int item = bx; item < 200; item += G) {
                        KArgsPtr KA = kargs();
                        if (item < 40) {
                            const int vloc = item >> 3, hd = (item & 7) >> 1, dir = item & 1;
#ifndef NO_RET
                            ret_item(lds, PROJ, dir ? YBK : YF, sub * 5 + vloc, vloc, hd, dir);
#endif
                        } else if (item < 120) {
                            const int q = item - 40, vloc = q >> 4, hh = (q & 15) >> 1, dir = q & 1;
#ifndef NO_SSD
                            ssd_item(lds, PROJ, CXB, dir ? YBK : YF, KA->in[16] + l * 16, KA->in[17] + l * 16, KA->in[18] + l * 8,
                                     sub * 5 + vloc, vloc, hh, dir);
#endif
                        } else {
                            const int q = item - 120, vloc = q >> 4, nb = (q & 15) >> 1, dir = q & 1;
#ifndef NO_LRU
                            lru_item(lds, PROJ, dir ? YBK : YF, KA->in[7] + (size_t)l * 4 * 512, KA->in[8] + l * 512, KA->in[9] + (size_t)l * 2 * 8 * 64 * 64, KA->in[10] + l * 1024,
                                     KA->in[11] + (size_t)l * 2 * 8 * 64 * 64, KA->in[12] + l * 1024, KA->in[13] + l * 1024, sub * 5 + vloc, vloc, nb, dir);
#endif
                        }
                    }
                    GRID_SYNC();
                    {
                        KArgsPtr KA = kargs();
                        const int tid = launder_tid(), lane = tid & 63;
                        const float* ssd_norm = KA->in[19] + l * 512; const float* ret_norm = KA->in[20] + l * 512;
                        const f32x8 nw_s = ld8f(ssd_norm + 8 * lane), nw_r = ld8f(ret_norm + 8 * lane);
                        for (int row = gw; row < THALF; row += NGW) {
                            bf16* yr = YF + (size_t)row * YLD; const bf16* yb = YBK + (size_t)row * YLD; const bf16* pr = PROJ + (size_t)row * PLD;
                            {
                                const f32x8 a = unpack8(*(const u32x4*)(yr + 8 * lane)), b = unpack8(*(const u32x4*)(yb + 8 * lane)), gt = unpack8(*(const u32x4*)(pr + PC_GATE + 8 * lane));
                                f32x8 o;
#pragma unroll
                                for (int e = 0; e < 8; ++e) o[e] = (a[e] + b[e]) * gelu_tanh(gt[e]);
                                *(u32x4*)(yr + 8 * lane) = pack8(o);
                            }
                            {
                                const f32x8 a = unpack8(*(const u32x4*)(yr + 512 + 8 * lane)), b = unpack8(*(const u32x4*)(yb + 512 + 8 * lane)), z = unpack8(*(const u32x4*)(pr + PC_Z + 8 * lane));
                                f32x8 v; float ss = 0.f;
#pragma unroll
                                for (int e = 0; e < 8; ++e) { v[e] = (a[e] + b[e]) * siluf(z[e]); ss += v[e] * v[e]; }
                                ss = wave_sum(ss);
                                const float rs = rsqrtf(ss * (1.0f / 512.0f) + EPSN);
                                *(u32x4*)(yr + 512 + 8 * lane) = pack8(v * rs * nw_s);
                            }
                            {
                                const f32x8 a = unpack8(*(const u32x4*)(yr + 1024 + 8 * lane)), b = unpack8(*(const u32x4*)(yb + 1024 + 8 * lane)), gg = unpack8(*(const u32x4*)(pr + PC_G + 8 * lane));
                                f32x8 v = a + b; float s1 = 0.f;
#pragma unroll
                                for (int e = 0; e < 8; ++e) s1 += v[e];
                                s1 += __shfl_xor(s1, 1); s1 += __shfl_xor(s1, 2); s1 += __shfl_xor(s1, 4); s1 += __shfl_xor(s1, 8);
                                const float mu = s1 * (1.0f / 128.0f); float s2 = 0.f;
#pragma unroll
                                for (int e = 0; e < 8; ++e) { v[e] -= mu; s2 += v[e] * v[e]; }
                                s2 += __shfl_xor(s2, 1); s2 += __shfl_xor(s2, 2); s2 += __shfl_xor(s2, 4); s2 += __shfl_xor(s2, 8);
                                const float rs = rsqrtf(s2 * (1.0f / 128.0f) + EPSN);
                                f32x8 o;
#pragma unroll
                                for (int e = 0; e < 8; ++e) o[e] = v[e] * rs * nw_r[e] * siluf(gg[e]);
                                *(u32x4*)(yr + 1024 + 8 * lane) = pack8(o);
                            }
                        }
                    }
                    GRID_SYNC();
                }
                {
                    pg8::Gemm g; float coef; int roff;
                    if (st != 1) { g = pg8::Gemm{HB, (const bf16*)(ws + (st == 0 ? WS_WD1 : WS_WD2) + l * SZ_WD), TT, DM, DFF}; coef = 0.5f; roff = 0; }
                    else { g = pg8::Gemm{YF, (const bf16*)(ws + WS_WOUT + l * SZ_WOUT), THALF, DM, NMIX}; coef = 1.0f; roff = sub * THALF; }
                    pg8::StaticOrder S; S.init(g.M, g.N, G, bx);
                    EpiRes E{X, XB, SSQ, coef, roff};
#ifndef NO_RES
                    pg8::gemm_phase<EpiRes, pg8::StaticOrder, PG8_ALIGN, PG8_SP2>(lds, g, S, E);
#endif
                }
                GRID_SYNC();
            }
        }
    }
    {
        KArgsPtr KA = kargs();
        const int tid = launder_tid(), lane = tid & 63;
        const float* fw = KA->in[25];
        for (int m = gw; m < TT; m += NGW) {
            const float rs = row_rs(SSQ, (size_t)m);
#pragma unroll
            for (int j = 0; j < 4; ++j) {
                float* p = X + (size_t)m * DM + 256 * j + 4 * lane;
                const f32x4 v = *(const f32x4*)p, w = *(const f32x4*)(fw + 256 * j + 4 * lane);
                *(f32x4*)p = v * rs * w;
            }
        }
    }
}

extern "C" void kernel_launch(void* const* d_in, const int* in_sizes, int n_in, void* d_out, int out_size, void* d_ws, size_t ws_size, hipStream_t stream) {
    static int grid = 0;
    if (grid == 0) {
        if (n_in != 26 || out_size != TT * DM || ws_size < WS_NEED) { fprintf(stderr, "kernel_launch: unexpected problem (n_in %d, out %d, ws %zu, need %zu)\n", n_in, out_size, ws_size, (size_t)WS_NEED); grid = -1; return; }
        int dev = 0, cus = 0, per_cu = 0;
        if (hipGetDevice(&dev) != hipSuccess || hipDeviceGetAttribute(&cus, hipDeviceAttributeMultiprocessorCount, dev) != hipSuccess) { grid = -1; return; }
        if (hipFuncSetAttribute((const void*)mega_fwd, hipFuncAttributeMaxDynamicSharedMemorySize, LDS_BYTES) != hipSuccess) { fprintf(stderr, "kernel_launch: hipFuncSetAttribute failed\n"); grid = -1; return; }
        if (hipOccupancyMaxActiveBlocksPerMultiprocessor(&per_cu, (const void*)mega_fwd, 512, LDS_BYTES) != hipSuccess || per_cu < 1) { fprintf(stderr, "kernel_launch: occupancy query says %d\n", per_cu); per_cu = 1; }
        (void)hipGetLastError();
        grid = cus;
    }
    if (grid < 0) return;
    Args a{};
    for (int i = 0; i < 26; ++i) a.in[i] = (const float*)d_in[i];
    a.out = (float*)d_out; a.ws = (unsigned char*)d_ws;
    if (hipMemsetAsync((unsigned char*)d_ws + WS_BAR, 0, 16384, stream) != hipSuccess) { fprintf(stderr, "kernel_launch: hipMemsetAsync of the barrier words failed\n"); return; }
    void* kargs[] = {&a};
    hipError_t e = hipLaunchCooperativeKernel((const void*)mega_fwd, dim3(grid), dim3(512), kargs, LDS_BYTES, stream);
    if (e != hipSuccess) fprintf(stderr, "kernel_launch: cooperative launch failed: %s (grid %d)\n", hipGetErrorString(e), grid);
}
```

```cpp
#include <hip/hip_runtime.h>
#include <hip/hip_cooperative_groups.h>
#include <cstdio>
#include <cstdint>
namespace cg = cooperative_groups;
namespace pg8 {
#define PG8_LAS __attribute__((address_space(3)))
typedef unsigned short bf16_t;
typedef short bf16x8 __attribute__((ext_vector_type(8)));
typedef float f32x4 __attribute__((ext_vector_type(4)));
typedef unsigned u32x4 __attribute__((ext_vector_type(4)));
constexpr int BM = 256, BK = 64, HALF = 128, HTB = HALF * BK * 2  , STAGE_BYTES = 8 * HTB, NXCD = 8, WGM = 8;

__host__ __device__ __forceinline__ int lds_byte(int r, int c) { const int st = (r >> 4) * 2 + (c >> 5), rr = r & 15, cc = c & 31, ob = rr * 64 + cc * 2; return st * 1024 + (ob ^ (((ob >> 9) & 1) << 5)); }
__host__ __device__ __forceinline__ void stage_rc(int b, int& R, int& C) { const int st = b / 1024, sb = b % 1024, swz = sb ^ (((sb >> 9) & 1) << 5); R = (st >> 1) * 16 + swz / 64; C = (st & 1) * 32 + (swz % 64) / 2; }
__host__ __device__ __forceinline__ int perm32(int rho) { const int n = rho >> 4, i = rho & 15; return 8 * (i >> 2) + 4 * n + (i & 3); }

struct Unit { int pm, pn; };
struct Gemm { const bf16_t* A; const bf16_t* Bt; int M, N, K; };

struct StaticOrder {
    int nM, nN, nwg, G, c;
    __host__ __device__ void init(int M, int N, int G_, int c_) { nM = M / BM; nN = N / BM; nwg = nM * nN; G = G_; c = c_; }
    __host__ __device__ bool next(int i, Unit& u) const {
        const long L = (long)i * G + c; if (L >= nwg) return false;
        int wgid = (int)L; { const int q = nwg / NXCD, r = nwg % NXCD, xcd = wgid % NXCD, off = wgid / NXCD; wgid = (xcd < r ? xcd * (q + 1) : r * (q + 1) + (xcd - r) * q) + off; }
        const int nig = WGM * nN, gid = wgid / nig, fm = gid * WGM, gsz = (nM - fm) < WGM ? (nM - fm) : WGM;
        u.pm = fm + ((wgid % nig) % gsz); u.pn = (wgid % nig) / gsz; return true;
    }
    __device__ __forceinline__ void a_ready(const Unit&) const {}
    __device__ __forceinline__ void done(const Unit&) const {}
};

__device__ __forceinline__ unsigned cvt_pk_bf16(float lo, float hi) { unsigned r; asm volatile("v_cvt_pk_bf16_f32 %0, %1, %2" : "=v"(r) : "v"(lo), "v"(hi)); return r; }
typedef float f32x2 __attribute__((ext_vector_type(2)));
template <class Epi, class Sched, bool ALIGN_EPI = false, bool SP2 = false>
__device__ __forceinline__ void gemm_phase(PG8_LAS unsigned char* lds, const Gemm g, const Sched& S, const Epi& E) {
    int tid_l = threadIdx.x; asm volatile("" : "+v"(tid_l));
    const int tid = tid_l, wid = __builtin_amdgcn_readfirstlane(tid >> 6), lane = tid & 63, wr = wid >> 2, wc = wid & 3, fr = lane & 15, fq = lane >> 4;
    const int K = g.K, nt = K / BK;
    unsigned voffA[2], voffB[2];
#pragma unroll
    for (int i = 0; i < 2; ++i) { int R, C; stage_rc(tid * 16 + i * 8192, R, C); const int Rb = Epi::PERM ? ((R & ~31) + perm32(R & 31)) : R;
        voffA[i] = (unsigned)(R * K + C) * 2u; voffB[i] = (unsigned)(Rb * K + C) * 2u; }
    const size_t kstep = (size_t)(BK * 2);
    const size_t hstep = (size_t)HALF * K * 2;
    const size_t tstep = 2 * hstep;
    const unsigned ldsw = (unsigned)wid * 1024u;
    const int aoff = lds_byte(wr * 64 + fr, fq * 8), boff = lds_byte(wc * 32 + fr, fq * 8);
#define PG8_SA(b, h) (((b) * 2 + (h)) * HTB)
#define PG8_SB(b, h) ((4 + (b) * 2 + (h)) * HTB)
#define PG8_STAGE(bufoff, gbase, voff) do { _Pragma("unroll") for (int _i = 0; _i < 2; ++_i) \
        __builtin_amdgcn_global_load_lds((const unsigned*)((const char*)(gbase) + (voff)[_i]), (PG8_LAS unsigned*)(lds + (bufoff) + ldsw + _i * 8192), 16, 0, 0); } while (0)
#define PG8_LDA(dst, b, h) do { _Pragma("unroll") for (int m = 0; m < 4; ++m) _Pragma("unroll") for (int k = 0; k < 2; ++k) dst[m][k] = *(const PG8_LAS bf16x8*)(lds + PG8_SA(b, h) + aoff + m * 2048 + k * 1024); } while (0)
#define PG8_LDB(dst, b, h) do { _Pragma("unroll") for (int n = 0; n < 2; ++n) _Pragma("unroll") for (int k = 0; k < 2; ++k) dst[n][k] = *(const PG8_LAS bf16x8*)(lds + PG8_SB(b, h) + boff + n * 2048 + k * 1024); } while (0)
#define PG8_MMA(ai, bj, At, Bt) do { __builtin_amdgcn_s_setprio(1); _Pragma("unroll") for (int m = 0; m < 4; ++m) _Pragma("unroll") for (int n = 0; n < 2; ++n) _Pragma("unroll") for (int k = 0; k < 2; ++k) \
        acc[ai][bj][m][n] = __builtin_amdgcn_mfma_f32_16x16x32_bf16(Bt[n][k], At[m][k], acc[ai][bj][m][n], 0, 0, 0); __builtin_amdgcn_s_setprio(0); } while (0)
#define PG8_WAIT_V(n) asm volatile("s_waitcnt vmcnt(" #n ")" ::: "memory")
#define PG8_WAIT_L(n) asm volatile("s_waitcnt lgkmcnt(" #n ")" ::: "memory")
#define PG8_BAR __builtin_amdgcn_s_barrier()
#define PG8_SCHED __builtin_amdgcn_sched_barrier(0)
    Unit cur, nxt; int ui = 0;
    if (!S.next(0, cur)) return;
    f32x4 acc[2][2][4][2];
#pragma unroll
    for (int a = 0; a < 2; ++a)
#pragma unroll
        for (int b = 0; b < 2; ++b)
#pragma unroll
            for (int m = 0; m < 4; ++m)
#pragma unroll
                for (int n = 0; n < 2; ++n) acc[a][b][m][n] = (f32x4){0.f, 0.f, 0.f, 0.f};
    bf16x8 At[4][2], B0[2][2], B1[2][2];
    const char* cA = (const char*)g.A + (size_t)cur.pm * tstep; const char* cB = (const char*)g.Bt + (size_t)cur.pn * tstep;
    S.a_ready(cur);
    if constexpr (SP2) {
        PG8_STAGE(PG8_SB(0, 0), cB, voffB); PG8_STAGE(PG8_SB(0, 1), cB + hstep, voffB); PG8_STAGE(PG8_SA(0, 0), cA, voffA); PG8_STAGE(PG8_SA(0, 1), cA + hstep, voffA);
        if (wr == 1) PG8_BAR;
        PG8_WAIT_V(2); PG8_BAR;
        PG8_STAGE(PG8_SB(1, 0), cB + kstep, voffB); PG8_STAGE(PG8_SA(1, 0), cA + kstep, voffA); PG8_STAGE(PG8_SB(1, 1), cB + hstep + kstep, voffB);
        PG8_WAIT_V(6); PG8_BAR;
    } else {
        PG8_STAGE(PG8_SB(0, 0), cB, voffB); PG8_STAGE(PG8_SA(0, 0), cA, voffA); PG8_STAGE(PG8_SB(0, 1), cB + hstep, voffB); PG8_STAGE(PG8_SA(0, 1), cA + hstep, voffA);
        if (wr == 1) PG8_BAR;
        PG8_WAIT_V(4); PG8_BAR;
        PG8_STAGE(PG8_SB(1, 0), cB + kstep, voffB); PG8_STAGE(PG8_SA(1, 0), cA + kstep, voffA); PG8_STAGE(PG8_SB(1, 1), cB + hstep + kstep, voffB);
        PG8_WAIT_V(6); PG8_BAR;
    }
    for (;;) {
        const bool has_next = S.next(ui + 1, nxt);
        const char* nA = has_next ? (const char*)g.A + (size_t)nxt.pm * tstep : cA; const char* nB = has_next ? (const char*)g.Bt + (size_t)nxt.pn * tstep : cB;
        for (int t = 0; t < nt; t += 2) {
            const bool last = (t == nt - 2);
            const char* a1 = cA + (size_t)(t + 1) * kstep;
            const char* a2 = last ? nA : cA + (size_t)(t + 2) * kstep; const char* b2 = last ? nB : cB + (size_t)(t + 2) * kstep;
            const char* a3 = a2 + kstep; const char* b3 = b2 + kstep;
            if (last && has_next) S.a_ready(nxt);
            if constexpr (SP2) {
            PG8_LDB(B0, 0, 0); PG8_LDB(B1, 0, 1); PG8_SCHED; PG8_LDA(At, 0, 0); PG8_STAGE(PG8_SA(1, 1), a1 + hstep, voffA);
            PG8_WAIT_V(8); PG8_WAIT_L(0); PG8_BAR; PG8_MMA(0, 0, At, B0); PG8_MMA(0, 1, At, B1); PG8_BAR; PG8_SCHED;
            PG8_LDA(At, 0, 1); PG8_STAGE(PG8_SB(0, 0), b2, voffB); PG8_STAGE(PG8_SB(0, 1), b2 + hstep, voffB); PG8_STAGE(PG8_SA(0, 0), a2, voffA);
            PG8_WAIT_V(8); PG8_WAIT_L(0); PG8_BAR; PG8_MMA(1, 0, At, B0); PG8_MMA(1, 1, At, B1); PG8_BAR; PG8_SCHED;
            PG8_LDB(B0, 1, 0); PG8_LDB(B1, 1, 1); PG8_SCHED; PG8_LDA(At, 1, 0); PG8_STAGE(PG8_SA(0, 1), a2 + hstep, voffA);
            PG8_WAIT_V(8); PG8_WAIT_L(0); PG8_BAR; PG8_MMA(0, 0, At, B0); PG8_MMA(0, 1, At, B1); PG8_BAR; PG8_SCHED;
            PG8_LDA(At, 1, 1); PG8_STAGE(PG8_SB(1, 0), b3, voffB); PG8_STAGE(PG8_SB(1, 1), b3 + hstep, voffB); PG8_STAGE(PG8_SA(1, 0), a3, voffA);
            PG8_WAIT_V(8); PG8_WAIT_L(0); PG8_BAR; PG8_MMA(1, 0, At, B0); PG8_MMA(1, 1, At, B1); PG8_BAR; PG8_SCHED;
            } else {
            PG8_LDB(B0, 0, 0); PG8_SCHED; PG8_LDA(At, 0, 0); PG8_STAGE(PG8_SA(1, 1), a1 + hstep, voffA);
            PG8_WAIT_L(8); PG8_BAR; PG8_WAIT_L(0); PG8_MMA(0, 0, At, B0); PG8_BAR; PG8_SCHED;
            PG8_LDB(B1, 0, 1); PG8_STAGE(PG8_SB(0, 0), b2, voffB);
            PG8_BAR; PG8_WAIT_L(0); PG8_MMA(0, 1, At, B1); PG8_BAR;
            PG8_LDA(At, 0, 1); PG8_STAGE(PG8_SA(0, 0), a2, voffA);
            PG8_BAR; PG8_WAIT_L(0); PG8_MMA(1, 0, At, B0); PG8_BAR; PG8_SCHED;
            PG8_STAGE(PG8_SB(0, 1), b2 + hstep, voffB);
            PG8_WAIT_V(6); PG8_BAR; PG8_MMA(1, 1, At, B1); PG8_BAR;
            PG8_LDB(B0, 1, 0); PG8_SCHED; PG8_LDA(At, 1, 0); PG8_STAGE(PG8_SA(0, 1), a2 + hstep, voffA);
            PG8_WAIT_L(8); PG8_BAR; PG8_WAIT_L(0); PG8_MMA(0, 0, At, B0); PG8_BAR; PG8_SCHED;
            PG8_LDB(B1, 1, 1); PG8_STAGE(PG8_SB(1, 0), b3, voffB);
            PG8_BAR; PG8_WAIT_L(0); PG8_MMA(0, 1, At, B1); PG8_BAR;
            PG8_LDA(At, 1, 1); PG8_STAGE(PG8_SA(1, 0), a3, voffA);
            PG8_BAR; PG8_WAIT_L(0); PG8_MMA(1, 0, At, B0); PG8_BAR; PG8_SCHED;
            PG8_STAGE(PG8_SB(1, 1), b3 + hstep, voffB);
            PG8_WAIT_V(6); PG8_BAR; PG8_MMA(1, 1, At, B1); PG8_BAR;
            }
        }
        if constexpr (ALIGN_EPI) { if (wr == 0) PG8_BAR; }
        if constexpr (!Epi::AFTER_DRAIN) { E(acc, cur, wr, wc, fr, fq); S.done(cur); }
        if (!has_next) break;
#pragma unroll
        for (int a = 0; a < 2; ++a)
#pragma unroll
            for (int b = 0; b < 2; ++b)
#pragma unroll
                for (int m = 0; m < 4; ++m)
#pragma unroll
                    for (int n = 0; n < 2; ++n) acc[a][b][m][n] = (f32x4){0.f, 0.f, 0.f, 0.f};
        cur = nxt; cA = nA; cB = nB; ++ui;
        if constexpr (ALIGN_EPI) { if (wr == 1) PG8_BAR; }
    }
    PG8_WAIT_V(0);
    if constexpr (!ALIGN_EPI) { if (wr == 0) PG8_BAR; }
    PG8_BAR;
    if constexpr (Epi::AFTER_DRAIN) { E.fused(acc, cur, wr, wc, fr, fq, lds, wid, lane); S.done(cur); }
#undef PG8_SA
#undef PG8_SB
#undef PG8_STAGE
#undef PG8_LDA
#undef PG8_LDB
#undef PG8_MMA
#undef PG8_WAIT_V
#undef PG8_WAIT_L
#undef PG8_BAR
#undef PG8_SCHED
}
}
#ifndef PG8_SP2
#define PG8_SP2 true
#endif
#ifndef PG8_ALIGN
#define PG8_ALIGN true
#endif

#define LAS __attribute__((address_space(3)))
typedef unsigned short bf16;
typedef float f32x4 __attribute__((ext_vector_type(4)));
typedef float f32x8 __attribute__((ext_vector_type(8)));
typedef short bf16x8 __attribute__((ext_vector_type(8)));
typedef unsigned u32x4 __attribute__((ext_vector_type(4)));
typedef unsigned u32x2 __attribute__((ext_vector_type(2)));

constexpr int DM = 1024, DFF = 2816, NGU = 5632, NIN = 4608, NMIX = 1536, NLAYER = 4;
constexpr int TT = 81920, THALF = 40960, PLD = NIN  , YLD = NMIX;
constexpr int W_IN_SRC = 4368;
constexpr float EPSN = 1e-6f;
constexpr int PC_LRUX = 0, PC_GATE = 512, PC_Z = 1024, PC_XBC = 1536, PC_Q = 2304, PC_K = 2816, PC_V = 3328, PC_G = 3840, PC_DT = 4352;

constexpr size_t al256(size_t x) { return (x + 255) & ~(size_t)255; }
constexpr size_t SZ_WGU = (size_t)NGU * DM * 2, SZ_WD = (size_t)DM * DFF * 2, SZ_WIN = (size_t)NIN * DM * 2, SZ_WOUT = (size_t)DM * NMIX * 2;
constexpr size_t WS_WGU1 = 0;
constexpr size_t WS_WD1 = WS_WGU1 + NLAYER * SZ_WGU;
constexpr size_t WS_WIN = WS_WD1 + NLAYER * SZ_WD;
constexpr size_t WS_WOUT = WS_WIN + NLAYER * SZ_WIN;
constexpr size_t WS_WGU2 = WS_WOUT + NLAYER * SZ_WOUT;
constexpr size_t WS_WD2 = WS_WGU2 + NLAYER * SZ_WGU;
constexpr size_t WS_XB = al256(WS_WD2 + NLAYER * SZ_WD);
constexpr size_t WS_SSQ = al256(WS_XB + (size_t)TT * DM * 2);
constexpr size_t WS_ROPE = al256(WS_SSQ + (size_t)TT * 16 * 4);
constexpr size_t WS_BIG = al256(WS_ROPE + (size_t)8192 * 64 * 4 * 2);
constexpr size_t WS_PROJ = WS_BIG;
constexpr size_t WS_Y = al256(WS_PROJ + (size_t)THALF * PLD * 2);
constexpr size_t WS_YB = al256(WS_Y + (size_t)THALF * YLD * 2);
constexpr size_t WS_CXB = al256(WS_YB + (size_t)THALF * YLD * 2);
constexpr size_t WS_BAR = al256(WS_CXB + (size_t)THALF * 768 * 2);
constexpr size_t WS_END1 = al256(WS_BAR + 16384);
constexpr size_t WS_H = WS_BIG;
constexpr size_t WS_END2 = al256(WS_H + (size_t)TT * DFF * 2);
constexpr size_t WS_NEED = WS_END1 > WS_END2 ? WS_END1 : WS_END2;

constexpr int LDS_BYTES = 147456;

__device__ __forceinline__ float bflo(unsigned w) { return __builtin_bit_cast(float, w << 16); }
__device__ __forceinline__ float bfhi(unsigned w) { return __builtin_bit_cast(float, w & 0xffff0000u); }
__device__ __forceinline__ float bf2f(bf16 b) { return __builtin_bit_cast(float, (unsigned)b << 16); }
__device__ __forceinline__ bf16 f2bf(float f) { unsigned u = __builtin_bit_cast(unsigned, f); return (bf16)((u + 0x7fffu + ((u >> 16) & 1u)) >> 16); }
__device__ __forceinline__ unsigned pk2(float lo, float hi) { return pg8::cvt_pk_bf16(lo, hi); }
__device__ __forceinline__ f32x8 unpack8(u32x4 w) { f32x8 o; o[0] = bflo(w.x); o[1] = bfhi(w.x); o[2] = bflo(w.y); o[3] = bfhi(w.y); o[4] = bflo(w.z); o[5] = bfhi(w.z); o[6] = bflo(w.w); o[7] = bfhi(w.w); return o; }
__device__ __forceinline__ u32x4 pack8(f32x8 v) { u32x4 w; w.x = pk2(v[0], v[1]); w.y = pk2(v[2], v[3]); w.z = pk2(v[4], v[5]); w.w = pk2(v[6], v[7]); return w; }
__device__ __forceinline__ f32x8 ld8f(const float* p) { const f32x4 a = *(const f32x4*)p, b = *(const f32x4*)(p + 4); f32x8 o; o[0] = a[0]; o[1] = a[1]; o[2] = a[2]; o[3] = a[3]; o[4] = b[0]; o[5] = b[1]; o[6] = b[2]; o[7] = b[3]; return o; }
__device__ __forceinline__ float sigm(float x) { return __builtin_amdgcn_rcpf(1.0f + __expf(-x)); }
__device__ __forceinline__ float siluf(float x) { return x * sigm(x); }
__device__ __forceinline__ float softplusf(float x) { return fmaxf(x, 0.f) + log1pf(__expf(-fabsf(x))); }
__device__ __forceinline__ float gelu_tanh(float x) { const float y = 0.7978845608028654f * (x + 0.044715f * x * x * x); const float t = 1.0f - 2.0f * __builtin_amdgcn_rcpf(1.0f + __expf(2.0f * y)); return 0.5f * x * (1.0f + t); }
__device__ __forceinline__ float wave_sum(float v) {
#pragma unroll
    for (int o = 1; o < 64; o <<= 1) v += __shfl_xor(v, o);
    return v;
}
__device__ __forceinline__ float row_rs(const float* ssq, size_t row) {
    const f32x4 a = *(const f32x4*)(ssq + row * 16), b = *(const f32x4*)(ssq + row * 16 + 4), c = *(const f32x4*)(ssq + row * 16 + 8), d = *(const f32x4*)(ssq + row * 16 + 12);
    const float s = ((a[0] + a[1]) + (a[2] + a[3])) + ((b[0] + b[1]) + (b[2] + b[3])) + ((c[0] + c[1]) + (c[2] + c[3])) + ((d[0] + d[1]) + (d[2] + d[3]));
    return rsqrtf(s * (1.0f / DM) + EPSN);
}
__device__ __forceinline__ int launder_tid() { int t = threadIdx.x; asm volatile("" : "+v"(t)); return t; }
__device__ __forceinline__ float row_rs4(const float* ssq, size_t row, int fq) {
    const f32x4 a = *(const f32x4*)(ssq + row * 16 + 4 * fq);
    float s = (a[0] + a[1]) + (a[2] + a[3]);
    s += __shfl_xor(s, 16); s += __shfl_xor(s, 32);
    return rsqrtf(s * (1.0f / DM) + EPSN);
}
#define MFMA16(a, b, c) __builtin_amdgcn_mfma_f32_16x16x32_bf16((a), (b), (c), 0, 0, 0)
__device__ __forceinline__ bf16x8 ldfrag(const LAS bf16* p) { return *(const LAS bf16x8*)p; }

struct EpiGU {
    static constexpr bool PERM = true, AFTER_DRAIN = false;
    bf16* H; const float* ssq;
    __device__ __forceinline__ void operator()(const pg8::f32x4 (&acc)[2][2][4][2], const pg8::Unit& u, int wr, int wc, int fr, int fq) const {
        const int row0 = u.pm * 256 + wr * 64 + fr, col0 = u.pn * 128 + wc * 32 + 8 * fq;
#pragma unroll
        for (int ai = 0; ai < 2; ++ai)
#pragma unroll
            for (int m = 0; m < 4; ++m) {
                const size_t row = (size_t)(row0 + ai * 128 + m * 16);
                const float rs = row_rs4(ssq, row, fq);
                const pg8::f32x4 g0 = acc[ai][0][m][0] * rs, g1 = acc[ai][0][m][1] * rs, u0 = acc[ai][1][m][0] * rs, u1 = acc[ai][1][m][1] * rs;
                u32x4 w;
                w.x = pk2(siluf(g0[0]) * u0[0], siluf(g0[1]) * u0[1]); w.y = pk2(siluf(g0[2]) * u0[2], siluf(g0[3]) * u0[3]);
                w.z = pk2(siluf(g1[0]) * u1[0], siluf(g1[1]) * u1[1]); w.w = pk2(siluf(g1[2]) * u1[2], siluf(g1[3]) * u1[3]);
                *(u32x4*)(H + row * DFF + col0) = w;
                if (m == 3) asm volatile("" ::: "memory");
            }
    }
};
struct EpiProj {
    static constexpr bool PERM = true, AFTER_DRAIN = false;
    bf16* P; const float* ssq; int row_off; const float* rcos; const float* rsin;
    __device__ __forceinline__ void operator()(const pg8::f32x4 (&acc)[2][2][4][2], const pg8::Unit& u, int wr, int wc, int fr, int fq) const {
        const int row0 = u.pm * 256 + wr * 64 + fr, col0 = u.pn * 256 + wc * 32 + 8 * fq;
        if (u.pn >= 9 && u.pn <= 12) {
            const float ksc = u.pn >= 11 ? 0.08838834764831845f : 1.0f;
            const int d0 = 32 * (wc & 1) + 8 * fq, colr = u.pn * 256 + 128 * (wc >> 1) + d0;
#pragma unroll
            for (int ai = 0; ai < 2; ++ai)
#pragma unroll
                for (int m = 0; m < 4; ++m) {
                    const size_t row = (size_t)(row0 + ai * 128 + m * 16);
                    const int gr = (int)row + row_off, pos = gr < 65536 ? (gr & 8191) : (gr & 4095);
                    const float rs = row_rs4(ssq, (size_t)gr, fq) * ksc;
                    u32x4 w1, w2;
#pragma unroll
                    for (int n = 0; n < 2; ++n) {
                        const pg8::f32x4 cs = *(const pg8::f32x4*)(rcos + (size_t)pos * 64 + d0 + 4 * n), sn = *(const pg8::f32x4*)(rsin + (size_t)pos * 64 + d0 + 4 * n);
                        const pg8::f32x4 t1 = acc[ai][0][m][n] * rs, t2 = acc[ai][1][m][n] * rs;
                        const pg8::f32x4 o1 = t1 * cs - t2 * sn, o2 = t1 * sn + t2 * cs;
                        if (n == 0) { w1.x = pk2(o1[0], o1[1]); w1.y = pk2(o1[2], o1[3]); w2.x = pk2(o2[0], o2[1]); w2.y = pk2(o2[2], o2[3]); }
                        else { w1.z = pk2(o1[0], o1[1]); w1.w = pk2(o1[2], o1[3]); w2.z = pk2(o2[0], o2[1]); w2.w = pk2(o2[2], o2[3]); }
                    }
                    *(u32x4*)(P + row * PLD + colr) = w1; *(u32x4*)(P + row * PLD + colr + 64) = w2;
                    asm volatile("" ::: "memory");
                }
            return;
        }
#pragma unroll
        for (int ai = 0; ai < 2; ++ai)
#pragma unroll
            for (int m = 0; m < 4; ++m) {
                const size_t row = (size_t)(row0 + ai * 128 + m * 16);
                const float rs = row_rs4(ssq, row + row_off, fq);
#pragma unroll
                for (int bj = 0; bj < 2; ++bj) {
                    const pg8::f32x4 v0 = acc[ai][bj][m][0] * rs, v1 = acc[ai][bj][m][1] * rs;
                    u32x4 w; w.x = pk2(v0[0], v0[1]); w.y = pk2(v0[2], v0[3]); w.z = pk2(v1[0], v1[1]); w.w = pk2(v1[2], v1[3]);
                    *(u32x4*)(P + row * PLD + col0 + bj * 128) = w;
                }
                asm volatile("" ::: "memory");
            }
    }
};
struct EpiRes {
    static constexpr bool PERM = true, AFTER_DRAIN = false;
    float* X; bf16* XB; float* ssq; float coef; int row_off;
    __device__ __forceinline__ void operator()(const pg8::f32x4 (&acc)[2][2][4][2], const pg8::Unit& u, int wr, int wc, int fr, int fq) const {
        const int row0 = row_off + u.pm * 256 + wr * 64 + fr, col0 = u.pn * 256 + wc * 32 + 8 * fq;
#pragma unroll
        for (int ai = 0; ai < 2; ++ai)
#pragma unroll
            for (int m = 0; m < 4; ++m) {
                const size_t row = (size_t)(row0 + ai * 128 + m * 16);
                float s = 0.f;
#pragma unroll
                for (int bj = 0; bj < 2; ++bj) {
                    float* xp = X + row * DM + col0 + bj * 128;
                    pg8::f32x4 x0 = *(const pg8::f32x4*)xp, x1 = *(const pg8::f32x4*)(xp + 4);
                    x0 += acc[ai][bj][m][0] * coef; x1 += acc[ai][bj][m][1] * coef;
                    *(pg8::f32x4*)xp = x0; *(pg8::f32x4*)(xp + 4) = x1;
                    s += (x0[0] * x0[0] + x0[1] * x0[1]) + (x0[2] * x0[2] + x0[3] * x0[3]) + (x1[0] * x1[0] + x1[1] * x1[1]) + (x1[2] * x1[2] + x1[3] * x1[3]);
                    u32x4 w; w.x = pk2(x0[0], x0[1]); w.y = pk2(x0[2], x0[3]); w.z = pk2(x1[0], x1[1]); w.w = pk2(x1[2], x1[3]);
                    *(u32x4*)(XB + row * DM + col0 + bj * 128) = w;
                }
                s += __shfl_xor(s, 16); s += __shfl_xor(s, 32);
                if (fq == 0) ssq[row * 16 + u.pn * 4 + wc] = s;
                asm volatile("" ::: "memory");
            }
    }
};

__device__ __forceinline__ int colmap(int kind, int n) {
    if (kind == 0) return n;
    if (kind == 1) { const int t = n >> 8, w = n & 255; return w < 128 ? 128 * t + w : DFF + 128 * t + (w - 128); }
    if (n < 2304) return n;
    if (n < 3328) { const int t = n >> 8, w = n & 255, bj = w >> 7, o = w & 127; return 256 * t + 128 * (o >> 6) + (o & 63) + 64 * bj + 16; }
    return n < 4352 ? n + 16 : (n < 4368 ? n - 4352 + 2304 : -1);
}
__device__ __forceinline__ void transpose_item(const float* W, int K, int Nsrc, int Ndst, const float* kscale, bf16* WT, int kind, int item, int lane, LAS float* scr) {
    const int nblk = Ndst / 32, kb = item / nblk, nb = item % nblk, k0 = 64 * kb, n0 = 32 * nb;
    const int sc = colmap(kind, n0 + (lane & 31));
#pragma unroll 8
    for (int i = 0; i < 32; ++i) { const int kk = 2 * i + (lane >> 5); float v = 0.f; if (sc >= 0) { v = W[(size_t)(k0 + kk) * Nsrc + sc]; if (kscale) v *= kscale[k0 + kk]; } scr[kk * 33 + (lane & 31)] = v; }
    asm volatile("s_waitcnt lgkmcnt(0)" ::: "memory");
    const int c = lane & 7;
#pragma unroll
    for (int j = 0; j < 4; ++j) { const int n = (lane >> 3) + 8 * j; const LAS float* s = scr + (8 * c) * 33 + n;
        u32x4 o; o.x = pk2(s[0 * 33], s[1 * 33]); o.y = pk2(s[2 * 33], s[3 * 33]); o.z = pk2(s[4 * 33], s[5 * 33]); o.w = pk2(s[6 * 33], s[7 * 33]);
        *(u32x4*)(WT + (size_t)(n0 + n) * K + k0 + 8 * c) = o; }
    asm volatile("s_waitcnt lgkmcnt(0)" ::: "memory");
}

struct Args { const float* in[26]; float* out; unsigned char* ws; };
typedef const __attribute__((address_space(4))) Args* KArgsPtr;
__device__ __forceinline__ KArgsPtr kargs() { KArgsPtr p = (KArgsPtr)__builtin_amdgcn_kernarg_segment_ptr(); asm volatile("" : "+s"(p)); return p; }

__device__ __forceinline__ f32x8 conv8(const bf16* proj, int lrow, int pcol, int pos, int seqlen, const float* cw, int cw_ld, const float* cb, int ccol) {
    f32x8 acc = ld8f(cb + ccol);
#pragma unroll
    for (int k = 0; k < 4; ++k) {
        const int s = pos + k - 2;
        if (s >= 0 && s < seqlen) {
            const u32x4 raw = *(const u32x4*)(proj + (size_t)(lrow + k - 2) * PLD + pcol);
            acc += ld8f(cw + k * cw_ld + ccol) * unpack8(raw);
        }
    }
    return acc;
}

__device__ __forceinline__ void ret_item(LAS unsigned char* lds, const bf16* proj, bf16* yout, int gv, int vloc, int hd, int dir) {
    const int tid = launder_tid(), wid = __builtin_amdgcn_readfirstlane(tid >> 6), lane = tid & 63, fr = lane & 15, fq = lane >> 4;
    constexpr int LD = 136;
    LAS bf16* KN = (LAS bf16*)lds; LAS bf16* KTW = KN + 128 * LD; LAS bf16* VT = KTW + 128 * LD; LAS bf16* RT = VT + 128 * LD;
    const int seqlen = gv < 8 ? 8192 : 4096;
    const float l2g = log2f(1.0f - exp2f(-5.0f - (float)hd));
    const float cdec = exp2f(l2g * 128.0f);
    const int i0 = 4 * ((tid >> 2) & 31), c8 = 8 * ((tid & 3) + 4 * (tid >> 7)), qi = 16 * wid + fr;
    float wl[4];
#pragma unroll
    for (int r = 0; r < 4; ++r) wl[r] = exp2f(l2g * (float)(dir ? i0 + r : 127 - (i0 + r)));
    const float rsc = exp2f(l2g * (float)(dir ? 128 - qi : qi + 1));
    f32x4 R[8];
#pragma unroll
    for (int i = 0; i < 8; ++i) R[i] = (f32x4){0.f, 0.f, 0.f, 0.f};
    for (int i = tid; i < 128 * LD / 2; i += 512) ((LAS unsigned*)RT)[i] = 0u;
    u32x4 kraw[4], vraw[4], qraw[4];
#define RET_LOAD(CC) do { const int lr0_ = vloc * 8192 + (CC) * 128; \
        _Pragma("unroll") for (int r = 0; r < 4; ++r) { const bf16* rp_ = proj + (size_t)(lr0_ + i0 + r) * PLD + 128 * hd + c8; kraw[r] = *(const u32x4*)(rp_ + PC_K); vraw[r] = *(const u32x4*)(rp_ + PC_V); } \
        _Pragma("unroll") for (int ks = 0; ks < 4; ++ks) qraw[ks] = *(const u32x4*)(proj + (size_t)(lr0_ + qi) * PLD + PC_Q + 128 * hd + 32 * ks + 8 * fq); } while (0)
    RET_LOAD(dir ? 63 : 0);
    __syncthreads();
    for (int c = 0; c < 64; ++c) {
        const int cc = dir ? 63 - c : c;
        const int lrow0 = vloc * 8192 + cc * 128;
        const bool do_intra = ((cc & 1) == dir);
        bool next_reset = false;
        if (c < 63) { const int ncc = dir ? cc - 1 : cc + 1; const int np = (ncc * 128) % seqlen; next_reset = dir ? (np + 128 == seqlen) : (np == 0); }
        {
            if (do_intra) {
#pragma unroll
                for (int r = 0; r < 4; ++r) *(LAS u32x4*)(KN + (i0 + r) * LD + c8) = kraw[r];
            }
            LAS bf16* kt = KTW + c8 * LD + i0; LAS bf16* vt = VT + c8 * LD + i0;
#pragma unroll
            for (int m = 0; m < 4; ++m) {
                u32x2 we, wo;
                we.x = pk2(bflo(kraw[0][m]) * wl[0], bflo(kraw[1][m]) * wl[1]); we.y = pk2(bflo(kraw[2][m]) * wl[2], bflo(kraw[3][m]) * wl[3]);
                wo.x = pk2(bfhi(kraw[0][m]) * wl[0], bfhi(kraw[1][m]) * wl[1]); wo.y = pk2(bfhi(kraw[2][m]) * wl[2], bfhi(kraw[3][m]) * wl[3]);
                *(LAS u32x2*)(kt + (2 * m) * LD) = we; *(LAS u32x2*)(kt + (2 * m + 1) * LD) = wo;
                u32x2 ve, vo;
                ve.x = (vraw[0][m] & 0xffffu) | (vraw[1][m] << 16); ve.y = (vraw[2][m] & 0xffffu) | (vraw[3][m] << 16);
                vo.x = (vraw[0][m] >> 16) | (vraw[1][m] & 0xffff0000u); vo.y = (vraw[2][m] >> 16) | (vraw[3][m] & 0xffff0000u);
                *(LAS u32x2*)(vt + (2 * m) * LD) = ve; *(LAS u32x2*)(vt + (2 * m + 1) * LD) = vo;
            }
        }
        bf16x8 qf[4];
#pragma unroll
        for (int ks = 0; ks < 4; ++ks) qf[ks] = __builtin_bit_cast(bf16x8, qraw[ks]);
        if (c < 63) { const int ncc = dir ? cc - 1 : cc + 1; RET_LOAD(ncc); }
        __syncthreads();
        unsigned sp[8][2];
        if (do_intra) {
#pragma unroll
            for (int ct = 0; ct < 8; ++ct) {
                f32x4 a = (f32x4){0.f, 0.f, 0.f, 0.f};
#pragma unroll
                for (int ks = 0; ks < 4; ++ks) a = MFMA16(ldfrag(KN + (16 * ct + fr) * LD + 32 * ks + 8 * fq), qf[ks], a);
                const int j0 = 16 * ct + 4 * fq;
                float dv[4];
#pragma unroll
                for (int e = 0; e < 4; ++e) { const int dd = qi - (j0 + e); dv[e] = a[e] * exp2f(l2g * (float)(dd < 0 ? -dd : dd)); }
                sp[ct][0] = pk2(dv[0], dv[1]); sp[ct][1] = pk2(dv[2], dv[3]);
            }
            __syncthreads();
#pragma unroll
            for (int ct = 0; ct < 8; ++ct) { u32x2 w; w.x = sp[ct][0]; w.y = sp[ct][1]; *(LAS u32x2*)(KN + qi * LD + 16 * ct + 4 * fq) = w; }
        }
        {
            f32x4 Y[8];
#pragma unroll
            for (int ct = 0; ct < 8; ++ct) {
                f32x4 a = (f32x4){0.f, 0.f, 0.f, 0.f};
#pragma unroll
                for (int ks = 0; ks < 4; ++ks) a = MFMA16(ldfrag(RT + (16 * ct + fr) * LD + 32 * ks + 8 * fq), qf[ks], a);
                Y[ct] = a * rsc;
            }
            if (do_intra) {
#pragma unroll
                for (int ks = 0; ks < 4; ++ks) {
                    const bf16x8 pf = ldfrag(KN + qi * LD + 32 * ks + 8 * fq);
#pragma unroll
                    for (int ct = 0; ct < 8; ++ct) Y[ct] = MFMA16(ldfrag(VT + (16 * ct + fr) * LD + 32 * ks + 8 * fq), pf, Y[ct]);
                }
            }
            bf16* yo = yout + (size_t)(lrow0 + qi) * YLD + 1024 + 128 * hd + 4 * fq;
#pragma unroll
            for (int ct = 0; ct < 8; ++ct) { u32x2 w; w.x = pk2(Y[ct][0], Y[ct][1]); w.y = pk2(Y[ct][2], Y[ct][3]); *(u32x2*)(yo + 16 * ct) = w; }
        }
#pragma unroll
        for (int ct = 0; ct < 8; ++ct) R[ct] *= cdec;
#pragma unroll
        for (int ks = 0; ks < 4; ++ks) {
            const bf16x8 kf = ldfrag(KTW + (16 * wid + fr) * LD + 32 * ks + 8 * fq);
#pragma unroll
            for (int ct = 0; ct < 8; ++ct) R[ct] = MFMA16(kf, ldfrag(VT + (16 * ct + fr) * LD + 32 * ks + 8 * fq), R[ct]);
        }
        if (next_reset) {
#pragma unroll
            for (int ct = 0; ct < 8; ++ct) R[ct] = (f32x4){0.f, 0.f, 0.f, 0.f};
        }
        __syncthreads();
#pragma unroll
        for (int ct = 0; ct < 8; ++ct) { u32x2 w; w.x = pk2(R[ct][0], R[ct][1]); w.y = pk2(R[ct][2], R[ct][3]); *(LAS u32x2*)(RT + (16 * ct + fr) * LD + 16 * wid + 4 * fq) = w; }
    }
#undef RET_LOAD
    __syncthreads();
}

__device__ __forceinline__ void ssd_item(LAS unsigned char* lds, const bf16* proj, const bf16* cxb, bf16* yout, const float* dt_bias, const float* a_log, const float* dskip,
                                         int gv, int vloc, int hh, int dir) {
    const int tid = launder_tid(), wid = __builtin_amdgcn_readfirstlane(tid >> 6), lane = tid & 63, fr = lane & 15, fq = lane >> 4;
    constexpr int LDL = 136, LDS_ = 72;
    LAS bf16* XST = (LAS bf16*)lds;
    LAS bf16* CN = XST + 64 * LDL;
    LAS bf16* BN = CN + 128 * LDS_;
    LAS bf16* BTW = BN + 128 * LDS_;
    LAS bf16* PP = BTW + 64 * LDL;
    LAS bf16* HL = PP + 128 * LDL;
    LAS float* DT = (LAS float*)(HL + 64 * LDS_);
    LAS float* ACUM = DT + 128;
    LAS float* CWL = ACUM + 128;
    const int seqlen = gv < 8 ? 8192 : 4096, grp = hh >> 2;
    const float aneg = -__expf(a_log[dir * 8 + hh]), dtb = dt_bias[dir * 8 + hh], dsk = dskip[hh];
    const int cg8 = tid % 24, rb = tid / 24, sec = cg8 >> 3, c8 = (cg8 & 7) * 8, i0 = 8 * rb;
    const int xc = sec == 0 ? 64 * hh + c8 : (sec == 1 ? 512 + 64 * grp + c8 : 640 + 64 * grp + c8);
    const bool stager = tid < 384;
    f32x4 Hc[2];
    Hc[0] = (f32x4){0.f, 0.f, 0.f, 0.f}; Hc[1] = (f32x4){0.f, 0.f, 0.f, 0.f};
    for (int i = tid; i < 64 * LDS_ / 2; i += 512) ((LAS unsigned*)HL)[i] = 0u;
    u32x4 raw[8]; float dtraw = 0.f;
#define SSD_LOAD(CC) do { const int lr0_ = vloc * 8192 + (CC) * 128; \
        if (stager) { _Pragma("unroll") for (int r = 0; r < 8; ++r) raw[r] = *(const u32x4*)(cxb + (size_t)(lr0_ + i0 + r) * 768 + xc); } \
        if (tid < 128) dtraw = bf2f(proj[(size_t)(lr0_ + tid) * PLD + PC_DT + dir * 8 + hh]); } while (0)
    SSD_LOAD(dir ? 63 : 0);
    __syncthreads();
    for (int c = 0; c < 64; ++c) {
        const int cc = dir ? 63 - c : c;
        const int lrow0 = vloc * 8192 + cc * 128;
        bool next_reset = false;
        if (c < 63) { const int ncc = dir ? cc - 1 : cc + 1; const int np = (ncc * 128) % seqlen; next_reset = dir ? (np + 128 == seqlen) : (np == 0); }
        if (tid < 128) DT[tid] = softplusf(dtraw + dtb);
        __syncthreads();
        float tot;
        {
            const float x0 = DT[2 * lane] * aneg, x1 = DT[2 * lane + 1] * aneg;
            float s = x0 + x1;
#pragma unroll
            for (int o = 1; o < 64; o <<= 1) { const float t = __shfl_up(s, o); if (lane >= o) s += t; }
            tot = __shfl(s, 63);
            const float p1 = s, p0 = s - x1;
            if (dir == 0) { ACUM[2 * lane] = p0; ACUM[2 * lane + 1] = p1; }
            else { ACUM[2 * lane] = tot - p0 + x0; ACUM[2 * lane + 1] = tot - p1 + x1; }
        }
        if (stager) {
#pragma unroll
            for (int hc = 0; hc < 2; ++hc) {
                u32x2 pv[4];
#pragma unroll
                for (int od = 0; od < 8; ++od) {
                    u32x2 pk; pk.x = raw[od][2 * hc]; pk.y = raw[od][2 * hc + 1];
                    if (sec == 0) pv[od & 3] = pk;
                    else if (sec == 1) { *(LAS u32x2*)(BN + (i0 + od) * LDS_ + c8 + 4 * hc) = pk; const float wr = __expf(tot - ACUM[i0 + od]) * DT[i0 + od];
                        u32x2 pw; pw.x = pk2(bflo(pk.x) * wr, bfhi(pk.x) * wr); pw.y = pk2(bflo(pk.y) * wr, bfhi(pk.y) * wr); pv[od & 3] = pw; }
                    else *(LAS u32x2*)(CN + (i0 + od) * LDS_ + c8 + 4 * hc) = pk;
                    if ((od & 3) == 3 && sec != 2) {
                        LAS bf16* dstT = (sec == 0 ? XST : BTW) + (c8 + 4 * hc) * LDL + i0 + (od - 3);
#pragma unroll
                        for (int m = 0; m < 2; ++m) {
                            u32x2 we, wo;
                            we.x = (pv[0][m] & 0xffffu) | (pv[1][m] << 16); we.y = (pv[2][m] & 0xffffu) | (pv[3][m] << 16);
                            wo.x = (pv[0][m] >> 16) | (pv[1][m] & 0xffff0000u); wo.y = (pv[2][m] >> 16) | (pv[3][m] & 0xffff0000u);
                            *(LAS u32x2*)(dstT + (2 * m) * LDL) = we; *(LAS u32x2*)(dstT + (2 * m + 1) * LDL) = wo;
                        }
                    }
                }
            }
        }
        if (c < 63) { const int ncc = dir ? cc - 1 : cc + 1; SSD_LOAD(ncc); }
        __syncthreads();
        const int qi = 16 * wid + fr;
        bf16x8 cf[2];
        cf[0] = ldfrag(CN + qi * LDS_ + 8 * fq); cf[1] = ldfrag(CN + qi * LDS_ + 32 + 8 * fq);
        const float aci = ACUM[qi];
#pragma unroll
        for (int ct = 0; ct < 8; ++ct) {
            f32x4 a = (f32x4){0.f, 0.f, 0.f, 0.f};
#pragma unroll
            for (int ks = 0; ks < 2; ++ks) a = MFMA16(ldfrag(BN + (16 * ct + fr) * LDS_ + 32 * ks + 8 * fq), cf[ks], a);
            const int j0 = 16 * ct + 4 * fq;
            const f32x4 acj = *(const LAS f32x4*)(ACUM + j0), dtj = *(const LAS f32x4*)(DT + j0);
            float wv[4];
#pragma unroll
            for (int e = 0; e < 4; ++e) { const int j = j0 + e; const bool ok = dir ? (j >= qi) : (j <= qi); wv[e] = ok ? a[e] * __expf(aci - acj[e]) * dtj[e] : 0.f; }
            u32x2 w; w.x = pk2(wv[0], wv[1]); w.y = pk2(wv[2], wv[3]);
            *(LAS u32x2*)(PP + qi * LDL + j0) = w;
        }
        {
            const float ea = __expf(aci);
            f32x4 Y[4];
#pragma unroll
            for (int pt = 0; pt < 4; ++pt) {
                f32x4 a = (f32x4){0.f, 0.f, 0.f, 0.f};
#pragma unroll
                for (int ks = 0; ks < 2; ++ks) a = MFMA16(ldfrag(HL + (16 * pt + fr) * LDS_ + 32 * ks + 8 * fq), cf[ks], a);
                Y[pt] = a * ea;
            }
#pragma unroll
            for (int ks = 0; ks < 4; ++ks) {
                const bf16x8 pf = ldfrag(PP + qi * LDL + 32 * ks + 8 * fq);
#pragma unroll
                for (int pt = 0; pt < 4; ++pt) Y[pt] = MFMA16(ldfrag(XST + (16 * pt + fr) * LDL + 32 * ks + 8 * fq), pf, Y[pt]);
            }
            bf16* yo = yout + (size_t)(lrow0 + qi) * YLD + 512 + 64 * hh + 4 * fq;
#pragma unroll
            for (int pt = 0; pt < 4; ++pt) {
                if (dir == 0) {
#pragma unroll
                    for (int e = 0; e < 4; ++e) Y[pt][e] += dsk * bf2f(XST[(16 * pt + 4 * fq + e) * LDL + qi]);
                }
                u32x2 w; w.x = pk2(Y[pt][0], Y[pt][1]); w.y = pk2(Y[pt][2], Y[pt][3]); *(u32x2*)(yo + 16 * pt) = w;
            }
        }
        {
            const float et = __expf(tot);
            Hc[0] *= et; Hc[1] *= et;
#pragma unroll
            for (int ks = 0; ks < 4; ++ks) {
                const bf16x8 xf = ldfrag(XST + (16 * (wid & 3) + fr) * LDL + 32 * ks + 8 * fq);
#pragma unroll
                for (int j2 = 0; j2 < 2; ++j2) Hc[j2] = MFMA16(ldfrag(BTW + (16 * (2 * (wid >> 2) + j2) + fr) * LDL + 32 * ks + 8 * fq), xf, Hc[j2]);
            }
            if (next_reset) { Hc[0] = (f32x4){0.f, 0.f, 0.f, 0.f}; Hc[1] = (f32x4){0.f, 0.f, 0.f, 0.f}; }
        }
        __syncthreads();
#pragma unroll
        for (int j2 = 0; j2 < 2; ++j2) { u32x2 w; w.x = pk2(Hc[j2][0], Hc[j2][1]); w.y = pk2(Hc[j2][2], Hc[j2][3]);
            *(LAS u32x2*)(HL + (16 * (wid & 3) + fr) * LDS_ + 16 * (2 * (wid >> 2) + j2) + 4 * fq) = w; }
    }
#undef SSD_LOAD
    __syncthreads();
}

__device__ __forceinline__ void lru_item(LAS unsigned char* lds, const bf16* proj, bf16* yout, const float* cw, const float* cb, const float* w_a, const float* b_a, const float* w_i, const float* b_i,
                                         const float* lam, int gv, int vloc, int nb, int dir) {
    const int tid = launder_tid(), wid = __builtin_amdgcn_readfirstlane(tid >> 6), lane = tid & 63, fr = lane & 15, fq = lane >> 4;
    constexpr int LDX = 72;
    LAS bf16* XCB = (LAS bf16*)lds;
    LAS bf16* WT = XCB + 128 * LDX;
    LAS float* AA = (LAS float*)(WT + 128 * LDX);
    LAS float* UU = AA + 128 * 64;
    LAS float* AGG = UU + 128 * 64;
    LAS float* CARRY = AGG + 8 * 64 * 2;
    LAS float* BA = CARRY + 128;
    LAS float* BI = BA + 64;
    LAS float* SP = BI + 64;
    const int seqlen = gv < 8 ? 8192 : 4096;
    for (int idx = tid; idx < 8192; idx += 512) {
        const int mat = idx >> 12, rem = idx & 4095, i = rem >> 6, j = rem & 63;
        const float* w = (mat ? w_i : w_a) + (size_t)((dir * 8 + nb) * 64 + i) * 64 + j;
        WT[(64 * mat + j) * LDX + i] = f2bf(*w);
    }
    if (tid < 64) { CARRY[tid] = 0.f; CARRY[64 + tid] = 0.f; BA[tid] = b_a[dir * 512 + 64 * nb + tid]; BI[tid] = b_i[dir * 512 + 64 * nb + tid]; SP[tid] = 8.0f * softplusf(-lam[dir * 512 + 64 * nb + tid]); }
    const int c8 = (tid & 7) * 8, i0 = 2 * (tid >> 3), ccol = 64 * nb + c8;
    const f32x8 w0 = ld8f(cw + 0 * 512 + ccol), w1 = ld8f(cw + 1 * 512 + ccol), w2 = ld8f(cw + 2 * 512 + ccol), w3 = ld8f(cw + 3 * 512 + ccol), bb = ld8f(cb + ccol);
    u32x4 raw[5];
#define LRU_LOAD(CC) do { const int lr0_ = vloc * 8192 + (CC) * 128, p0_ = ((CC) * 128) % seqlen; \
        _Pragma("unroll") for (int r = 0; r < 5; ++r) { const int s_ = p0_ + i0 - 2 + r; raw[r] = (u32x4){0u, 0u, 0u, 0u}; \
            if (s_ >= 0 && s_ < seqlen) raw[r] = *(const u32x4*)(proj + (size_t)(lr0_ + i0 - 2 + r) * PLD + PC_LRUX + ccol); } } while (0)
    LRU_LOAD(dir ? 63 : 0);
    __syncthreads();
    for (int c = 0; c < 64; ++c) {
        const int cc = dir ? 63 - c : c;
        const int lrow0 = vloc * 8192 + cc * 128;
        bool next_reset = false;
        if (c < 63) { const int ncc = dir ? cc - 1 : cc + 1; const int np = (ncc * 128) % seqlen; next_reset = dir ? (np + 128 == seqlen) : (np == 0); }
#pragma unroll
        for (int r = 0; r < 2; ++r) {
            const f32x8 v = bb + w0 * unpack8(raw[r]) + w1 * unpack8(raw[r + 1]) + w2 * unpack8(raw[r + 2]) + w3 * unpack8(raw[r + 3]);
            *(LAS u32x4*)(XCB + (i0 + r) * LDX + c8) = pack8(v);
        }
        if (c < 63) { const int ncc = dir ? cc - 1 : cc + 1; LRU_LOAD(ncc); }
        __syncthreads();
        const int t = 16 * wid + fr;
        {
            bf16x8 xf[2];
            xf[0] = ldfrag(XCB + t * LDX + 8 * fq); xf[1] = ldfrag(XCB + t * LDX + 32 + 8 * fq);
            f32x4 Gt[8];
#pragma unroll
            for (int ct = 0; ct < 8; ++ct) {
                f32x4 a = (f32x4){0.f, 0.f, 0.f, 0.f};
#pragma unroll
                for (int ks = 0; ks < 2; ++ks) a = MFMA16(ldfrag(WT + (16 * ct + fr) * LDX + 32 * ks + 8 * fq), xf[ks], a);
                Gt[ct] = a;
            }
#pragma unroll
            for (int ct = 0; ct < 4; ++ct) {
                const int c0 = 16 * ct + 4 * fq;
                const f32x4 ba = *(const LAS f32x4*)(BA + c0), bi = *(const LAS f32x4*)(BI + c0), sp = *(const LAS f32x4*)(SP + c0);
                const u32x2 xw = *(const LAS u32x2*)(XCB + t * LDX + c0);
                const float xv[4] = {bflo(xw.x), bfhi(xw.x), bflo(xw.y), bfhi(xw.y)};
                f32x4 av, uv;
#pragma unroll
                for (int e = 0; e < 4; ++e) {
                    const float r = sigm(Gt[ct][e] + ba[e]), ig = sigm(Gt[ct + 4][e] + bi[e]);
                    const float la = -r * sp[e];
                    const float a = __expf(la);
                    av[e] = a;
                    uv[e] = sqrtf(fmaxf((1.0f - a) * (1.0f + a), 0.f)) * ig * xv[e];
                }
                *(LAS f32x4*)(AA + t * 64 + c0) = av; *(LAS f32x4*)(UU + t * 64 + c0) = uv;
            }
        }
        __syncthreads();
        {
            const int ch = tid & 63, seg = tid >> 6;
            float Pp = 1.f, h = 0.f;
#pragma unroll
            for (int k = 0; k < 16; ++k) { const int o = seg * 16 + k, tt = dir ? 127 - o : o; const float a = AA[tt * 64 + ch], u = UU[tt * 64 + ch]; h = a * h + u; Pp *= a; }
            AGG[(seg * 64 + ch) * 2] = Pp; AGG[(seg * 64 + ch) * 2 + 1] = h;
            __syncthreads();
            float cin = CARRY[(c & 1) * 64 + ch];
            for (int s = 0; s < seg; ++s) cin = AGG[(s * 64 + ch) * 2] * cin + AGG[(s * 64 + ch) * 2 + 1];
            h = cin;
            bf16* yo = yout + (size_t)lrow0 * YLD + 64 * nb + ch;
#pragma unroll
            for (int k = 0; k < 16; ++k) { const int o = seg * 16 + k, tt = dir ? 127 - o : o; const float a = AA[tt * 64 + ch], u = UU[tt * 64 + ch]; h = a * h + u; yo[(size_t)tt * YLD] = f2bf(h); }
            if (seg == 7) CARRY[((c + 1) & 1) * 64 + ch] = next_reset ? 0.f : h;
        }
    }
#undef LRU_LOAD
    __syncthreads();
}

__device__ __forceinline__ void conv_prepass(const bf16* proj, bf16* cxb, const float* cw, const float* cb, int sub, int bx, int G) {
    const int tid = launder_tid();
    for (int id = bx * 512 + tid; id < 96 * (THALF / 32); id += G * 512) {
        const int cgp = id % 96, seg = id / 96, xc = 8 * cgp;
        const int row0 = seg * 32, gv = sub * 5 + (row0 >> 13), seqlen = gv < 8 ? 8192 : 4096, posb = row0 % seqlen;
#pragma unroll 1
        for (int blk = 0; blk < 4; ++blk) {
            const int r0 = row0 + 8 * blk, p0 = posb + 8 * blk;
            u32x4 raw[11];
#pragma unroll
            for (int r = 0; r < 11; ++r) { const int s_ = p0 - 2 + r; raw[r] = (u32x4){0u, 0u, 0u, 0u}; if (s_ >= 0 && s_ < seqlen) raw[r] = *(const u32x4*)(proj + (size_t)(r0 - 2 + r) * PLD + PC_XBC + xc); }
#pragma unroll
            for (int hc = 0; hc < 2; ++hc) {
                const int cl = xc + 4 * hc;
                const f32x4 w0 = *(const f32x4*)(cw + 0 * 768 + cl), w1 = *(const f32x4*)(cw + 1 * 768 + cl), w2 = *(const f32x4*)(cw + 2 * 768 + cl), w3 = *(const f32x4*)(cw + 3 * 768 + cl), bb = *(const f32x4*)(cb + cl);
                f32x4 ring[4] = {bb, bb, bb, bb};
#pragma unroll
                for (int r = 0; r < 11; ++r) {
                    const unsigned xa = raw[r][2 * hc], xb = raw[r][2 * hc + 1];
                    const f32x4 x = (f32x4){bflo(xa), bfhi(xa), bflo(xb), bfhi(xb)};
                    if (r <= 7) ring[r & 3] += w0 * x;
                    if (r >= 1 && r <= 8) ring[(r - 1) & 3] += w1 * x;
                    if (r >= 2 && r <= 9) ring[(r - 2) & 3] += w2 * x;
                    if (r >= 3) {
                        const int od = r - 3;
                        f32x4 t = ring[od & 3] + w3 * x;
                        ring[od & 3] = bb;
#pragma unroll
                        for (int e = 0; e < 4; ++e) t[e] = siluf(t[e]);
                        u32x2 pk; pk.x = pk2(t[0], t[1]); pk.y = pk2(t[2], t[3]);
                        *(u32x2*)(cxb + (size_t)(r0 + od) * 768 + cl) = pk;
                    }
                }
            }
        }
    }
}

constexpr int I_GU = (DM / 64) * (NGU / 32), I_D = (DFF / 64) * (DM / 32), I_IN = (DM / 64) * (NIN / 32), I_OUT = (NMIX / 64) * (DM / 32);
constexpr int I_LAYER = 2 * I_GU + 2 * I_D + I_IN + I_OUT;
__device__ __forceinline__ void convert_item(KArgsPtr KA, unsigned char* ws, int l, int r, int lane, LAS float* scr) {
    if (r < I_GU) { transpose_item(KA->in[3] + (size_t)l * DM * NGU, DM, NGU, NGU, KA->in[2] + l * DM, (bf16*)(ws + WS_WGU1 + l * SZ_WGU), 1, r, lane, scr); return; } r -= I_GU;
    if (r < I_GU) { transpose_item(KA->in[23] + (size_t)l * DM * NGU, DM, NGU, NGU, KA->in[22] + l * DM, (bf16*)(ws + WS_WGU2 + l * SZ_WGU), 1, r, lane, scr); return; } r -= I_GU;
    if (r < I_D) { transpose_item(KA->in[4] + (size_t)l * DFF * DM, DFF, DM, DM, nullptr, (bf16*)(ws + WS_WD1 + l * SZ_WD), 0, r, lane, scr); return; } r -= I_D;
    if (r < I_D) { transpose_item(KA->in[24] + (size_t)l * DFF * DM, DFF, DM, DM, nullptr, (bf16*)(ws + WS_WD2 + l * SZ_WD), 0, r, lane, scr); return; } r -= I_D;
    if (r < I_IN) { transpose_item(KA->in[6] + (size_t)l * DM * W_IN_SRC, DM, W_IN_SRC, NIN, KA->in[5] + l * DM, (bf16*)(ws + WS_WIN + l * SZ_WIN), 2, r, lane, scr); return; } r -= I_IN;
    transpose_item(KA->in[21] + (size_t)l * NMIX * DM, NMIX, DM, DM, nullptr, (bf16*)(ws + WS_WOUT + l * SZ_WOUT), 0, r, lane, scr);
}

#define XB_TMO      128
#define XB_XCNT(j)  (256  + 64 * (j))
#define XB_XSUB(j)  (1280 + 64 * (j))
#define XB_XGEN(j)  (2304 + 64 * (j))
#define XB_TOP      3328
#define XB_TOPGEN   3392
#define XCD_BAR_WORDS 3456
#define XB_SPIN_CAP (1u << 18)

__device__ __forceinline__ unsigned xb_ld(unsigned* p)              { return __hip_atomic_load(p, __ATOMIC_RELAXED, __HIP_MEMORY_SCOPE_AGENT); }
__device__ __forceinline__ unsigned xb_add(unsigned* p, unsigned v) { return __hip_atomic_fetch_add(p, v, __ATOMIC_RELAXED, __HIP_MEMORY_SCOPE_AGENT); }
__device__ __forceinline__ unsigned xb_xcc_id() { return (unsigned)__builtin_amdgcn_s_getreg((3 << 11) | 20) & 0xFu; }
#define XB_SPIN(cond, bar) do { unsigned _sp = 0; while (cond) { __builtin_amdgcn_s_sleep(1); \
    if ((++_sp & 255u) == 0u) { if (xb_ld(&(bar)[XB_TMO])) break; if (_sp > XB_SPIN_CAP) { atomicAdd(&(bar)[XB_TMO], 1u); break; } } } } while (0)

struct XcdBarrier {
    unsigned* bar; unsigned x;
    volatile LAS unsigned* st;
};

__device__ __forceinline__ XcdBarrier xcd_barrier_post(unsigned* bar, volatile LAS unsigned* st) {
    XcdBarrier b; b.bar = bar; b.x = xb_xcc_id(); b.st = st;
    if (threadIdx.x == 0) (void)xb_add(&bar[XB_XCNT(b.x)], 1u);
    return b;
}
__device__ __forceinline__ void xcd_barrier_complete(unsigned* bar, unsigned x, unsigned& nloc, unsigned& nx) {
    const unsigned G = gridDim.x * gridDim.y * gridDim.z;
    unsigned sum, cnt, mine, sp = 0u;
    for (;;) {
        sum = 0u; cnt = 0u; mine = 0u;
#pragma unroll
        for (unsigned j = 0; j < 16; ++j) { const unsigned c = xb_ld(&bar[XB_XCNT(j)]); sum += c; cnt += (c > 0u) ? 1u : 0u; mine = (j == x) ? c : mine; }
        if (sum == G) break;
        __builtin_amdgcn_s_sleep(1);
        if ((++sp & 255u) == 0u) { if (xb_ld(&bar[XB_TMO])) break; if (sp > XB_SPIN_CAP) { atomicAdd(&bar[XB_TMO], 1u); break; } }
    }
    nloc = mine > 0u ? mine : 1u; nx = cnt > 0u ? cnt : 1u;
}

__device__ __forceinline__ void xcd_barrier(const XcdBarrier& b) {
    asm volatile("s_waitcnt vmcnt(0)" ::: "memory");
    __syncthreads();
    if (threadIdx.x == 0) {
        unsigned* bar = b.bar;
        __builtin_amdgcn_s_waitcnt(0);
        unsigned nloc = b.st[0], nx = b.st[1];
        if (nloc == 0u) { xcd_barrier_complete(bar, b.x, nloc, nx); b.st[0] = nloc; b.st[1] = nx; }
        const unsigned old = xb_add(&bar[XB_XSUB(b.x)], 1u);
        const unsigned gen = old / nloc;
        if (old + 1u == (gen + 1u) * nloc) {
            __builtin_amdgcn_fence(__ATOMIC_RELEASE, "agent");
            asm volatile("s_waitcnt vmcnt(0)" ::: "memory");
            const unsigned og = xb_add(&bar[XB_TOP], 1u);
            const unsigned tg = og / nx;
            if (og + 1u == (tg + 1u) * nx) xb_add(&bar[XB_TOPGEN], 1u);
            else XB_SPIN(xb_ld(&bar[XB_TOPGEN]) == tg, bar);
            __builtin_amdgcn_fence(__ATOMIC_ACQUIRE, "agent");
            xb_add(&bar[XB_XGEN(b.x)], 1u);
            asm volatile("s_waitcnt vmcnt(0)" ::: "memory");
        } else {
            XB_SPIN(xb_ld(&bar[XB_XGEN(b.x)]) == gen, bar);
            __builtin_amdgcn_fence(__ATOMIC_ACQUIRE, "agent");
            asm volatile("s_waitcnt vmcnt(0)" ::: "memory");
        }
    }
    __syncthreads();
}


__global__ void __launch_bounds__(512, 2) mega_fwd(Args args) {
    extern __shared__ __attribute__((aligned(16))) unsigned char lds_raw[];
    LAS unsigned char* lds = (LAS unsigned char*)lds_raw;
    cg::grid_group grid = cg::this_grid();
#define CG_SYNC() do { asm volatile("s_waitcnt vmcnt(0) lgkmcnt(0)" ::: "memory"); __syncthreads(); grid.sync(); } while (0)
    volatile LAS unsigned* xb_st = (volatile LAS unsigned*)((LAS unsigned char*)lds_raw + LDS_BYTES - 64);
    if (threadIdx.x == 0) { xb_st[0] = 0u; xb_st[1] = 0u; }
    __syncthreads();
    const XcdBarrier xbar = xcd_barrier_post((unsigned*)(kargs()->ws + WS_BAR), xb_st);
#define GRID_SYNC() xcd_barrier(xbar)
    const int wid = __builtin_amdgcn_readfirstlane(launder_tid() >> 6), G = gridDim.x, bx = blockIdx.x;
    unsigned char* ws; float* X;
    { KArgsPtr KA0 = kargs(); ws = KA0->ws; X = KA0->out; }
    bf16* XB = (bf16*)(ws + WS_XB); float* SSQ = (float*)(ws + WS_SSQ);
    float* RCOS = (float*)(ws + WS_ROPE); float* RSIN = RCOS + 8192 * 64;
    bf16* PROJ = (bf16*)(ws + WS_PROJ); bf16* YF = (bf16*)(ws + WS_Y); bf16* YBK = (bf16*)(ws + WS_YB); bf16* HB = (bf16*)(ws + WS_H);
    const int gw = bx * 8 + wid, NGW = G * 8;

    {
        KArgsPtr KA = kargs();
        const int tid = launder_tid(), lane = tid & 63;
        LAS float* scr = (LAS float*)(lds + wid * 16384);
        for (int it = gw; it < I_LAYER; it += NGW) convert_item(KA, ws, 0, it, lane, scr);
        for (int m = gw; m < TT; m += NGW) {
            const float* src = m < 65536 ? KA->in[0] + (size_t)m * DM : KA->in[1] + (size_t)(m - 65536) * DM;
            float s = 0.f;
#pragma unroll
            for (int j = 0; j < 4; ++j) {
                const f32x4 v = *(const f32x4*)(src + 256 * j + 4 * lane);
                *(f32x4*)(X + (size_t)m * DM + 256 * j + 4 * lane) = v;
                u32x2 w; w.x = pk2(v[0], v[1]); w.y = pk2(v[2], v[3]);
                *(u32x2*)(XB + (size_t)m * DM + 256 * j + 4 * lane) = w;
                s += (v[0] * v[0] + v[1] * v[1]) + (v[2] * v[2] + v[3] * v[3]);
            }
            s = wave_sum(s);
            if (lane < 16) SSQ[(size_t)m * 16 + lane] = lane == 0 ? s : 0.f;
        }
        for (int i = bx * 512 + tid; i < 8192 * 64; i += G * 512) {
            const int pos = i >> 6, f = i & 63;
            const float inv = 1.0f / powf(10000.0f, (float)(2 * f) / 128.0f);
            const float ang = (float)pos * inv;
            RCOS[i] = cosf(ang); RSIN[i] = sinf(ang);
        }
    }
    CG_SYNC();

    for (int l = 0; l < NLAYER; ++l) {
        for (int st = 0; st < 3; ++st) {
            const int nsub = st == 1 ? 2 : 1;
            for (int sub = 0; sub < nsub; ++sub) {
                if (st != 1) {
                    const bf16* Wgu = (const bf16*)(ws + (st == 0 ? WS_WGU1 : WS_WGU2) + l * SZ_WGU);
                    pg8::Gemm g{XB, Wgu, TT, NGU, DM}; pg8::StaticOrder S; S.init(TT, NGU, G, bx);
                    EpiGU E{HB, SSQ};
#ifndef NO_GU
                    pg8::gemm_phase<EpiGU, pg8::StaticOrder, PG8_ALIGN, PG8_SP2>(lds, g, S, E);
#endif
                } else {
                    const bf16* Win = (const bf16*)(ws + WS_WIN + l * SZ_WIN);
                    pg8::Gemm g{XB + (size_t)sub * THALF * DM, Win, THALF, NIN, DM}; pg8::StaticOrder S; S.init(THALF, NIN, G, bx);
                    EpiProj E{PROJ, SSQ, sub * THALF, RCOS, RSIN};
#ifndef NO_PROJ
                    pg8::gemm_phase<EpiProj, pg8::StaticOrder, PG8_ALIGN, PG8_SP2>(lds, g, S, E);
#endif
                }
                GRID_SYNC();
                if (st == 1) {
                    bf16* CXB = (bf16*)(ws + WS_CXB);
                    { KArgsPtr KA = kargs(); conv_prepass(PROJ, CXB, KA->in[14] + (size_t)l * 4 * 768, KA->in[15] + l * 768, sub, bx, G); }
                    GRID_SYNC();
                    if (bx >= 200 && l + 1 < NLAYER) {
                        KArgsPtr KA = kargs();
                        const int tid = launder_tid(), lane = tid & 63, wv = __builtin_amdgcn_readfirstlane(tid >> 6);
                        LAS float* scr = (LAS float*)(lds + wv * 16384);
                        const int lo = sub * (I_LAYER / 2), hi = lo + I_LAYER / 2, nwv = (G - 200) * 8;
                        for (int it = lo + (bx - 200) * 8 + wv; it < hi; it += nwv) convert_item(KA, ws, l + 1, it, lane, scr);
                    }
                    for (int item = bx; item < 200; item += G) {
                        KArgsPtr KA = kargs();
                        if (item < 40) {
                            const int vloc = item >> 3, hd = (item & 7) >> 1, dir = item & 1;
#ifndef NO_RET
                            ret_item(lds, PROJ, dir ? YBK : YF, sub * 5 + vloc, vloc, hd, dir);
#endif
                        } else if (item < 120) {
                            const int q = item - 40, vloc = q >> 4, hh = (q & 15) >> 1, dir = q & 1;
#ifndef NO_SSD
                            ssd_item(lds, PROJ, CXB, dir ? YBK : YF, KA->in[16] + l * 16, KA->in[17] + l * 16, KA->in[18] + l * 8,
                                     sub * 5 + vloc, vloc, hh, dir);
#endif
                        } else {
                            const int q = item - 120, vloc = q >> 4, nb = (q & 15) >> 1, dir = q & 1;
#ifndef NO_LRU
                            lru_item(lds, PROJ, dir ? YBK : YF, KA->in[7] + (size_t)l * 4 * 512, KA->in[8] + l * 512, KA->in[9] + (size_t)l * 2 * 8 * 64 * 64, KA->in[10] + l * 1024,
                                     KA->in[11] + (size_t)l * 2 * 8 * 64 * 64, KA->in[12] + l * 1024, KA->in[13] + l * 1024, sub * 5 + vloc, vloc, nb, dir);
#endif
                        }
                    }
                    GRID_SYNC();
                    {
                        KArgsPtr KA = kargs();
                        const int tid = launder_tid(), lane = tid & 63;
                        const float* ssd_norm = KA->in[19] + l * 512; const float* ret_norm = KA->in[20] + l * 512;
                        const f32x8 nw_s = ld8f(ssd_norm + 8 * lane), nw_r = ld8f(ret_norm + 8 * lane);
                        for (int row = gw; row < THALF; row += NGW) {
                            bf16* yr = YF + (size_t)row * YLD; const bf16* yb = YBK + (size_t)row * YLD; const bf16* pr = PROJ + (size_t)row * PLD;
                            {
                                const f32x8 a = unpack8(*(const u32x4*)(yr + 8 * lane)), b = unpack8(*(const u32x4*)(yb + 8 * lane)), gt = unpack8(*(const u32x4*)(pr + PC_GATE + 8 * lane));
                                f32x8 o;
#pragma unroll
                                for (int e = 0; e < 8; ++e) o[e] = (a[e] + b[e]) * gelu_tanh(gt[e]);
                                *(u32x4*)(yr + 8 * lane) = pack8(o);
                            }
                            {
                                const f32x8 a = unpack8(*(const u32x4*)(yr + 512 + 8 * lane)), b = unpack8(*(const u32x4*)(yb + 512 + 8 * lane)), z = unpack8(*(const u32x4*)(pr + PC_Z + 8 * lane));
                                f32x8 v; float ss = 0.f;
#pragma unroll
                                for (int e = 0; e < 8; ++e) { v[e] = (a[e] + b[e]) * siluf(z[e]); ss += v[e] * v[e]; }
                                ss = wave_sum(ss);
                                const float rs = rsqrtf(ss * (1.0f / 512.0f) + EPSN);
                                *(u32x4*)(yr + 512 + 8 * lane) = pack8(v * rs * nw_s);
                            }
                            {
                                const f32x8 a = unpack8(*(const u32x4*)(yr + 1024 + 8 * lane)), b = unpack8(*(const u32x4*)(yb + 1024 + 8 * lane)), gg = unpack8(*(const u32x4*)(pr + PC_G + 8 * lane));
                                f32x8 v = a + b; float s1 = 0.f;
#pragma unroll
                                for (int e = 0; e < 8; ++e) s1 += v[e];
                                s1 += __shfl_xor(s1, 1); s1 += __shfl_xor(s1, 2); s1 += __shfl_xor(s1, 4); s1 += __shfl_xor(s1, 8);
                                const float mu = s1 * (1.0f / 128.0f); float s2 = 0.f;
#pragma unroll
                                for (int e = 0; e < 8; ++e) { v[e] -= mu; s2 += v[e] * v[e]; }
                                s2 += __shfl_xor(s2, 1); s2 += __shfl_xor(s2, 2); s2 += __shfl_xor(s2, 4); s2 += __shfl_xor(s2, 8);
                                const float rs = rsqrtf(s2 * (1.0f / 128.0f) + EPSN);
                                f32x8 o;
#pragma unroll
                                for (int e = 0; e < 8; ++e) o[e] = v[e] * rs * nw_r[e] * siluf(gg[e]);
                                *(u32x4*)(yr + 1024 + 8 * lane) = pack8(o);
                            }
                        }
                    }
                    GRID_SYNC();
                }
                {
                    pg8::Gemm g; float coef; int roff;
                    if (st != 1) { g = pg8::Gemm{HB, (const bf16*)(ws + (st == 0 ? WS_WD1 : WS_WD2) + l * SZ_WD), TT, DM, DFF}; coef = 0.5f; roff = 0; }
                    else { g = pg8::Gemm{YF, (const bf16*)(ws + WS_WOUT + l * SZ_WOUT), THALF, DM, NMIX}; coef = 1.0f; roff = sub * THALF; }
                    pg8::StaticOrder S; S.init(g.M, g.N, G, bx);
                    EpiRes E{X, XB, SSQ, coef, roff};
#ifndef NO_RES
                    pg8::gemm_phase<EpiRes, pg8::StaticOrder, PG8_ALIGN, PG8_SP2>(lds, g, S, E);
#endif
                }
                GRID_SYNC();
            }
        }
    }
    {
        KArgsPtr KA = kargs();
        const int tid = launder_tid(), lane = tid & 63;
        const float* fw = KA->in[25];
        for (int m = gw; m < TT; m += NGW) {
            const float rs = row_rs(SSQ, (size_t)m);
#pragma unroll
            for (int j = 0; j < 4; ++j) {
                float* p = X + (size_t)m * DM + 256 * j + 4 * lane;
                const f32x4 v = *(const f32x4*)p, w = *(const f32x4*)(fw + 256 * j + 4 * lane);
                *(f32x4*)p = v * rs * w;
            }
        }
    }
}

extern "C" void kernel_launch(void* const* d_in, const int* in_sizes, int n_in, void* d_out, int out_size, void* d_ws, size_t ws_size, hipStream_t stream) {
    static int grid = 0;
    if (grid == 0) {
        if (n_in != 26 || out_size != TT * DM || ws_size < WS_NEED) { fprintf(stderr, "kernel_launch: unexpected problem (n_in %d, out %d, ws %zu, need %zu)\n", n_in, out_size, ws_size, (size_t)WS_NEED); grid = -1; return; }
        int dev = 0, cus = 0, per_cu = 0;
        if (hipGetDevice(&dev) != hipSuccess || hipDeviceGetAttribute(&cus, hipDeviceAttributeMultiprocessorCount, dev) != hipSuccess) { grid = -1; return; }
        if (hipFuncSetAttribute((const void*)mega_fwd, hipFuncAttributeMaxDynamicSharedMemorySize, LDS_BYTES) != hipSuccess) { fprintf(stderr, "kernel_launch: hipFuncSetAttribute failed\n"); grid = -1; return; }
        if (hipOccupancyMaxActiveBlocksPerMultiprocessor(&per_cu, (const void*)mega_fwd, 512, LDS_BYTES) != hipSuccess || per_cu < 1) { fprintf(stderr, "kernel_launch: occupancy query says %d\n", per_cu); per_cu = 1; }
        (void)hipGetLastError();
        grid = cus;
    }
    if (grid < 0) return;
    Args a{};
    for (int i = 0; i < 26; ++i) a.in[i] = (const float*)d_in[i];
    a.out = (float*)d_out; a.ws = (unsigned char*)d_ws;
    if (hipMemsetAsync((unsigned char*)d_ws + WS_BAR, 0, 16384, stream) != hipSuccess) { fprintf(stderr, "kernel_launch: hipMemsetAsync of the barrier words failed\n"); return; }
    void* kargs[] = {&a};
    hipError_t e = hipLaunchCooperativeKernel((const void*)mega_fwd, dim3(grid), dim3(512), kargs, LDS_BYTES, stream);
    if (e != hipSuccess) fprintf(stderr, "kernel_launch: cooperative launch failed: %s (grid %d)\n", hipGetErrorString(e), grid);
}
```
